# Optimizing an MI355X kernel written in HIP

```python
import jax, jax.numpy as jnp
from jax import lax
import numpy as np

D_MODEL = 1024
BATCH = 2
SEQ = 16384
DEPTH = 2
DEC_BATCH = 4
DEC_SEQ = 4096
PAST_LEN = 128

GRID_W = 64
N_MEM = 256
EPS = 1e-6
CONV_W = 1024
CONV_K = 3
NA_HEADS = 16
NA_HEAD_DIM = 64
NA_W = NA_HEADS * NA_HEAD_DIM
NA_WIN_ROWS = 8
NA_WIN_COLS = 16
LRU_W = 1024
LRU_BLOCKS = 8
LRU_BW = LRU_W // LRU_BLOCKS
LRU_CONV_K = 4
LRU_C = 8.0
SGU_W = 1024
SGU_GROUPS = 8
SGU_GD = SGU_W // SGU_GROUPS
SGU_CHUNK = 128
MEM_HEADS = 4
MEM_HEAD_DIM = 128
MEM_W = MEM_HEADS * MEM_HEAD_DIM
N_EVEN = (DEPTH + 1) // 2
N_ODD = DEPTH // 2
EVEN_SIZES = (CONV_W, CONV_W, CONV_W, CONV_W, NA_W, NA_W, NA_W, NA_W, MEM_W, MEM_W)
ODD_SIZES = (LRU_W, LRU_W, SGU_W, SGU_W, SGU_W, MEM_W, MEM_W)
EVEN_IN = sum(EVEN_SIZES)
ODD_IN = sum(ODD_SIZES)
EVEN_OUT = CONV_W + NA_W + MEM_W
ODD_OUT = LRU_W + SGU_W + MEM_W

kernel_name = "hybrid_bidir_conv_na_rglru_sgu_encoder"


def rmsnorm(x, g):
    xf = x.astype(jnp.float32)
    y = xf * lax.rsqrt(jnp.mean(xf * xf, axis=-1, keepdims=True) + EPS)
    return (y * g.astype(jnp.float32)).astype(x.dtype)


def split_cols(z, sizes):
    idx = [int(s) for s in np.cumsum(sizes)[:-1]]
    return jnp.split(z, idx, axis=-1)


def depthwise_conv(x, w, b, pad_left):
    K = w.shape[0]
    T = x.shape[1]
    xp = jnp.pad(x, ((0, 0), (pad_left, K - 1 - pad_left), (0, 0)))
    y = b
    for j in range(K):
        y = y + w[j] * xp[:, j:j + T]
    return y


def neighbourhood_attention(q, k, v, rpb):
    Bsz, T, H, Dh = q.shape
    rows = T // GRID_W
    wr = min(NA_WIN_ROWS, rows)
    qg = q.reshape(Bsz, rows, GRID_W, H, Dh) * (Dh ** -0.5)
    kg = k.reshape(Bsz, rows, GRID_W, H, Dh)
    vg = v.reshape(Bsz, rows, GRID_W, H, Dh)
    col = jnp.arange(GRID_W)
    cstart = jnp.clip(col - NA_WIN_COLS // 2, 0, GRID_W - NA_WIN_COLS)
    col_ok = (col[None, :] >= cstart[:, None]) & (col[None, :] < cstart[:, None] + NA_WIN_COLS)
    dc_idx = jnp.clip(col[None, :] - col[:, None], -(NA_WIN_COLS - 1), NA_WIN_COLS - 1) + NA_WIN_COLS - 1
    rpb32 = rpb.astype(jnp.float32)

    def row_block(r):
        rstart = jnp.clip(r - wr // 2, 0, rows - wr)
        k_blk = lax.dynamic_slice_in_dim(kg, rstart, wr, axis=1)
        v_blk = lax.dynamic_slice_in_dim(vg, rstart, wr, axis=1)
        q_r = lax.dynamic_index_in_dim(qg, r, axis=1, keepdims=False)
        s = jnp.einsum('bchd,bwkhd->bhcwk', q_r, k_blk).astype(jnp.float32)
        dr_idx = rstart + jnp.arange(wr) - r + NA_WIN_ROWS - 1
        bias = rpb32[:, dr_idx[None, :, None], dc_idx[:, None, :]]
        s = jnp.where(col_ok[None, None, :, None, :], s + bias[None], -jnp.inf)
        p = jax.nn.softmax(s, axis=(-2, -1)).astype(v.dtype)
        return jnp.einsum('bhcwk,bwkhd->bchd', p, v_blk)

    out = lax.map(row_block, jnp.arange(rows))
    return jnp.moveaxis(out, 0, 1).reshape(Bsz, T, H * Dh)


def memory_attention(q, mem_k, mem_v):
    Bsz, T = q.shape[:2]
    s = jnp.einsum('bthd,bmhd->bhtm', q, mem_k).astype(jnp.float32) * (MEM_HEAD_DIM ** -0.5)
    p = jax.nn.softmax(s, axis=-1).astype(q.dtype)
    return jnp.einsum('bhtm,bmhd->bthd', p, mem_v).reshape(Bsz, T, MEM_W)


def lru_combine(c1, c2):
    a1, b1 = c1
    a2, b2 = c2
    return a1 * a2, a2 * b1 + b2


def rglru_direction(xc, wa, ba, wi, bi, lam, reverse):
    Bsz, T, _ = xc.shape
    xb = xc.reshape(Bsz, T, LRU_BLOCKS, LRU_BW)
    r = jax.nn.sigmoid(jnp.einsum('btni,nij->btnj', xb, wa.astype(jnp.float32)).reshape(Bsz, T, LRU_W) + ba.astype(jnp.float32))
    i = jax.nn.sigmoid(jnp.einsum('btni,nij->btnj', xb, wi.astype(jnp.float32)).reshape(Bsz, T, LRU_W) + bi.astype(jnp.float32))
    log_a = -LRU_C * r * jax.nn.softplus(-lam.astype(jnp.float32))
    a = jnp.exp(log_a)
    b = jnp.sqrt(-jnp.expm1(2.0 * log_a)) * (i * xc)
    _, h = lax.associative_scan(lru_combine, (a, b), axis=1, reverse=reverse)
    return h


def spatial_gating(u, v, g, ws, bs):
    Bsz, T, _ = v.shape
    vn = rmsnorm(v, g).reshape(Bsz, T // SGU_CHUNK, SGU_CHUNK, SGU_GROUPS, SGU_GD)
    mixed = jnp.einsum('gpq,bnqgd->bnpgd', ws, vn) + bs.T[None, None, :, :, None]
    return u * mixed.reshape(Bsz, T, SGU_W)


def even_mixer(h, mem_k, mem_v, w_in, conv_w, conv_b, rpb, w_out):
    Bsz, T, _ = h.shape
    bg, cg, xv, ga, q, k, v, gb, qm, gm = split_cols(h @ w_in, EVEN_SIZES)
    ya = bg * depthwise_conv(cg * xv, conv_w, conv_b, CONV_K // 2) * jax.nn.silu(ga)
    hs = (Bsz, T, NA_HEADS, NA_HEAD_DIM)
    yb = neighbourhood_attention(q.reshape(hs), k.reshape(hs), v.reshape(hs), rpb) * jax.nn.silu(gb)
    ym = memory_attention(qm.reshape(Bsz, T, MEM_HEADS, MEM_HEAD_DIM), mem_k, mem_v) * jax.nn.silu(gm)
    return jnp.concatenate([ya, yb, ym], axis=-1) @ w_out


def odd_mixer(h, mem_k, mem_v, w_in, conv_w, conv_b, lru_wa, lru_ba, lru_wi, lru_bi, lru_lam,
              sgu_g, sgu_w, sgu_b, w_out):
    Bsz, T, _ = h.shape
    xr, gc, u, v, gd, qm, gm = split_cols(h @ w_in, ODD_SIZES)
    xc = depthwise_conv(xr, conv_w, conv_b, LRU_CONV_K // 2).astype(jnp.float32)
    hc = (rglru_direction(xc, lru_wa[0], lru_ba[0], lru_wi[0], lru_bi[0], lru_lam[0], False)
          + rglru_direction(xc, lru_wa[1], lru_ba[1], lru_wi[1], lru_bi[1], lru_lam[1], True))
    yc = hc.astype(h.dtype) * jax.nn.silu(gc)
    yd = spatial_gating(u, v, sgu_g, sgu_w, sgu_b) * jax.nn.silu(gd)
    ym = memory_attention(qm.reshape(Bsz, T, MEM_HEADS, MEM_HEAD_DIM), mem_k, mem_v) * jax.nn.silu(gm)
    return jnp.concatenate([yc, yd, ym], axis=-1) @ w_out


def trunk(x, mem, norm_g, mem_norm_g, w_mem_kv, ev_w_in, ev_conv_w, ev_conv_b, ev_rpb, ev_w_out,
          od_w_in, od_conv_w, od_conv_b, od_lru_wa, od_lru_ba, od_lru_wi, od_lru_bi, od_lru_lam,
          od_sgu_g, od_sgu_w, od_sgu_b, od_w_out, final_g):
    Bsz, n_mem, _ = mem.shape
    for layer in range(DEPTH):
        mk, mv = split_cols(rmsnorm(mem, mem_norm_g[layer]) @ w_mem_kv[layer], (MEM_W, MEM_W))
        mk = mk.reshape(Bsz, n_mem, MEM_HEADS, MEM_HEAD_DIM)
        mv = mv.reshape(Bsz, n_mem, MEM_HEADS, MEM_HEAD_DIM)
        h = rmsnorm(x, norm_g[layer])
        if layer % 2 == 0:
            e = layer // 2
            x = x + even_mixer(h, mk, mv, ev_w_in[e], ev_conv_w[e], ev_conv_b[e], ev_rpb[e], ev_w_out[e])
        else:
            o = layer // 2
            x = x + odd_mixer(h, mk, mv, od_w_in[o], od_conv_w[o], od_conv_b[o], od_lru_wa[o], od_lru_ba[o],
                              od_lru_wi[o], od_lru_bi[o], od_lru_lam[o], od_sgu_g[o], od_sgu_w[o], od_sgu_b[o],
                              od_w_out[o])
    return rmsnorm(x, final_g)


def setup_inputs(seed: int = 0) -> dict:
    key = jax.random.key(seed)
    ks = jax.random.split(key, 32)
    f32 = jnp.float32

    def nrm(k, shape, scale):
        return jax.random.normal(k, shape, f32) * scale

    a0 = jax.random.uniform(ks[20], (N_ODD, 2, LRU_W), f32, minval=0.9, maxval=0.999)
    return {
        "x_prompt": nrm(ks[0], (BATCH, SEQ, D_MODEL), 1.0),
        "x_sample": nrm(ks[1], (DEC_BATCH, DEC_SEQ, D_MODEL), 1.0),
        "mem_prompt": nrm(ks[2], (BATCH, N_MEM, D_MODEL), 1.0),
        "mem_sample": nrm(ks[3], (DEC_BATCH, N_MEM, D_MODEL), 1.0),
        "norm_g": 1.0 + nrm(ks[4], (DEPTH, D_MODEL), 0.01),
        "mem_norm_g": 1.0 + nrm(ks[5], (DEPTH, D_MODEL), 0.01),
        "w_mem_kv": nrm(ks[6], (DEPTH, D_MODEL, 2 * MEM_W), D_MODEL ** -0.5),
        "ev_w_in": nrm(ks[7], (N_EVEN, D_MODEL, EVEN_IN), D_MODEL ** -0.5),
        "ev_conv_w": nrm(ks[8], (N_EVEN, CONV_K, CONV_W), CONV_K ** -0.5),
        "ev_conv_b": nrm(ks[9], (N_EVEN, CONV_W), 0.01),
        "ev_rpb": nrm(ks[10], (N_EVEN, NA_HEADS, 2 * NA_WIN_ROWS - 1, 2 * NA_WIN_COLS - 1), 0.1),
        "ev_w_out": nrm(ks[11], (N_EVEN, EVEN_OUT, D_MODEL), EVEN_OUT ** -0.5),
        "od_w_in": nrm(ks[12], (N_ODD, D_MODEL, ODD_IN), D_MODEL ** -0.5),
        "od_conv_w": nrm(ks[13], (N_ODD, LRU_CONV_K, LRU_W), LRU_CONV_K ** -0.5),
        "od_conv_b": nrm(ks[14], (N_ODD, LRU_W), 0.01),
        "od_lru_wa": nrm(ks[15], (N_ODD, 2, LRU_BLOCKS, LRU_BW, LRU_BW), LRU_BW ** -0.5),
        "od_lru_ba": nrm(ks[16], (N_ODD, 2, LRU_W), 0.1),
        "od_lru_wi": nrm(ks[17], (N_ODD, 2, LRU_BLOCKS, LRU_BW, LRU_BW), LRU_BW ** -0.5),
        "od_lru_bi": nrm(ks[18], (N_ODD, 2, LRU_W), 0.1),
        "od_lru_lam": jnp.log(a0) - jnp.log1p(-a0),
        "od_sgu_g": 1.0 + nrm(ks[21], (N_ODD, SGU_W), 0.01),
        "od_sgu_w": nrm(ks[22], (N_ODD, SGU_GROUPS, SGU_CHUNK, SGU_CHUNK), SGU_CHUNK ** -0.5),
        "od_sgu_b": 1.0 + nrm(ks[23], (N_ODD, SGU_GROUPS, SGU_CHUNK), 0.01),
        "od_w_out": nrm(ks[24], (N_ODD, ODD_OUT, D_MODEL), ODD_OUT ** -0.5),
        "final_g": 1.0 + nrm(ks[25], (D_MODEL,), 0.01),
    }


def reference(x_prompt, x_sample, mem_prompt, mem_sample, norm_g, mem_norm_g, w_mem_kv, ev_w_in, ev_conv_w,
              ev_conv_b, ev_rpb, ev_w_out, od_w_in, od_conv_w, od_conv_b, od_lru_wa, od_lru_ba, od_lru_wi,
              od_lru_bi, od_lru_lam, od_sgu_g, od_sgu_w, od_sgu_b, od_w_out, final_g):
    y_prompt = trunk(x_prompt, mem_prompt, norm_g, mem_norm_g, w_mem_kv, ev_w_in, ev_conv_w, ev_conv_b, ev_rpb,
                     ev_w_out, od_w_in, od_conv_w, od_conv_b, od_lru_wa, od_lru_ba, od_lru_wi, od_lru_bi,
                     od_lru_lam, od_sgu_g, od_sgu_w, od_sgu_b, od_w_out, final_g)
    y_sample = trunk(x_sample, mem_sample, norm_g, mem_norm_g, w_mem_kv, ev_w_in, ev_conv_w, ev_conv_b, ev_rpb,
                     ev_w_out, od_w_in, od_conv_w, od_conv_b, od_lru_wa, od_lru_ba, od_lru_wi, od_lru_bi,
                     od_lru_lam, od_sgu_g, od_sgu_w, od_sgu_b, od_w_out, final_g)
    return (y_prompt, y_sample)
```

```cpp
#include <hip/hip_runtime.h>
#include <hip/hip_cooperative_groups.h>
#include <cstdio>
namespace cg = cooperative_groups;
namespace pg8 {
#define PG8_LAS __attribute__((address_space(3)))
typedef unsigned short bf16_t;
typedef short bf16x8 __attribute__((ext_vector_type(8)));
typedef float f32x4 __attribute__((ext_vector_type(4)));
typedef unsigned u32x4 __attribute__((ext_vector_type(4)));
constexpr int BM = 256, BK = 64, HALF = 128, HTB = HALF * BK * 2  , STAGE_BYTES = 8 * HTB, NXCD = 8, WGM = 8;

__host__ __device__ __forceinline__ int lds_byte(int r, int c) { const int st = (r >> 4) * 2 + (c >> 5), rr = r & 15, cc = c & 31, ob = rr * 64 + cc * 2; return st * 1024 + (ob ^ (((ob >> 9) & 1) << 5)); }
__host__ __device__ __forceinline__ void stage_rc(int b, int& R, int& C) { const int st = b / 1024, sb = b % 1024, swz = sb ^ (((sb >> 9) & 1) << 5); R = (st >> 1) * 16 + swz / 64; C = (st & 1) * 32 + (swz % 64) / 2; }
__host__ __device__ __forceinline__ int perm32(int rho) { const int n = rho >> 4, i = rho & 15; return 8 * (i >> 2) + 4 * n + (i & 3); }

struct Unit { int pm, pn; };
struct Gemm { const bf16_t* A; const bf16_t* Bt; int M, N, K; };

struct StaticOrder {
    int nM, nN, nwg, G, c;
    __host__ __device__ void init(int M, int N, int G_, int c_) { nM = M / BM; nN = N / BM; nwg = nM * nN; G = G_; c = c_; }
    __host__ __device__ bool next(int i, Unit& u) const {
        const long L = (long)i * G + c; if (L >= nwg) return false;
        int wgid = (int)L; { const int q = nwg / NXCD, r = nwg % NXCD, xcd = wgid % NXCD, off = wgid / NXCD; wgid = (xcd < r ? xcd * (q + 1) : r * (q + 1) + (xcd - r) * q) + off; }
        const int nig = WGM * nN, gid = wgid / nig, fm = gid * WGM, gsz = (nM - fm) < WGM ? (nM - fm) : WGM;
        u.pm = fm + ((wgid % nig) % gsz); u.pn = (wgid % nig) / gsz; return true;
    }
    __device__ __forceinline__ void a_ready(const Unit&) const {}
    __device__ __forceinline__ void done(const Unit&) const {}
};

struct SkipOrder : StaticOrder {
    int skip_from, skip_n;
    __device__ __forceinline__ bool next(int i, Unit& u) const {
        if (!StaticOrder::next(i, u)) return false;
        if (u.pn >= skip_from) u.pn += skip_n;
        return true;
    }
};

__device__ __forceinline__ unsigned cvt_pk_bf16(float lo, float hi) { unsigned r; asm volatile("v_cvt_pk_bf16_f32 %0, %1, %2" : "=v"(r) : "v"(lo), "v"(hi)); return r; }

struct EpiZ {
    static constexpr bool PERM = true, AFTER_DRAIN = false;
    bf16_t* O; int ldc; int skip_from, skip_n;
    __device__ __forceinline__ void operator()(const f32x4 (&acc)[2][2][4][2], const Unit& u, int wr, int wc, int fr, int fq) const {
        const int row0 = u.pm * BM + wr * 64 + fr; const int ct = (u.pn >= skip_from + skip_n) ? (u.pn - skip_n) : u.pn;
        const int col0 = ct * BM + wc * 32 + 8 * fq;
#pragma unroll
        for (int ai = 0; ai < 2; ++ai)
#pragma unroll
            for (int m = 0; m < 4; ++m) { bf16_t* rowp = O + (size_t)(row0 + ai * HALF + m * 16) * ldc + col0;
#pragma unroll
                for (int bj = 0; bj < 2; ++bj) { const f32x4 v0 = acc[ai][bj][m][0], v1 = acc[ai][bj][m][1];
                    u32x4 w; w.x = cvt_pk_bf16(v0[0], v0[1]); w.y = cvt_pk_bf16(v0[2], v0[3]); w.z = cvt_pk_bf16(v1[0], v1[1]); w.w = cvt_pk_bf16(v1[2], v1[3]);
                    *(u32x4*)(rowp + bj * HALF) = w; } }
    }
};
struct EpiRes {
    static constexpr bool PERM = false, AFTER_DRAIN = false;
    const float* xin; float* out;
    __device__ __forceinline__ void operator()(const f32x4 (&acc)[2][2][4][2], const Unit& u, int wr, int wc, int fr, int fq) const {
        const int row0 = u.pm * BM + wr * 64 + fr, col0 = u.pn * BM + wc * 32 + 4 * fq;
#pragma unroll
        for (int ai = 0; ai < 2; ++ai)
#pragma unroll
            for (int m = 0; m < 4; ++m) { const size_t ro = (size_t)(row0 + ai * HALF + m * 16) * 1024 + col0;
#pragma unroll
                for (int bj = 0; bj < 2; ++bj)
#pragma unroll
                    for (int n = 0; n < 2; ++n) { const f32x4 xv = *(const f32x4*)(xin + ro + bj * HALF + n * 16);
                        *(f32x4*)(out + ro + bj * HALF + n * 16) = acc[ai][bj][m][n] + xv; } }
    }
};

template <class Epi, class Sched>
__device__ __forceinline__ void gemm_phase(PG8_LAS unsigned char* lds, const Gemm g, const Sched& S, const Epi& E) {
    int tid = threadIdx.x; asm volatile("" : "+v"(tid));
    const int wid = __builtin_amdgcn_readfirstlane(tid >> 6), lane = tid & 63, wr = wid >> 2, wc = wid & 3, fr = lane & 15, fq = lane >> 4;
    const int K = g.K, nt = K / BK;
    const char* gA = (const char*)g.A; const char* gB = (const char*)g.Bt; asm volatile("" : "+s"(gA), "+s"(gB));
    unsigned voffA[2], voffB[2];
#pragma unroll
    for (int i = 0; i < 2; ++i) { int R, C; stage_rc(tid * 16 + i * 8192, R, C); const int Rb = Epi::PERM ? ((R & ~31) + perm32(R & 31)) : R;
        voffA[i] = (unsigned)(R * K + C) * 2u; voffB[i] = (unsigned)(Rb * K + C) * 2u; }
    const size_t kstep = (size_t)(BK * 2);
    const size_t hstep = (size_t)HALF * K * 2;
    const size_t tstep = 2 * hstep;
    const unsigned ldsw = (unsigned)wid * 1024u;
    const int aoff = lds_byte(wr * 64 + fr, fq * 8), boff = lds_byte(wc * 32 + fr, fq * 8);
#define PG8_SA(b, h) (((b) * 2 + (h)) * HTB)
#define PG8_SB(b, h) ((4 + (b) * 2 + (h)) * HTB)
#define PG8_STAGE(bufoff, gbase, voff) do { _Pragma("unroll") for (int _i = 0; _i < 2; ++_i) \
        __builtin_amdgcn_global_load_lds((const unsigned*)((const char*)(gbase) + (voff)[_i]), (PG8_LAS unsigned*)(lds + (bufoff) + ldsw + _i * 8192), 16, 0, 0); } while (0)
#define PG8_LDA(dst, b, h) do { _Pragma("unroll") for (int m = 0; m < 4; ++m) _Pragma("unroll") for (int k = 0; k < 2; ++k) dst[m][k] = *(const PG8_LAS bf16x8*)(lds + PG8_SA(b, h) + aoff + m * 2048 + k * 1024); } while (0)
#define PG8_LDB(dst, b, h) do { _Pragma("unroll") for (int n = 0; n < 2; ++n) _Pragma("unroll") for (int k = 0; k < 2; ++k) dst[n][k] = *(const PG8_LAS bf16x8*)(lds + PG8_SB(b, h) + boff + n * 2048 + k * 1024); } while (0)
#define PG8_MMA(ai, bj, At, Bt) do { __builtin_amdgcn_s_setprio(1); _Pragma("unroll") for (int m = 0; m < 4; ++m) _Pragma("unroll") for (int n = 0; n < 2; ++n) _Pragma("unroll") for (int k = 0; k < 2; ++k) \
        acc[ai][bj][m][n] = __builtin_amdgcn_mfma_f32_16x16x32_bf16(Bt[n][k], At[m][k], acc[ai][bj][m][n], 0, 0, 0); __builtin_amdgcn_s_setprio(0); } while (0)
#define PG8_WAIT_V(n) asm volatile("s_waitcnt vmcnt(" #n ")" ::: "memory")
#define PG8_WAIT_L(n) asm volatile("s_waitcnt lgkmcnt(" #n ")" ::: "memory")
#define PG8_BAR __builtin_amdgcn_s_barrier()
#define PG8_SCHED __builtin_amdgcn_sched_barrier(0)
    Unit cur, nxt; int ui = 0;
    if (!S.next(0, cur)) return;
    f32x4 acc[2][2][4][2];
#pragma unroll
    for (int a = 0; a < 2; ++a)
#pragma unroll
        for (int b = 0; b < 2; ++b)
#pragma unroll
            for (int m = 0; m < 4; ++m)
#pragma unroll
                for (int n = 0; n < 2; ++n) acc[a][b][m][n] = (f32x4){0.f, 0.f, 0.f, 0.f};
    bf16x8 At[4][2], B0[2][2], B1[2][2];
    const char* cA = gA + (size_t)cur.pm * tstep; const char* cB = gB + (size_t)cur.pn * tstep;
    S.a_ready(cur);
    PG8_STAGE(PG8_SB(0, 0), cB, voffB); PG8_STAGE(PG8_SA(0, 0), cA, voffA); PG8_STAGE(PG8_SB(0, 1), cB + hstep, voffB); PG8_STAGE(PG8_SA(0, 1), cA + hstep, voffA);
    if (wr == 1) PG8_BAR;
    PG8_WAIT_V(4); PG8_BAR;
    PG8_STAGE(PG8_SB(1, 0), cB + kstep, voffB); PG8_STAGE(PG8_SA(1, 0), cA + kstep, voffA); PG8_STAGE(PG8_SB(1, 1), cB + hstep + kstep, voffB);
    PG8_WAIT_V(6); PG8_BAR;
    for (;;) {
        const bool has_next = S.next(ui + 1, nxt);
        const char* nA = has_next ? gA + (size_t)nxt.pm * tstep : cA; const char* nB = has_next ? gB + (size_t)nxt.pn * tstep : cB;
        for (int t = 0; t < nt; t += 2) {
            const bool last = (t == nt - 2);
            const char* a1 = cA + (size_t)(t + 1) * kstep;
            const char* a2 = last ? nA : cA + (size_t)(t + 2) * kstep; const char* b2 = last ? nB : cB + (size_t)(t + 2) * kstep;
            const char* a3 = a2 + kstep; const char* b3 = b2 + kstep;
            if (last && has_next) S.a_ready(nxt);
            PG8_LDB(B0, 0, 0); PG8_SCHED; PG8_LDA(At, 0, 0); PG8_STAGE(PG8_SA(1, 1), a1 + hstep, voffA);
            PG8_WAIT_L(8); PG8_BAR; PG8_WAIT_L(0); PG8_MMA(0, 0, At, B0); PG8_BAR; PG8_SCHED;
            PG8_LDB(B1, 0, 1); PG8_STAGE(PG8_SB(0, 0), b2, voffB);
            PG8_BAR; PG8_WAIT_L(0); PG8_MMA(0, 1, At, B1); PG8_BAR;
            PG8_LDA(At, 0, 1); PG8_STAGE(PG8_SA(0, 0), a2, voffA);
            PG8_BAR; PG8_WAIT_L(0); PG8_MMA(1, 0, At, B0); PG8_BAR; PG8_SCHED;
            PG8_STAGE(PG8_SB(0, 1), b2 + hstep, voffB);
            PG8_WAIT_V(6); PG8_BAR; PG8_MMA(1, 1, At, B1); PG8_BAR;
            PG8_LDB(B0, 1, 0); PG8_SCHED; PG8_LDA(At, 1, 0); PG8_STAGE(PG8_SA(0, 1), a2 + hstep, voffA);
            PG8_WAIT_L(8); PG8_BAR; PG8_WAIT_L(0); PG8_MMA(0, 0, At, B0); PG8_BAR; PG8_SCHED;
            PG8_LDB(B1, 1, 1); PG8_STAGE(PG8_SB(1, 0), b3, voffB);
            PG8_BAR; PG8_WAIT_L(0); PG8_MMA(0, 1, At, B1); PG8_BAR;
            PG8_LDA(At, 1, 1); PG8_STAGE(PG8_SA(1, 0), a3, voffA);
            PG8_BAR; PG8_WAIT_L(0); PG8_MMA(1, 0, At, B0); PG8_BAR; PG8_SCHED;
            PG8_STAGE(PG8_SB(1, 1), b3 + hstep, voffB);
            PG8_WAIT_V(6); PG8_BAR; PG8_MMA(1, 1, At, B1); PG8_BAR;
        }
        if constexpr (!Epi::AFTER_DRAIN) { E(acc, cur, wr, wc, fr, fq); S.done(cur); }
        if (!has_next) break;
#pragma unroll
        for (int a = 0; a < 2; ++a)
#pragma unroll
            for (int b = 0; b < 2; ++b)
#pragma unroll
                for (int m = 0; m < 4; ++m)
#pragma unroll
                    for (int n = 0; n < 2; ++n) acc[a][b][m][n] = (f32x4){0.f, 0.f, 0.f, 0.f};
        cur = nxt; cA = nA; cB = nB; ++ui;
    }
    PG8_WAIT_V(0);
    if (wr == 0) PG8_BAR;
    PG8_BAR;
    if constexpr (Epi::AFTER_DRAIN) { E.fused(acc, cur, wr, wc, fr, fq, lds, wid, lane); S.done(cur); }
#undef PG8_SA
#undef PG8_SB
#undef PG8_STAGE
#undef PG8_LDA
#undef PG8_LDB
#undef PG8_MMA
#undef PG8_WAIT_V
#undef PG8_WAIT_L
#undef PG8_BAR
#undef PG8_SCHED
}
}

using pg8::bf16_t; using pg8::bf16x8; using pg8::f32x4;
typedef unsigned u32x2_t __attribute__((ext_vector_type(2)));
typedef unsigned u32x4_t __attribute__((ext_vector_type(4)));

constexpr int DM = 1024, SEG = 16384, LDZ = 8192, LDY = 2560;
constexpr float EPS = 1e-6f;
constexpr int LDS_BYTES = 131072;
constexpr size_t WS_WIN_E = 0;
constexpr size_t WS_WIN_O = WS_WIN_E + (size_t)9216 * 1024 * 2;
constexpr size_t WS_WOUT_E = WS_WIN_O + (size_t)6144 * 1024 * 2;
constexpr size_t WS_WOUT_O = WS_WOUT_E + (size_t)1024 * 2560 * 2;
constexpr size_t WS_WKV = WS_WOUT_O + (size_t)1024 * 2560 * 2;
constexpr size_t WS_LRUW = WS_WKV + (size_t)2 * 1024 * 1024 * 2;
constexpr size_t WS_SGUW = WS_LRUW + (size_t)2 * 2 * 8 * 128 * 128 * 2;
constexpr size_t WS_MEMN = WS_SGUW + (size_t)8 * 128 * 128 * 2;
constexpr size_t WS_MK = WS_MEMN + (size_t)2 * 1536 * 1024 * 2;
constexpr size_t WS_MVT = WS_MK + (size_t)2 * 1536 * 512 * 2;
constexpr size_t WS_H = WS_MVT + (size_t)2 * 512 * 1536 * 2;
constexpr size_t WS_Z = WS_H + (size_t)SEG * 1024 * 2;
constexpr size_t WS_VT = WS_Z + (size_t)SEG * LDZ * 2;
constexpr size_t WS_Y = WS_VT + (size_t)1024 * SEG * 2;
constexpr size_t WS_AGG = WS_Y + (size_t)SEG * LDY * 2;
constexpr size_t WS_CARRY = WS_AGG + (size_t)2 * 128 * 1024 * 2 * 4;
constexpr size_t WS_RSTD = WS_CARRY + (size_t)2 * 128 * 1024 * 4;
constexpr size_t WS_END = WS_RSTD + (size_t)SEG * 4;

struct Params { const float* in[25]; float* out; unsigned char* ws; };

__device__ __forceinline__ float bf2f(unsigned short b) { return __uint_as_float(((unsigned)b) << 16); }
__device__ __forceinline__ unsigned short f2bf(float f) { unsigned u = __float_as_uint(f); u += 0x7FFFu + ((u >> 16) & 1u); return (unsigned short)(u >> 16); }
__device__ __forceinline__ float bflo(unsigned w) { return __uint_as_float(w << 16); }
__device__ __forceinline__ float bfhi(unsigned w) { return __uint_as_float(w & 0xffff0000u); }
__device__ __forceinline__ unsigned pk2(float lo, float hi) { return pg8::cvt_pk_bf16(lo, hi); }
__device__ __forceinline__ float silu(float x) { return x / (1.0f + __expf(-x)); }
__device__ __forceinline__ float sigm(float x) { return 1.0f / (1.0f + __expf(-x)); }
__device__ __forceinline__ float wave_sum(float v) {
#pragma unroll
    for (int o = 1; o < 64; o <<= 1) v += __shfl_xor(v, o);
    return v;
}
__device__ __forceinline__ f32x4 mfma16(bf16x8 a, bf16x8 b, f32x4 c) { return __builtin_amdgcn_mfma_f32_16x16x32_bf16(a, b, c, 0, 0, 0); }
__device__ __forceinline__ bf16x8 ld8(const bf16_t* p) { return *(const bf16x8*)p; }
__device__ __forceinline__ bf16x8 pack8(const float (&v)[8]) {
    u32x4_t w; w.x = pk2(v[0], v[1]); w.y = pk2(v[2], v[3]); w.z = pk2(v[4], v[5]); w.w = pk2(v[6], v[7]);
    return __builtin_bit_cast(bf16x8, w);
}

__device__ __forceinline__ void transpose_tile(const float* src, int R, int C, bf16_t* dst, int tile, float* lds) {
    const int ntc = C >> 6, tr = tile / ntc, tc = tile - tr * ntc, r0 = tr * 64, c0 = tc * 64;
    const int tx = threadIdx.x & 63, ty = threadIdx.x >> 6;
#pragma unroll
    for (int i = 0; i < 8; ++i) { const int r = ty + 8 * i; lds[r * 65 + tx] = src[(size_t)(r0 + r) * C + c0 + tx]; }
    __syncthreads();
#pragma unroll
    for (int i = 0; i < 8; ++i) { const int c = ty + 8 * i; dst[(size_t)(c0 + c) * R + r0 + tx] = f2bf(lds[tx * 65 + c]); }
    __syncthreads();
}

__device__ __forceinline__ void rms_row_bf16(const float* xrow, const float* g, bf16_t* orow, int lane) {
    const f32x4* xr = (const f32x4*)xrow + lane; f32x4 v[4]; float s = 0.f;
#pragma unroll
    for (int j = 0; j < 4; ++j) { v[j] = xr[64 * j]; s += (v[j].x * v[j].x + v[j].y * v[j].y) + (v[j].z * v[j].z + v[j].w * v[j].w); }
    const float rstd = 1.0f / sqrtf(wave_sum(s) * (1.0f / 1024.0f) + EPS);
    const f32x4* gr = (const f32x4*)g + lane; u32x2_t* o8 = (u32x2_t*)orow + lane;
#pragma unroll
    for (int j = 0; j < 4; ++j) { const f32x4 gg = gr[64 * j]; u32x2_t o; o.x = pk2(v[j].x * rstd * gg.x, v[j].y * rstd * gg.y); o.y = pk2(v[j].z * rstd * gg.z, v[j].w * rstd * gg.w); o8[64 * j] = o; }
}
__device__ __forceinline__ void rms_row_f32(float* xrow, const float* g, int lane) {
    f32x4* xr = (f32x4*)xrow + lane; f32x4 v[4]; float s = 0.f;
#pragma unroll
    for (int j = 0; j < 4; ++j) { v[j] = xr[64 * j]; s += (v[j].x * v[j].x + v[j].y * v[j].y) + (v[j].z * v[j].z + v[j].w * v[j].w); }
    const float rstd = 1.0f / sqrtf(wave_sum(s) * (1.0f / 1024.0f) + EPS);
    const f32x4* gr = (const f32x4*)g + lane;
#pragma unroll
    for (int j = 0; j < 4; ++j) { const f32x4 gg = gr[64 * j]; f32x4 o; o.x = v[j].x * rstd * gg.x; o.y = v[j].y * rstd * gg.y; o.z = v[j].z * rstd * gg.z; o.w = v[j].w * rstd * gg.w; xr[64 * j] = o; }
}

__device__ __forceinline__ void conv_even_item(const bf16_t* z, const float* cw, const float* cb, bf16_t* y, int t, int T, int lane) {
    const int s = t & (T - 1);
#pragma unroll
    for (int half = 0; half < 2; ++half) {
        const int c0 = half * 512 + lane * 8;
        const bf16_t* zr = z + (size_t)t * LDZ + c0;
        const u32x4_t bg = *(const u32x4_t*)(zr), ga = *(const u32x4_t*)(zr + 3072);
        const u32x4_t cg1 = *(const u32x4_t*)(zr + 1024), xv1 = *(const u32x4_t*)(zr + 2048);
        u32x4_t cg0 = {0, 0, 0, 0}, xv0 = {0, 0, 0, 0}, cg2 = {0, 0, 0, 0}, xv2 = {0, 0, 0, 0};
        if (s > 0) { cg0 = *(const u32x4_t*)(zr - LDZ + 1024); xv0 = *(const u32x4_t*)(zr - LDZ + 2048); }
        if (s < T - 1) { cg2 = *(const u32x4_t*)(zr + LDZ + 1024); xv2 = *(const u32x4_t*)(zr + LDZ + 2048); }
        float w0[8], w1[8], w2[8], bb[8];
#pragma unroll
        for (int e = 0; e < 8; e += 4) {
            const f32x4 a = *(const f32x4*)(cw + c0 + e), b = *(const f32x4*)(cw + 1024 + c0 + e), c = *(const f32x4*)(cw + 2048 + c0 + e), d = *(const f32x4*)(cb + c0 + e);
#pragma unroll
            for (int k = 0; k < 4; ++k) { w0[e + k] = a[k]; w1[e + k] = b[k]; w2[e + k] = c[k]; bb[e + k] = d[k]; }
        }
        float o[8];
#pragma unroll
        for (int k = 0; k < 4; ++k) {
            const float p0l = bflo(cg0[k]) * bflo(xv0[k]), p0h = bfhi(cg0[k]) * bfhi(xv0[k]);
            const float p1l = bflo(cg1[k]) * bflo(xv1[k]), p1h = bfhi(cg1[k]) * bfhi(xv1[k]);
            const float p2l = bflo(cg2[k]) * bflo(xv2[k]), p2h = bfhi(cg2[k]) * bfhi(xv2[k]);
            const float cl = bb[2 * k] + w0[2 * k] * p0l + w1[2 * k] * p1l + w2[2 * k] * p2l;
            const float ch = bb[2 * k + 1] + w0[2 * k + 1] * p0h + w1[2 * k + 1] * p1h + w2[2 * k + 1] * p2h;
            o[2 * k] = bflo(bg[k]) * cl * silu(bflo(ga[k]));
            o[2 * k + 1] = bfhi(bg[k]) * ch * silu(bfhi(ga[k]));
        }
        u32x4_t w; w.x = pk2(o[0], o[1]); w.y = pk2(o[2], o[3]); w.z = pk2(o[4], o[5]); w.w = pk2(o[6], o[7]);
        *(u32x4_t*)(y + (size_t)t * LDY + c0) = w;
    }
}

__device__ __forceinline__ void conv_odd_item(const bf16_t* z, const float* cw, const float* cb, bf16_t* xc, int t, int T, int lane) {
    const int s = t & (T - 1);
#pragma unroll
    for (int half = 0; half < 2; ++half) {
        const int c0 = half * 512 + lane * 8;
        const bf16_t* zr = z + (size_t)t * LDZ + c0;
        float acc[8];
#pragma unroll
        for (int e = 0; e < 8; e += 4) { const f32x4 d = *(const f32x4*)(cb + c0 + e); acc[e] = d[0]; acc[e + 1] = d[1]; acc[e + 2] = d[2]; acc[e + 3] = d[3]; }
#pragma unroll
        for (int j = 0; j < 4; ++j) {
            const int sj = s + j - 2;
            if (sj >= 0 && sj < T) {
                const u32x4_t xv = *(const u32x4_t*)(zr + (ptrdiff_t)(j - 2) * LDZ);
                const f32x4 wa = *(const f32x4*)(cw + j * 1024 + c0), wb = *(const f32x4*)(cw + j * 1024 + c0 + 4);
                acc[0] += wa[0] * bflo(xv[0]); acc[1] += wa[1] * bfhi(xv[0]); acc[2] += wa[2] * bflo(xv[1]); acc[3] += wa[3] * bfhi(xv[1]);
                acc[4] += wb[0] * bflo(xv[2]); acc[5] += wb[1] * bfhi(xv[2]); acc[6] += wb[2] * bflo(xv[3]); acc[7] += wb[3] * bfhi(xv[3]);
            }
        }
        u32x4_t w; w.x = pk2(acc[0], acc[1]); w.y = pk2(acc[2], acc[3]); w.z = pk2(acc[4], acc[5]); w.w = pk2(acc[6], acc[7]);
        *(u32x4_t*)(xc + (size_t)t * 1024 + c0) = w;
    }
}
__device__ __forceinline__ void rstd_item(const bf16_t* vT, float* rstd, int tg, int lane) {
    const bf16_t* p = vT + tg * 64 + lane; float a0 = 0.f, a1 = 0.f, a2 = 0.f, a3 = 0.f;
#pragma unroll 4
    for (int c = 0; c < 1024; c += 4) {
        const float v0 = bf2f(p[(size_t)c * SEG]), v1 = bf2f(p[(size_t)(c + 1) * SEG]), v2 = bf2f(p[(size_t)(c + 2) * SEG]), v3 = bf2f(p[(size_t)(c + 3) * SEG]);
        a0 += v0 * v0; a1 += v1 * v1; a2 += v2 * v2; a3 += v3 * v3;
    }
    rstd[tg * 64 + lane] = 1.0f / sqrtf(((a0 + a1) + (a2 + a3)) * (1.0f / 1024.0f) + EPS);
}

__device__ __forceinline__ void na_item(const bf16_t* z, const bf16_t* vT, bf16_t* y, const float* rpb, int item, int T, int lane) {
    const int g = item & 3, h = (item >> 2) & 15, R = item >> 6;
    const int rows = T >> 6, seq = R / rows, r = R - seq * rows, seq_base = seq * T;
    int rstart = r - 4; rstart = rstart < 0 ? 0 : rstart; rstart = rstart > rows - 8 ? rows - 8 : rstart;
    const int wb = (g == 0) ? 0 : (g == 1) ? 8 : (g == 2) ? 24 : 32;
    const int fr = lane & 15, fq = lane >> 4;
    const bf16_t* qp = z + (size_t)(seq_base + r * 64 + g * 16 + fr) * LDZ + 4096 + h * 64 + fq * 8;
    const bf16x8 q0 = ld8(qp), q1 = ld8(qp + 32);
    const int kcolA = wb + (fr >> 2) * 8 + (fr & 3);
    const int qc = g * 16 + fr;
    int cstart = qc - 8; cstart = cstart < 0 ? 0 : cstart; cstart = cstart > 48 ? 48 : cstart;
    float s[8][8];
    float mx = -1e30f;
#pragma unroll
    for (int kr = 0; kr < 8; ++kr) {
        const bf16_t* kp = z + (size_t)(seq_base + (rstart + kr) * 64 + kcolA) * LDZ + 5120 + h * 64 + fq * 8;
        const bf16x8 k00 = ld8(kp), k01 = ld8(kp + 32), k10 = ld8(kp + 4 * LDZ), k11 = ld8(kp + 4 * LDZ + 32);
        f32x4 a0 = {0.f, 0.f, 0.f, 0.f}, a1 = {0.f, 0.f, 0.f, 0.f};
        a0 = mfma16(k00, q0, a0); a0 = mfma16(k01, q1, a0);
        a1 = mfma16(k10, q0, a1); a1 = mfma16(k11, q1, a1);
        const int dr = rstart + kr - r + 7;
        const float* bp = rpb + (h * 15 + dr) * 31 + 15;
#pragma unroll
        for (int e = 0; e < 8; ++e) {
            const int kc = wb + fq * 8 + e;
            const bool ok = (kc >= cstart) && (kc < cstart + 16);
            int dc = kc - qc; dc = dc < -15 ? -15 : dc; dc = dc > 15 ? 15 : dc;
            const float sc = (e < 4 ? a0[e & 3] : a1[e & 3]) * 0.125f + bp[dc];
            s[kr][e] = ok ? sc : -1e30f;
            mx = fmaxf(mx, s[kr][e]);
        }
    }
    mx = fmaxf(mx, __shfl_xor(mx, 16)); mx = fmaxf(mx, __shfl_xor(mx, 32));
    float sum = 0.f;
#pragma unroll
    for (int kr = 0; kr < 8; ++kr)
#pragma unroll
        for (int e = 0; e < 8; ++e) { const float p = __expf(s[kr][e] - mx); s[kr][e] = p; sum += p; }
    sum += __shfl_xor(sum, 16); sum += __shfl_xor(sum, 32);
    f32x4 o[4];
#pragma unroll
    for (int dt = 0; dt < 4; ++dt) o[dt] = (f32x4){0.f, 0.f, 0.f, 0.f};
#pragma unroll
    for (int kr = 0; kr < 8; ++kr) {
        const bf16x8 pf = pack8(s[kr]);
        const bf16_t* vp = vT + (size_t)(h * 64 + fr) * SEG + seq_base + (rstart + kr) * 64 + wb + fq * 8;
#pragma unroll
        for (int dt = 0; dt < 4; ++dt) o[dt] = mfma16(pf, ld8(vp + (size_t)dt * 16 * SEG), o[dt]);
    }
    const float inv = 1.0f / sum;
#pragma unroll
    for (int jj = 0; jj < 4; ++jj) {
        const float iv = __shfl(inv, fq * 4 + jj);
        const int tok = seq_base + r * 64 + g * 16 + fq * 4 + jj;
#pragma unroll
        for (int dt = 0; dt < 4; ++dt) {
            const int d = dt * 16 + fr;
            const float gb = bf2f(z[(size_t)tok * LDZ + 6144 + h * 64 + d]);
            y[(size_t)tok * LDY + 1024 + h * 64 + d] = f2bf(o[dt][jj] * iv * silu(gb));
        }
    }
}

__device__ __forceinline__ void mem_item(const bf16_t* z, int qcol, int gcol, const bf16_t* mk, const bf16_t* mvT, bf16_t* y, int item, int seg, int lane) {
    const int h = item & 3, tg = item >> 2, tok0 = tg * 16;
    const int mb = seg < 2 ? seg : 2 + (tok0 >> 12);
    const int fr = lane & 15, fq = lane >> 4;
    const bf16_t* qp = z + (size_t)(tok0 + fr) * LDZ + qcol + h * 128 + fq * 8;
    bf16x8 q[4];
#pragma unroll
    for (int ks = 0; ks < 4; ++ks) q[ks] = ld8(qp + ks * 32);
    const int mrowA = (fr >> 2) * 8 + (fr & 3);
    float s[8][8];
    float mx = -1e30f;
#pragma unroll
    for (int kb = 0; kb < 8; ++kb) {
        const bf16_t* kp = mk + (size_t)(mb * 256 + kb * 32 + mrowA) * 512 + h * 128 + fq * 8;
        f32x4 a0 = {0.f, 0.f, 0.f, 0.f}, a1 = {0.f, 0.f, 0.f, 0.f};
#pragma unroll
        for (int ks = 0; ks < 4; ++ks) { a0 = mfma16(ld8(kp + ks * 32), q[ks], a0); a1 = mfma16(ld8(kp + 4 * 512 + ks * 32), q[ks], a1); }
#pragma unroll
        for (int e = 0; e < 8; ++e) { s[kb][e] = (e < 4 ? a0[e & 3] : a1[e & 3]) * 0.08838834764831845f; mx = fmaxf(mx, s[kb][e]); }
    }
    mx = fmaxf(mx, __shfl_xor(mx, 16)); mx = fmaxf(mx, __shfl_xor(mx, 32));
    float sum = 0.f;
#pragma unroll
    for (int kb = 0; kb < 8; ++kb)
#pragma unroll
        for (int e = 0; e < 8; ++e) { const float p = __expf(s[kb][e] - mx); s[kb][e] = p; sum += p; }
    sum += __shfl_xor(sum, 16); sum += __shfl_xor(sum, 32);
    f32x4 o[8];
#pragma unroll
    for (int dt = 0; dt < 8; ++dt) o[dt] = (f32x4){0.f, 0.f, 0.f, 0.f};
#pragma unroll
    for (int kb = 0; kb < 8; ++kb) {
        const bf16x8 pf = pack8(s[kb]);
        const bf16_t* vp = mvT + (size_t)(h * 128 + fr) * 1536 + mb * 256 + kb * 32 + fq * 8;
#pragma unroll
        for (int dt = 0; dt < 8; ++dt) o[dt] = mfma16(pf, ld8(vp + (size_t)dt * 16 * 1536), o[dt]);
    }
    const float inv = 1.0f / sum;
#pragma unroll
    for (int jj = 0; jj < 4; ++jj) {
        const float iv = __shfl(inv, fq * 4 + jj);
        const int tok = tok0 + fq * 4 + jj;
#pragma unroll
        for (int dt = 0; dt < 8; ++dt) {
            const int d = dt * 16 + fr;
            const float gm = bf2f(z[(size_t)tok * LDZ + gcol + h * 128 + d]);
            y[(size_t)tok * LDY + 2048 + h * 128 + d] = f2bf(o[dt][jj] * iv * silu(gm));
        }
    }
}

template <int CTRL> __device__ __forceinline__ float dppf(float oldv, float src) {
    return __int_as_float(__builtin_amdgcn_update_dpp(__float_as_int(oldv), __float_as_int(src), CTRL, 0xf, 0xf, false));
}
template <int DIR> __device__ __forceinline__ void scan16(float& A, float& B) {
    constexpr int BASE = DIR == 0 ? 0x110 : 0x100;
    { const float ap = dppf<BASE + 1>(1.f, A), bp = dppf<BASE + 1>(0.f, B); B = A * bp + B; A = A * ap; }
    { const float ap = dppf<BASE + 2>(1.f, A), bp = dppf<BASE + 2>(0.f, B); B = A * bp + B; A = A * ap; }
    { const float ap = dppf<BASE + 4>(1.f, A), bp = dppf<BASE + 4>(0.f, B); B = A * bp + B; A = A * ap; }
    { const float ap = dppf<BASE + 8>(1.f, A), bp = dppf<BASE + 8>(0.f, B); B = A * bp + B; A = A * ap; }
}
struct LruW { bf16x8 Wa[4], Wi[4]; float ba[4], bi[4], c8[4]; };
template <int DIR, bool FINAL> __device__ __forceinline__ void lru_tile(const bf16_t* xc, const LruW& W, int tok, int blk, int ch4, int lane, float (&hin)[4], float (&arun)[4], float (&hout)[4]) {
    const int fq = lane >> 4;
    const bf16_t* xp = xc + (size_t)tok * 1024 + blk * 128 + fq * 8;
    f32x4 accR = {0.f, 0.f, 0.f, 0.f}, accI = {0.f, 0.f, 0.f, 0.f};
#pragma unroll
    for (int ks = 0; ks < 4; ++ks) { const bf16x8 X = ld8(xp + ks * 32); accR = mfma16(W.Wa[ks], X, accR); accI = mfma16(W.Wi[ks], X, accI); }
    const u32x2_t xr = *(const u32x2_t*)(xc + (size_t)tok * 1024 + ch4);
    const float xv[4] = {bflo(xr.x), bfhi(xr.x), bflo(xr.y), bfhi(xr.y)};
    const int src = (lane & 48) + (DIR == 0 ? 15 : 0);
#pragma unroll
    for (int jj = 0; jj < 4; ++jj) {
        const float rg = sigm(accR[jj] + W.ba[jj]), ig = sigm(accI[jj] + W.bi[jj]);
        const float la = W.c8[jj] * rg;
        float A = __expf(la);
        float B = sqrtf(fmaxf(1.0f - __expf(2.0f * la), 0.f)) * (ig * xv[jj]);
        scan16<DIR>(A, B);
        const float hval = A * hin[jj] + B;
        hout[jj] = hval;
        hin[jj] = __shfl(hval, src);
        if (!FINAL) arun[jj] *= __shfl(A, src);
    }
}
template <bool FINAL> __device__ __forceinline__ void lru_item(const bf16_t* xc, const bf16_t* z, const bf16_t* lruw, const float* ba_, const float* bi_, const float* lam_,
                                                               float* agg, const float* carry, bf16_t* y, int item, int lane) {
    const int cgi = item & 63, chunk = item >> 6, blk = cgi >> 3, w = cgi & 7;
    const int fr = lane & 15, fq = lane >> 4;
    const int ch4 = blk * 128 + w * 16 + fq * 4;
    float hf[8][4];
#pragma unroll
    for (int dir = 0; dir < 2; ++dir) {
        LruW W;
        const bf16_t* wa = lruw + ((size_t)((0 * 2 + dir) * 8 + blk) * 128 + w * 16 + fr) * 128 + fq * 8;
        const bf16_t* wi = lruw + ((size_t)((1 * 2 + dir) * 8 + blk) * 128 + w * 16 + fr) * 128 + fq * 8;
#pragma unroll
        for (int ks = 0; ks < 4; ++ks) { W.Wa[ks] = ld8(wa + ks * 32); W.Wi[ks] = ld8(wi + ks * 32); }
        float hin[4], arun[4];
#pragma unroll
        for (int jj = 0; jj < 4; ++jj) {
            W.ba[jj] = ba_[dir * 1024 + ch4 + jj]; W.bi[jj] = bi_[dir * 1024 + ch4 + jj];
            const float lam = lam_[dir * 1024 + ch4 + jj];
            W.c8[jj] = -8.0f * log1pf(__expf(-lam));
            hin[jj] = FINAL ? carry[(size_t)(dir * 128 + chunk) * 1024 + ch4 + jj] : 0.f;
            arun[jj] = 1.f;
        }
#pragma unroll
        for (int step = 0; step < 8; ++step) {
            const int tt = dir == 0 ? step : 7 - step;
            const int tok = chunk * 128 + tt * 16 + fr;
            float hv[4];
            if (dir == 0) lru_tile<0, FINAL>(xc, W, tok, blk, ch4, lane, hin, arun, hv);
            else lru_tile<1, FINAL>(xc, W, tok, blk, ch4, lane, hin, arun, hv);
            if (FINAL) {
                if (dir == 0) {
#pragma unroll
                    for (int jj = 0; jj < 4; ++jj) hf[tt][jj] = hv[jj];
                } else {
                    const u32x2_t gr = *(const u32x2_t*)(z + (size_t)tok * LDZ + 1024 + ch4);
                    const float gc[4] = {bflo(gr.x), bfhi(gr.x), bflo(gr.y), bfhi(gr.y)};
                    float o[4];
#pragma unroll
                    for (int jj = 0; jj < 4; ++jj) o[jj] = (hf[tt][jj] + hv[jj]) * silu(gc[jj]);
                    u32x2_t ow; ow.x = pk2(o[0], o[1]); ow.y = pk2(o[2], o[3]);
                    *(u32x2_t*)(y + (size_t)tok * LDY + ch4) = ow;
                }
            }
        }
        if (!FINAL && fr == 0) {
#pragma unroll
            for (int jj = 0; jj < 4; ++jj) { float2 v; v.x = arun[jj]; v.y = hin[jj]; *(float2*)(agg + ((size_t)(dir * 128 + chunk) * 1024 + ch4 + jj) * 2) = v; }
        }
    }
}
__device__ __forceinline__ void carry_phase(const float* agg, float* carry, int nseq, int gtid, int gthreads) {
    const int nc = 128 / nseq;
    for (int idx = gtid; idx < 2 * nseq * 1024; idx += gthreads) {
        const int ch = idx & 1023, rest = idx >> 10, dir = rest & 1, sq = rest >> 1, base = sq * nc;
        float h = 0.f;
#pragma unroll 8
        for (int c = 0; c < nc; ++c) {
            const int C = base + (dir == 0 ? c : nc - 1 - c);
            const size_t o = (size_t)(dir * 128 + C) * 1024 + ch;
            const float2 ah = *(const float2*)(agg + o * 2);
            carry[o] = h;
            h = ah.x * h + ah.y;
        }
    }
}

__device__ __forceinline__ void sgu_item(const bf16_t* vT, const float* rstd, const bf16_t* z, const bf16_t* sguw, const float* sgu_g, const float* sgu_b, bf16_t* y, int item, int lane) {
    const int dd = item & 7, g = (item >> 3) & 7, n = item >> 6;
    const int fr = lane & 15, fq = lane >> 4;
    const int tokc = n * 128;
    const bf16_t* ap = vT + (size_t)(g * 128 + dd * 16 + fr) * SEG + tokc + fq * 8;
    bf16x8 Af[4];
#pragma unroll
    for (int ks = 0; ks < 4; ++ks) {
        const u32x4_t raw = *(const u32x4_t*)(ap + ks * 32);
        const f32x4 r0 = *(const f32x4*)(rstd + tokc + ks * 32 + fq * 8), r1 = *(const f32x4*)(rstd + tokc + ks * 32 + fq * 8 + 4);
        u32x4_t w;
        w.x = pk2(bflo(raw.x) * r0[0], bfhi(raw.x) * r0[1]); w.y = pk2(bflo(raw.y) * r0[2], bfhi(raw.y) * r0[3]);
        w.z = pk2(bflo(raw.z) * r1[0], bfhi(raw.z) * r1[1]); w.w = pk2(bflo(raw.w) * r1[2], bfhi(raw.w) * r1[3]);
        Af[ks] = __builtin_bit_cast(bf16x8, w);
    }
    const int ch4 = g * 128 + dd * 16 + fq * 4;
    const f32x4 g4 = *(const f32x4*)(sgu_g + ch4);
#pragma unroll
    for (int pt = 0; pt < 8; ++pt) {
        const int p = pt * 16 + fr;
        const bf16_t* bp = sguw + (size_t)(g * 128 + p) * 128 + fq * 8;
        f32x4 acc = {0.f, 0.f, 0.f, 0.f};
#pragma unroll
        for (int ks = 0; ks < 4; ++ks) acc = mfma16(Af[ks], ld8(bp + ks * 32), acc);
        const int tok = tokc + p;
        const float bsv = sgu_b[g * 128 + p];
        const u32x2_t ur = *(const u32x2_t*)(z + (size_t)tok * LDZ + 2048 + ch4), gr = *(const u32x2_t*)(z + (size_t)tok * LDZ + 3072 + ch4);
        const float uu[4] = {bflo(ur.x), bfhi(ur.x), bflo(ur.y), bfhi(ur.y)}, gd[4] = {bflo(gr.x), bfhi(gr.x), bflo(gr.y), bfhi(gr.y)};
        float o[4];
#pragma unroll
        for (int jj = 0; jj < 4; ++jj) o[jj] = uu[jj] * (acc[jj] * g4[jj] + bsv) * silu(gd[jj]);
        u32x2_t ow; ow.x = pk2(o[0], o[1]); ow.y = pk2(o[2], o[3]);
        *(u32x2_t*)(y + (size_t)tok * LDY + 1024 + ch4) = ow;
    }
}

__global__ void __launch_bounds__(512, 2) fwd_megakernel(Params P) {
    extern __shared__ __attribute__((aligned(16))) unsigned char shm[];
    cg::grid_group grid = cg::this_grid();
    PG8_LAS unsigned char* lds = (PG8_LAS unsigned char*)shm;
    const int G = gridDim.x, NW = G * 8;
#define FRESH_TID() int tid = threadIdx.x; asm volatile("" : "+v"(tid)); const int lane = tid & 63, wid = tid >> 6, gw = blockIdx.x * 8 + wid; (void)lane; (void)gw
    unsigned char* ws = P.ws;
    bf16_t* WIN_E = (bf16_t*)(ws + WS_WIN_E); bf16_t* WIN_O = (bf16_t*)(ws + WS_WIN_O);
    bf16_t* WOUT_E = (bf16_t*)(ws + WS_WOUT_E); bf16_t* WOUT_O = (bf16_t*)(ws + WS_WOUT_O);
    bf16_t* WKV = (bf16_t*)(ws + WS_WKV); bf16_t* LRUW = (bf16_t*)(ws + WS_LRUW); bf16_t* SGUW = (bf16_t*)(ws + WS_SGUW);
    bf16_t* MEMN = (bf16_t*)(ws + WS_MEMN); bf16_t* MK = (bf16_t*)(ws + WS_MK); bf16_t* MVT = (bf16_t*)(ws + WS_MVT);
    bf16_t* H = (bf16_t*)(ws + WS_H); bf16_t* Z = (bf16_t*)(ws + WS_Z); bf16_t* VT = (bf16_t*)(ws + WS_VT); bf16_t* Y = (bf16_t*)(ws + WS_Y);
    float* AGG = (float*)(ws + WS_AGG); float* CARRY = (float*)(ws + WS_CARRY); float* RSTD = (float*)(ws + WS_RSTD);

    {
        FRESH_TID();
        float* scr = (float*)shm;
        constexpr int I0 = 16 * 144, I1 = 16 * 96, I2 = 40 * 16, I3 = 40 * 16, I4 = 256, I5 = 256, I6 = 64, I7 = 64;
        constexpr int NIT = I0 + I1 + I2 + I3 + I4 + I5 + I6 + I7;
        for (int it = blockIdx.x; it < NIT; it += G) {
            int r = it;
            if (r < I0) { transpose_tile(P.in[7], 1024, 9216, WIN_E, r, scr); continue; } r -= I0;
            if (r < I1) { transpose_tile(P.in[12], 1024, 6144, WIN_O, r, scr); continue; } r -= I1;
            if (r < I2) { transpose_tile(P.in[11], 2560, 1024, WOUT_E, r, scr); continue; } r -= I2;
            if (r < I3) { transpose_tile(P.in[23], 2560, 1024, WOUT_O, r, scr); continue; } r -= I3;
            if (r < I4) { transpose_tile(P.in[6], 1024, 1024, WKV, r, scr); continue; } r -= I4;
            if (r < I5) { transpose_tile(P.in[6] + (size_t)1024 * 1024, 1024, 1024, WKV + (size_t)1024 * 1024, r, scr); continue; } r -= I5;
            if (r < I6) { const int m = r >> 2; transpose_tile(P.in[15] + (size_t)m * 16384, 128, 128, LRUW + (size_t)m * 16384, r & 3, scr); continue; } r -= I6;
            { const int m = r >> 2; transpose_tile(P.in[17] + (size_t)m * 16384, 128, 128, LRUW + (size_t)(16 + m) * 16384, r & 3, scr); }
        }
        for (int i = blockIdx.x * 512 + tid; i < 8 * 128 * 128; i += G * 512) SGUW[i] = f2bf(P.in[21][i]);
        for (int it = gw; it < 2 * 1536; it += NW) {
            const int l = it / 1536, row = it - l * 1536;
            const float* src = row < 512 ? P.in[2] + (size_t)row * 1024 : P.in[3] + (size_t)(row - 512) * 1024;
            rms_row_bf16(src, P.in[5] + l * 1024, MEMN + ((size_t)l * 1536 + row) * 1024, lane);
        }
    }

    for (int seg = 0; seg < 3; ++seg) {
        const float* xin = seg < 2 ? P.in[0] + (size_t)seg * SEG * 1024 : P.in[1];
        float* xout = P.out + (size_t)seg * SEG * 1024;
        const int T = seg < 2 ? 16384 : 4096, nseq = seg < 2 ? 1 : 4;

        { FRESH_TID();
        for (int it = gw; it < SEG; it += NW) rms_row_bf16(xin + (size_t)it * 1024, P.in[4], H + (size_t)it * 1024, lane); }
        grid.sync();

        {
            pg8::Gemm g; g.A = H; g.Bt = WIN_E; g.M = SEG; g.N = 8192; g.K = 1024;
            pg8::SkipOrder S; S.init(SEG, 8192, G, blockIdx.x); S.skip_from = 24; S.skip_n = 4;
            pg8::EpiZ E; E.O = Z; E.ldc = LDZ; E.skip_from = 24; E.skip_n = 4;
            pg8::gemm_phase(lds, g, S, E);
        }
        {
            pg8::Gemm g; g.A = WIN_E + (size_t)6144 * 1024; g.Bt = H; g.M = 1024; g.N = SEG; g.K = 1024;
            pg8::SkipOrder S; S.init(1024, SEG, G, blockIdx.x); S.skip_from = 1 << 20; S.skip_n = 0;
            pg8::EpiZ E; E.O = VT; E.ldc = SEG; E.skip_from = 1 << 20; E.skip_n = 0;
            pg8::gemm_phase(lds, g, S, E);
        }
        if (seg == 0) {
#pragma unroll 1
            for (int l = 0; l < 2; ++l) {
                {
                    pg8::Gemm g; g.A = MEMN + (size_t)l * 1536 * 1024; g.Bt = WKV + (size_t)l * 1024 * 1024; g.M = 1536; g.N = 512; g.K = 1024;
                    pg8::SkipOrder S; S.init(1536, 512, G, (blockIdx.x + G - (32 * l) % G) % G); S.skip_from = 1 << 20; S.skip_n = 0;
                    pg8::EpiZ E; E.O = MK + (size_t)l * 1536 * 512; E.ldc = 512; E.skip_from = 1 << 20; E.skip_n = 0;
                    pg8::gemm_phase(lds, g, S, E);
                }
                {
                    pg8::Gemm g; g.A = WKV + (size_t)l * 1024 * 1024 + (size_t)512 * 1024; g.Bt = MEMN + (size_t)l * 1536 * 1024; g.M = 512; g.N = 1536; g.K = 1024;
                    pg8::SkipOrder S; S.init(512, 1536, G, (blockIdx.x + G - (32 * l + 16) % G) % G); S.skip_from = 1 << 20; S.skip_n = 0;
                    pg8::EpiZ E; E.O = MVT + (size_t)l * 512 * 1536; E.ldc = 1536; E.skip_from = 1 << 20; E.skip_n = 0;
                    pg8::gemm_phase(lds, g, S, E);
                }
            }
        }
        grid.sync();

        { FRESH_TID();
        for (int it = gw; it < 16384 + 4096 + 16384; it += NW) {
            if (it < 16384) na_item(Z, VT, Y, P.in[10], it, T, lane);
            else if (it < 16384 + 4096) mem_item(Z, 7168, 7680, MK, MVT, Y, it - 16384, seg, lane);
            else conv_even_item(Z, P.in[8], P.in[9], Y, it - 20480, T, lane);
        } }
        grid.sync();

        {
            pg8::Gemm g; g.A = Y; g.Bt = WOUT_E; g.M = SEG; g.N = 1024; g.K = 2560;
            pg8::StaticOrder S; S.init(SEG, 1024, G, blockIdx.x);
            pg8::EpiRes E; E.xin = xin; E.out = xout;
            pg8::gemm_phase(lds, g, S, E);
        }
        grid.sync();

        { FRESH_TID();
        for (int it = gw; it < SEG; it += NW) rms_row_bf16(xout + (size_t)it * 1024, P.in[4] + 1024, H + (size_t)it * 1024, lane); }
        grid.sync();

        {
            pg8::Gemm g; g.A = H; g.Bt = WIN_O; g.M = SEG; g.N = 5120; g.K = 1024;
            pg8::SkipOrder S; S.init(SEG, 5120, G, blockIdx.x); S.skip_from = 12; S.skip_n = 4;
            pg8::EpiZ E; E.O = Z; E.ldc = LDZ; E.skip_from = 12; E.skip_n = 4;
            pg8::gemm_phase(lds, g, S, E);
        }
        {
            pg8::Gemm g; g.A = WIN_O + (size_t)3072 * 1024; g.Bt = H; g.M = 1024; g.N = SEG; g.K = 1024;
            pg8::SkipOrder S; S.init(1024, SEG, G, blockIdx.x); S.skip_from = 1 << 20; S.skip_n = 0;
            pg8::EpiZ E; E.O = VT; E.ldc = SEG; E.skip_from = 1 << 20; E.skip_n = 0;
            pg8::gemm_phase(lds, g, S, E);
        }
        grid.sync();

        { FRESH_TID();
        for (int it = gw; it < SEG + 256; it += NW) {
            if (it < SEG) conv_odd_item(Z, P.in[13], P.in[14], H, it, T, lane);
            else rstd_item(VT, RSTD, it - SEG, lane);
        } }
        grid.sync();

        { FRESH_TID();
        for (int it = gw; it < 8192 + 8192 + 4096; it += NW) {
            if (it < 8192) lru_item<false>(H, Z, LRUW, P.in[16], P.in[18], P.in[19], AGG, CARRY, Y, it, lane);
            else if (it < 16384) sgu_item(VT, RSTD, Z, SGUW, P.in[20], P.in[22], Y, it - 8192, lane);
            else mem_item(Z, 4096, 4608, MK + (size_t)1536 * 512, MVT + (size_t)512 * 1536, Y, it - 16384, seg, lane);
        } }
        grid.sync();

        { FRESH_TID(); carry_phase(AGG, CARRY, nseq, blockIdx.x * 512 + tid, G * 512); }
        grid.sync();

        { FRESH_TID();
        for (int it = gw; it < 8192; it += NW) lru_item<true>(H, Z, LRUW, P.in[16], P.in[18], P.in[19], AGG, CARRY, Y, it, lane); }
        grid.sync();

        {
            pg8::Gemm g; g.A = Y; g.Bt = WOUT_O; g.M = SEG; g.N = 1024; g.K = 2560;
            pg8::StaticOrder S; S.init(SEG, 1024, G, blockIdx.x);
            pg8::EpiRes E; E.xin = xout; E.out = xout;
            pg8::gemm_phase(lds, g, S, E);
        }
        grid.sync();

        { FRESH_TID();
        for (int it = gw; it < SEG; it += NW) rms_row_f32(xout + (size_t)it * 1024, P.in[24], lane); }
    }
}

extern "C" void kernel_launch(void* const* d_in, const int* in_sizes, int n_in, void* d_out, int out_size, void* d_ws, size_t ws_size, hipStream_t stream) {
    static int grid_blocks = 0;
    if (grid_blocks == 0) {
        if (n_in != 25 || ws_size < WS_END) { fprintf(stderr, "kernel_launch: need 25 inputs and %zu bytes of workspace; got %d, %zu\n", (size_t)WS_END, n_in, ws_size); grid_blocks = -1; return; }
        int dev = 0, cus = 0, per_cu = 0;
        hipGetDevice(&dev);
        hipDeviceGetAttribute(&cus, hipDeviceAttributeMultiprocessorCount, dev);
        hipFuncSetAttribute((const void*)fwd_megakernel, hipFuncAttributeMaxDynamicSharedMemorySize, LDS_BYTES);
        hipOccupancyMaxActiveBlocksPerMultiprocessor(&per_cu, (const void*)fwd_megakernel, 512, LDS_BYTES);
        if (per_cu < 1) { fprintf(stderr, "kernel_launch: occupancy query says %d blocks per CU\n", per_cu); grid_blocks = -1; return; }
        grid_blocks = cus;
    }
    if (grid_blocks < 0) return;
    Params p{};
    for (int i = 0; i < 25; ++i) p.in[i] = (const float*)d_in[i];
    p.out = (float*)d_out; p.ws = (unsigned char*)d_ws;
    void* args[] = {&p};
    hipError_t e = hipLaunchCooperativeKernel((const void*)fwd_megakernel, dim3(grid_blocks), dim3(512), args, LDS_BYTES, stream);
    if (e != hipSuccess) fprintf(stderr, "cooperative launch failed: %s (grid %d)\n", hipGetErrorString(e), grid_blocks);
}
```

```cpp
#include <hip/hip_runtime.h>
#include <hip/hip_cooperative_groups.h>
#include <cstdio>
namespace cg = cooperative_groups;
namespace pg8 {
#define PG8_LAS __attribute__((address_space(3)))
typedef unsigned short bf16_t;
typedef short bf16x8 __attribute__((ext_vector_type(8)));
typedef float f32x4 __attribute__((ext_vector_type(4)));
typedef unsigned u32x4 __attribute__((ext_vector_type(4)));
constexpr int BM = 256, BK = 64, HALF = 128, HTB = HALF * BK * 2  , STAGE_BYTES = 8 * HTB, NXCD = 8, WGM = 8;

__host__ __device__ __forceinline__ int lds_byte(int r, int c) { const int st = (r >> 4) * 2 + (c >> 5), rr = r & 15, cc = c & 31, ob = rr * 64 + cc * 2; return st * 1024 + (ob ^ (((ob >> 9) & 1) << 5)); }
__host__ __device__ __forceinline__ void stage_rc(int b, int& R, int& C) { const int st = b / 1024, sb = b % 1024, swz = sb ^ (((sb >> 9) & 1) << 5); R = (st >> 1) * 16 + swz / 64; C = (st & 1) * 32 + (swz % 64) / 2; }
__host__ __device__ __forceinline__ int perm32(int rho) { const int n = rho >> 4, i = rho & 15; return 8 * (i >> 2) + 4 * n + (i & 3); }

struct Unit { int pm, pn; };
struct Gemm { const bf16_t* A; const bf16_t* Bt; int M, N, K; };

struct StaticOrder {
    int nM, nN, nwg, G, c;
    __host__ __device__ void init(int M, int N, int G_, int c_) { nM = M / BM; nN = N / BM; nwg = nM * nN; G = G_; c = c_; }
    __host__ __device__ bool next(int i, Unit& u) const {
        const long L = (long)i * G + c; if (L >= nwg) return false;
        int wgid = (int)L; { const int q = nwg / NXCD, r = nwg % NXCD, xcd = wgid % NXCD, off = wgid / NXCD; wgid = (xcd < r ? xcd * (q + 1) : r * (q + 1) + (xcd - r) * q) + off; }
        const int nig = WGM * nN, gid = wgid / nig, fm = gid * WGM, gsz = (nM - fm) < WGM ? (nM - fm) : WGM;
        u.pm = fm + ((wgid % nig) % gsz); u.pn = (wgid % nig) / gsz; return true;
    }
    __device__ __forceinline__ void a_ready(const Unit&) const {}
    __device__ __forceinline__ void done(const Unit&) const {}
};

struct SkipOrder : StaticOrder {
    int skip_from, skip_n;
    __device__ __forceinline__ bool next(int i, Unit& u) const {
        if (!StaticOrder::next(i, u)) return false;
        if (u.pn >= skip_from) u.pn += skip_n;
        return true;
    }
};

__device__ __forceinline__ unsigned cvt_pk_bf16(float lo, float hi) { unsigned r; asm volatile("v_cvt_pk_bf16_f32 %0, %1, %2" : "=v"(r) : "v"(lo), "v"(hi)); return r; }

struct EpiZ {
    static constexpr bool PERM = true, AFTER_DRAIN = false;
    bf16_t* O; int ldc; int skip_from, skip_n;
    __device__ __forceinline__ void operator()(const f32x4 (&acc)[2][2][4][2], const Unit& u, int wr, int wc, int fr, int fq) const {
        const int row0 = u.pm * BM + wr * 64 + fr; const int ct = (u.pn >= skip_from + skip_n) ? (u.pn - skip_n) : u.pn;
        const int col0 = ct * BM + wc * 32 + 8 * fq;
#pragma unroll
        for (int ai = 0; ai < 2; ++ai)
#pragma unroll
            for (int m = 0; m < 4; ++m) { bf16_t* rowp = O + (size_t)(row0 + ai * HALF + m * 16) * ldc + col0;
#pragma unroll
                for (int bj = 0; bj < 2; ++bj) { const f32x4 v0 = acc[ai][bj][m][0], v1 = acc[ai][bj][m][1];
                    u32x4 w; w.x = cvt_pk_bf16(v0[0], v0[1]); w.y = cvt_pk_bf16(v0[2], v0[3]); w.z = cvt_pk_bf16(v1[0], v1[1]); w.w = cvt_pk_bf16(v1[2], v1[3]);
                    *(u32x4*)(rowp + bj * HALF) = w; } }
    }
};
struct EpiRes {
    static constexpr bool PERM = false, AFTER_DRAIN = false;
    const float* xin; float* out;
    __device__ __forceinline__ void operator()(const f32x4 (&acc)[2][2][4][2], const Unit& u, int wr, int wc, int fr, int fq) const {
        const int row0 = u.pm * BM + wr * 64 + fr, col0 = u.pn * BM + wc * 32 + 4 * fq;
#pragma unroll
        for (int ai = 0; ai < 2; ++ai)
#pragma unroll
            for (int m = 0; m < 4; ++m) { const size_t ro = (size_t)(row0 + ai * HALF + m * 16) * 1024 + col0;
#pragma unroll
                for (int bj = 0; bj < 2; ++bj)
#pragma unroll
                    for (int n = 0; n < 2; ++n) { const f32x4 xv = *(const f32x4*)(xin + ro + bj * HALF + n * 16);
                        *(f32x4*)(out + ro + bj * HALF + n * 16) = acc[ai][bj][m][n] + xv; } }
    }
};

template <class Epi, class Sched>
__device__ __forceinline__ void gemm_phase(PG8_LAS unsigned char* lds, const Gemm g, const Sched& S, const Epi& E) {
    int tid = threadIdx.x; asm volatile("" : "+v"(tid));
    const int wid = __builtin_amdgcn_readfirstlane(tid >> 6), lane = tid & 63, wr = wid >> 2, wc = wid & 3, fr = lane & 15, fq = lane >> 4;
    const int K = g.K, nt = K / BK;
    const char* gA = (const char*)g.A; const char* gB = (const char*)g.Bt; asm volatile("" : "+s"(gA), "+s"(gB));
    unsigned voffA[2], voffB[2];
#pragma unroll
    for (int i = 0; i < 2; ++i) { int R, C; stage_rc(tid * 16 + i * 8192, R, C); const int Rb = Epi::PERM ? ((R & ~31) + perm32(R & 31)) : R;
        voffA[i] = (unsigned)(R * K + C) * 2u; voffB[i] = (unsigned)(Rb * K + C) * 2u; }
    const size_t kstep = (size_t)(BK * 2);
    const size_t hstep = (size_t)HALF * K * 2;
    const size_t tstep = 2 * hstep;
    const unsigned ldsw = (unsigned)wid * 1024u;
    const int aoff = lds_byte(wr * 64 + fr, fq * 8), boff = lds_byte(wc * 32 + fr, fq * 8);
#define PG8_SA(b, h) (((b) * 2 + (h)) * HTB)
#define PG8_SB(b, h) ((4 + (b) * 2 + (h)) * HTB)
#define PG8_STAGE(bufoff, gbase, voff) do { _Pragma("unroll") for (int _i = 0; _i < 2; ++_i) \
        __builtin_amdgcn_global_load_lds((const unsigned*)((const char*)(gbase) + (voff)[_i]), (PG8_LAS unsigned*)(lds + (bufoff) + ldsw + _i * 8192), 16, 0, 0); } while (0)
#define PG8_LDA(dst, b, h) do { _Pragma("unroll") for (int m = 0; m < 4; ++m) _Pragma("unroll") for (int k = 0; k < 2; ++k) dst[m][k] = *(const PG8_LAS bf16x8*)(lds + PG8_SA(b, h) + aoff + m * 2048 + k * 1024); } while (0)
#define PG8_LDB(dst, b, h) do { _Pragma("unroll") for (int n = 0; n < 2; ++n) _Pragma("unroll") for (int k = 0; k < 2; ++k) dst[n][k] = *(const PG8_LAS bf16x8*)(lds + PG8_SB(b, h) + boff + n * 2048 + k * 1024); } while (0)
#define PG8_MMA(ai, bj, At, Bt) do { __builtin_amdgcn_s_setprio(1); _Pragma("unroll") for (int m = 0; m < 4; ++m) _Pragma("unroll") for (int n = 0; n < 2; ++n) _Pragma("unroll") for (int k = 0; k < 2; ++k) \
        acc[ai][bj][m][n] = __builtin_amdgcn_mfma_f32_16x16x32_bf16(Bt[n][k], At[m][k], acc[ai][bj][m][n], 0, 0, 0); __builtin_amdgcn_s_setprio(0); } while (0)
#define PG8_WAIT_V(n) asm volatile("s_waitcnt vmcnt(" #n ")" ::: "memory")
#define PG8_WAIT_L(n) asm volatile("s_waitcnt lgkmcnt(" #n ")" ::: "memory")
#define PG8_BAR __builtin_amdgcn_s_barrier()
#define PG8_SCHED __builtin_amdgcn_sched_barrier(0)
    Unit cur, nxt; int ui = 0;
    if (!S.next(0, cur)) return;
    f32x4 acc[2][2][4][2];
#pragma unroll
    for (int a = 0; a < 2; ++a)
#pragma unroll
        for (int b = 0; b < 2; ++b)
#pragma unroll
            for (int m = 0; m < 4; ++m)
#pragma unroll
                for (int n = 0; n < 2; ++n) acc[a][b][m][n] = (f32x4){0.f, 0.f, 0.f, 0.f};
    bf16x8 At[4][2], B0[2][2], B1[2][2];
    const char* cA = gA + (size_t)cur.pm * tstep; const char* cB = gB + (size_t)cur.pn * tstep;
    S.a_ready(cur);
    PG8_STAGE(PG8_SB(0, 0), cB, voffB); PG8_STAGE(PG8_SA(0, 0), cA, voffA); PG8_STAGE(PG8_SB(0, 1), cB + hstep, voffB); PG8_STAGE(PG8_SA(0, 1), cA + hstep, voffA);
    if (wr == 1) PG8_BAR;
    PG8_WAIT_V(4); PG8_BAR;
    PG8_STAGE(PG8_SB(1, 0), cB + kstep, voffB); PG8_STAGE(PG8_SA(1, 0), cA + kstep, voffA); PG8_STAGE(PG8_SB(1, 1), cB + hstep + kstep, voffB);
    PG8_WAIT_V(6); PG8_BAR;
    for (;;) {
        const bool has_next = S.next(ui + 1, nxt);
        const char* nA = has_next ? gA + (size_t)nxt.pm * tstep : cA; const char* nB = has_next ? gB + (size_t)nxt.pn * tstep : cB;
        for (int t = 0; t < nt; t += 2) {
            const bool last = (t == nt - 2);
            const char* a1 = cA + (size_t)(t + 1) * kstep;
            const char* a2 = last ? nA : cA + (size_t)(t + 2) * kstep; const char* b2 = last ? nB : cB + (size_t)(t + 2) * kstep;
            const char* a3 = a2 + kstep; const char* b3 = b2 + kstep;
            if (last && has_next) S.a_ready(nxt);
            PG8_LDB(B0, 0, 0); PG8_SCHED; PG8_LDA(At, 0, 0); PG8_STAGE(PG8_SA(1, 1), a1 + hstep, voffA);
            PG8_WAIT_L(8); PG8_BAR; PG8_WAIT_L(0); PG8_MMA(0, 0, At, B0); PG8_BAR; PG8_SCHED;
            PG8_LDB(B1, 0, 1); PG8_STAGE(PG8_SB(0, 0), b2, voffB);
            PG8_BAR; PG8_WAIT_L(0); PG8_MMA(0, 1, At, B1); PG8_BAR;
            PG8_LDA(At, 0, 1); PG8_STAGE(PG8_SA(0, 0), a2, voffA);
            PG8_BAR; PG8_WAIT_L(0); PG8_MMA(1, 0, At, B0); PG8_BAR; PG8_SCHED;
            PG8_STAGE(PG8_SB(0, 1), b2 + hstep, voffB);
            PG8_WAIT_V(6); PG8_BAR; PG8_MMA(1, 1, At, B1); PG8_BAR;
            PG8_LDB(B0, 1, 0); PG8_SCHED; PG8_LDA(At, 1, 0); PG8_STAGE(PG8_SA(0, 1), a2 + hstep, voffA);
            PG8_WAIT_L(8); PG8_BAR; PG8_WAIT_L(0); PG8_MMA(0, 0, At, B0); PG8_BAR; PG8_SCHED;
            PG8_LDB(B1, 1, 1); PG8_STAGE(PG8_SB(1, 0), b3, voffB);
            PG8_BAR; PG8_WAIT_L(0); PG8_MMA(0, 1, At, B1); PG8_BAR;
            PG8_LDA(At, 1, 1); PG8_STAGE(PG8_SA(1, 0), a3, voffA);
            PG8_BAR; PG8_WAIT_L(0); PG8_MMA(1, 0, At, B0); PG8_BAR; PG8_SCHED;
            PG8_STAGE(PG8_SB(1, 1), b3 + hstep, voffB);
            PG8_WAIT_V(6); PG8_BAR; PG8_MMA(1, 1, At, B1); PG8_BAR;
        }
        if constexpr (!Epi::AFTER_DRAIN) { E(acc, cur, wr, wc, fr, fq); S.done(cur); }
        if (!has_next) break;
#pragma unroll
        for (int a = 0; a < 2; ++a)
#pragma unroll
            for (int b = 0; b < 2; ++b)
#pragma unroll
                for (int m = 0; m < 4; ++m)
#pragma unroll
                    for (int n = 0; n < 2; ++n) acc[a][b][m][n] = (f32x4){0.f, 0.f, 0.f, 0.f};
        cur = nxt; cA = nA; cB = nB; ++ui;
    }
    PG8_WAIT_V(0);
    if (wr == 0) PG8_BAR;
    PG8_BAR;
    if constexpr (Epi::AFTER_DRAIN) { E.fused(acc, cur, wr, wc, fr, fq, lds, wid, lane); S.done(cur); }
#undef PG8_SA
#undef PG8_SB
#undef PG8_STAGE
#undef PG8_LDA
#undef PG8_LDB
#undef PG8_MMA
#undef PG8_WAIT_V
#undef PG8_WAIT_L
#undef PG8_BAR
#undef PG8_SCHED
}
}

#define XB_TMO      128
#define XB_XCNT(j)  (256  + 64 * (j))
#define XB_XSUB(j)  (1280 + 64 * (j))
#define XB_XGEN(j)  (2304 + 64 * (j))
#define XB_TOP      3328
#define XB_TOPGEN   3392
#define XCD_BAR_WORDS 3456
#define XB_SPIN_CAP (1u << 18)
#define LAS __attribute__((address_space(3)))

__device__ __forceinline__ unsigned xb_ld(unsigned* p)              { return __hip_atomic_load(p, __ATOMIC_RELAXED, __HIP_MEMORY_SCOPE_AGENT); }
__device__ __forceinline__ unsigned xb_add(unsigned* p, unsigned v) { return __hip_atomic_fetch_add(p, v, __ATOMIC_RELAXED, __HIP_MEMORY_SCOPE_AGENT); }
__device__ __forceinline__ unsigned xb_xcc_id() { return (unsigned)__builtin_amdgcn_s_getreg((3 << 11) | 20) & 0xFu; }
#define XB_SPIN(cond, bar) do { unsigned _sp = 0; while (cond) { __builtin_amdgcn_s_sleep(1); \
    if ((++_sp & 255u) == 0u) { if (xb_ld(&(bar)[XB_TMO])) break; if (_sp > XB_SPIN_CAP) { atomicAdd(&(bar)[XB_TMO], 1u); break; } } } } while (0)

struct XcdBarrier {
    unsigned* bar; unsigned x;
    volatile LAS unsigned* st;
};

__device__ __forceinline__ XcdBarrier xcd_barrier_post(unsigned* bar, volatile LAS unsigned* st) {
    XcdBarrier b; b.bar = bar; b.x = xb_xcc_id(); b.st = st;
    if (threadIdx.x == 0) (void)xb_add(&bar[XB_XCNT(b.x)], 1u);
    return b;
}
__device__ __forceinline__ void xcd_barrier_complete(unsigned* bar, unsigned x, unsigned& nloc, unsigned& nx) {
    const unsigned G = gridDim.x * gridDim.y * gridDim.z;
    unsigned sum, cnt, mine, sp = 0u;
    for (;;) {
        sum = 0u; cnt = 0u; mine = 0u;
#pragma unroll
        for (unsigned j = 0; j < 16; ++j) { const unsigned c = xb_ld(&bar[XB_XCNT(j)]); sum += c; cnt += (c > 0u) ? 1u : 0u; mine = (j == x) ? c : mine; }
        if (sum == G) break;
        __builtin_amdgcn_s_sleep(1);
        if ((++sp & 255u) == 0u) { if (xb_ld(&bar[XB_TMO])) break; if (sp > XB_SPIN_CAP) { atomicAdd(&bar[XB_TMO], 1u); break; } }
    }
    nloc = mine > 0u ? mine : 1u; nx = cnt > 0u ? cnt : 1u;
}

__device__ __forceinline__ void xcd_barrier(const XcdBarrier& b) {
    asm volatile("s_waitcnt vmcnt(0)" ::: "memory");
    __syncthreads();
    if (threadIdx.x == 0) {
        unsigned* bar = b.bar;
        __builtin_amdgcn_s_waitcnt(0);
        unsigned nloc = b.st[0], nx = b.st[1];
        if (nloc == 0u) { xcd_barrier_complete(bar, b.x, nloc, nx); b.st[0] = nloc; b.st[1] = nx; }
        const unsigned old = xb_add(&bar[XB_XSUB(b.x)], 1u);
        const unsigned gen = old / nloc;
        if (old + 1u == (gen + 1u) * nloc) {
            __builtin_amdgcn_fence(__ATOMIC_RELEASE, "agent");
            asm volatile("s_waitcnt vmcnt(0)" ::: "memory");
            const unsigned og = xb_add(&bar[XB_TOP], 1u);
            const unsigned tg = og / nx;
            if (og + 1u == (tg + 1u) * nx) xb_add(&bar[XB_TOPGEN], 1u);
            else XB_SPIN(xb_ld(&bar[XB_TOPGEN]) == tg, bar);
            __builtin_amdgcn_fence(__ATOMIC_ACQUIRE, "agent");
            xb_add(&bar[XB_XGEN(b.x)], 1u);
            asm volatile("s_waitcnt vmcnt(0)" ::: "memory");
        } else {
            XB_SPIN(xb_ld(&bar[XB_XGEN(b.x)]) == gen, bar);
            __builtin_amdgcn_fence(__ATOMIC_ACQUIRE, "agent");
            asm volatile("s_waitcnt vmcnt(0)" ::: "memory");
        }
    }
    __syncthreads();
}

using pg8::bf16_t; using pg8::bf16x8; using pg8::f32x4;
typedef unsigned u32x2_t __attribute__((ext_vector_type(2)));
typedef unsigned u32x4_t __attribute__((ext_vector_type(4)));

constexpr int DM = 1024, SEG = 16384, LDZ = 8192, LDY = 2560;
constexpr float EPS = 1e-6f;
constexpr int LDS_BYTES = 131072 + 64;
constexpr size_t WS_WIN_E = 0;
constexpr size_t WS_WIN_O = WS_WIN_E + (size_t)9216 * 1024 * 2;
constexpr size_t WS_WOUT_E = WS_WIN_O + (size_t)6144 * 1024 * 2;
constexpr size_t WS_WOUT_O = WS_WOUT_E + (size_t)1024 * 2560 * 2;
constexpr size_t WS_WKV = WS_WOUT_O + (size_t)1024 * 2560 * 2;
constexpr size_t WS_LRUW = WS_WKV + (size_t)2 * 1024 * 1024 * 2;
constexpr size_t WS_SGUW = WS_LRUW + (size_t)2 * 2 * 8 * 128 * 128 * 2;
constexpr size_t WS_MEMN = WS_SGUW + (size_t)8 * 128 * 128 * 2;
constexpr size_t WS_MK = WS_MEMN + (size_t)2 * 1536 * 1024 * 2;
constexpr size_t WS_MVT = WS_MK + (size_t)2 * 1536 * 512 * 2;
constexpr size_t WS_H = WS_MVT + (size_t)2 * 512 * 1536 * 2;
constexpr size_t WS_Z = WS_H + (size_t)SEG * 1024 * 2;
constexpr size_t WS_VT = WS_Z + (size_t)SEG * LDZ * 2;
constexpr size_t WS_Y = WS_VT + (size_t)1024 * SEG * 2;
constexpr size_t WS_AGG = WS_Y + (size_t)SEG * LDY * 2;
constexpr size_t WS_CARRY = WS_AGG + (size_t)2 * 128 * 1024 * 2 * 4;
constexpr size_t WS_RSTD = WS_CARRY + (size_t)2 * 128 * 1024 * 4;
constexpr size_t WS_BAR = WS_RSTD + (size_t)SEG * 4;
constexpr size_t WS_END = WS_BAR + 16384;

struct Params { const float* in[25]; float* out; unsigned char* ws; };

__device__ __forceinline__ float bf2f(unsigned short b) { return __uint_as_float(((unsigned)b) << 16); }
__device__ __forceinline__ unsigned short f2bf(float f) { unsigned u = __float_as_uint(f); u += 0x7FFFu + ((u >> 16) & 1u); return (unsigned short)(u >> 16); }
__device__ __forceinline__ float bflo(unsigned w) { return __uint_as_float(w << 16); }
__device__ __forceinline__ float bfhi(unsigned w) { return __uint_as_float(w & 0xffff0000u); }
__device__ __forceinline__ unsigned pk2(float lo, float hi) { return pg8::cvt_pk_bf16(lo, hi); }
__device__ __forceinline__ float frcp(float x) { return __builtin_amdgcn_rcpf(x); }
__device__ __forceinline__ float silu(float x) { return x * frcp(1.0f + __expf(-x)); }
__device__ __forceinline__ float sigm(float x) { return frcp(1.0f + __expf(-x)); }
__device__ __forceinline__ float wave_sum(float v) {
#pragma unroll
    for (int o = 1; o < 64; o <<= 1) v += __shfl_xor(v, o);
    return v;
}
__device__ __forceinline__ f32x4 mfma16(bf16x8 a, bf16x8 b, f32x4 c) { return __builtin_amdgcn_mfma_f32_16x16x32_bf16(a, b, c, 0, 0, 0); }
__device__ __forceinline__ bf16x8 ld8(const bf16_t* p) { return *(const bf16x8*)p; }
__device__ __forceinline__ bf16x8 pack8(const float (&v)[8]) {
    u32x4_t w; w.x = pk2(v[0], v[1]); w.y = pk2(v[2], v[3]); w.z = pk2(v[4], v[5]); w.w = pk2(v[6], v[7]);
    return __builtin_bit_cast(bf16x8, w);
}

__device__ __forceinline__ void transpose_tile(const float* src, int R, int C, bf16_t* dst, int tile, float* lds) {
    const int ntc = C >> 6, tr = tile / ntc, tc = tile - tr * ntc, r0 = tr * 64, c0 = tc * 64;
    const int tx = threadIdx.x & 63, ty = threadIdx.x >> 6;
#pragma unroll
    for (int i = 0; i < 8; ++i) { const int r = ty + 8 * i; lds[r * 65 + tx] = src[(size_t)(r0 + r) * C + c0 + tx]; }
    __syncthreads();
#pragma unroll
    for (int i = 0; i < 8; ++i) { const int c = ty + 8 * i; dst[(size_t)(c0 + c) * R + r0 + tx] = f2bf(lds[tx * 65 + c]); }
    __syncthreads();
}

__device__ __forceinline__ void rms_row_bf16(const float* xrow, const float* g, bf16_t* orow, int lane) {
    const f32x4* xr = (const f32x4*)xrow + lane; f32x4 v[4]; float s = 0.f;
#pragma unroll
    for (int j = 0; j < 4; ++j) { v[j] = xr[64 * j]; s += (v[j].x * v[j].x + v[j].y * v[j].y) + (v[j].z * v[j].z + v[j].w * v[j].w); }
    const float rstd = __builtin_amdgcn_rsqf(wave_sum(s) * (1.0f / 1024.0f) + EPS);
    const f32x4* gr = (const f32x4*)g + lane; u32x2_t* o8 = (u32x2_t*)orow + lane;
#pragma unroll
    for (int j = 0; j < 4; ++j) { const f32x4 gg = gr[64 * j]; u32x2_t o; o.x = pk2(v[j].x * rstd * gg.x, v[j].y * rstd * gg.y); o.y = pk2(v[j].z * rstd * gg.z, v[j].w * rstd * gg.w); o8[64 * j] = o; }
}
__device__ __forceinline__ void rms_row_f32(float* xrow, const float* g, int lane) {
    f32x4* xr = (f32x4*)xrow + lane; f32x4 v[4]; float s = 0.f;
#pragma unroll
    for (int j = 0; j < 4; ++j) { v[j] = xr[64 * j]; s += (v[j].x * v[j].x + v[j].y * v[j].y) + (v[j].z * v[j].z + v[j].w * v[j].w); }
    const float rstd = __builtin_amdgcn_rsqf(wave_sum(s) * (1.0f / 1024.0f) + EPS);
    const f32x4* gr = (const f32x4*)g + lane;
#pragma unroll
    for (int j = 0; j < 4; ++j) { const f32x4 gg = gr[64 * j]; f32x4 o; o.x = v[j].x * rstd * gg.x; o.y = v[j].y * rstd * gg.y; o.z = v[j].z * rstd * gg.z; o.w = v[j].w * rstd * gg.w; xr[64 * j] = o; }
}

__device__ __forceinline__ void conv_even_item(const bf16_t* z, const float* cw, const float* cb, bf16_t* y, int t, int T, int lane) {
    const int s = t & (T - 1);
#pragma unroll
    for (int half = 0; half < 2; ++half) {
        const int c0 = half * 512 + lane * 8;
        const bf16_t* zr = z + (size_t)t * LDZ + c0;
        const u32x4_t bg = *(const u32x4_t*)(zr), ga = *(const u32x4_t*)(zr + 3072);
        const u32x4_t cg1 = *(const u32x4_t*)(zr + 1024), xv1 = *(const u32x4_t*)(zr + 2048);
        u32x4_t cg0 = {0, 0, 0, 0}, xv0 = {0, 0, 0, 0}, cg2 = {0, 0, 0, 0}, xv2 = {0, 0, 0, 0};
        if (s > 0) { cg0 = *(const u32x4_t*)(zr - LDZ + 1024); xv0 = *(const u32x4_t*)(zr - LDZ + 2048); }
        if (s < T - 1) { cg2 = *(const u32x4_t*)(zr + LDZ + 1024); xv2 = *(const u32x4_t*)(zr + LDZ + 2048); }
        float w0[8], w1[8], w2[8], bb[8];
#pragma unroll
        for (int e = 0; e < 8; e += 4) {
            const f32x4 a = *(const f32x4*)(cw + c0 + e), b = *(const f32x4*)(cw + 1024 + c0 + e), c = *(const f32x4*)(cw + 2048 + c0 + e), d = *(const f32x4*)(cb + c0 + e);
#pragma unroll
            for (int k = 0; k < 4; ++k) { w0[e + k] = a[k]; w1[e + k] = b[k]; w2[e + k] = c[k]; bb[e + k] = d[k]; }
        }
        float o[8];
#pragma unroll
        for (int k = 0; k < 4; ++k) {
            const float p0l = bflo(cg0[k]) * bflo(xv0[k]), p0h = bfhi(cg0[k]) * bfhi(xv0[k]);
            const float p1l = bflo(cg1[k]) * bflo(xv1[k]), p1h = bfhi(cg1[k]) * bfhi(xv1[k]);
            const float p2l = bflo(cg2[k]) * bflo(xv2[k]), p2h = bfhi(cg2[k]) * bfhi(xv2[k]);
            const float cl = bb[2 * k] + w0[2 * k] * p0l + w1[2 * k] * p1l + w2[2 * k] * p2l;
            const float ch = bb[2 * k + 1] + w0[2 * k + 1] * p0h + w1[2 * k + 1] * p1h + w2[2 * k + 1] * p2h;
            o[2 * k] = bflo(bg[k]) * cl * silu(bflo(ga[k]));
            o[2 * k + 1] = bfhi(bg[k]) * ch * silu(bfhi(ga[k]));
        }
        u32x4_t w; w.x = pk2(o[0], o[1]); w.y = pk2(o[2], o[3]); w.z = pk2(o[4], o[5]); w.w = pk2(o[6], o[7]);
        *(u32x4_t*)(y + (size_t)t * LDY + c0) = w;
    }
}

__device__ __forceinline__ void conv_odd_item(const bf16_t* z, const float* cw, const float* cb, bf16_t* xc, int t, int T, int lane) {
    const int s = t & (T - 1);
#pragma unroll
    for (int half = 0; half < 2; ++half) {
        const int c0 = half * 512 + lane * 8;
        const bf16_t* zr = z + (size_t)t * LDZ + c0;
        float acc[8];
#pragma unroll
        for (int e = 0; e < 8; e += 4) { const f32x4 d = *(const f32x4*)(cb + c0 + e); acc[e] = d[0]; acc[e + 1] = d[1]; acc[e + 2] = d[2]; acc[e + 3] = d[3]; }
#pragma unroll
        for (int j = 0; j < 4; ++j) {
            const int sj = s + j - 2;
            if (sj >= 0 && sj < T) {
                const u32x4_t xv = *(const u32x4_t*)(zr + (ptrdiff_t)(j - 2) * LDZ);
                const f32x4 wa = *(const f32x4*)(cw + j * 1024 + c0), wb = *(const f32x4*)(cw + j * 1024 + c0 + 4);
                acc[0] += wa[0] * bflo(xv[0]); acc[1] += wa[1] * bfhi(xv[0]); acc[2] += wa[2] * bflo(xv[1]); acc[3] += wa[3] * bfhi(xv[1]);
                acc[4] += wb[0] * bflo(xv[2]); acc[5] += wb[1] * bfhi(xv[2]); acc[6] += wb[2] * bflo(xv[3]); acc[7] += wb[3] * bfhi(xv[3]);
            }
        }
        u32x4_t w; w.x = pk2(acc[0], acc[1]); w.y = pk2(acc[2], acc[3]); w.z = pk2(acc[4], acc[5]); w.w = pk2(acc[6], acc[7]);
        *(u32x4_t*)(xc + (size_t)t * 1024 + c0) = w;
    }
}
__device__ __forceinline__ void rstd_item(const bf16_t* vT, float* rstd, int tg, int lane) {
    const bf16_t* p = vT + tg * 64 + lane; float a0 = 0.f, a1 = 0.f, a2 = 0.f, a3 = 0.f;
#pragma unroll 4
    for (int c = 0; c < 1024; c += 4) {
        const float v0 = bf2f(p[(size_t)c * SEG]), v1 = bf2f(p[(size_t)(c + 1) * SEG]), v2 = bf2f(p[(size_t)(c + 2) * SEG]), v3 = bf2f(p[(size_t)(c + 3) * SEG]);
        a0 += v0 * v0; a1 += v1 * v1; a2 += v2 * v2; a3 += v3 * v3;
    }
    rstd[tg * 64 + lane] = __builtin_amdgcn_rsqf(((a0 + a1) + (a2 + a3)) * (1.0f / 1024.0f) + EPS);
}

__device__ __forceinline__ void na_item(const bf16_t* z, const bf16_t* vT, bf16_t* y, const float* rpb, int item, int T, int lane) {
    const int g = item & 3, h = (item >> 2) & 15, R = item >> 6;
    const int rows = T >> 6, seq = R / rows, r = R - seq * rows, seq_base = seq * T;
    int rstart = r - 4; rstart = rstart < 0 ? 0 : rstart; rstart = rstart > rows - 8 ? rows - 8 : rstart;
    const int wb = (g == 0) ? 0 : (g == 1) ? 8 : (g == 2) ? 24 : 32;
    const int fr = lane & 15, fq = lane >> 4;
    const bf16_t* qp = z + (size_t)(seq_base + r * 64 + g * 16 + fr) * LDZ + 4096 + h * 64 + fq * 8;
    const bf16x8 q0 = ld8(qp), q1 = ld8(qp + 32);
    const int kcolA = wb + (fr >> 2) * 8 + (fr & 3);
    const int qc = g * 16 + fr;
    int cstart = qc - 8; cstart = cstart < 0 ? 0 : cstart; cstart = cstart > 48 ? 48 : cstart;
    float s[8][8];
    float mx = -1e30f;
#pragma unroll
    for (int kr = 0; kr < 8; ++kr) {
        const bf16_t* kp = z + (size_t)(seq_base + (rstart + kr) * 64 + kcolA) * LDZ + 5120 + h * 64 + fq * 8;
        const bf16x8 k00 = ld8(kp), k01 = ld8(kp + 32), k10 = ld8(kp + 4 * LDZ), k11 = ld8(kp + 4 * LDZ + 32);
        f32x4 a0 = {0.f, 0.f, 0.f, 0.f}, a1 = {0.f, 0.f, 0.f, 0.f};
        a0 = mfma16(k00, q0, a0); a0 = mfma16(k01, q1, a0);
        a1 = mfma16(k10, q0, a1); a1 = mfma16(k11, q1, a1);
        const int dr = rstart + kr - r + 7;
        const float* bp = rpb + (h * 15 + dr) * 31 + 15;
#pragma unroll
        for (int e = 0; e < 8; ++e) {
            const int kc = wb + fq * 8 + e;
            const bool ok = (kc >= cstart) && (kc < cstart + 16);
            int dc = kc - qc; dc = dc < -15 ? -15 : dc; dc = dc > 15 ? 15 : dc;
            const float sc = (e < 4 ? a0[e & 3] : a1[e & 3]) * 0.125f + bp[dc];
            s[kr][e] = ok ? sc : -1e30f;
            mx = fmaxf(mx, s[kr][e]);
        }
    }
    mx = fmaxf(mx, __shfl_xor(mx, 16)); mx = fmaxf(mx, __shfl_xor(mx, 32));
    float sum = 0.f;
#pragma unroll
    for (int kr = 0; kr < 8; ++kr)
#pragma unroll
        for (int e = 0; e < 8; ++e) { const float p = __expf(s[kr][e] - mx); s[kr][e] = p; sum += p; }
    sum += __shfl_xor(sum, 16); sum += __shfl_xor(sum, 32);
    f32x4 o[4];
#pragma unroll
    for (int dt = 0; dt < 4; ++dt) o[dt] = (f32x4){0.f, 0.f, 0.f, 0.f};
#pragma unroll
    for (int kr = 0; kr < 8; ++kr) {
        const bf16x8 pf = pack8(s[kr]);
        const bf16_t* vp = vT + (size_t)(h * 64 + fr) * SEG + seq_base + (rstart + kr) * 64 + wb + fq * 8;
#pragma unroll
        for (int dt = 0; dt < 4; ++dt) o[dt] = mfma16(pf, ld8(vp + (size_t)dt * 16 * SEG), o[dt]);
    }
    const float inv = frcp(sum);
#pragma unroll
    for (int jj = 0; jj < 4; ++jj) {
        const float iv = __shfl(inv, fq * 4 + jj);
        const int tok = seq_base + r * 64 + g * 16 + fq * 4 + jj;
#pragma unroll
        for (int dt = 0; dt < 4; ++dt) {
            const int d = dt * 16 + fr;
            const float gb = bf2f(z[(size_t)tok * LDZ + 6144 + h * 64 + d]);
            y[(size_t)tok * LDY + 1024 + h * 64 + d] = f2bf(o[dt][jj] * iv * silu(gb));
        }
    }
}

__device__ __forceinline__ void mem_item(const bf16_t* z, int qcol, int gcol, const bf16_t* mk, const bf16_t* mvT, bf16_t* y, int item, int seg, int lane) {
    const int h = item & 3, tg = item >> 2, tok0 = tg * 16;
    const int mb = seg < 2 ? seg : 2 + (tok0 >> 12);
    const int fr = lane & 15, fq = lane >> 4;
    const bf16_t* qp = z + (size_t)(tok0 + fr) * LDZ + qcol + h * 128 + fq * 8;
    bf16x8 q[4];
#pragma unroll
    for (int ks = 0; ks < 4; ++ks) q[ks] = ld8(qp + ks * 32);
    const int mrowA = (fr >> 2) * 8 + (fr & 3);
    float s[8][8];
    float mx = -1e30f;
#pragma unroll
    for (int kb = 0; kb < 8; ++kb) {
        const bf16_t* kp = mk + (size_t)(mb * 256 + kb * 32 + mrowA) * 512 + h * 128 + fq * 8;
        f32x4 a0 = {0.f, 0.f, 0.f, 0.f}, a1 = {0.f, 0.f, 0.f, 0.f};
#pragma unroll
        for (int ks = 0; ks < 4; ++ks) { a0 = mfma16(ld8(kp + ks * 32), q[ks], a0); a1 = mfma16(ld8(kp + 4 * 512 + ks * 32), q[ks], a1); }
#pragma unroll
        for (int e = 0; e < 8; ++e) { s[kb][e] = (e < 4 ? a0[e & 3] : a1[e & 3]) * 0.08838834764831845f; mx = fmaxf(mx, s[kb][e]); }
    }
    mx = fmaxf(mx, __shfl_xor(mx, 16)); mx = fmaxf(mx, __shfl_xor(mx, 32));
    float sum = 0.f;
#pragma unroll
    for (int kb = 0; kb < 8; ++kb)
#pragma unroll
        for (int e = 0; e < 8; ++e) { const float p = __expf(s[kb][e] - mx); s[kb][e] = p; sum += p; }
    sum += __shfl_xor(sum, 16); sum += __shfl_xor(sum, 32);
    f32x4 o[8];
#pragma unroll
    for (int dt = 0; dt < 8; ++dt) o[dt] = (f32x4){0.f, 0.f, 0.f, 0.f};
#pragma unroll
    for (int kb = 0; kb < 8; ++kb) {
        const bf16x8 pf = pack8(s[kb]);
        const bf16_t* vp = mvT + (size_t)(h * 128 + fr) * 1536 + mb * 256 + kb * 32 + fq * 8;
#pragma unroll
        for (int dt = 0; dt < 8; ++dt) o[dt] = mfma16(pf, ld8(vp + (size_t)dt * 16 * 1536), o[dt]);
    }
    const float inv = frcp(sum);
#pragma unroll
    for (int jj = 0; jj < 4; ++jj) {
        const float iv = __shfl(inv, fq * 4 + jj);
        const int tok = tok0 + fq * 4 + jj;
#pragma unroll
        for (int dt = 0; dt < 8; ++dt) {
            const int d = dt * 16 + fr;
            const float gm = bf2f(z[(size_t)tok * LDZ + gcol + h * 128 + d]);
            y[(size_t)tok * LDY + 2048 + h * 128 + d] = f2bf(o[dt][jj] * iv * silu(gm));
        }
    }
}

template <int CTRL> __device__ __forceinline__ float dppf(float oldv, float src) {
    return __int_as_float(__builtin_amdgcn_update_dpp(__float_as_int(oldv), __float_as_int(src), CTRL, 0xf, 0xf, false));
}
template <int DIR> __device__ __forceinline__ void scan16(float& A, float& B) {
    constexpr int BASE = DIR == 0 ? 0x110 : 0x100;
    { const float ap = dppf<BASE + 1>(1.f, A), bp = dppf<BASE + 1>(0.f, B); B = A * bp + B; A = A * ap; }
    { const float ap = dppf<BASE + 2>(1.f, A), bp = dppf<BASE + 2>(0.f, B); B = A * bp + B; A = A * ap; }
    { const float ap = dppf<BASE + 4>(1.f, A), bp = dppf<BASE + 4>(0.f, B); B = A * bp + B; A = A * ap; }
    { const float ap = dppf<BASE + 8>(1.f, A), bp = dppf<BASE + 8>(0.f, B); B = A * bp + B; A = A * ap; }
}
struct LruW { bf16x8 Wa[4], Wi[4]; float ba[4], bi[4], c8[4]; };
template <int DIR, bool FINAL> __device__ __forceinline__ void lru_tile(const bf16_t* xc, const LruW& W, int tok, int blk, int ch4, int lane, float (&hin)[4], float (&arun)[4], float (&hout)[4]) {
    const int fq = lane >> 4;
    const bf16_t* xp = xc + (size_t)tok * 1024 + blk * 128 + fq * 8;
    f32x4 accR = {0.f, 0.f, 0.f, 0.f}, accI = {0.f, 0.f, 0.f, 0.f};
#pragma unroll
    for (int ks = 0; ks < 4; ++ks) { const bf16x8 X = ld8(xp + ks * 32); accR = mfma16(W.Wa[ks], X, accR); accI = mfma16(W.Wi[ks], X, accI); }
    const u32x2_t xr = *(const u32x2_t*)(xc + (size_t)tok * 1024 + ch4);
    const float xv[4] = {bflo(xr.x), bfhi(xr.x), bflo(xr.y), bfhi(xr.y)};
    const int src = (lane & 48) + (DIR == 0 ? 15 : 0);
#pragma unroll
    for (int jj = 0; jj < 4; ++jj) {
        const float rg = sigm(accR[jj] + W.ba[jj]), ig = sigm(accI[jj] + W.bi[jj]);
        const float la = W.c8[jj] * rg;
        float A = __expf(la);
        float B = __builtin_amdgcn_sqrtf(fmaxf(1.0f - A * A, 0.f)) * (ig * xv[jj]);
        scan16<DIR>(A, B);
        const float hval = A * hin[jj] + B;
        hout[jj] = hval;
        hin[jj] = __shfl(hval, src);
        if (!FINAL) arun[jj] *= __shfl(A, src);
    }
}
template <bool FINAL> __device__ __forceinline__ void lru_item(const bf16_t* xc, const bf16_t* z, const bf16_t* lruw, const float* ba_, const float* bi_, const float* lam_,
                                                               float* agg, const float* carry, bf16_t* y, int item, int lane) {
    const int cgi = item & 63, chunk = item >> 6, blk = cgi >> 3, w = cgi & 7;
    const int fr = lane & 15, fq = lane >> 4;
    const int ch4 = blk * 128 + w * 16 + fq * 4;
    float hf[8][4];
#pragma unroll
    for (int dir = 0; dir < 2; ++dir) {
        LruW W;
        const bf16_t* wa = lruw + ((size_t)((0 * 2 + dir) * 8 + blk) * 128 + w * 16 + fr) * 128 + fq * 8;
        const bf16_t* wi = lruw + ((size_t)((1 * 2 + dir) * 8 + blk) * 128 + w * 16 + fr) * 128 + fq * 8;
#pragma unroll
        for (int ks = 0; ks < 4; ++ks) { W.Wa[ks] = ld8(wa + ks * 32); W.Wi[ks] = ld8(wi + ks * 32); }
        float hin[4], arun[4];
#pragma unroll
        for (int jj = 0; jj < 4; ++jj) {
            W.ba[jj] = ba_[dir * 1024 + ch4 + jj]; W.bi[jj] = bi_[dir * 1024 + ch4 + jj];
            const float lam = lam_[dir * 1024 + ch4 + jj];
            W.c8[jj] = -8.0f * log1pf(__expf(-lam));
            hin[jj] = FINAL ? carry[(size_t)(dir * 128 + chunk) * 1024 + ch4 + jj] : 0.f;
            arun[jj] = 1.f;
        }
#pragma unroll
        for (int step = 0; step < 8; ++step) {
            const int tt = dir == 0 ? step : 7 - step;
            const int tok = chunk * 128 + tt * 16 + fr;
            float hv[4];
            if (dir == 0) lru_tile<0, FINAL>(xc, W, tok, blk, ch4, lane, hin, arun, hv);
            else lru_tile<1, FINAL>(xc, W, tok, blk, ch4, lane, hin, arun, hv);
            if (FINAL) {
                if (dir == 0) {
#pragma unroll
                    for (int jj = 0; jj < 4; ++jj) hf[tt][jj] = hv[jj];
                } else {
                    const u32x2_t gr = *(const u32x2_t*)(z + (size_t)tok * LDZ + 1024 + ch4);
                    const float gc[4] = {bflo(gr.x), bfhi(gr.x), bflo(gr.y), bfhi(gr.y)};
                    float o[4];
#pragma unroll
                    for (int jj = 0; jj < 4; ++jj) o[jj] = (hf[tt][jj] + hv[jj]) * silu(gc[jj]);
                    u32x2_t ow; ow.x = pk2(o[0], o[1]); ow.y = pk2(o[2], o[3]);
                    *(u32x2_t*)(y + (size_t)tok * LDY + ch4) = ow;
                }
            }
        }
        if (!FINAL && fr == 0) {
#pragma unroll
            for (int jj = 0; jj < 4; ++jj) { float2 v; v.x = arun[jj]; v.y = hin[jj]; *(float2*)(agg + ((size_t)(dir * 128 + chunk) * 1024 + ch4 + jj) * 2) = v; }
        }
    }
}
__device__ __forceinline__ void carry_phase(const float* agg, float* carry, int nseq, int gtid, int gthreads) {
    const int nc = 128 / nseq;
    for (int idx = gtid; idx < 2 * nseq * 1024; idx += gthreads) {
        const int ch = idx & 1023, rest = idx >> 10, dir = rest & 1, sq = rest >> 1, base = sq * nc;
        float h = 0.f;
#pragma unroll 8
        for (int c = 0; c < nc; ++c) {
            const int C = base + (dir == 0 ? c : nc - 1 - c);
            const size_t o = (size_t)(dir * 128 + C) * 1024 + ch;
            const float2 ah = *(const float2*)(agg + o * 2);
            carry[o] = h;
            h = ah.x * h + ah.y;
        }
    }
}

__device__ __forceinline__ void sgu_item(const bf16_t* vT, const float* rstd, const bf16_t* z, const bf16_t* sguw, const float* sgu_g, const float* sgu_b, bf16_t* y, int item, int lane) {
    const int dd = item & 7, g = (item >> 3) & 7, n = item >> 6;
    const int fr = lane & 15, fq = lane >> 4;
    const int tokc = n * 128;
    const bf16_t* ap = vT + (size_t)(g * 128 + dd * 16 + fr) * SEG + tokc + fq * 8;
    bf16x8 Af[4];
#pragma unroll
    for (int ks = 0; ks < 4; ++ks) {
        const u32x4_t raw = *(const u32x4_t*)(ap + ks * 32);
        const f32x4 r0 = *(const f32x4*)(rstd + tokc + ks * 32 + fq * 8), r1 = *(const f32x4*)(rstd + tokc + ks * 32 + fq * 8 + 4);
        u32x4_t w;
        w.x = pk2(bflo(raw.x) * r0[0], bfhi(raw.x) * r0[1]); w.y = pk2(bflo(raw.y) * r0[2], bfhi(raw.y) * r0[3]);
        w.z = pk2(bflo(raw.z) * r1[0], bfhi(raw.z) * r1[1]); w.w = pk2(bflo(raw.w) * r1[2], bfhi(raw.w) * r1[3]);
        Af[ks] = __builtin_bit_cast(bf16x8, w);
    }
    const int ch4 = g * 128 + dd * 16 + fq * 4;
    const f32x4 g4 = *(const f32x4*)(sgu_g + ch4);
#pragma unroll
    for (int pt = 0; pt < 8; ++pt) {
        const int p = pt * 16 + fr;
        const bf16_t* bp = sguw + (size_t)(g * 128 + p) * 128 + fq * 8;
        f32x4 acc = {0.f, 0.f, 0.f, 0.f};
#pragma unroll
        for (int ks = 0; ks < 4; ++ks) acc = mfma16(Af[ks], ld8(bp + ks * 32), acc);
        const int tok = tokc + p;
        const float bsv = sgu_b[g * 128 + p];
        const u32x2_t ur = *(const u32x2_t*)(z + (size_t)tok * LDZ + 2048 + ch4), gr = *(const u32x2_t*)(z + (size_t)tok * LDZ + 3072 + ch4);
        const float uu[4] = {bflo(ur.x), bfhi(ur.x), bflo(ur.y), bfhi(ur.y)}, gd[4] = {bflo(gr.x), bfhi(gr.x), bflo(gr.y), bfhi(gr.y)};
        float o[4];
#pragma unroll
        for (int jj = 0; jj < 4; ++jj) o[jj] = uu[jj] * (acc[jj] * g4[jj] + bsv) * silu(gd[jj]);
        u32x2_t ow; ow.x = pk2(o[0], o[1]); ow.y = pk2(o[2], o[3]);
        *(u32x2_t*)(y + (size_t)tok * LDY + 1024 + ch4) = ow;
    }
}

__global__ void __launch_bounds__(512, 2) fwd_megakernel(Params P) {
    extern __shared__ __attribute__((aligned(16))) unsigned char shm[];
    cg::grid_group grid = cg::this_grid();
    PG8_LAS unsigned char* lds = (PG8_LAS unsigned char*)shm;
    const int G = gridDim.x, NW = G * 8;
#define FRESH_TID() int tid = threadIdx.x; asm volatile("" : "+v"(tid)); const int lane = tid & 63, wid = tid >> 6, gw = blockIdx.x * 8 + wid; (void)lane; (void)gw
    unsigned char* ws = P.ws;
    bf16_t* WIN_E = (bf16_t*)(ws + WS_WIN_E); bf16_t* WIN_O = (bf16_t*)(ws + WS_WIN_O);
    bf16_t* WOUT_E = (bf16_t*)(ws + WS_WOUT_E); bf16_t* WOUT_O = (bf16_t*)(ws + WS_WOUT_O);
    bf16_t* WKV = (bf16_t*)(ws + WS_WKV); bf16_t* LRUW = (bf16_t*)(ws + WS_LRUW); bf16_t* SGUW = (bf16_t*)(ws + WS_SGUW);
    bf16_t* MEMN = (bf16_t*)(ws + WS_MEMN); bf16_t* MK = (bf16_t*)(ws + WS_MK); bf16_t* MVT = (bf16_t*)(ws + WS_MVT);
    bf16_t* H = (bf16_t*)(ws + WS_H); bf16_t* Z = (bf16_t*)(ws + WS_Z); bf16_t* VT = (bf16_t*)(ws + WS_VT); bf16_t* Y = (bf16_t*)(ws + WS_Y);
    float* AGG = (float*)(ws + WS_AGG); float* CARRY = (float*)(ws + WS_CARRY); float* RSTD = (float*)(ws + WS_RSTD);

    unsigned* BAR = (unsigned*)(ws + WS_BAR);
    volatile LAS unsigned* xst = (volatile LAS unsigned*)(lds + 131072);
    {
        FRESH_TID();
        if (tid < 2) xst[tid] = 0u;
        if (blockIdx.x == 0) for (int i = tid; i < XCD_BAR_WORDS; i += 512) BAR[i] = 0u;
        float* scr = (float*)shm;
        constexpr int I0 = 16 * 144, I1 = 16 * 96, I2 = 40 * 16, I3 = 40 * 16, I4 = 256, I5 = 256, I6 = 64, I7 = 64;
        constexpr int NIT = I0 + I1 + I2 + I3 + I4 + I5 + I6 + I7;
        for (int it = blockIdx.x; it < NIT; it += G) {
            int r = it;
            if (r < I0) { transpose_tile(P.in[7], 1024, 9216, WIN_E, r, scr); continue; } r -= I0;
            if (r < I1) { transpose_tile(P.in[12], 1024, 6144, WIN_O, r, scr); continue; } r -= I1;
            if (r < I2) { transpose_tile(P.in[11], 2560, 1024, WOUT_E, r, scr); continue; } r -= I2;
            if (r < I3) { transpose_tile(P.in[23], 2560, 1024, WOUT_O, r, scr); continue; } r -= I3;
            if (r < I4) { transpose_tile(P.in[6], 1024, 1024, WKV, r, scr); continue; } r -= I4;
            if (r < I5) { transpose_tile(P.in[6] + (size_t)1024 * 1024, 1024, 1024, WKV + (size_t)1024 * 1024, r, scr); continue; } r -= I5;
            if (r < I6) { const int m = r >> 2; transpose_tile(P.in[15] + (size_t)m * 16384, 128, 128, LRUW + (size_t)m * 16384, r & 3, scr); continue; } r -= I6;
            { const int m = r >> 2; transpose_tile(P.in[17] + (size_t)m * 16384, 128, 128, LRUW + (size_t)(16 + m) * 16384, r & 3, scr); }
        }
        for (int i = blockIdx.x * 512 + tid; i < 8 * 128 * 128; i += G * 512) SGUW[i] = f2bf(P.in[21][i]);
        for (int it = gw; it < 2 * 1536; it += NW) {
            const int l = it / 1536, row = it - l * 1536;
            const float* src = row < 512 ? P.in[2] + (size_t)row * 1024 : P.in[3] + (size_t)(row - 512) * 1024;
            rms_row_bf16(src, P.in[5] + l * 1024, MEMN + ((size_t)l * 1536 + row) * 1024, lane);
        }
    }

    grid.sync();
    const XcdBarrier xb = xcd_barrier_post(BAR, xst);
    for (int seg = 0; seg < 3; ++seg) {
        const float* xin = seg < 2 ? P.in[0] + (size_t)seg * SEG * 1024 : P.in[1];
        float* xout = P.out + (size_t)seg * SEG * 1024;
        const int T = seg < 2 ? 16384 : 4096, nseq = seg < 2 ? 1 : 4;

        { FRESH_TID();
        for (int it = gw; it < SEG; it += NW) rms_row_bf16(xin + (size_t)it * 1024, P.in[4], H + (size_t)it * 1024, lane); }
        xcd_barrier(xb);

        {
            pg8::Gemm g; g.A = H; g.Bt = WIN_E; g.M = SEG; g.N = 8192; g.K = 1024;
            pg8::SkipOrder S; S.init(SEG, 8192, G, blockIdx.x); S.skip_from = 24; S.skip_n = 4;
            pg8::EpiZ E; E.O = Z; E.ldc = LDZ; E.skip_from = 24; E.skip_n = 4;
            pg8::gemm_phase(lds, g, S, E);
        }
        {
            pg8::Gemm g; g.A = WIN_E + (size_t)6144 * 1024; g.Bt = H; g.M = 1024; g.N = SEG; g.K = 1024;
            pg8::SkipOrder S; S.init(1024, SEG, G, blockIdx.x); S.skip_from = 1 << 20; S.skip_n = 0;
            pg8::EpiZ E; E.O = VT; E.ldc = SEG; E.skip_from = 1 << 20; E.skip_n = 0;
            pg8::gemm_phase(lds, g, S, E);
        }
        if (seg == 0) {
#pragma unroll 1
            for (int l = 0; l < 2; ++l) {
                {
                    pg8::Gemm g; g.A = MEMN + (size_t)l * 1536 * 1024; g.Bt = WKV + (size_t)l * 1024 * 1024; g.M = 1536; g.N = 512; g.K = 1024;
                    pg8::SkipOrder S; S.init(1536, 512, G, (blockIdx.x + G - (32 * l) % G) % G); S.skip_from = 1 << 20; S.skip_n = 0;
                    pg8::EpiZ E; E.O = MK + (size_t)l * 1536 * 512; E.ldc = 512; E.skip_from = 1 << 20; E.skip_n = 0;
                    pg8::gemm_phase(lds, g, S, E);
                }
                {
                    pg8::Gemm g; g.A = WKV + (size_t)l * 1024 * 1024 + (size_t)512 * 1024; g.Bt = MEMN + (size_t)l * 1536 * 1024; g.M = 512; g.N = 1536; g.K = 1024;
                    pg8::SkipOrder S; S.init(512, 1536, G, (blockIdx.x + G - (32 * l + 16) % G) % G); S.skip_from = 1 << 20; S.skip_n = 0;
                    pg8::EpiZ E; E.O = MVT + (size_t)l * 512 * 1536; E.ldc = 1536; E.skip_from = 1 << 20; E.skip_n = 0;
                    pg8::gemm_phase(lds, g, S, E);
                }
            }
        }
        xcd_barrier(xb);

        { FRESH_TID();
        for (int it = gw; it < 16384 + 4096 + 16384; it += NW) {
            if (it < 16384) na_item(Z, VT, Y, P.in[10], it, T, lane);
            else if (it < 16384 + 4096) mem_item(Z, 7168, 7680, MK, MVT, Y, it - 16384, seg, lane);
            else conv_even_item(Z, P.in[8], P.in[9], Y, it - 20480, T, lane);
        } }
        xcd_barrier(xb);

        {
            pg8::Gemm g; g.A = Y; g.Bt = WOUT_E; g.M = SEG; g.N = 1024; g.K = 2560;
            pg8::StaticOrder S; S.init(SEG, 1024, G, blockIdx.x);
            pg8::EpiRes E; E.xin = xin; E.out = xout;
            pg8::gemm_phase(lds, g, S, E);
        }
        xcd_barrier(xb);

        { FRESH_TID();
        for (int it = gw; it < SEG; it += NW) rms_row_bf16(xout + (size_t)it * 1024, P.in[4] + 1024, H + (size_t)it * 1024, lane); }
        xcd_barrier(xb);

        {
            pg8::Gemm g; g.A = H; g.Bt = WIN_O; g.M = SEG; g.N = 5120; g.K = 1024;
            pg8::SkipOrder S; S.init(SEG, 5120, G, blockIdx.x); S.skip_from = 12; S.skip_n = 4;
            pg8::EpiZ E; E.O = Z; E.ldc = LDZ; E.skip_from = 12; E.skip_n = 4;
            pg8::gemm_phase(lds, g, S, E);
        }
        {
            pg8::Gemm g; g.A = WIN_O + (size_t)3072 * 1024; g.Bt = H; g.M = 1024; g.N = SEG; g.K = 1024;
            pg8::SkipOrder S; S.init(1024, SEG, G, blockIdx.x); S.skip_from = 1 << 20; S.skip_n = 0;
            pg8::EpiZ E; E.O = VT; E.ldc = SEG; E.skip_from = 1 << 20; E.skip_n = 0;
            pg8::gemm_phase(lds, g, S, E);
        }
        xcd_barrier(xb);

        { FRESH_TID();
        for (int it = gw; it < SEG + 256; it += NW) {
            if (it < SEG) conv_odd_item(Z, P.in[13], P.in[14], H, it, T, lane);
            else rstd_item(VT, RSTD, it - SEG, lane);
        } }
        xcd_barrier(xb);

        { FRESH_TID();
        for (int it = gw; it < 8192 + 8192 + 4096; it += NW) {
            if (it < 8192) lru_item<false>(H, Z, LRUW, P.in[16], P.in[18], P.in[19], AGG, CARRY, Y, it, lane);
            else if (it < 16384) sgu_item(VT, RSTD, Z, SGUW, P.in[20], P.in[22], Y, it - 8192, lane);
            else mem_item(Z, 4096, 4608, MK + (size_t)1536 * 512, MVT + (size_t)512 * 1536, Y, it - 16384, seg, lane);
        } }
        xcd_barrier(xb);

        { FRESH_TID(); carry_phase(AGG, CARRY, nseq, blockIdx.x * 512 + tid, G * 512); }
        xcd_barrier(xb);

        { FRESH_TID();
        for (int it = gw; it < 8192; it += NW) lru_item<true>(H, Z, LRUW, P.in[16], P.in[18], P.in[19], AGG, CARRY, Y, it, lane); }
        xcd_barrier(xb);

        {
            pg8::Gemm g; g.A = Y; g.Bt = WOUT_O; g.M = SEG; g.N = 1024; g.K = 2560;
            pg8::StaticOrder S; S.init(SEG, 1024, G, blockIdx.x);
            pg8::EpiRes E; E.xin = xout; E.out = xout;
            pg8::gemm_phase(lds, g, S, E);
        }
        xcd_barrier(xb);

        { FRESH_TID();
        for (int it = gw; it < SEG; it += NW) rms_row_f32(xout + (size_t)it * 1024, P.in[24], lane); }
    }
}

extern "C" void kernel_launch(void* const* d_in, const int* in_sizes, int n_in, void* d_out, int out_size, void* d_ws, size_t ws_size, hipStream_t stream) {
    static int grid_blocks = 0;
    if (grid_blocks == 0) {
        if (n_in != 25 || ws_size < WS_END) { fprintf(stderr, "kernel_launch: need 25 inputs and %zu bytes of workspace; got %d, %zu\n", (size_t)WS_END, n_in, ws_size); grid_blocks = -1; return; }
        int dev = 0, cus = 0, per_cu = 0;
        hipGetDevice(&dev);
        hipDeviceGetAttribute(&cus, hipDeviceAttributeMultiprocessorCount, dev);
        hipFuncSetAttribute((const void*)fwd_megakernel, hipFuncAttributeMaxDynamicSharedMemorySize, LDS_BYTES);
        hipOccupancyMaxActiveBlocksPerMultiprocessor(&per_cu, (const void*)fwd_megakernel, 512, LDS_BYTES);
        if (per_cu < 1) { fprintf(stderr, "kernel_launch: occupancy query says %d blocks per CU\n", per_cu); grid_blocks = -1; return; }
        grid_blocks = cus;
    }
    if (grid_blocks < 0) return;
    Params p{};
    for (int i = 0; i < 25; ++i) p.in[i] = (const float*)d_in[i];
    p.out = (float*)d_out; p.ws = (unsigned char*)d_ws;
    void* args[] = {&p};
    hipError_t e = hipLaunchCooperativeKernel((const void*)fwd_megakernel, dim3(grid_blocks), dim3(512), args, LDS_BYTES, stream);
    if (e != hipSuccess) fprintf(stderr, "cooperative launch failed: %s (grid %d)\n", hipGetErrorString(e), grid_blocks);
}
```

```cpp
#include <hip/hip_runtime.h>
#include <hip/hip_cooperative_groups.h>
#include <cstdio>
namespace cg = cooperative_groups;
namespace pg8 {
#define PG8_LAS __attribute__((address_space(3)))
typedef unsigned short bf16_t;
typedef short bf16x8 __attribute__((ext_vector_type(8)));
typedef float f32x4 __attribute__((ext_vector_type(4)));
typedef unsigned u32x4 __attribute__((ext_vector_type(4)));
constexpr int BM = 256, BK = 64, HALF = 128, HTB = HALF * BK * 2  , STAGE_BYTES = 8 * HTB, NXCD = 8, WGM = 8;

__host__ __device__ __forceinline__ int lds_byte(int r, int c) { const int st = (r >> 4) * 2 + (c >> 5), rr = r & 15, cc = c & 31, ob = rr * 64 + cc * 2; return st * 1024 + (ob ^ (((ob >> 9) & 1) << 5)); }
__host__ __device__ __forceinline__ void stage_rc(int b, int& R, int& C) { const int st = b / 1024, sb = b % 1024, swz = sb ^ (((sb >> 9) & 1) << 5); R = (st >> 1) * 16 + swz / 64; C = (st & 1) * 32 + (swz % 64) / 2; }
__host__ __device__ __forceinline__ int perm32(int rho) { const int n = rho >> 4, i = rho & 15; return 8 * (i >> 2) + 4 * n + (i & 3); }

struct Unit { int pm, pn; };
struct Gemm { const bf16_t* A; const bf16_t* Bt; int M, N, K; };

struct StaticOrder {
    int nM, nN, nwg, G, c;
    __host__ __device__ void init(int M, int N, int G_, int c_) { nM = M / BM; nN = N / BM; nwg = nM * nN; G = G_; c = c_; }
    __host__ __device__ bool next(int i, Unit& u) const {
        const long L = (long)i * G + c; if (L >= nwg) return false;
        int wgid = (int)L; { const int q = nwg / NXCD, r = nwg % NXCD, xcd = wgid % NXCD, off = wgid / NXCD; wgid = (xcd < r ? xcd * (q + 1) : r * (q + 1) + (xcd - r) * q) + off; }
        const int nig = WGM * nN, gid = wgid / nig, fm = gid * WGM, gsz = (nM - fm) < WGM ? (nM - fm) : WGM;
        u.pm = fm + ((wgid % nig) % gsz); u.pn = (wgid % nig) / gsz; return true;
    }
    __device__ __forceinline__ void a_ready(const Unit&) const {}
    __device__ __forceinline__ void done(const Unit&) const {}
};

struct SkipOrder : StaticOrder {
    int skip_from, skip_n;
    __device__ __forceinline__ bool next(int i, Unit& u) const {
        if (!StaticOrder::next(i, u)) return false;
        if (u.pn >= skip_from) u.pn += skip_n;
        return true;
    }
};

__device__ __forceinline__ unsigned cvt_pk_bf16(float lo, float hi) { unsigned r; asm volatile("v_cvt_pk_bf16_f32 %0, %1, %2" : "=v"(r) : "v"(lo), "v"(hi)); return r; }

struct EpiZ {
    static constexpr bool PERM = true, AFTER_DRAIN = false;
    bf16_t* O; int ldc; int skip_from, skip_n; float* colsq; int colsq_ld;
    __device__ __forceinline__ void operator()(const f32x4 (&acc)[2][2][4][2], const Unit& u, int wr, int wc, int fr, int fq) const {
        const int row0 = u.pm * BM + wr * 64 + fr; const int ct = (u.pn >= skip_from + skip_n) ? (u.pn - skip_n) : u.pn;
        const int col0 = ct * BM + wc * 32 + 8 * fq;
#pragma unroll
        for (int ai = 0; ai < 2; ++ai)
#pragma unroll
            for (int m = 0; m < 4; ++m) { bf16_t* rowp = O + (size_t)(row0 + ai * HALF + m * 16) * ldc + col0;
#pragma unroll
                for (int bj = 0; bj < 2; ++bj) { const f32x4 v0 = acc[ai][bj][m][0], v1 = acc[ai][bj][m][1];
                    u32x4 w; w.x = cvt_pk_bf16(v0[0], v0[1]); w.y = cvt_pk_bf16(v0[2], v0[3]); w.z = cvt_pk_bf16(v1[0], v1[1]); w.w = cvt_pk_bf16(v1[2], v1[3]);
                    *(u32x4*)(rowp + bj * HALF) = w; } }
        if (colsq) {
#pragma unroll
            for (int bj = 0; bj < 2; ++bj)
#pragma unroll
                for (int n = 0; n < 2; ++n) {
                    f32x4 ss = {0.f, 0.f, 0.f, 0.f};
#pragma unroll
                    for (int ai = 0; ai < 2; ++ai)
#pragma unroll
                        for (int m = 0; m < 4; ++m) ss += acc[ai][bj][m][n] * acc[ai][bj][m][n];
#pragma unroll
                    for (int o = 1; o < 16; o <<= 1) { ss[0] += __shfl_xor(ss[0], o); ss[1] += __shfl_xor(ss[1], o); ss[2] += __shfl_xor(ss[2], o); ss[3] += __shfl_xor(ss[3], o); }
                    if (fr == 0) *(f32x4*)(colsq + (size_t)(2 * u.pm + wr) * colsq_ld + ct * BM + bj * HALF + wc * 32 + 8 * fq + 4 * n) = ss;
                }
        }
    }
};
struct EpiRes {
    static constexpr bool PERM = false, AFTER_DRAIN = false;
    const float* xin; float* out;
    __device__ __forceinline__ void operator()(const f32x4 (&acc)[2][2][4][2], const Unit& u, int wr, int wc, int fr, int fq) const {
        const int row0 = u.pm * BM + wr * 64 + fr, col0 = u.pn * BM + wc * 32 + 4 * fq;
#pragma unroll
        for (int ai = 0; ai < 2; ++ai)
#pragma unroll
            for (int m = 0; m < 4; ++m) { const size_t ro = (size_t)(row0 + ai * HALF + m * 16) * 1024 + col0;
#pragma unroll
                for (int bj = 0; bj < 2; ++bj)
#pragma unroll
                    for (int n = 0; n < 2; ++n) { const f32x4 xv = *(const f32x4*)(xin + ro + bj * HALF + n * 16);
                        *(f32x4*)(out + ro + bj * HALF + n * 16) = acc[ai][bj][m][n] + xv; } }
    }
};

template <class Epi, class Sched>
__device__ __forceinline__ void gemm_phase(PG8_LAS unsigned char* lds, const Gemm g, const Sched& S, const Epi& E) {
    int tid = threadIdx.x; asm volatile("" : "+v"(tid));
    const int wid = __builtin_amdgcn_readfirstlane(tid >> 6), lane = tid & 63, wr = wid >> 2, wc = wid & 3, fr = lane & 15, fq = lane >> 4;
    const int K = g.K, nt = K / BK;
    const char* gA = (const char*)g.A; const char* gB = (const char*)g.Bt; asm volatile("" : "+s"(gA), "+s"(gB));
    unsigned voffA[2], voffB[2];
#pragma unroll
    for (int i = 0; i < 2; ++i) { int R, C; stage_rc(tid * 16 + i * 8192, R, C); const int Rb = Epi::PERM ? ((R & ~31) + perm32(R & 31)) : R;
        voffA[i] = (unsigned)(R * K + C) * 2u; voffB[i] = (unsigned)(Rb * K + C) * 2u; }
    const size_t kstep = (size_t)(BK * 2);
    const size_t hstep = (size_t)HALF * K * 2;
    const size_t tstep = 2 * hstep;
    const unsigned ldsw = (unsigned)wid * 1024u;
    const int aoff = lds_byte(wr * 64 + fr, fq * 8), boff = lds_byte(wc * 32 + fr, fq * 8);
#define PG8_SA(b, h) (((b) * 2 + (h)) * HTB)
#define PG8_SB(b, h) ((4 + (b) * 2 + (h)) * HTB)
#define PG8_STAGE(bufoff, gbase, voff) do { _Pragma("unroll") for (int _i = 0; _i < 2; ++_i) \
        __builtin_amdgcn_global_load_lds((const unsigned*)((const char*)(gbase) + (voff)[_i]), (PG8_LAS unsigned*)(lds + (bufoff) + ldsw + _i * 8192), 16, 0, 0); } while (0)
#define PG8_LDA(dst, b, h) do { _Pragma("unroll") for (int m = 0; m < 4; ++m) _Pragma("unroll") for (int k = 0; k < 2; ++k) dst[m][k] = *(const PG8_LAS bf16x8*)(lds + PG8_SA(b, h) + aoff + m * 2048 + k * 1024); } while (0)
#define PG8_LDB(dst, b, h) do { _Pragma("unroll") for (int n = 0; n < 2; ++n) _Pragma("unroll") for (int k = 0; k < 2; ++k) dst[n][k] = *(const PG8_LAS bf16x8*)(lds + PG8_SB(b, h) + boff + n * 2048 + k * 1024); } while (0)
#define PG8_MMA(ai, bj, At, Bt) do { __builtin_amdgcn_s_setprio(1); _Pragma("unroll") for (int m = 0; m < 4; ++m) _Pragma("unroll") for (int n = 0; n < 2; ++n) _Pragma("unroll") for (int k = 0; k < 2; ++k) \
        acc[ai][bj][m][n] = __builtin_amdgcn_mfma_f32_16x16x32_bf16(Bt[n][k], At[m][k], acc[ai][bj][m][n], 0, 0, 0); __builtin_amdgcn_s_setprio(0); } while (0)
#define PG8_WAIT_V(n) asm volatile("s_waitcnt vmcnt(" #n ")" ::: "memory")
#define PG8_WAIT_L(n) asm volatile("s_waitcnt lgkmcnt(" #n ")" ::: "memory")
#define PG8_BAR __builtin_amdgcn_s_barrier()
#define PG8_SCHED __builtin_amdgcn_sched_barrier(0)
    Unit cur, nxt; int ui = 0;
    if (!S.next(0, cur)) return;
    f32x4 acc[2][2][4][2];
#pragma unroll
    for (int a = 0; a < 2; ++a)
#pragma unroll
        for (int b = 0; b < 2; ++b)
#pragma unroll
            for (int m = 0; m < 4; ++m)
#pragma unroll
                for (int n = 0; n < 2; ++n) acc[a][b][m][n] = (f32x4){0.f, 0.f, 0.f, 0.f};
    bf16x8 At[4][2], B0[2][2], B1[2][2];
    const char* cA = gA + (size_t)cur.pm * tstep; const char* cB = gB + (size_t)cur.pn * tstep;
    S.a_ready(cur);
    PG8_STAGE(PG8_SB(0, 0), cB, voffB); PG8_STAGE(PG8_SA(0, 0), cA, voffA); PG8_STAGE(PG8_SB(0, 1), cB + hstep, voffB); PG8_STAGE(PG8_SA(0, 1), cA + hstep, voffA);
    if (wr == 1) PG8_BAR;
    PG8_WAIT_V(4); PG8_BAR;
    PG8_STAGE(PG8_SB(1, 0), cB + kstep, voffB); PG8_STAGE(PG8_SA(1, 0), cA + kstep, voffA); PG8_STAGE(PG8_SB(1, 1), cB + hstep + kstep, voffB);
    PG8_WAIT_V(6); PG8_BAR;
    for (;;) {
        const bool has_next = S.next(ui + 1, nxt);
        const char* nA = has_next ? gA + (size_t)nxt.pm * tstep : cA; const char* nB = has_next ? gB + (size_t)nxt.pn * tstep : cB;
        for (int t = 0; t < nt; t += 2) {
            const bool last = (t == nt - 2);
            const char* a1 = cA + (size_t)(t + 1) * kstep;
            const char* a2 = last ? nA : cA + (size_t)(t + 2) * kstep; const char* b2 = last ? nB : cB + (size_t)(t + 2) * kstep;
            const char* a3 = a2 + kstep; const char* b3 = b2 + kstep;
            if (last && has_next) S.a_ready(nxt);
            PG8_LDB(B0, 0, 0); PG8_SCHED; PG8_LDA(At, 0, 0); PG8_STAGE(PG8_SA(1, 1), a1 + hstep, voffA);
            PG8_WAIT_L(8); PG8_BAR; PG8_WAIT_L(0); PG8_MMA(0, 0, At, B0); PG8_BAR; PG8_SCHED;
            PG8_LDB(B1, 0, 1); PG8_STAGE(PG8_SB(0, 0), b2, voffB);
            PG8_BAR; PG8_WAIT_L(0); PG8_MMA(0, 1, At, B1); PG8_BAR;
            PG8_LDA(At, 0, 1); PG8_STAGE(PG8_SA(0, 0), a2, voffA);
            PG8_BAR; PG8_WAIT_L(0); PG8_MMA(1, 0, At, B0); PG8_BAR; PG8_SCHED;
            PG8_STAGE(PG8_SB(0, 1), b2 + hstep, voffB);
            PG8_WAIT_V(6); PG8_BAR; PG8_MMA(1, 1, At, B1); PG8_BAR;
            PG8_LDB(B0, 1, 0); PG8_SCHED; PG8_LDA(At, 1, 0); PG8_STAGE(PG8_SA(0, 1), a2 + hstep, voffA);
            PG8_WAIT_L(8); PG8_BAR; PG8_WAIT_L(0); PG8_MMA(0, 0, At, B0); PG8_BAR; PG8_SCHED;
            PG8_LDB(B1, 1, 1); PG8_STAGE(PG8_SB(1, 0), b3, voffB);
            PG8_BAR; PG8_WAIT_L(0); PG8_MMA(0, 1, At, B1); PG8_BAR;
            PG8_LDA(At, 1, 1); PG8_STAGE(PG8_SA(1, 0), a3, voffA);
            PG8_BAR; PG8_WAIT_L(0); PG8_MMA(1, 0, At, B0); PG8_BAR; PG8_SCHED;
            PG8_STAGE(PG8_SB(1, 1), b3 + hstep, voffB);
            PG8_WAIT_V(6); PG8_BAR; PG8_MMA(1, 1, At, B1); PG8_BAR;
        }
        if constexpr (!Epi::AFTER_DRAIN) { E(acc, cur, wr, wc, fr, fq); S.done(cur); }
        if (!has_next) break;
#pragma unroll
        for (int a = 0; a < 2; ++a)
#pragma unroll
            for (int b = 0; b < 2; ++b)
#pragma unroll
                for (int m = 0; m < 4; ++m)
#pragma unroll
                    for (int n = 0; n < 2; ++n) acc[a][b][m][n] = (f32x4){0.f, 0.f, 0.f, 0.f};
        cur = nxt; cA = nA; cB = nB; ++ui;
    }
    PG8_WAIT_V(0);
    if (wr == 0) PG8_BAR;
    PG8_BAR;
    if constexpr (Epi::AFTER_DRAIN) { E.fused(acc, cur, wr, wc, fr, fq, lds, wid, lane); S.done(cur); }
#undef PG8_SA
#undef PG8_SB
#undef PG8_STAGE
#undef PG8_LDA
#undef PG8_LDB
#undef PG8_MMA
#undef PG8_WAIT_V
#undef PG8_WAIT_L
#undef PG8_BAR
#undef PG8_SCHED
}
}

#define XB_TMO      128
#define XB_XCNT(j)  (256  + 64 * (j))
#define XB_XSUB(j)  (1280 + 64 * (j))
#define XB_XGEN(j)  (2304 + 64 * (j))
#define XB_TOP      3328
#define XB_TOPGEN   3392
#define XCD_BAR_WORDS 3456
#define XB_SPIN_CAP (1u << 18)
#define LAS __attribute__((address_space(3)))

__device__ __forceinline__ unsigned xb_ld(unsigned* p)              { return __hip_atomic_load(p, __ATOMIC_RELAXED, __HIP_MEMORY_SCOPE_AGENT); }
__device__ __forceinline__ unsigned xb_add(unsigned* p, unsigned v) { return __hip_atomic_fetch_add(p, v, __ATOMIC_RELAXED, __HIP_MEMORY_SCOPE_AGENT); }
__device__ __forceinline__ unsigned xb_xcc_id() { return (unsigned)__builtin_amdgcn_s_getreg((3 << 11) | 20) & 0xFu; }
#define XB_SPIN(cond, bar) do { unsigned _sp = 0; while (cond) { __builtin_amdgcn_s_sleep(1); \
    if ((++_sp & 255u) == 0u) { if (xb_ld(&(bar)[XB_TMO])) break; if (_sp > XB_SPIN_CAP) { atomicAdd(&(bar)[XB_TMO], 1u); break; } } } } while (0)

struct XcdBarrier {
    unsigned* bar; unsigned x;
    volatile LAS unsigned* st;
};

__device__ __forceinline__ XcdBarrier xcd_barrier_post(unsigned* bar, volatile LAS unsigned* st) {
    XcdBarrier b; b.bar = bar; b.x = xb_xcc_id(); b.st = st;
    if (threadIdx.x == 0) (void)xb_add(&bar[XB_XCNT(b.x)], 1u);
    return b;
}
__device__ __forceinline__ void xcd_barrier_complete(unsigned* bar, unsigned x, unsigned& nloc, unsigned& nx) {
    const unsigned G = gridDim.x * gridDim.y * gridDim.z;
    unsigned sum, cnt, mine, sp = 0u;
    for (;;) {
        sum = 0u; cnt = 0u; mine = 0u;
#pragma unroll
        for (unsigned j = 0; j < 16; ++j) { const unsigned c = xb_ld(&bar[XB_XCNT(j)]); sum += c; cnt += (c > 0u) ? 1u : 0u; mine = (j == x) ? c : mine; }
        if (sum == G) break;
        __builtin_amdgcn_s_sleep(1);
        if ((++sp & 255u) == 0u) { if (xb_ld(&bar[XB_TMO])) break; if (sp > XB_SPIN_CAP) { atomicAdd(&bar[XB_TMO], 1u); break; } }
    }
    nloc = mine > 0u ? mine : 1u; nx = cnt > 0u ? cnt : 1u;
}

__device__ __forceinline__ void xcd_barrier(const XcdBarrier& b) {
    asm volatile("s_waitcnt vmcnt(0)" ::: "memory");
    __syncthreads();
    if (threadIdx.x == 0) {
        unsigned* bar = b.bar;
        __builtin_amdgcn_s_waitcnt(0);
        unsigned nloc = b.st[0], nx = b.st[1];
        if (nloc == 0u) { xcd_barrier_complete(bar, b.x, nloc, nx); b.st[0] = nloc; b.st[1] = nx; }
        const unsigned old = xb_add(&bar[XB_XSUB(b.x)], 1u);
        const unsigned gen = old / nloc;
        if (old + 1u == (gen + 1u) * nloc) {
            __builtin_amdgcn_fence(__ATOMIC_RELEASE, "agent");
            asm volatile("s_waitcnt vmcnt(0)" ::: "memory");
            const unsigned og = xb_add(&bar[XB_TOP], 1u);
            const unsigned tg = og / nx;
            if (og + 1u == (tg + 1u) * nx) xb_add(&bar[XB_TOPGEN], 1u);
            else XB_SPIN(xb_ld(&bar[XB_TOPGEN]) == tg, bar);
            __builtin_amdgcn_fence(__ATOMIC_ACQUIRE, "agent");
            xb_add(&bar[XB_XGEN(b.x)], 1u);
            asm volatile("s_waitcnt vmcnt(0)" ::: "memory");
        } else {
            XB_SPIN(xb_ld(&bar[XB_XGEN(b.x)]) == gen, bar);
            __builtin_amdgcn_fence(__ATOMIC_ACQUIRE, "agent");
            asm volatile("s_waitcnt vmcnt(0)" ::: "memory");
        }
    }
    __syncthreads();
}

using pg8::bf16_t; using pg8::bf16x8; using pg8::f32x4;
typedef unsigned u32x2_t __attribute__((ext_vector_type(2)));
typedef unsigned u32x4_t __attribute__((ext_vector_type(4)));

constexpr int DM = 1024, SEG = 16384, LDZ = 8192, LDY = 2560;
constexpr float EPS = 1e-6f;
constexpr int LDS_BYTES = 131072 + 64;
constexpr size_t WS_WIN_E = 0;
constexpr size_t WS_WIN_O = WS_WIN_E + (size_t)9216 * 1024 * 2;
constexpr size_t WS_WOUT_E = WS_WIN_O + (size_t)6144 * 1024 * 2;
constexpr size_t WS_WOUT_O = WS_WOUT_E + (size_t)1024 * 2560 * 2;
constexpr size_t WS_WKV = WS_WOUT_O + (size_t)1024 * 2560 * 2;
constexpr size_t WS_LRUW = WS_WKV + (size_t)2 * 1024 * 1024 * 2;
constexpr size_t WS_SGUW = WS_LRUW + (size_t)2 * 2 * 8 * 128 * 128 * 2;
constexpr size_t WS_MEMN = WS_SGUW + (size_t)8 * 128 * 128 * 2;
constexpr size_t WS_MK = WS_MEMN + (size_t)2 * 1536 * 1024 * 2;
constexpr size_t WS_MVT = WS_MK + (size_t)2 * 1536 * 512 * 2;
constexpr size_t WS_H = WS_MVT + (size_t)2 * 512 * 1536 * 2;
constexpr size_t WS_Z = WS_H + (size_t)SEG * 1024 * 2;
constexpr size_t WS_VT = WS_Z + (size_t)SEG * LDZ * 2;
constexpr size_t WS_Y = WS_VT + (size_t)1024 * SEG * 2;
constexpr size_t WS_AGG = WS_Y + (size_t)SEG * LDY * 2;
constexpr size_t WS_CARRY = WS_AGG + (size_t)2 * 128 * 1024 * 2 * 4;
constexpr size_t WS_RSTD = WS_CARRY + (size_t)2 * 128 * 1024 * 4;
constexpr size_t WS_PART = WS_RSTD + (size_t)SEG * 4;
constexpr size_t WS_BAR = WS_PART + (size_t)8 * SEG * 4;
constexpr size_t WS_END = WS_BAR + 16384;

struct Params { const float* in[25]; float* out; unsigned char* ws; };

__device__ __forceinline__ float bf2f(unsigned short b) { return __uint_as_float(((unsigned)b) << 16); }
__device__ __forceinline__ unsigned short f2bf(float f) { unsigned u = __float_as_uint(f); u += 0x7FFFu + ((u >> 16) & 1u); return (unsigned short)(u >> 16); }
__device__ __forceinline__ float bflo(unsigned w) { return __uint_as_float(w << 16); }
__device__ __forceinline__ float bfhi(unsigned w) { return __uint_as_float(w & 0xffff0000u); }
__device__ __forceinline__ unsigned pk2(float lo, float hi) { return pg8::cvt_pk_bf16(lo, hi); }
__device__ __forceinline__ float frcp(float x) { return __builtin_amdgcn_rcpf(x); }
__device__ __forceinline__ float silu(float x) { return x * frcp(1.0f + __expf(-x)); }
__device__ __forceinline__ float sigm(float x) { return frcp(1.0f + __expf(-x)); }
__device__ __forceinline__ float wave_sum(float v) {
#pragma unroll
    for (int o = 1; o < 64; o <<= 1) v += __shfl_xor(v, o);
    return v;
}
__device__ __forceinline__ f32x4 mfma16(bf16x8 a, bf16x8 b, f32x4 c) { return __builtin_amdgcn_mfma_f32_16x16x32_bf16(a, b, c, 0, 0, 0); }
__device__ __forceinline__ bf16x8 ld8(const bf16_t* p) { return *(const bf16x8*)p; }
__device__ __forceinline__ bf16x8 pack8(const float (&v)[8]) {
    u32x4_t w; w.x = pk2(v[0], v[1]); w.y = pk2(v[2], v[3]); w.z = pk2(v[4], v[5]); w.w = pk2(v[6], v[7]);
    return __builtin_bit_cast(bf16x8, w);
}

__device__ __forceinline__ void transpose_tile(const float* src, int R, int C, bf16_t* dst, int tile, float* lds) {
    const int ntc = C >> 6, tr = tile / ntc, tc = tile - tr * ntc, r0 = tr * 64, c0 = tc * 64;
    const int tx = threadIdx.x & 63, ty = threadIdx.x >> 6;
#pragma unroll
    for (int i = 0; i < 8; ++i) { const int r = ty + 8 * i; lds[r * 65 + tx] = src[(size_t)(r0 + r) * C + c0 + tx]; }
    __syncthreads();
#pragma unroll
    for (int i = 0; i < 8; ++i) { const int c = ty + 8 * i; dst[(size_t)(c0 + c) * R + r0 + tx] = f2bf(lds[tx * 65 + c]); }
    __syncthreads();
}

__device__ __forceinline__ void rms_row_bf16(const float* xrow, const float* g, bf16_t* orow, int lane) {
    const f32x4* xr = (const f32x4*)xrow + lane; f32x4 v[4]; float s = 0.f;
#pragma unroll
    for (int j = 0; j < 4; ++j) { v[j] = xr[64 * j]; s += (v[j].x * v[j].x + v[j].y * v[j].y) + (v[j].z * v[j].z + v[j].w * v[j].w); }
    const float rstd = __builtin_amdgcn_rsqf(wave_sum(s) * (1.0f / 1024.0f) + EPS);
    const f32x4* gr = (const f32x4*)g + lane; u32x2_t* o8 = (u32x2_t*)orow + lane;
#pragma unroll
    for (int j = 0; j < 4; ++j) { const f32x4 gg = gr[64 * j]; u32x2_t o; o.x = pk2(v[j].x * rstd * gg.x, v[j].y * rstd * gg.y); o.y = pk2(v[j].z * rstd * gg.z, v[j].w * rstd * gg.w); o8[64 * j] = o; }
}
__device__ __forceinline__ void rms_row_f32(float* xrow, const float* g, int lane) {
    f32x4* xr = (f32x4*)xrow + lane; f32x4 v[4]; float s = 0.f;
#pragma unroll
    for (int j = 0; j < 4; ++j) { v[j] = xr[64 * j]; s += (v[j].x * v[j].x + v[j].y * v[j].y) + (v[j].z * v[j].z + v[j].w * v[j].w); }
    const float rstd = __builtin_amdgcn_rsqf(wave_sum(s) * (1.0f / 1024.0f) + EPS);
    const f32x4* gr = (const f32x4*)g + lane;
#pragma unroll
    for (int j = 0; j < 4; ++j) { const f32x4 gg = gr[64 * j]; f32x4 o; o.x = v[j].x * rstd * gg.x; o.y = v[j].y * rstd * gg.y; o.z = v[j].z * rstd * gg.z; o.w = v[j].w * rstd * gg.w; xr[64 * j] = o; }
}

__device__ __forceinline__ void conv_even_item(const bf16_t* z, const float* cw, const float* cb, bf16_t* y, int t, int T, int lane) {
    const int s = t & (T - 1);
#pragma unroll
    for (int half = 0; half < 2; ++half) {
        const int c0 = half * 512 + lane * 8;
        const bf16_t* zr = z + (size_t)t * LDZ + c0;
        const u32x4_t bg = *(const u32x4_t*)(zr), ga = *(const u32x4_t*)(zr + 3072);
        const u32x4_t cg1 = *(const u32x4_t*)(zr + 1024), xv1 = *(const u32x4_t*)(zr + 2048);
        u32x4_t cg0 = {0, 0, 0, 0}, xv0 = {0, 0, 0, 0}, cg2 = {0, 0, 0, 0}, xv2 = {0, 0, 0, 0};
        if (s > 0) { cg0 = *(const u32x4_t*)(zr - LDZ + 1024); xv0 = *(const u32x4_t*)(zr - LDZ + 2048); }
        if (s < T - 1) { cg2 = *(const u32x4_t*)(zr + LDZ + 1024); xv2 = *(const u32x4_t*)(zr + LDZ + 2048); }
        float w0[8], w1[8], w2[8], bb[8];
#pragma unroll
        for (int e = 0; e < 8; e += 4) {
            const f32x4 a = *(const f32x4*)(cw + c0 + e), b = *(const f32x4*)(cw + 1024 + c0 + e), c = *(const f32x4*)(cw + 2048 + c0 + e), d = *(const f32x4*)(cb + c0 + e);
#pragma unroll
            for (int k = 0; k < 4; ++k) { w0[e + k] = a[k]; w1[e + k] = b[k]; w2[e + k] = c[k]; bb[e + k] = d[k]; }
        }
        float o[8];
#pragma unroll
        for (int k = 0; k < 4; ++k) {
            const float p0l = bflo(cg0[k]) * bflo(xv0[k]), p0h = bfhi(cg0[k]) * bfhi(xv0[k]);
            const float p1l = bflo(cg1[k]) * bflo(xv1[k]), p1h = bfhi(cg1[k]) * bfhi(xv1[k]);
            const float p2l = bflo(cg2[k]) * bflo(xv2[k]), p2h = bfhi(cg2[k]) * bfhi(xv2[k]);
            const float cl = bb[2 * k] + w0[2 * k] * p0l + w1[2 * k] * p1l + w2[2 * k] * p2l;
            const float ch = bb[2 * k + 1] + w0[2 * k + 1] * p0h + w1[2 * k + 1] * p1h + w2[2 * k + 1] * p2h;
            o[2 * k] = bflo(bg[k]) * cl * silu(bflo(ga[k]));
            o[2 * k + 1] = bfhi(bg[k]) * ch * silu(bfhi(ga[k]));
        }
        u32x4_t w; w.x = pk2(o[0], o[1]); w.y = pk2(o[2], o[3]); w.z = pk2(o[4], o[5]); w.w = pk2(o[6], o[7]);
        *(u32x4_t*)(y + (size_t)t * LDY + c0) = w;
    }
}

__device__ __forceinline__ void conv_odd_item(const bf16_t* z, const float* cw, const float* cb, bf16_t* xc, int t, int T, int lane) {
    const int s = t & (T - 1);
#pragma unroll
    for (int half = 0; half < 2; ++half) {
        const int c0 = half * 512 + lane * 8;
        const bf16_t* zr = z + (size_t)t * LDZ + c0;
        float acc[8];
#pragma unroll
        for (int e = 0; e < 8; e += 4) { const f32x4 d = *(const f32x4*)(cb + c0 + e); acc[e] = d[0]; acc[e + 1] = d[1]; acc[e + 2] = d[2]; acc[e + 3] = d[3]; }
#pragma unroll
        for (int j = 0; j < 4; ++j) {
            const int sj = s + j - 2;
            if (sj >= 0 && sj < T) {
                const u32x4_t xv = *(const u32x4_t*)(zr + (ptrdiff_t)(j - 2) * LDZ);
                const f32x4 wa = *(const f32x4*)(cw + j * 1024 + c0), wb = *(const f32x4*)(cw + j * 1024 + c0 + 4);
                acc[0] += wa[0] * bflo(xv[0]); acc[1] += wa[1] * bfhi(xv[0]); acc[2] += wa[2] * bflo(xv[1]); acc[3] += wa[3] * bfhi(xv[1]);
                acc[4] += wb[0] * bflo(xv[2]); acc[5] += wb[1] * bfhi(xv[2]); acc[6] += wb[2] * bflo(xv[3]); acc[7] += wb[3] * bfhi(xv[3]);
            }
        }
        u32x4_t w; w.x = pk2(acc[0], acc[1]); w.y = pk2(acc[2], acc[3]); w.z = pk2(acc[4], acc[5]); w.w = pk2(acc[6], acc[7]);
        *(u32x4_t*)(xc + (size_t)t * 1024 + c0) = w;
    }
}
__device__ __forceinline__ void rstd_item(const float* part, float* rstd, int tg, int lane) {
    const float* p = part + tg * 64 + lane; float s = 0.f;
#pragma unroll
    for (int i = 0; i < 8; ++i) s += p[(size_t)i * SEG];
    rstd[tg * 64 + lane] = __builtin_amdgcn_rsqf(s * (1.0f / 1024.0f) + EPS);
}

__device__ __forceinline__ void na_item(const bf16_t* z, const bf16_t* vT, bf16_t* y, const float* rpb, int item, int T, int lane) {
    const int g = item & 3, h = (item >> 2) & 15, R = item >> 6;
    const int rows = T >> 6, seq = R / rows, r = R - seq * rows, seq_base = seq * T;
    int rstart = r - 4; rstart = rstart < 0 ? 0 : rstart; rstart = rstart > rows - 8 ? rows - 8 : rstart;
    const int wb = (g == 0) ? 0 : (g == 1) ? 8 : (g == 2) ? 24 : 32;
    const int fr = lane & 15, fq = lane >> 4;
    const bf16_t* qp = z + (size_t)(seq_base + r * 64 + g * 16 + fr) * LDZ + 4096 + h * 64 + fq * 8;
    const bf16x8 q0 = ld8(qp), q1 = ld8(qp + 32);
    const int kcolA = wb + (fr >> 2) * 8 + (fr & 3);
    const int qc = g * 16 + fr;
    int cstart = qc - 8; cstart = cstart < 0 ? 0 : cstart; cstart = cstart > 48 ? 48 : cstart;
    float s[8][8];
    float mx = -1e30f;
#pragma unroll
    for (int kr = 0; kr < 8; ++kr) {
        const bf16_t* kp = z + (size_t)(seq_base + (rstart + kr) * 64 + kcolA) * LDZ + 5120 + h * 64 + fq * 8;
        const bf16x8 k00 = ld8(kp), k01 = ld8(kp + 32), k10 = ld8(kp + 4 * LDZ), k11 = ld8(kp + 4 * LDZ + 32);
        f32x4 a0 = {0.f, 0.f, 0.f, 0.f}, a1 = {0.f, 0.f, 0.f, 0.f};
        a0 = mfma16(k00, q0, a0); a0 = mfma16(k01, q1, a0);
        a1 = mfma16(k10, q0, a1); a1 = mfma16(k11, q1, a1);
        const int dr = rstart + kr - r + 7;
        const float* bp = rpb + (h * 15 + dr) * 31 + 15;
#pragma unroll
        for (int e = 0; e < 8; ++e) {
            const int kc = wb + fq * 8 + e;
            const bool ok = (kc >= cstart) && (kc < cstart + 16);
            int dc = kc - qc; dc = dc < -15 ? -15 : dc; dc = dc > 15 ? 15 : dc;
            const float sc = (e < 4 ? a0[e & 3] : a1[e & 3]) * 0.125f + bp[dc];
            s[kr][e] = ok ? sc : -1e30f;
            mx = fmaxf(mx, s[kr][e]);
        }
    }
    mx = fmaxf(mx, __shfl_xor(mx, 16)); mx = fmaxf(mx, __shfl_xor(mx, 32));
    float sum = 0.f;
#pragma unroll
    for (int kr = 0; kr < 8; ++kr)
#pragma unroll
        for (int e = 0; e < 8; ++e) { const float p = __expf(s[kr][e] - mx); s[kr][e] = p; sum += p; }
    sum += __shfl_xor(sum, 16); sum += __shfl_xor(sum, 32);
    f32x4 o[4];
#pragma unroll
    for (int dt = 0; dt < 4; ++dt) o[dt] = (f32x4){0.f, 0.f, 0.f, 0.f};
#pragma unroll
    for (int kr = 0; kr < 8; ++kr) {
        const bf16x8 pf = pack8(s[kr]);
        const bf16_t* vp = vT + (size_t)(h * 64 + fr) * SEG + seq_base + (rstart + kr) * 64 + wb + fq * 8;
#pragma unroll
        for (int dt = 0; dt < 4; ++dt) o[dt] = mfma16(ld8(vp + (size_t)dt * 16 * SEG), pf, o[dt]);
    }
    const float inv = frcp(sum);
    const int tok = seq_base + r * 64 + g * 16 + fr;
#pragma unroll
    for (int dt = 0; dt < 4; ++dt) {
        const int d4 = dt * 16 + fq * 4;
        const u32x2_t gr = *(const u32x2_t*)(z + (size_t)tok * LDZ + 6144 + h * 64 + d4);
        u32x2_t ow;
        ow.x = pk2(o[dt][0] * inv * silu(bflo(gr.x)), o[dt][1] * inv * silu(bfhi(gr.x)));
        ow.y = pk2(o[dt][2] * inv * silu(bflo(gr.y)), o[dt][3] * inv * silu(bfhi(gr.y)));
        *(u32x2_t*)(y + (size_t)tok * LDY + 1024 + h * 64 + d4) = ow;
    }
}

__device__ __forceinline__ void mem_item(const bf16_t* z, int qcol, int gcol, const bf16_t* mk, const bf16_t* mvT, bf16_t* y, int item, int seg, int lane) {
    const int h = item & 3, tg = item >> 2, tok0 = tg * 16;
    const int mb = seg < 2 ? seg : 2 + (tok0 >> 12);
    const int fr = lane & 15, fq = lane >> 4;
    const bf16_t* qp = z + (size_t)(tok0 + fr) * LDZ + qcol + h * 128 + fq * 8;
    bf16x8 q[4];
#pragma unroll
    for (int ks = 0; ks < 4; ++ks) q[ks] = ld8(qp + ks * 32);
    const int mrowA = (fr >> 2) * 8 + (fr & 3);
    float s[8][8];
    float mx = -1e30f;
#pragma unroll
    for (int kb = 0; kb < 8; ++kb) {
        const bf16_t* kp = mk + (size_t)(mb * 256 + kb * 32 + mrowA) * 512 + h * 128 + fq * 8;
        f32x4 a0 = {0.f, 0.f, 0.f, 0.f}, a1 = {0.f, 0.f, 0.f, 0.f};
#pragma unroll
        for (int ks = 0; ks < 4; ++ks) { a0 = mfma16(ld8(kp + ks * 32), q[ks], a0); a1 = mfma16(ld8(kp + 4 * 512 + ks * 32), q[ks], a1); }
#pragma unroll
        for (int e = 0; e < 8; ++e) { s[kb][e] = (e < 4 ? a0[e & 3] : a1[e & 3]) * 0.08838834764831845f; mx = fmaxf(mx, s[kb][e]); }
    }
    mx = fmaxf(mx, __shfl_xor(mx, 16)); mx = fmaxf(mx, __shfl_xor(mx, 32));
    float sum = 0.f;
#pragma unroll
    for (int kb = 0; kb < 8; ++kb)
#pragma unroll
        for (int e = 0; e < 8; ++e) { const float p = __expf(s[kb][e] - mx); s[kb][e] = p; sum += p; }
    sum += __shfl_xor(sum, 16); sum += __shfl_xor(sum, 32);
    f32x4 o[8];
#pragma unroll
    for (int dt = 0; dt < 8; ++dt) o[dt] = (f32x4){0.f, 0.f, 0.f, 0.f};
#pragma unroll
    for (int kb = 0; kb < 8; ++kb) {
        const bf16x8 pf = pack8(s[kb]);
        const bf16_t* vp = mvT + (size_t)(h * 128 + fr) * 1536 + mb * 256 + kb * 32 + fq * 8;
#pragma unroll
        for (int dt = 0; dt < 8; ++dt) o[dt] = mfma16(ld8(vp + (size_t)dt * 16 * 1536), pf, o[dt]);
    }
    const float inv = frcp(sum);
    const int tok = tok0 + fr;
#pragma unroll
    for (int dt = 0; dt < 8; ++dt) {
        const int d4 = dt * 16 + fq * 4;
        const u32x2_t gr = *(const u32x2_t*)(z + (size_t)tok * LDZ + gcol + h * 128 + d4);
        u32x2_t ow;
        ow.x = pk2(o[dt][0] * inv * silu(bflo(gr.x)), o[dt][1] * inv * silu(bfhi(gr.x)));
        ow.y = pk2(o[dt][2] * inv * silu(bflo(gr.y)), o[dt][3] * inv * silu(bfhi(gr.y)));
        *(u32x2_t*)(y + (size_t)tok * LDY + 2048 + h * 128 + d4) = ow;
    }
}

template <int CTRL> __device__ __forceinline__ float dppf(float oldv, float src) {
    return __int_as_float(__builtin_amdgcn_update_dpp(__float_as_int(oldv), __float_as_int(src), CTRL, 0xf, 0xf, false));
}
template <int DIR> __device__ __forceinline__ void scan16(float& A, float& B) {
    constexpr int BASE = DIR == 0 ? 0x110 : 0x100;
    { const float ap = dppf<BASE + 1>(1.f, A), bp = dppf<BASE + 1>(0.f, B); B = A * bp + B; A = A * ap; }
    { const float ap = dppf<BASE + 2>(1.f, A), bp = dppf<BASE + 2>(0.f, B); B = A * bp + B; A = A * ap; }
    { const float ap = dppf<BASE + 4>(1.f, A), bp = dppf<BASE + 4>(0.f, B); B = A * bp + B; A = A * ap; }
    { const float ap = dppf<BASE + 8>(1.f, A), bp = dppf<BASE + 8>(0.f, B); B = A * bp + B; A = A * ap; }
}
struct LruW { bf16x8 Wa[4], Wi[4]; float ba[4], bi[4], c8[4]; };
template <int DIR, bool FINAL> __device__ __forceinline__ void lru_tile(const bf16_t* xc, const LruW& W, int tok, int blk, int ch4, int lane, float (&hin)[4], float (&arun)[4], float (&hout)[4]) {
    const int fq = lane >> 4;
    const bf16_t* xp = xc + (size_t)tok * 1024 + blk * 128 + fq * 8;
    f32x4 accR = {0.f, 0.f, 0.f, 0.f}, accI = {0.f, 0.f, 0.f, 0.f};
#pragma unroll
    for (int ks = 0; ks < 4; ++ks) { const bf16x8 X = ld8(xp + ks * 32); accR = mfma16(W.Wa[ks], X, accR); accI = mfma16(W.Wi[ks], X, accI); }
    const u32x2_t xr = *(const u32x2_t*)(xc + (size_t)tok * 1024 + ch4);
    const float xv[4] = {bflo(xr.x), bfhi(xr.x), bflo(xr.y), bfhi(xr.y)};
    const int src = (lane & 48) + (DIR == 0 ? 15 : 0);
#pragma unroll
    for (int jj = 0; jj < 4; ++jj) {
        const float rg = sigm(accR[jj] + W.ba[jj]), ig = sigm(accI[jj] + W.bi[jj]);
        const float la = W.c8[jj] * rg;
        float A = __expf(la);
        float B = __builtin_amdgcn_sqrtf(fmaxf(1.0f - A * A, 0.f)) * (ig * xv[jj]);
        scan16<DIR>(A, B);
        const float hval = A * hin[jj] + B;
        hout[jj] = hval;
        hin[jj] = __shfl(hval, src);
        if (!FINAL) arun[jj] *= __shfl(A, src);
    }
}
template <bool FINAL> __device__ __forceinline__ void lru_item(const bf16_t* xc, const bf16_t* z, const bf16_t* lruw, const float* ba_, const float* bi_, const float* lam_,
                                                               float* agg, const float* carry, bf16_t* y, int item, int lane) {
    const int cgi = item & 63, chunk = item >> 6, blk = cgi >> 3, w = cgi & 7;
    const int fr = lane & 15, fq = lane >> 4;
    const int ch4 = blk * 128 + w * 16 + fq * 4;
    float hf[8][4];
#pragma unroll
    for (int dir = 0; dir < 2; ++dir) {
        LruW W;
        const bf16_t* wa = lruw + ((size_t)((0 * 2 + dir) * 8 + blk) * 128 + w * 16 + fr) * 128 + fq * 8;
        const bf16_t* wi = lruw + ((size_t)((1 * 2 + dir) * 8 + blk) * 128 + w * 16 + fr) * 128 + fq * 8;
#pragma unroll
        for (int ks = 0; ks < 4; ++ks) { W.Wa[ks] = ld8(wa + ks * 32); W.Wi[ks] = ld8(wi + ks * 32); }
        float hin[4], arun[4];
#pragma unroll
        for (int jj = 0; jj < 4; ++jj) {
            W.ba[jj] = ba_[dir * 1024 + ch4 + jj]; W.bi[jj] = bi_[dir * 1024 + ch4 + jj];
            const float lam = lam_[dir * 1024 + ch4 + jj];
            W.c8[jj] = -8.0f * log1pf(__expf(-lam));
            hin[jj] = FINAL ? carry[(size_t)(dir * 128 + chunk) * 1024 + ch4 + jj] : 0.f;
            arun[jj] = 1.f;
        }
#pragma unroll
        for (int step = 0; step < 8; ++step) {
            const int tt = dir == 0 ? step : 7 - step;
            const int tok = chunk * 128 + tt * 16 + fr;
            float hv[4];
            if (dir == 0) lru_tile<0, FINAL>(xc, W, tok, blk, ch4, lane, hin, arun, hv);
            else lru_tile<1, FINAL>(xc, W, tok, blk, ch4, lane, hin, arun, hv);
            if (FINAL) {
                if (dir == 0) {
#pragma unroll
                    for (int jj = 0; jj < 4; ++jj) hf[tt][jj] = hv[jj];
                } else {
                    const u32x2_t gr = *(const u32x2_t*)(z + (size_t)tok * LDZ + 1024 + ch4);
                    const float gc[4] = {bflo(gr.x), bfhi(gr.x), bflo(gr.y), bfhi(gr.y)};
                    float o[4];
#pragma unroll
                    for (int jj = 0; jj < 4; ++jj) o[jj] = (hf[tt][jj] + hv[jj]) * silu(gc[jj]);
                    u32x2_t ow; ow.x = pk2(o[0], o[1]); ow.y = pk2(o[2], o[3]);
                    *(u32x2_t*)(y + (size_t)tok * LDY + ch4) = ow;
                }
            }
        }
        if (!FINAL && fr == 0) {
#pragma unroll
            for (int jj = 0; jj < 4; ++jj) { float2 v; v.x = arun[jj]; v.y = hin[jj]; *(float2*)(agg + ((size_t)(dir * 128 + chunk) * 1024 + ch4 + jj) * 2) = v; }
        }
    }
}
__device__ __forceinline__ void carry_phase(const float* agg, float* carry, int nseq, int gtid, int gthreads) {
    const int nc = 128 / nseq;
    for (int idx = gtid; idx < 2 * nseq * 1024; idx += gthreads) {
        const int ch = idx & 1023, rest = idx >> 10, dir = rest & 1, sq = rest >> 1, base = sq * nc;
        float h = 0.f;
#pragma unroll 8
        for (int c = 0; c < nc; ++c) {
            const int C = base + (dir == 0 ? c : nc - 1 - c);
            const size_t o = (size_t)(dir * 128 + C) * 1024 + ch;
            const float2 ah = *(const float2*)(agg + o * 2);
            carry[o] = h;
            h = ah.x * h + ah.y;
        }
    }
}

__device__ __forceinline__ void sgu_item(const bf16_t* vT, const float* rstd, const bf16_t* z, const bf16_t* sguw, const float* sgu_g, const float* sgu_b, bf16_t* y, int item, int lane) {
    const int dd = item & 7, g = (item >> 3) & 7, n = item >> 6;
    const int fr = lane & 15, fq = lane >> 4;
    const int tokc = n * 128;
    const bf16_t* ap = vT + (size_t)(g * 128 + dd * 16 + fr) * SEG + tokc + fq * 8;
    bf16x8 Af[4];
#pragma unroll
    for (int ks = 0; ks < 4; ++ks) {
        const u32x4_t raw = *(const u32x4_t*)(ap + ks * 32);
        const f32x4 r0 = *(const f32x4*)(rstd + tokc + ks * 32 + fq * 8), r1 = *(const f32x4*)(rstd + tokc + ks * 32 + fq * 8 + 4);
        u32x4_t w;
        w.x = pk2(bflo(raw.x) * r0[0], bfhi(raw.x) * r0[1]); w.y = pk2(bflo(raw.y) * r0[2], bfhi(raw.y) * r0[3]);
        w.z = pk2(bflo(raw.z) * r1[0], bfhi(raw.z) * r1[1]); w.w = pk2(bflo(raw.w) * r1[2], bfhi(raw.w) * r1[3]);
        Af[ks] = __builtin_bit_cast(bf16x8, w);
    }
    const int ch4 = g * 128 + dd * 16 + fq * 4;
    const f32x4 g4 = *(const f32x4*)(sgu_g + ch4);
#pragma unroll
    for (int pt = 0; pt < 8; ++pt) {
        const int p = pt * 16 + fr;
        const bf16_t* bp = sguw + (size_t)(g * 128 + p) * 128 + fq * 8;
        f32x4 acc = {0.f, 0.f, 0.f, 0.f};
#pragma unroll
        for (int ks = 0; ks < 4; ++ks) acc = mfma16(Af[ks], ld8(bp + ks * 32), acc);
        const int tok = tokc + p;
        const float bsv = sgu_b[g * 128 + p];
        const u32x2_t ur = *(const u32x2_t*)(z + (size_t)tok * LDZ + 2048 + ch4), gr = *(const u32x2_t*)(z + (size_t)tok * LDZ + 3072 + ch4);
        const float uu[4] = {bflo(ur.x), bfhi(ur.x), bflo(ur.y), bfhi(ur.y)}, gd[4] = {bflo(gr.x), bfhi(gr.x), bflo(gr.y), bfhi(gr.y)};
        float o[4];
#pragma unroll
        for (int jj = 0; jj < 4; ++jj) o[jj] = uu[jj] * (acc[jj] * g4[jj] + bsv) * silu(gd[jj]);
        u32x2_t ow; ow.x = pk2(o[0], o[1]); ow.y = pk2(o[2], o[3]);
        *(u32x2_t*)(y + (size_t)tok * LDY + 1024 + ch4) = ow;
    }
}

__global__ void __launch_bounds__(512, 2) fwd_megakernel(Params P) {
    extern __shared__ __attribute__((aligned(16))) unsigned char shm[];
    cg::grid_group grid = cg::this_grid();
    PG8_LAS unsigned char* lds = (PG8_LAS unsigned char*)shm;
    const int G = gridDim.x, NW = G * 8;
#define FRESH_TID() int tid = threadIdx.x; asm volatile("" : "+v"(tid)); const int lane = tid & 63, wid = tid >> 6, gw = blockIdx.x * 8 + wid; (void)lane; (void)gw
    unsigned char* ws = P.ws;
    bf16_t* WIN_E = (bf16_t*)(ws + WS_WIN_E); bf16_t* WIN_O = (bf16_t*)(ws + WS_WIN_O);
    bf16_t* WOUT_E = (bf16_t*)(ws + WS_WOUT_E); bf16_t* WOUT_O = (bf16_t*)(ws + WS_WOUT_O);
    bf16_t* WKV = (bf16_t*)(ws + WS_WKV); bf16_t* LRUW = (bf16_t*)(ws + WS_LRUW); bf16_t* SGUW = (bf16_t*)(ws + WS_SGUW);
    bf16_t* MEMN = (bf16_t*)(ws + WS_MEMN); bf16_t* MK = (bf16_t*)(ws + WS_MK); bf16_t* MVT = (bf16_t*)(ws + WS_MVT);
    bf16_t* H = (bf16_t*)(ws + WS_H); bf16_t* Z = (bf16_t*)(ws + WS_Z); bf16_t* VT = (bf16_t*)(ws + WS_VT); bf16_t* Y = (bf16_t*)(ws + WS_Y);
    float* AGG = (float*)(ws + WS_AGG); float* CARRY = (float*)(ws + WS_CARRY); float* RSTD = (float*)(ws + WS_RSTD); float* PART = (float*)(ws + WS_PART);

    unsigned* BAR = (unsigned*)(ws + WS_BAR);
    volatile LAS unsigned* xst = (volatile LAS unsigned*)(lds + 131072);
    {
        FRESH_TID();
        if (tid < 2) xst[tid] = 0u;
        if (blockIdx.x == 0) for (int i = tid; i < XCD_BAR_WORDS; i += 512) BAR[i] = 0u;
        float* scr = (float*)shm;
        constexpr int I0 = 16 * 144, I1 = 16 * 96, I2 = 40 * 16, I3 = 40 * 16, I4 = 256, I5 = 256, I6 = 64, I7 = 64;
        constexpr int NIT = I0 + I1 + I2 + I3 + I4 + I5 + I6 + I7;
        for (int it = blockIdx.x; it < NIT; it += G) {
            int r = it;
            if (r < I0) { transpose_tile(P.in[7], 1024, 9216, WIN_E, r, scr); continue; } r -= I0;
            if (r < I1) { transpose_tile(P.in[12], 1024, 6144, WIN_O, r, scr); continue; } r -= I1;
            if (r < I2) { transpose_tile(P.in[11], 2560, 1024, WOUT_E, r, scr); continue; } r -= I2;
            if (r < I3) { transpose_tile(P.in[23], 2560, 1024, WOUT_O, r, scr); continue; } r -= I3;
            if (r < I4) { transpose_tile(P.in[6], 1024, 1024, WKV, r, scr); continue; } r -= I4;
            if (r < I5) { transpose_tile(P.in[6] + (size_t)1024 * 1024, 1024, 1024, WKV + (size_t)1024 * 1024, r, scr); continue; } r -= I5;
            if (r < I6) { const int m = r >> 2; transpose_tile(P.in[15] + (size_t)m * 16384, 128, 128, LRUW + (size_t)m * 16384, r & 3, scr); continue; } r -= I6;
            { const int m = r >> 2; transpose_tile(P.in[17] + (size_t)m * 16384, 128, 128, LRUW + (size_t)(16 + m) * 16384, r & 3, scr); }
        }
        for (int i = blockIdx.x * 512 + tid; i < 8 * 128 * 128; i += G * 512) SGUW[i] = f2bf(P.in[21][i]);
        for (int it = gw; it < 2 * 1536; it += NW) {
            const int l = it / 1536, row = it - l * 1536;
            const float* src = row < 512 ? P.in[2] + (size_t)row * 1024 : P.in[3] + (size_t)(row - 512) * 1024;
            rms_row_bf16(src, P.in[5] + l * 1024, MEMN + ((size_t)l * 1536 + row) * 1024, lane);
        }
    }

    grid.sync();
    const XcdBarrier xb = xcd_barrier_post(BAR, xst);
    for (int seg = 0; seg < 3; ++seg) {
        const float* xin = seg < 2 ? P.in[0] + (size_t)seg * SEG * 1024 : P.in[1];
        float* xout = P.out + (size_t)seg * SEG * 1024;
        const int T = seg < 2 ? 16384 : 4096, nseq = seg < 2 ? 1 : 4;

        { FRESH_TID();
        for (int it = gw; it < SEG; it += NW) rms_row_bf16(xin + (size_t)it * 1024, P.in[4], H + (size_t)it * 1024, lane); }
        xcd_barrier(xb);

        {
            pg8::Gemm g; g.A = H; g.Bt = WIN_E; g.M = SEG; g.N = 8192; g.K = 1024;
            pg8::SkipOrder S; S.init(SEG, 8192, G, blockIdx.x); S.skip_from = 24; S.skip_n = 4;
            pg8::EpiZ E; E.O = Z; E.ldc = LDZ; E.skip_from = 24; E.skip_n = 4; E.colsq = nullptr; E.colsq_ld = 0;
            pg8::gemm_phase(lds, g, S, E);
        }
        {
            pg8::Gemm g; g.A = WIN_E + (size_t)6144 * 1024; g.Bt = H; g.M = 1024; g.N = SEG; g.K = 1024;
            pg8::SkipOrder S; S.init(1024, SEG, G, blockIdx.x); S.skip_from = 1 << 20; S.skip_n = 0;
            pg8::EpiZ E; E.O = VT; E.ldc = SEG; E.skip_from = 1 << 20; E.skip_n = 0; E.colsq = nullptr; E.colsq_ld = 0;
            pg8::gemm_phase(lds, g, S, E);
        }
        if (seg == 0) {
#pragma unroll 1
            for (int l = 0; l < 2; ++l) {
                {
                    pg8::Gemm g; g.A = MEMN + (size_t)l * 1536 * 1024; g.Bt = WKV + (size_t)l * 1024 * 1024; g.M = 1536; g.N = 512; g.K = 1024;
                    pg8::SkipOrder S; S.init(1536, 512, G, (blockIdx.x + G - (32 * l) % G) % G); S.skip_from = 1 << 20; S.skip_n = 0;
                    pg8::EpiZ E; E.O = MK + (size_t)l * 1536 * 512; E.ldc = 512; E.skip_from = 1 << 20; E.skip_n = 0; E.colsq = nullptr; E.colsq_ld = 0;
                    pg8::gemm_phase(lds, g, S, E);
                }
                {
                    pg8::Gemm g; g.A = WKV + (size_t)l * 1024 * 1024 + (size_t)512 * 1024; g.Bt = MEMN + (size_t)l * 1536 * 1024; g.M = 512; g.N = 1536; g.K = 1024;
                    pg8::SkipOrder S; S.init(512, 1536, G, (blockIdx.x + G - (32 * l + 16) % G) % G); S.skip_from = 1 << 20; S.skip_n = 0;
                    pg8::EpiZ E; E.O = MVT + (size_t)l * 512 * 1536; E.ldc = 1536; E.skip_from = 1 << 20; E.skip_n = 0; E.colsq = nullptr; E.colsq_ld = 0;
                    pg8::gemm_phase(lds, g, S, E);
                }
            }
        }
        xcd_barrier(xb);

        { FRESH_TID();
        for (int it = gw; it < 16384 + 4096 + 16384; it += NW) {
            if (it < 16384) na_item(Z, VT, Y, P.in[10], it, T, lane);
            else if (it < 16384 + 4096) mem_item(Z, 7168, 7680, MK, MVT, Y, it - 16384, seg, lane);
            else conv_even_item(Z, P.in[8], P.in[9], Y, it - 20480, T, lane);
        } }
        xcd_barrier(xb);

        {
            pg8::Gemm g; g.A = Y; g.Bt = WOUT_E; g.M = SEG; g.N = 1024; g.K = 2560;
            pg8::StaticOrder S; S.init(SEG, 1024, G, blockIdx.x);
            pg8::EpiRes E; E.xin = xin; E.out = xout;
            pg8::gemm_phase(lds, g, S, E);
        }
        xcd_barrier(xb);

        { FRESH_TID();
        for (int it = gw; it < SEG; it += NW) rms_row_bf16(xout + (size_t)it * 1024, P.in[4] + 1024, H + (size_t)it * 1024, lane); }
        xcd_barrier(xb);

        {
            pg8::Gemm g; g.A = H; g.Bt = WIN_O; g.M = SEG; g.N = 5120; g.K = 1024;
            pg8::SkipOrder S; S.init(SEG, 5120, G, blockIdx.x); S.skip_from = 12; S.skip_n = 4;
            pg8::EpiZ E; E.O = Z; E.ldc = LDZ; E.skip_from = 12; E.skip_n = 4; E.colsq = nullptr; E.colsq_ld = 0;
            pg8::gemm_phase(lds, g, S, E);
        }
        {
            pg8::Gemm g; g.A = WIN_O + (size_t)3072 * 1024; g.Bt = H; g.M = 1024; g.N = SEG; g.K = 1024;
            pg8::SkipOrder S; S.init(1024, SEG, G, blockIdx.x); S.skip_from = 1 << 20; S.skip_n = 0;
            pg8::EpiZ E; E.O = VT; E.ldc = SEG; E.skip_from = 1 << 20; E.skip_n = 0; E.colsq = PART; E.colsq_ld = SEG;
            pg8::gemm_phase(lds, g, S, E);
        }
        xcd_barrier(xb);

        { FRESH_TID();
        for (int it = gw; it < SEG + 256; it += NW) {
            if (it < SEG) conv_odd_item(Z, P.in[13], P.in[14], H, it, T, lane);
            else rstd_item(PART, RSTD, it - SEG, lane);
        } }
        xcd_barrier(xb);

        { FRESH_TID();
        for (int it = gw; it < 8192 + 8192 + 4096; it += NW) {
            if (it < 8192) lru_item<false>(H, Z, LRUW, P.in[16], P.in[18], P.in[19], AGG, CARRY, Y, it, lane);
            else if (it < 16384) sgu_item(VT, RSTD, Z, SGUW, P.in[20], P.in[22], Y, it - 8192, lane);
            else mem_item(Z, 4096, 4608, MK + (size_t)1536 * 512, MVT + (size_t)512 * 1536, Y, it - 16384, seg, lane);
        } }
        xcd_barrier(xb);

        { FRESH_TID(); carry_phase(AGG, CARRY, nseq, blockIdx.x * 512 + tid, G * 512); }
        xcd_barrier(xb);

        { FRESH_TID();
        for (int it = gw; it < 8192; it += NW) lru_item<true>(H, Z, LRUW, P.in[16], P.in[18], P.in[19], AGG, CARRY, Y, it, lane); }
        xcd_barrier(xb);

        {
            pg8::Gemm g; g.A = Y; g.Bt = WOUT_O; g.M = SEG; g.N = 1024; g.K = 2560;
            pg8::StaticOrder S; S.init(SEG, 1024, G, blockIdx.x);
            pg8::EpiRes E; E.xin = xout; E.out = xout;
            pg8::gemm_phase(lds, g, S, E);
        }
        xcd_barrier(xb);

        { FRESH_TID();
        for (int it = gw; it < SEG; it += NW) rms_row_f32(xout + (size_t)it * 1024, P.in[24], lane); }
    }
}

extern "C" void kernel_launch(void* const* d_in, const int* in_sizes, int n_in, void* d_out, int out_size, void* d_ws, size_t ws_size, hipStream_t stream) {
    static int grid_blocks = 0;
    if (grid_blocks == 0) {
        if (n_in != 25 || ws_size < WS_END) { fprintf(stderr, "kernel_launch: need 25 inputs and %zu bytes of workspace; got %d, %zu\n", (size_t)WS_END, n_in, ws_size); grid_blocks = -1; return; }
        int dev = 0, cus = 0, per_cu = 0;
        hipGetDevice(&dev);
        hipDeviceGetAttribute(&cus, hipDeviceAttributeMultiprocessorCount, dev);
        hipFuncSetAttribute((const void*)fwd_megakernel, hipFuncAttributeMaxDynamicSharedMemorySize, LDS_BYTES);
        hipOccupancyMaxActiveBlocksPerMultiprocessor(&per_cu, (const void*)fwd_megakernel, 512, LDS_BYTES);
        if (per_cu < 1) { fprintf(stderr, "kernel_launch: occupancy query says %d blocks per CU\n", per_cu); grid_blocks = -1; return; }
        grid_blocks = cus;
    }
    if (grid_blocks < 0) return;
    Params p{};
    for (int i = 0; i < 25; ++i) p.in[i] = (const float*)d_in[i];
    p.out = (float*)d_out; p.ws = (unsigned char*)d_ws;
    void* args[] = {&p};
    hipError_t e = hipLaunchCooperativeKernel((const void*)fwd_megakernel, dim3(grid_blocks), dim3(512), args, LDS_BYTES, stream);
    if (e != hipSuccess) fprintf(stderr, "cooperative launch failed: %s (grid %d)\n", hipGetErrorString(e), grid_blocks);
}
```

```cpp
#include <hip/hip_runtime.h>
#include <hip/hip_cooperative_groups.h>
#include <cstdio>
namespace cg = cooperative_groups;
namespace pg8 {
#define PG8_LAS __attribute__((address_space(3)))
typedef unsigned short bf16_t;
typedef short bf16x8 __attribute__((ext_vector_type(8)));
typedef float f32x4 __attribute__((ext_vector_type(4)));
typedef unsigned u32x4 __attribute__((ext_vector_type(4)));
constexpr int BM = 256, BK = 64, HALF = 128, HTB = HALF * BK * 2  , STAGE_BYTES = 8 * HTB, NXCD = 8, WGM = 8;

__host__ __device__ __forceinline__ int lds_byte(int r, int c) { const int st = (r >> 4) * 2 + (c >> 5), rr = r & 15, cc = c & 31, ob = rr * 64 + cc * 2; return st * 1024 + (ob ^ (((ob >> 9) & 1) << 5)); }
__host__ __device__ __forceinline__ void stage_rc(int b, int& R, int& C) { const int st = b / 1024, sb = b % 1024, swz = sb ^ (((sb >> 9) & 1) << 5); R = (st >> 1) * 16 + swz / 64; C = (st & 1) * 32 + (swz % 64) / 2; }
__host__ __device__ __forceinline__ int perm32(int rho) { const int n = rho >> 4, i = rho & 15; return 8 * (i >> 2) + 4 * n + (i & 3); }

struct Unit { int pm, pn; };
struct Gemm { const bf16_t* A; const bf16_t* Bt; int M, N, K; };

struct StaticOrder {
    int nM, nN, nwg, G, c;
    __host__ __device__ void init(int M, int N, int G_, int c_) { nM = M / BM; nN = N / BM; nwg = nM * nN; G = G_; c = c_; }
    __host__ __device__ bool next(int i, Unit& u) const {
        const long L = (long)i * G + c; if (L >= nwg) return false;
        int wgid = (int)L; { const int q = nwg / NXCD, r = nwg % NXCD, xcd = wgid % NXCD, off = wgid / NXCD; wgid = (xcd < r ? xcd * (q + 1) : r * (q + 1) + (xcd - r) * q) + off; }
        const int nig = WGM * nN, gid = wgid / nig, fm = gid * WGM, gsz = (nM - fm) < WGM ? (nM - fm) : WGM;
        u.pm = fm + ((wgid % nig) % gsz); u.pn = (wgid % nig) / gsz; return true;
    }
    __device__ __forceinline__ void a_ready(const Unit&) const {}
    __device__ __forceinline__ void done(const Unit&) const {}
};

struct SkipOrder : StaticOrder {
    int skip_from, skip_n;
    __device__ __forceinline__ bool next(int i, Unit& u) const {
        if (!StaticOrder::next(i, u)) return false;
        if (u.pn >= skip_from) u.pn += skip_n;
        return true;
    }
};

__device__ __forceinline__ unsigned cvt_pk_bf16(float lo, float hi) { unsigned r; asm volatile("v_cvt_pk_bf16_f32 %0, %1, %2" : "=v"(r) : "v"(lo), "v"(hi)); return r; }

struct EpiZ {
    static constexpr bool PERM = true, AFTER_DRAIN = false;
    bf16_t* O; int ldc; int skip_from, skip_n; float* colsq; int colsq_ld;
    __device__ __forceinline__ void operator()(const f32x4 (&acc)[2][2][4][2], const Unit& u, int wr, int wc, int fr, int fq) const {
        const int row0 = u.pm * BM + wr * 64 + fr; const int ct = (u.pn >= skip_from + skip_n) ? (u.pn - skip_n) : u.pn;
        const int col0 = ct * BM + wc * 32 + 8 * fq;
#pragma unroll
        for (int ai = 0; ai < 2; ++ai)
#pragma unroll
            for (int m = 0; m < 4; ++m) { bf16_t* rowp = O + (size_t)(row0 + ai * HALF + m * 16) * ldc + col0;
#pragma unroll
                for (int bj = 0; bj < 2; ++bj) { const f32x4 v0 = acc[ai][bj][m][0], v1 = acc[ai][bj][m][1];
                    u32x4 w; w.x = cvt_pk_bf16(v0[0], v0[1]); w.y = cvt_pk_bf16(v0[2], v0[3]); w.z = cvt_pk_bf16(v1[0], v1[1]); w.w = cvt_pk_bf16(v1[2], v1[3]);
                    *(u32x4*)(rowp + bj * HALF) = w; } }
        if (colsq) {
#pragma unroll
            for (int bj = 0; bj < 2; ++bj)
#pragma unroll
                for (int n = 0; n < 2; ++n) {
                    f32x4 ss = {0.f, 0.f, 0.f, 0.f};
#pragma unroll
                    for (int ai = 0; ai < 2; ++ai)
#pragma unroll
                        for (int m = 0; m < 4; ++m) ss += acc[ai][bj][m][n] * acc[ai][bj][m][n];
#pragma unroll
                    for (int o = 1; o < 16; o <<= 1) { ss[0] += __shfl_xor(ss[0], o); ss[1] += __shfl_xor(ss[1], o); ss[2] += __shfl_xor(ss[2], o); ss[3] += __shfl_xor(ss[3], o); }
                    if (fr == 0) *(f32x4*)(colsq + (size_t)(2 * u.pm + wr) * colsq_ld + ct * BM + bj * HALF + wc * 32 + 8 * fq + 4 * n) = ss;
                }
        }
    }
};
struct EpiRes {
    static constexpr bool PERM = false, AFTER_DRAIN = false;
    const float* xin; float* out;
    __device__ __forceinline__ void operator()(const f32x4 (&acc)[2][2][4][2], const Unit& u, int wr, int wc, int fr, int fq) const {
        const int row0 = u.pm * BM + wr * 64 + fr, col0 = u.pn * BM + wc * 32 + 4 * fq;
#pragma unroll
        for (int ai = 0; ai < 2; ++ai)
#pragma unroll
            for (int m = 0; m < 4; ++m) { const size_t ro = (size_t)(row0 + ai * HALF + m * 16) * 1024 + col0;
#pragma unroll
                for (int bj = 0; bj < 2; ++bj)
#pragma unroll
                    for (int n = 0; n < 2; ++n) { const f32x4 xv = *(const f32x4*)(xin + ro + bj * HALF + n * 16);
                        *(f32x4*)(out + ro + bj * HALF + n * 16) = acc[ai][bj][m][n] + xv; } }
    }
};

template <class Epi, class Sched>
__device__ __forceinline__ void gemm_phase(PG8_LAS unsigned char* lds, const Gemm g, const Sched& S, const Epi& E) {
    int tid = threadIdx.x; asm volatile("" : "+v"(tid));
    const int wid = __builtin_amdgcn_readfirstlane(tid >> 6), lane = tid & 63, wr = wid >> 2, wc = wid & 3, fr = lane & 15, fq = lane >> 4;
    const int K = g.K, nt = K / BK;
    const char* gA = (const char*)g.A; const char* gB = (const char*)g.Bt; asm volatile("" : "+s"(gA), "+s"(gB));
    unsigned voffA[2], voffB[2];
#pragma unroll
    for (int i = 0; i < 2; ++i) { int R, C; stage_rc(tid * 16 + i * 8192, R, C); const int Rb = Epi::PERM ? ((R & ~31) + perm32(R & 31)) : R;
        voffA[i] = (unsigned)(R * K + C) * 2u; voffB[i] = (unsigned)(Rb * K + C) * 2u; }
    const size_t kstep = (size_t)(BK * 2);
    const size_t hstep = (size_t)HALF * K * 2;
    const size_t tstep = 2 * hstep;
    const unsigned ldsw = (unsigned)wid * 1024u;
    const int aoff = lds_byte(wr * 64 + fr, fq * 8), boff = lds_byte(wc * 32 + fr, fq * 8);
#define PG8_SA(b, h) (((b) * 2 + (h)) * HTB)
#define PG8_SB(b, h) ((4 + (b) * 2 + (h)) * HTB)
#define PG8_STAGE(bufoff, gbase, voff) do { _Pragma("unroll") for (int _i = 0; _i < 2; ++_i) \
        __builtin_amdgcn_global_load_lds((const unsigned*)((const char*)(gbase) + (voff)[_i]), (PG8_LAS unsigned*)(lds + (bufoff) + ldsw + _i * 8192), 16, 0, 0); } while (0)
#define PG8_LDA(dst, b, h) do { _Pragma("unroll") for (int m = 0; m < 4; ++m) _Pragma("unroll") for (int k = 0; k < 2; ++k) dst[m][k] = *(const PG8_LAS bf16x8*)(lds + PG8_SA(b, h) + aoff + m * 2048 + k * 1024); } while (0)
#define PG8_LDB(dst, b, h) do { _Pragma("unroll") for (int n = 0; n < 2; ++n) _Pragma("unroll") for (int k = 0; k < 2; ++k) dst[n][k] = *(const PG8_LAS bf16x8*)(lds + PG8_SB(b, h) + boff + n * 2048 + k * 1024); } while (0)
#define PG8_MMA(ai, bj, At, Bt) do { __builtin_amdgcn_s_setprio(1); _Pragma("unroll") for (int m = 0; m < 4; ++m) _Pragma("unroll") for (int n = 0; n < 2; ++n) _Pragma("unroll") for (int k = 0; k < 2; ++k) \
        acc[ai][bj][m][n] = __builtin_amdgcn_mfma_f32_16x16x32_bf16(Bt[n][k], At[m][k], acc[ai][bj][m][n], 0, 0, 0); __builtin_amdgcn_s_setprio(0); } while (0)
#define PG8_WAIT_V(n) asm volatile("s_waitcnt vmcnt(" #n ")" ::: "memory")
#define PG8_WAIT_L(n) asm volatile("s_waitcnt lgkmcnt(" #n ")" ::: "memory")
#define PG8_BAR __builtin_amdgcn_s_barrier()
#define PG8_SCHED __builtin_amdgcn_sched_barrier(0)
    Unit cur, nxt; int ui = 0;
    if (!S.next(0, cur)) return;
    f32x4 acc[2][2][4][2];
#pragma unroll
    for (int a = 0; a < 2; ++a)
#pragma unroll
        for (int b = 0; b < 2; ++b)
#pragma unroll
            for (int m = 0; m < 4; ++m)
#pragma unroll
                for (int n = 0; n < 2; ++n) acc[a][b][m][n] = (f32x4){0.f, 0.f, 0.f, 0.f};
    bf16x8 At[4][2], B0[2][2], B1[2][2];
    const char* cA = gA + (size_t)cur.pm * tstep; const char* cB = gB + (size_t)cur.pn * tstep;
    S.a_ready(cur);
    PG8_STAGE(PG8_SB(0, 0), cB, voffB); PG8_STAGE(PG8_SA(0, 0), cA, voffA); PG8_STAGE(PG8_SB(0, 1), cB + hstep, voffB); PG8_STAGE(PG8_SA(0, 1), cA + hstep, voffA);
    if (wr == 1) PG8_BAR;
    PG8_WAIT_V(4); PG8_BAR;
    PG8_STAGE(PG8_SB(1, 0), cB + kstep, voffB); PG8_STAGE(PG8_SA(1, 0), cA + kstep, voffA); PG8_STAGE(PG8_SB(1, 1), cB + hstep + kstep, voffB);
    PG8_WAIT_V(6); PG8_BAR;
    for (;;) {
        const bool has_next = S.next(ui + 1, nxt);
        const char* nA = has_next ? gA + (size_t)nxt.pm * tstep : cA; const char* nB = has_next ? gB + (size_t)nxt.pn * tstep : cB;
        for (int t = 0; t < nt; t += 2) {
            const bool last = (t == nt - 2);
            const char* a1 = cA + (size_t)(t + 1) * kstep;
            const char* a2 = last ? nA : cA + (size_t)(t + 2) * kstep; const char* b2 = last ? nB : cB + (size_t)(t + 2) * kstep;
            const char* a3 = a2 + kstep; const char* b3 = b2 + kstep;
            if (last && has_next) S.a_ready(nxt);
            PG8_LDB(B0, 0, 0); PG8_SCHED; PG8_LDA(At, 0, 0); PG8_STAGE(PG8_SA(1, 1), a1 + hstep, voffA);
            PG8_WAIT_L(8); PG8_BAR; PG8_WAIT_L(0); PG8_MMA(0, 0, At, B0); PG8_BAR; PG8_SCHED;
            PG8_LDB(B1, 0, 1); PG8_STAGE(PG8_SB(0, 0), b2, voffB);
            PG8_BAR; PG8_WAIT_L(0); PG8_MMA(0, 1, At, B1); PG8_BAR;
            PG8_LDA(At, 0, 1); PG8_STAGE(PG8_SA(0, 0), a2, voffA);
            PG8_BAR; PG8_WAIT_L(0); PG8_MMA(1, 0, At, B0); PG8_BAR; PG8_SCHED;
            PG8_STAGE(PG8_SB(0, 1), b2 + hstep, voffB);
            PG8_WAIT_V(6); PG8_BAR; PG8_MMA(1, 1, At, B1); PG8_BAR;
            PG8_LDB(B0, 1, 0); PG8_SCHED; PG8_LDA(At, 1, 0); PG8_STAGE(PG8_SA(0, 1), a2 + hstep, voffA);
            PG8_WAIT_L(8); PG8_BAR; PG8_WAIT_L(0); PG8_MMA(0, 0, At, B0); PG8_BAR; PG8_SCHED;
            PG8_LDB(B1, 1, 1); PG8_STAGE(PG8_SB(1, 0), b3, voffB);
            PG8_BAR; PG8_WAIT_L(0); PG8_MMA(0, 1, At, B1); PG8_BAR;
            PG8_LDA(At, 1, 1); PG8_STAGE(PG8_SA(1, 0), a3, voffA);
            PG8_BAR; PG8_WAIT_L(0); PG8_MMA(1, 0, At, B0); PG8_BAR; PG8_SCHED;
            PG8_STAGE(PG8_SB(1, 1), b3 + hstep, voffB);
            PG8_WAIT_V(6); PG8_BAR; PG8_MMA(1, 1, At, B1); PG8_BAR;
        }
        if constexpr (!Epi::AFTER_DRAIN) { E(acc, cur, wr, wc, fr, fq); S.done(cur); }
        if (!has_next) break;
#pragma unroll
        for (int a = 0; a < 2; ++a)
#pragma unroll
            for (int b = 0; b < 2; ++b)
#pragma unroll
                for (int m = 0; m < 4; ++m)
#pragma unroll
                    for (int n = 0; n < 2; ++n) acc[a][b][m][n] = (f32x4){0.f, 0.f, 0.f, 0.f};
        cur = nxt; cA = nA; cB = nB; ++ui;
    }
    PG8_WAIT_V(0);
    if (wr == 0) PG8_BAR;
    PG8_BAR;
    if constexpr (Epi::AFTER_DRAIN) { E.fused(acc, cur, wr, wc, fr, fq, lds, wid, lane); S.done(cur); }
#undef PG8_SA
#undef PG8_SB
#undef PG8_STAGE
#undef PG8_LDA
#undef PG8_LDB
#undef PG8_MMA
#undef PG8_WAIT_V
#undef PG8_WAIT_L
#undef PG8_BAR
#undef PG8_SCHED
}
}

#define XB_TMO      128
#define XB_XCNT(j)  (256  + 64 * (j))
#define XB_XSUB(j)  (1280 + 64 * (j))
#define XB_XGEN(j)  (2304 + 64 * (j))
#define XB_TOP      3328
#define XB_TOPGEN   3392
#define XCD_BAR_WORDS 3456
#define XB_SPIN_CAP (1u << 18)
#define LAS __attribute__((address_space(3)))

__device__ __forceinline__ unsigned xb_ld(unsigned* p)              { return __hip_atomic_load(p, __ATOMIC_RELAXED, __HIP_MEMORY_SCOPE_AGENT); }
__device__ __forceinline__ unsigned xb_add(unsigned* p, unsigned v) { return __hip_atomic_fetch_add(p, v, __ATOMIC_RELAXED, __HIP_MEMORY_SCOPE_AGENT); }
__device__ __forceinline__ unsigned xb_xcc_id() { return (unsigned)__builtin_amdgcn_s_getreg((3 << 11) | 20) & 0xFu; }
#define XB_SPIN(cond, bar) do { unsigned _sp = 0; while (cond) { __builtin_amdgcn_s_sleep(1); \
    if ((++_sp & 255u) == 0u) { if (xb_ld(&(bar)[XB_TMO])) break; if (_sp > XB_SPIN_CAP) { atomicAdd(&(bar)[XB_TMO], 1u); break; } } } } while (0)

struct XcdBarrier {
    unsigned* bar; unsigned x;
    volatile LAS unsigned* st;
};

__device__ __forceinline__ XcdBarrier xcd_barrier_post(unsigned* bar, volatile LAS unsigned* st) {
    XcdBarrier b; b.bar = bar; b.x = xb_xcc_id(); b.st = st;
    if (threadIdx.x == 0) (void)xb_add(&bar[XB_XCNT(b.x)], 1u);
    return b;
}
__device__ __forceinline__ void xcd_barrier_complete(unsigned* bar, unsigned x, unsigned& nloc, unsigned& nx) {
    const unsigned G = gridDim.x * gridDim.y * gridDim.z;
    unsigned sum, cnt, mine, sp = 0u;
    for (;;) {
        sum = 0u; cnt = 0u; mine = 0u;
#pragma unroll
        for (unsigned j = 0; j < 16; ++j) { const unsigned c = xb_ld(&bar[XB_XCNT(j)]); sum += c; cnt += (c > 0u) ? 1u : 0u; mine = (j == x) ? c : mine; }
        if (sum == G) break;
        __builtin_amdgcn_s_sleep(1);
        if ((++sp & 255u) == 0u) { if (xb_ld(&bar[XB_TMO])) break; if (sp > XB_SPIN_CAP) { atomicAdd(&bar[XB_TMO], 1u); break; } }
    }
    nloc = mine > 0u ? mine : 1u; nx = cnt > 0u ? cnt : 1u;
}

__device__ __forceinline__ void xcd_barrier(const XcdBarrier& b) {
    asm volatile("s_waitcnt vmcnt(0)" ::: "memory");
    __syncthreads();
    if (threadIdx.x == 0) {
        unsigned* bar = b.bar;
        __builtin_amdgcn_s_waitcnt(0);
        unsigned nloc = b.st[0], nx = b.st[1];
        if (nloc == 0u) { xcd_barrier_complete(bar, b.x, nloc, nx); b.st[0] = nloc; b.st[1] = nx; }
        const unsigned old = xb_add(&bar[XB_XSUB(b.x)], 1u);
        const unsigned gen = old / nloc;
        if (old + 1u == (gen + 1u) * nloc) {
            __builtin_amdgcn_fence(__ATOMIC_RELEASE, "agent");
            asm volatile("s_waitcnt vmcnt(0)" ::: "memory");
            const unsigned og = xb_add(&bar[XB_TOP], 1u);
            const unsigned tg = og / nx;
            if (og + 1u == (tg + 1u) * nx) xb_add(&bar[XB_TOPGEN], 1u);
            else XB_SPIN(xb_ld(&bar[XB_TOPGEN]) == tg, bar);
            __builtin_amdgcn_fence(__ATOMIC_ACQUIRE, "agent");
            xb_add(&bar[XB_XGEN(b.x)], 1u);
            asm volatile("s_waitcnt vmcnt(0)" ::: "memory");
        } else {
            XB_SPIN(xb_ld(&bar[XB_XGEN(b.x)]) == gen, bar);
            __builtin_amdgcn_fence(__ATOMIC_ACQUIRE, "agent");
            asm volatile("s_waitcnt vmcnt(0)" ::: "memory");
        }
    }
    __syncthreads();
}

using pg8::bf16_t; using pg8::bf16x8; using pg8::f32x4;
typedef unsigned u32x2_t __attribute__((ext_vector_type(2)));
typedef unsigned u32x4_t __attribute__((ext_vector_type(4)));

constexpr int DM = 1024, SEG = 16384, LDZ = 8192, LDY = 2560;
constexpr float EPS = 1e-6f;
constexpr int LDS_BYTES = 131072 + 64;
constexpr size_t WS_WIN_E = 0;
constexpr size_t WS_WIN_O = WS_WIN_E + (size_t)9216 * 1024 * 2;
constexpr size_t WS_WOUT_E = WS_WIN_O + (size_t)6144 * 1024 * 2;
constexpr size_t WS_WOUT_O = WS_WOUT_E + (size_t)1024 * 2560 * 2;
constexpr size_t WS_WKV = WS_WOUT_O + (size_t)1024 * 2560 * 2;
constexpr size_t WS_LRUW = WS_WKV + (size_t)2 * 1024 * 1024 * 2;
constexpr size_t WS_SGUW = WS_LRUW + (size_t)2 * 2 * 8 * 128 * 128 * 2;
constexpr size_t WS_MEMN = WS_SGUW + (size_t)8 * 128 * 128 * 2;
constexpr size_t WS_MK = WS_MEMN + (size_t)2 * 1536 * 1024 * 2;
constexpr size_t WS_MVT = WS_MK + (size_t)2 * 1536 * 512 * 2;
constexpr size_t WS_H = WS_MVT + (size_t)2 * 512 * 1536 * 2;
constexpr size_t WS_Z = WS_H + (size_t)SEG * 1024 * 2;
constexpr size_t WS_VT = WS_Z + (size_t)SEG * LDZ * 2;
constexpr size_t WS_Y = WS_VT + (size_t)1024 * SEG * 2;
constexpr size_t WS_AGG = WS_Y + (size_t)SEG * LDY * 2;
constexpr size_t WS_CARRY = WS_AGG + (size_t)2 * 128 * 1024 * 2 * 4;
constexpr size_t WS_RSTD = WS_CARRY + (size_t)2 * 128 * 1024 * 4;
constexpr size_t WS_PART = WS_RSTD + (size_t)SEG * 4;
constexpr size_t WS_BAR = WS_PART + (size_t)8 * SEG * 4;
constexpr size_t WS_END = WS_BAR + 16384;

struct Params { const float* in[25]; float* out; unsigned char* ws; };

__device__ __forceinline__ float bf2f(unsigned short b) { return __uint_as_float(((unsigned)b) << 16); }
__device__ __forceinline__ unsigned short f2bf(float f) { unsigned u = __float_as_uint(f); u += 0x7FFFu + ((u >> 16) & 1u); return (unsigned short)(u >> 16); }
__device__ __forceinline__ float bflo(unsigned w) { return __uint_as_float(w << 16); }
__device__ __forceinline__ float bfhi(unsigned w) { return __uint_as_float(w & 0xffff0000u); }
__device__ __forceinline__ unsigned pk2(float lo, float hi) { return pg8::cvt_pk_bf16(lo, hi); }
__device__ __forceinline__ float frcp(float x) { return __builtin_amdgcn_rcpf(x); }
__device__ __forceinline__ float silu(float x) { return x * frcp(1.0f + __expf(-x)); }
__device__ __forceinline__ float sigm(float x) { return frcp(1.0f + __expf(-x)); }
__device__ __forceinline__ float wave_sum(float v) {
#pragma unroll
    for (int o = 1; o < 64; o <<= 1) v += __shfl_xor(v, o);
    return v;
}
__device__ __forceinline__ f32x4 mfma16(bf16x8 a, bf16x8 b, f32x4 c) { return __builtin_amdgcn_mfma_f32_16x16x32_bf16(a, b, c, 0, 0, 0); }
__device__ __forceinline__ bf16x8 ld8(const bf16_t* p) { return *(const bf16x8*)p; }
__device__ __forceinline__ bf16x8 pack8(const float (&v)[8]) {
    u32x4_t w; w.x = pk2(v[0], v[1]); w.y = pk2(v[2], v[3]); w.z = pk2(v[4], v[5]); w.w = pk2(v[6], v[7]);
    return __builtin_bit_cast(bf16x8, w);
}

__device__ __forceinline__ void transpose_tile(const float* src, int R, int C, bf16_t* dst, int tile, float* lds) {
    const int ntc = C >> 6, tr = tile / ntc, tc = tile - tr * ntc, r0 = tr * 64, c0 = tc * 64;
    const int tx = threadIdx.x & 63, ty = threadIdx.x >> 6;
#pragma unroll
    for (int i = 0; i < 8; ++i) { const int r = ty + 8 * i; lds[r * 65 + tx] = src[(size_t)(r0 + r) * C + c0 + tx]; }
    __syncthreads();
#pragma unroll
    for (int i = 0; i < 8; ++i) { const int c = ty + 8 * i; dst[(size_t)(c0 + c) * R + r0 + tx] = f2bf(lds[tx * 65 + c]); }
    __syncthreads();
}

__device__ __forceinline__ void rms_row_bf16(const float* xrow, const float* g, bf16_t* orow, int lane) {
    const f32x4* xr = (const f32x4*)xrow + lane; f32x4 v[4]; float s = 0.f;
#pragma unroll
    for (int j = 0; j < 4; ++j) { v[j] = xr[64 * j]; s += (v[j].x * v[j].x + v[j].y * v[j].y) + (v[j].z * v[j].z + v[j].w * v[j].w); }
    const float rstd = __builtin_amdgcn_rsqf(wave_sum(s) * (1.0f / 1024.0f) + EPS);
    const f32x4* gr = (const f32x4*)g + lane; u32x2_t* o8 = (u32x2_t*)orow + lane;
#pragma unroll
    for (int j = 0; j < 4; ++j) { const f32x4 gg = gr[64 * j]; u32x2_t o; o.x = pk2(v[j].x * rstd * gg.x, v[j].y * rstd * gg.y); o.y = pk2(v[j].z * rstd * gg.z, v[j].w * rstd * gg.w); o8[64 * j] = o; }
}
__device__ __forceinline__ void rms_row_f32(float* xrow, const float* g, int lane) {
    f32x4* xr = (f32x4*)xrow + lane; f32x4 v[4]; float s = 0.f;
#pragma unroll
    for (int j = 0; j < 4; ++j) { v[j] = xr[64 * j]; s += (v[j].x * v[j].x + v[j].y * v[j].y) + (v[j].z * v[j].z + v[j].w * v[j].w); }
    const float rstd = __builtin_amdgcn_rsqf(wave_sum(s) * (1.0f / 1024.0f) + EPS);
    const f32x4* gr = (const f32x4*)g + lane;
#pragma unroll
    for (int j = 0; j < 4; ++j) { const f32x4 gg = gr[64 * j]; f32x4 o; o.x = v[j].x * rstd * gg.x; o.y = v[j].y * rstd * gg.y; o.z = v[j].z * rstd * gg.z; o.w = v[j].w * rstd * gg.w; xr[64 * j] = o; }
}

__device__ __forceinline__ void conv_even_item(const bf16_t* z, const float* cw, const float* cb, bf16_t* y, int t, int T, int lane) {
    const int s = t & (T - 1);
#pragma unroll
    for (int half = 0; half < 2; ++half) {
        const int c0 = half * 512 + lane * 8;
        const bf16_t* zr = z + (size_t)t * LDZ + c0;
        const u32x4_t bg = *(const u32x4_t*)(zr), ga = *(const u32x4_t*)(zr + 3072);
        const u32x4_t cg1 = *(const u32x4_t*)(zr + 1024), xv1 = *(const u32x4_t*)(zr + 2048);
        u32x4_t cg0 = {0, 0, 0, 0}, xv0 = {0, 0, 0, 0}, cg2 = {0, 0, 0, 0}, xv2 = {0, 0, 0, 0};
        if (s > 0) { cg0 = *(const u32x4_t*)(zr - LDZ + 1024); xv0 = *(const u32x4_t*)(zr - LDZ + 2048); }
        if (s < T - 1) { cg2 = *(const u32x4_t*)(zr + LDZ + 1024); xv2 = *(const u32x4_t*)(zr + LDZ + 2048); }
        float w0[8], w1[8], w2[8], bb[8];
#pragma unroll
        for (int e = 0; e < 8; e += 4) {
            const f32x4 a = *(const f32x4*)(cw + c0 + e), b = *(const f32x4*)(cw + 1024 + c0 + e), c = *(const f32x4*)(cw + 2048 + c0 + e), d = *(const f32x4*)(cb + c0 + e);
#pragma unroll
            for (int k = 0; k < 4; ++k) { w0[e + k] = a[k]; w1[e + k] = b[k]; w2[e + k] = c[k]; bb[e + k] = d[k]; }
        }
        float o[8];
#pragma unroll
        for (int k = 0; k < 4; ++k) {
            const float p0l = bflo(cg0[k]) * bflo(xv0[k]), p0h = bfhi(cg0[k]) * bfhi(xv0[k]);
            const float p1l = bflo(cg1[k]) * bflo(xv1[k]), p1h = bfhi(cg1[k]) * bfhi(xv1[k]);
            const float p2l = bflo(cg2[k]) * bflo(xv2[k]), p2h = bfhi(cg2[k]) * bfhi(xv2[k]);
            const float cl = bb[2 * k] + w0[2 * k] * p0l + w1[2 * k] * p1l + w2[2 * k] * p2l;
            const float ch = bb[2 * k + 1] + w0[2 * k + 1] * p0h + w1[2 * k + 1] * p1h + w2[2 * k + 1] * p2h;
            o[2 * k] = bflo(bg[k]) * cl * silu(bflo(ga[k]));
            o[2 * k + 1] = bfhi(bg[k]) * ch * silu(bfhi(ga[k]));
        }
        u32x4_t w; w.x = pk2(o[0], o[1]); w.y = pk2(o[2], o[3]); w.z = pk2(o[4], o[5]); w.w = pk2(o[6], o[7]);
        *(u32x4_t*)(y + (size_t)t * LDY + c0) = w;
    }
}

__device__ __forceinline__ void conv_odd_item(const bf16_t* z, const float* cw, const float* cb, bf16_t* xc, int t, int T, int lane) {
    const int s = t & (T - 1);
#pragma unroll
    for (int half = 0; half < 2; ++half) {
        const int c0 = half * 512 + lane * 8;
        const bf16_t* zr = z + (size_t)t * LDZ + c0;
        float acc[8];
#pragma unroll
        for (int e = 0; e < 8; e += 4) { const f32x4 d = *(const f32x4*)(cb + c0 + e); acc[e] = d[0]; acc[e + 1] = d[1]; acc[e + 2] = d[2]; acc[e + 3] = d[3]; }
#pragma unroll
        for (int j = 0; j < 4; ++j) {
            const int sj = s + j - 2;
            if (sj >= 0 && sj < T) {
                const u32x4_t xv = *(const u32x4_t*)(zr + (ptrdiff_t)(j - 2) * LDZ);
                const f32x4 wa = *(const f32x4*)(cw + j * 1024 + c0), wb = *(const f32x4*)(cw + j * 1024 + c0 + 4);
                acc[0] += wa[0] * bflo(xv[0]); acc[1] += wa[1] * bfhi(xv[0]); acc[2] += wa[2] * bflo(xv[1]); acc[3] += wa[3] * bfhi(xv[1]);
                acc[4] += wb[0] * bflo(xv[2]); acc[5] += wb[1] * bfhi(xv[2]); acc[6] += wb[2] * bflo(xv[3]); acc[7] += wb[3] * bfhi(xv[3]);
            }
        }
        u32x4_t w; w.x = pk2(acc[0], acc[1]); w.y = pk2(acc[2], acc[3]); w.z = pk2(acc[4], acc[5]); w.w = pk2(acc[6], acc[7]);
        *(u32x4_t*)(xc + (size_t)t * 1024 + c0) = w;
    }
}
__device__ __forceinline__ void rstd_item(const float* part, float* rstd, int tg, int lane) {
    const float* p = part + tg * 64 + lane; float s = 0.f;
#pragma unroll
    for (int i = 0; i < 8; ++i) s += p[(size_t)i * SEG];
    rstd[tg * 64 + lane] = __builtin_amdgcn_rsqf(s * (1.0f / 1024.0f) + EPS);
}

__device__ __forceinline__ void na_item(const bf16_t* z, const bf16_t* vT, bf16_t* y, const LAS float* rpbL, int item, int T, int lane) {
    const int g = item & 3, h = (item >> 2) & 15, R = item >> 6;
    const int rows = T >> 6, seq = R / rows, r = R - seq * rows, seq_base = seq * T;
    int rstart = r - 4; rstart = rstart < 0 ? 0 : rstart; rstart = rstart > rows - 8 ? rows - 8 : rstart;
    const int wb = (g == 0) ? 0 : (g == 1) ? 8 : (g == 2) ? 24 : 32;
    const int fr = lane & 15, fq = lane >> 4;
    const int tok = seq_base + r * 64 + g * 16 + fr;
    const bf16_t* qp = z + (size_t)tok * LDZ + 4096 + h * 64 + fq * 8;
    const bf16x8 q0 = ld8(qp), q1 = ld8(qp + 32);
    const int kcolA = wb + (fr >> 2) * 8 + (fr & 3);
    const bf16_t* kp0 = z + (size_t)(seq_base + rstart * 64 + kcolA) * LDZ + 5120 + h * 64 + fq * 8;
    bf16x8 kf[8][4];
#pragma unroll
    for (int kr = 0; kr < 8; ++kr) { const bf16_t* kp = kp0 + (size_t)kr * 64 * LDZ; kf[kr][0] = ld8(kp); kf[kr][1] = ld8(kp + 32); kf[kr][2] = ld8(kp + 4 * LDZ); kf[kr][3] = ld8(kp + 4 * LDZ + 32); }
    const int qc = g * 16 + fr;
    int cstart = qc - 8; cstart = cstart < 0 ? 0 : cstart; cstart = cstart > 48 ? 48 : cstart;
    int dcs[8]; bool oks[8];
#pragma unroll
    for (int e = 0; e < 8; ++e) { const int kc = wb + fq * 8 + e; oks[e] = (kc >= cstart) && (kc < cstart + 16); int dc = kc - qc; dc = dc < -15 ? -15 : dc; dc = dc > 15 ? 15 : dc; dcs[e] = dc + 15; }
    const LAS float* bp0 = rpbL + (h * 15 + rstart - r + 7) * 31;
    float s[8][8];
    float mx = -1e30f;
#pragma unroll
    for (int kr = 0; kr < 8; ++kr) {
        f32x4 a0 = {0.f, 0.f, 0.f, 0.f}, a1 = {0.f, 0.f, 0.f, 0.f};
        a0 = mfma16(kf[kr][0], q0, a0); a0 = mfma16(kf[kr][1], q1, a0);
        a1 = mfma16(kf[kr][2], q0, a1); a1 = mfma16(kf[kr][3], q1, a1);
#pragma unroll
        for (int e = 0; e < 8; ++e) {
            const float sc = (e < 4 ? a0[e & 3] : a1[e & 3]) * 0.125f + bp0[kr * 31 + dcs[e]];
            s[kr][e] = oks[e] ? sc : -1e30f;
            mx = fmaxf(mx, s[kr][e]);
        }
    }
    const bf16_t* vp0 = vT + (size_t)(h * 64 + fr) * SEG + seq_base + rstart * 64 + wb + fq * 8;
    bf16x8 vf[8][4];
#pragma unroll
    for (int kr = 0; kr < 8; ++kr)
#pragma unroll
        for (int dt = 0; dt < 4; ++dt) vf[kr][dt] = ld8(vp0 + kr * 64 + (size_t)dt * 16 * SEG);
    u32x2_t gr[4];
#pragma unroll
    for (int dt = 0; dt < 4; ++dt) gr[dt] = *(const u32x2_t*)(z + (size_t)tok * LDZ + 6144 + h * 64 + dt * 16 + fq * 4);
    mx = fmaxf(mx, __shfl_xor(mx, 16)); mx = fmaxf(mx, __shfl_xor(mx, 32));
    float sum = 0.f;
#pragma unroll
    for (int kr = 0; kr < 8; ++kr)
#pragma unroll
        for (int e = 0; e < 8; ++e) { const float p = __expf(s[kr][e] - mx); s[kr][e] = p; sum += p; }
    sum += __shfl_xor(sum, 16); sum += __shfl_xor(sum, 32);
    f32x4 o[4];
#pragma unroll
    for (int dt = 0; dt < 4; ++dt) o[dt] = (f32x4){0.f, 0.f, 0.f, 0.f};
#pragma unroll
    for (int kr = 0; kr < 8; ++kr) {
        const bf16x8 pf = pack8(s[kr]);
#pragma unroll
        for (int dt = 0; dt < 4; ++dt) o[dt] = mfma16(vf[kr][dt], pf, o[dt]);
    }
    const float inv = frcp(sum);
#pragma unroll
    for (int dt = 0; dt < 4; ++dt) {
        const int d4 = dt * 16 + fq * 4;
        u32x2_t ow;
        ow.x = pk2(o[dt][0] * inv * silu(bflo(gr[dt].x)), o[dt][1] * inv * silu(bfhi(gr[dt].x)));
        ow.y = pk2(o[dt][2] * inv * silu(bflo(gr[dt].y)), o[dt][3] * inv * silu(bfhi(gr[dt].y)));
        *(u32x2_t*)(y + (size_t)tok * LDY + 1024 + h * 64 + d4) = ow;
    }
}

__device__ __forceinline__ void mem_unit(const bf16_t* z, int qcol, int gcol, const bf16_t* mk, const bf16_t* mvT, bf16_t* y, int unit, int seg, LAS unsigned char* lds, int tid) {
    const int h = unit & 3, range = unit >> 2, tokr = range * 256;
    const int mb = seg < 2 ? seg : 2 + (tokr >> 12);
    const int lane = tid & 63, wid = tid >> 6, fr = lane & 15, fq = lane >> 4;
    __syncthreads();
#pragma unroll
    for (int i = 0; i < 8; ++i) {
        const int idx = tid + 512 * i, rho = idx >> 4, c = idx & 15, f = (rho & 3) | (((rho >> 3) & 3) << 2);
        const u32x4_t v = *(const u32x4_t*)(mk + (size_t)(mb * 256 + rho) * 512 + h * 128 + c * 8);
        *(LAS u32x4_t*)(lds + rho * 256 + ((c ^ f) << 4)) = v;
    }
#pragma unroll
    for (int i = 0; i < 8; ++i) {
        const int idx = tid + 512 * i, d = idx >> 5, c = idx & 31;
        const u32x4_t v = *(const u32x4_t*)(mvT + (size_t)(h * 128 + d) * 1536 + mb * 256 + c * 8);
        *(LAS u32x4_t*)(lds + 65536 + d * 512 + ((c ^ (d & 15)) << 4)) = v;
    }
    __syncthreads();
    const int mrowA = (fr >> 2) * 8 + (fr & 3);
    const LAS unsigned char* kbase = lds + mrowA * 256 + ((fq ^ (fr & 3)) << 4);
    const LAS unsigned char* vbase = lds + 65536 + fr * 512 + ((fq ^ (fr & 3)) << 4);
    const int hi = fr >> 2;
#pragma unroll 1
    for (int gi = 0; gi < 2; ++gi) {
        const int tok = tokr + (wid + 8 * gi) * 16 + fr;
        const bf16_t* qp = z + (size_t)tok * LDZ + qcol + h * 128 + fq * 8;
        bf16x8 q[4];
#pragma unroll
        for (int ks = 0; ks < 4; ++ks) q[ks] = ld8(qp + ks * 32);
        u32x2_t gr[8];
#pragma unroll
        for (int dt = 0; dt < 8; ++dt) gr[dt] = *(const u32x2_t*)(z + (size_t)tok * LDZ + gcol + h * 128 + dt * 16 + fq * 4);
        float s[8][8];
        float mx = -1e30f;
#pragma unroll
        for (int kb = 0; kb < 8; ++kb) {
            f32x4 a0 = {0.f, 0.f, 0.f, 0.f}, a1 = {0.f, 0.f, 0.f, 0.f};
#pragma unroll
            for (int ks = 0; ks < 4; ++ks) {
                const LAS unsigned char* kp = kbase + kb * 8192 + ((ks ^ hi) << 6);
                a0 = mfma16(*(const LAS bf16x8*)kp, q[ks], a0); a1 = mfma16(*(const LAS bf16x8*)(kp + 1024), q[ks], a1);
            }
#pragma unroll
            for (int e = 0; e < 8; ++e) { s[kb][e] = (e < 4 ? a0[e & 3] : a1[e & 3]) * 0.08838834764831845f; mx = fmaxf(mx, s[kb][e]); }
        }
        mx = fmaxf(mx, __shfl_xor(mx, 16)); mx = fmaxf(mx, __shfl_xor(mx, 32));
        float sum = 0.f;
#pragma unroll
        for (int kb = 0; kb < 8; ++kb)
#pragma unroll
            for (int e = 0; e < 8; ++e) { const float p = __expf(s[kb][e] - mx); s[kb][e] = p; sum += p; }
        sum += __shfl_xor(sum, 16); sum += __shfl_xor(sum, 32);
        f32x4 o[8];
#pragma unroll
        for (int dt = 0; dt < 8; ++dt) o[dt] = (f32x4){0.f, 0.f, 0.f, 0.f};
#pragma unroll
        for (int kb = 0; kb < 8; ++kb) {
            const bf16x8 pf = pack8(s[kb]);
            const LAS unsigned char* vp = vbase + (((kb ^ hi) & 7) << 6);
#pragma unroll
            for (int dt = 0; dt < 8; ++dt) o[dt] = mfma16(*(const LAS bf16x8*)(vp + dt * 8192), pf, o[dt]);
        }
        const float inv = frcp(sum);
#pragma unroll
        for (int dt = 0; dt < 8; ++dt) {
            const int d4 = dt * 16 + fq * 4;
            u32x2_t ow;
            ow.x = pk2(o[dt][0] * inv * silu(bflo(gr[dt].x)), o[dt][1] * inv * silu(bfhi(gr[dt].x)));
            ow.y = pk2(o[dt][2] * inv * silu(bflo(gr[dt].y)), o[dt][3] * inv * silu(bfhi(gr[dt].y)));
            *(u32x2_t*)(y + (size_t)tok * LDY + 2048 + h * 128 + d4) = ow;
        }
    }
}

template <int CTRL> __device__ __forceinline__ float dppf(float oldv, float src) {
    return __int_as_float(__builtin_amdgcn_update_dpp(__float_as_int(oldv), __float_as_int(src), CTRL, 0xf, 0xf, false));
}
template <int DIR> __device__ __forceinline__ void scan16(float& A, float& B) {
    constexpr int BASE = DIR == 0 ? 0x110 : 0x100;
    { const float ap = dppf<BASE + 1>(1.f, A), bp = dppf<BASE + 1>(0.f, B); B = A * bp + B; A = A * ap; }
    { const float ap = dppf<BASE + 2>(1.f, A), bp = dppf<BASE + 2>(0.f, B); B = A * bp + B; A = A * ap; }
    { const float ap = dppf<BASE + 4>(1.f, A), bp = dppf<BASE + 4>(0.f, B); B = A * bp + B; A = A * ap; }
    { const float ap = dppf<BASE + 8>(1.f, A), bp = dppf<BASE + 8>(0.f, B); B = A * bp + B; A = A * ap; }
}
struct LruW { bf16x8 Wa[4], Wi[4]; float ba[4], bi[4], c8[4]; };
template <int DIR, bool FINAL> __device__ __forceinline__ void lru_tile(const bf16_t* xc, const LruW& W, int tok, int blk, int ch4, int lane, float (&hin)[4], float (&arun)[4], float (&hout)[4]) {
    const int fq = lane >> 4;
    const bf16_t* xp = xc + (size_t)tok * 1024 + blk * 128 + fq * 8;
    f32x4 accR = {0.f, 0.f, 0.f, 0.f}, accI = {0.f, 0.f, 0.f, 0.f};
#pragma unroll
    for (int ks = 0; ks < 4; ++ks) { const bf16x8 X = ld8(xp + ks * 32); accR = mfma16(W.Wa[ks], X, accR); accI = mfma16(W.Wi[ks], X, accI); }
    const u32x2_t xr = *(const u32x2_t*)(xc + (size_t)tok * 1024 + ch4);
    const float xv[4] = {bflo(xr.x), bfhi(xr.x), bflo(xr.y), bfhi(xr.y)};
    const int src = (lane & 48) + (DIR == 0 ? 15 : 0);
#pragma unroll
    for (int jj = 0; jj < 4; ++jj) {
        const float rg = sigm(accR[jj] + W.ba[jj]), ig = sigm(accI[jj] + W.bi[jj]);
        const float la = W.c8[jj] * rg;
        float A = __expf(la);
        float B = __builtin_amdgcn_sqrtf(fmaxf(1.0f - A * A, 0.f)) * (ig * xv[jj]);
        scan16<DIR>(A, B);
        const float hval = A * hin[jj] + B;
        hout[jj] = hval;
        hin[jj] = __shfl(hval, src);
        if (!FINAL) arun[jj] *= __shfl(A, src);
    }
}
template <bool FINAL> __device__ __forceinline__ void lru_item(const bf16_t* xc, const bf16_t* z, const bf16_t* lruw, const float* ba_, const float* bi_, const float* lam_,
                                                               float* agg, const float* carry, bf16_t* y, int item, int lane) {
    const int cgi = item & 63, chunk = item >> 6, blk = cgi >> 3, w = cgi & 7;
    const int fr = lane & 15, fq = lane >> 4;
    const int ch4 = blk * 128 + w * 16 + fq * 4;
    float hf[8][4];
#pragma unroll
    for (int dir = 0; dir < 2; ++dir) {
        LruW W;
        const bf16_t* wa = lruw + ((size_t)((0 * 2 + dir) * 8 + blk) * 128 + w * 16 + fr) * 128 + fq * 8;
        const bf16_t* wi = lruw + ((size_t)((1 * 2 + dir) * 8 + blk) * 128 + w * 16 + fr) * 128 + fq * 8;
#pragma unroll
        for (int ks = 0; ks < 4; ++ks) { W.Wa[ks] = ld8(wa + ks * 32); W.Wi[ks] = ld8(wi + ks * 32); }
        float hin[4], arun[4];
#pragma unroll
        for (int jj = 0; jj < 4; ++jj) {
            W.ba[jj] = ba_[dir * 1024 + ch4 + jj]; W.bi[jj] = bi_[dir * 1024 + ch4 + jj];
            const float lam = lam_[dir * 1024 + ch4 + jj];
            W.c8[jj] = -8.0f * log1pf(__expf(-lam));
            hin[jj] = FINAL ? carry[(size_t)(dir * 128 + chunk) * 1024 + ch4 + jj] : 0.f;
            arun[jj] = 1.f;
        }
#pragma unroll
        for (int step = 0; step < 8; ++step) {
            const int tt = dir == 0 ? step : 7 - step;
            const int tok = chunk * 128 + tt * 16 + fr;
            float hv[4];
            if (dir == 0) lru_tile<0, FINAL>(xc, W, tok, blk, ch4, lane, hin, arun, hv);
            else lru_tile<1, FINAL>(xc, W, tok, blk, ch4, lane, hin, arun, hv);
            if (FINAL) {
                if (dir == 0) {
#pragma unroll
                    for (int jj = 0; jj < 4; ++jj) hf[tt][jj] = hv[jj];
                } else {
                    const u32x2_t gr = *(const u32x2_t*)(z + (size_t)tok * LDZ + 1024 + ch4);
                    const float gc[4] = {bflo(gr.x), bfhi(gr.x), bflo(gr.y), bfhi(gr.y)};
                    float o[4];
#pragma unroll
                    for (int jj = 0; jj < 4; ++jj) o[jj] = (hf[tt][jj] + hv[jj]) * silu(gc[jj]);
                    u32x2_t ow; ow.x = pk2(o[0], o[1]); ow.y = pk2(o[2], o[3]);
                    *(u32x2_t*)(y + (size_t)tok * LDY + ch4) = ow;
                }
            }
        }
        if (!FINAL && fr == 0) {
#pragma unroll
            for (int jj = 0; jj < 4; ++jj) { float2 v; v.x = arun[jj]; v.y = hin[jj]; *(float2*)(agg + ((size_t)(dir * 128 + chunk) * 1024 + ch4 + jj) * 2) = v; }
        }
    }
}
__device__ __forceinline__ void carry_phase(const float* agg, float* carry, int nseq, int gtid, int gthreads) {
    const int nc = 128 / nseq;
    for (int idx = gtid; idx < 2 * nseq * 1024; idx += gthreads) {
        const int ch = idx & 1023, rest = idx >> 10, dir = rest & 1, sq = rest >> 1, base = sq * nc;
        float h = 0.f;
#pragma unroll 8
        for (int c = 0; c < nc; ++c) {
            const int C = base + (dir == 0 ? c : nc - 1 - c);
            const size_t o = (size_t)(dir * 128 + C) * 1024 + ch;
            const float2 ah = *(const float2*)(agg + o * 2);
            carry[o] = h;
            h = ah.x * h + ah.y;
        }
    }
}

__device__ __forceinline__ void sgu_item(const bf16_t* vT, const float* rstd, const bf16_t* z, const bf16_t* sguw, const float* sgu_g, const float* sgu_b, bf16_t* y, int item, int lane) {
    const int dd = item & 7, g = (item >> 3) & 7, n = item >> 6;
    const int fr = lane & 15, fq = lane >> 4;
    const int tokc = n * 128;
    const bf16_t* ap = vT + (size_t)(g * 128 + dd * 16 + fr) * SEG + tokc + fq * 8;
    bf16x8 Af[4];
#pragma unroll
    for (int ks = 0; ks < 4; ++ks) {
        const u32x4_t raw = *(const u32x4_t*)(ap + ks * 32);
        const f32x4 r0 = *(const f32x4*)(rstd + tokc + ks * 32 + fq * 8), r1 = *(const f32x4*)(rstd + tokc + ks * 32 + fq * 8 + 4);
        u32x4_t w;
        w.x = pk2(bflo(raw.x) * r0[0], bfhi(raw.x) * r0[1]); w.y = pk2(bflo(raw.y) * r0[2], bfhi(raw.y) * r0[3]);
        w.z = pk2(bflo(raw.z) * r1[0], bfhi(raw.z) * r1[1]); w.w = pk2(bflo(raw.w) * r1[2], bfhi(raw.w) * r1[3]);
        Af[ks] = __builtin_bit_cast(bf16x8, w);
    }
    const int ch4 = g * 128 + dd * 16 + fq * 4;
    const f32x4 g4 = *(const f32x4*)(sgu_g + ch4);
#pragma unroll
    for (int pt = 0; pt < 8; ++pt) {
        const int p = pt * 16 + fr;
        const bf16_t* bp = sguw + (size_t)(g * 128 + p) * 128 + fq * 8;
        f32x4 acc = {0.f, 0.f, 0.f, 0.f};
#pragma unroll
        for (int ks = 0; ks < 4; ++ks) acc = mfma16(Af[ks], ld8(bp + ks * 32), acc);
        const int tok = tokc + p;
        const float bsv = sgu_b[g * 128 + p];
        const u32x2_t ur = *(const u32x2_t*)(z + (size_t)tok * LDZ + 2048 + ch4), gr = *(const u32x2_t*)(z + (size_t)tok * LDZ + 3072 + ch4);
        const float uu[4] = {bflo(ur.x), bfhi(ur.x), bflo(ur.y), bfhi(ur.y)}, gd[4] = {bflo(gr.x), bfhi(gr.x), bflo(gr.y), bfhi(gr.y)};
        float o[4];
#pragma unroll
        for (int jj = 0; jj < 4; ++jj) o[jj] = uu[jj] * (acc[jj] * g4[jj] + bsv) * silu(gd[jj]);
        u32x2_t ow; ow.x = pk2(o[0], o[1]); ow.y = pk2(o[2], o[3]);
        *(u32x2_t*)(y + (size_t)tok * LDY + 1024 + ch4) = ow;
    }
}

__global__ void __launch_bounds__(512, 2) fwd_megakernel(Params P) {
    extern __shared__ __attribute__((aligned(16))) unsigned char shm[];
    cg::grid_group grid = cg::this_grid();
    PG8_LAS unsigned char* lds = (PG8_LAS unsigned char*)shm;
    const int G = gridDim.x, NW = G * 8;
#define FRESH_TID() int tid = threadIdx.x; asm volatile("" : "+v"(tid)); const int lane = tid & 63, wid = tid >> 6, gw = blockIdx.x * 8 + wid; (void)lane; (void)gw
    unsigned char* ws = P.ws;
    bf16_t* WIN_E = (bf16_t*)(ws + WS_WIN_E); bf16_t* WIN_O = (bf16_t*)(ws + WS_WIN_O);
    bf16_t* WOUT_E = (bf16_t*)(ws + WS_WOUT_E); bf16_t* WOUT_O = (bf16_t*)(ws + WS_WOUT_O);
    bf16_t* WKV = (bf16_t*)(ws + WS_WKV); bf16_t* LRUW = (bf16_t*)(ws + WS_LRUW); bf16_t* SGUW = (bf16_t*)(ws + WS_SGUW);
    bf16_t* MEMN = (bf16_t*)(ws + WS_MEMN); bf16_t* MK = (bf16_t*)(ws + WS_MK); bf16_t* MVT = (bf16_t*)(ws + WS_MVT);
    bf16_t* H = (bf16_t*)(ws + WS_H); bf16_t* Z = (bf16_t*)(ws + WS_Z); bf16_t* VT = (bf16_t*)(ws + WS_VT); bf16_t* Y = (bf16_t*)(ws + WS_Y);
    float* AGG = (float*)(ws + WS_AGG); float* CARRY = (float*)(ws + WS_CARRY); float* RSTD = (float*)(ws + WS_RSTD); float* PART = (float*)(ws + WS_PART);

    unsigned* BAR = (unsigned*)(ws + WS_BAR);
    volatile LAS unsigned* xst = (volatile LAS unsigned*)(lds + 131072);
    {
        FRESH_TID();
        if (tid < 2) xst[tid] = 0u;
        if (blockIdx.x == 0) for (int i = tid; i < XCD_BAR_WORDS; i += 512) BAR[i] = 0u;
        float* scr = (float*)shm;
        constexpr int I0 = 16 * 144, I1 = 16 * 96, I2 = 40 * 16, I3 = 40 * 16, I4 = 256, I5 = 256, I6 = 64, I7 = 64;
        constexpr int NIT = I0 + I1 + I2 + I3 + I4 + I5 + I6 + I7;
        for (int it = blockIdx.x; it < NIT; it += G) {
            int r = it;
            if (r < I0) { transpose_tile(P.in[7], 1024, 9216, WIN_E, r, scr); continue; } r -= I0;
            if (r < I1) { transpose_tile(P.in[12], 1024, 6144, WIN_O, r, scr); continue; } r -= I1;
            if (r < I2) { transpose_tile(P.in[11], 2560, 1024, WOUT_E, r, scr); continue; } r -= I2;
            if (r < I3) { transpose_tile(P.in[23], 2560, 1024, WOUT_O, r, scr); continue; } r -= I3;
            if (r < I4) { transpose_tile(P.in[6], 1024, 1024, WKV, r, scr); continue; } r -= I4;
            if (r < I5) { transpose_tile(P.in[6] + (size_t)1024 * 1024, 1024, 1024, WKV + (size_t)1024 * 1024, r, scr); continue; } r -= I5;
            if (r < I6) { const int m = r >> 2; transpose_tile(P.in[15] + (size_t)m * 16384, 128, 128, LRUW + (size_t)m * 16384, r & 3, scr); continue; } r -= I6;
            { const int m = r >> 2; transpose_tile(P.in[17] + (size_t)m * 16384, 128, 128, LRUW + (size_t)(16 + m) * 16384, r & 3, scr); }
        }
        for (int i = blockIdx.x * 512 + tid; i < 8 * 128 * 128; i += G * 512) SGUW[i] = f2bf(P.in[21][i]);
        for (int it = gw; it < 2 * 1536; it += NW) {
            const int l = it / 1536, row = it - l * 1536;
            const float* src = row < 512 ? P.in[2] + (size_t)row * 1024 : P.in[3] + (size_t)(row - 512) * 1024;
            rms_row_bf16(src, P.in[5] + l * 1024, MEMN + ((size_t)l * 1536 + row) * 1024, lane);
        }
    }

    grid.sync();
    const XcdBarrier xb = xcd_barrier_post(BAR, xst);
    for (int seg = 0; seg < 3; ++seg) {
        const float* xin = seg < 2 ? P.in[0] + (size_t)seg * SEG * 1024 : P.in[1];
        float* xout = P.out + (size_t)seg * SEG * 1024;
        const int T = seg < 2 ? 16384 : 4096, nseq = seg < 2 ? 1 : 4;

        { FRESH_TID();
        for (int it = gw; it < SEG; it += NW) rms_row_bf16(xin + (size_t)it * 1024, P.in[4], H + (size_t)it * 1024, lane); }
        xcd_barrier(xb);

        {
            pg8::Gemm g; g.A = H; g.Bt = WIN_E; g.M = SEG; g.N = 8192; g.K = 1024;
            pg8::SkipOrder S; S.init(SEG, 8192, G, blockIdx.x); S.skip_from = 24; S.skip_n = 4;
            pg8::EpiZ E; E.O = Z; E.ldc = LDZ; E.skip_from = 24; E.skip_n = 4; E.colsq = nullptr; E.colsq_ld = 0;
            pg8::gemm_phase(lds, g, S, E);
        }
        {
            pg8::Gemm g; g.A = WIN_E + (size_t)6144 * 1024; g.Bt = H; g.M = 1024; g.N = SEG; g.K = 1024;
            pg8::SkipOrder S; S.init(1024, SEG, G, blockIdx.x); S.skip_from = 1 << 20; S.skip_n = 0;
            pg8::EpiZ E; E.O = VT; E.ldc = SEG; E.skip_from = 1 << 20; E.skip_n = 0; E.colsq = nullptr; E.colsq_ld = 0;
            pg8::gemm_phase(lds, g, S, E);
        }
        if (seg == 0) {
#pragma unroll 1
            for (int l = 0; l < 2; ++l) {
                {
                    pg8::Gemm g; g.A = MEMN + (size_t)l * 1536 * 1024; g.Bt = WKV + (size_t)l * 1024 * 1024; g.M = 1536; g.N = 512; g.K = 1024;
                    pg8::SkipOrder S; S.init(1536, 512, G, (blockIdx.x + G - (32 * l) % G) % G); S.skip_from = 1 << 20; S.skip_n = 0;
                    pg8::EpiZ E; E.O = MK + (size_t)l * 1536 * 512; E.ldc = 512; E.skip_from = 1 << 20; E.skip_n = 0; E.colsq = nullptr; E.colsq_ld = 0;
                    pg8::gemm_phase(lds, g, S, E);
                }
                {
                    pg8::Gemm g; g.A = WKV + (size_t)l * 1024 * 1024 + (size_t)512 * 1024; g.Bt = MEMN + (size_t)l * 1536 * 1024; g.M = 512; g.N = 1536; g.K = 1024;
                    pg8::SkipOrder S; S.init(512, 1536, G, (blockIdx.x + G - (32 * l + 16) % G) % G); S.skip_from = 1 << 20; S.skip_n = 0;
                    pg8::EpiZ E; E.O = MVT + (size_t)l * 512 * 1536; E.ldc = 1536; E.skip_from = 1 << 20; E.skip_n = 0; E.colsq = nullptr; E.colsq_ld = 0;
                    pg8::gemm_phase(lds, g, S, E);
                }
            }
        }
        xcd_barrier(xb);

        { FRESH_TID();
        for (int u = blockIdx.x; u < 256; u += G) mem_unit(Z, 7168, 7680, MK, MVT, Y, u, seg, lds, tid);
        __syncthreads();
        LAS float* rpbL = (LAS float*)lds;
        for (int i = tid; i < 16 * 15 * 31; i += 512) rpbL[i] = P.in[10][i];
        __syncthreads();
        for (int it = gw; it < 16384 + 16384; it += NW) {
            if (it < 16384) na_item(Z, VT, Y, rpbL, it, T, lane);
            else conv_even_item(Z, P.in[8], P.in[9], Y, it - 16384, T, lane);
        } }
        xcd_barrier(xb);

        {
            pg8::Gemm g; g.A = Y; g.Bt = WOUT_E; g.M = SEG; g.N = 1024; g.K = 2560;
            pg8::StaticOrder S; S.init(SEG, 1024, G, blockIdx.x);
            pg8::EpiRes E; E.xin = xin; E.out = xout;
            pg8::gemm_phase(lds, g, S, E);
        }
        xcd_barrier(xb);

        { FRESH_TID();
        for (int it = gw; it < SEG; it += NW) rms_row_bf16(xout + (size_t)it * 1024, P.in[4] + 1024, H + (size_t)it * 1024, lane); }
        xcd_barrier(xb);

        {
            pg8::Gemm g; g.A = H; g.Bt = WIN_O; g.M = SEG; g.N = 5120; g.K = 1024;
            pg8::SkipOrder S; S.init(SEG, 5120, G, blockIdx.x); S.skip_from = 12; S.skip_n = 4;
            pg8::EpiZ E; E.O = Z; E.ldc = LDZ; E.skip_from = 12; E.skip_n = 4; E.colsq = nullptr; E.colsq_ld = 0;
            pg8::gemm_phase(lds, g, S, E);
        }
        {
            pg8::Gemm g; g.A = WIN_O + (size_t)3072 * 1024; g.Bt = H; g.M = 1024; g.N = SEG; g.K = 1024;
            pg8::SkipOrder S; S.init(1024, SEG, G, blockIdx.x); S.skip_from = 1 << 20; S.skip_n = 0;
            pg8::EpiZ E; E.O = VT; E.ldc = SEG; E.skip_from = 1 << 20; E.skip_n = 0; E.colsq = PART; E.colsq_ld = SEG;
            pg8::gemm_phase(lds, g, S, E);
        }
        xcd_barrier(xb);

        { FRESH_TID();
        for (int it = gw; it < SEG + 256; it += NW) {
            if (it < SEG) conv_odd_item(Z, P.in[13], P.in[14], H, it, T, lane);
            else rstd_item(PART, RSTD, it - SEG, lane);
        } }
        xcd_barrier(xb);

        { FRESH_TID();
        for (int u = blockIdx.x; u < 256; u += G) mem_unit(Z, 4096, 4608, MK + (size_t)1536 * 512, MVT + (size_t)512 * 1536, Y, u, seg, lds, tid);
        for (int it = gw; it < 8192 + 8192; it += NW) {
            if (it < 8192) lru_item<false>(H, Z, LRUW, P.in[16], P.in[18], P.in[19], AGG, CARRY, Y, it, lane);
            else sgu_item(VT, RSTD, Z, SGUW, P.in[20], P.in[22], Y, it - 8192, lane);
        } }
        xcd_barrier(xb);

        { FRESH_TID(); carry_phase(AGG, CARRY, nseq, blockIdx.x * 512 + tid, G * 512); }
        xcd_barrier(xb);

        { FRESH_TID();
        for (int it = gw; it < 8192; it += NW) lru_item<true>(H, Z, LRUW, P.in[16], P.in[18], P.in[19], AGG, CARRY, Y, it, lane); }
        xcd_barrier(xb);

        {
            pg8::Gemm g; g.A = Y; g.Bt = WOUT_O; g.M = SEG; g.N = 1024; g.K = 2560;
            pg8::StaticOrder S; S.init(SEG, 1024, G, blockIdx.x);
            pg8::EpiRes E; E.xin = xout; E.out = xout;
            pg8::gemm_phase(lds, g, S, E);
        }
        xcd_barrier(xb);

        { FRESH_TID();
        for (int it = gw; it < SEG; it += NW) rms_row_f32(xout + (size_t)it * 1024, P.in[24], lane); }
    }
}

extern "C" void kernel_launch(void* const* d_in, const int* in_sizes, int n_in, void* d_out, int out_size, void* d_ws, size_t ws_size, hipStream_t stream) {
    static int grid_blocks = 0;
    if (grid_blocks == 0) {
        if (n_in != 25 || ws_size < WS_END) { fprintf(stderr, "kernel_launch: need 25 inputs and %zu bytes of workspace; got %d, %zu\n", (size_t)WS_END, n_in, ws_size); grid_blocks = -1; return; }
        int dev = 0, cus = 0, per_cu = 0;
        hipGetDevice(&dev);
        hipDeviceGetAttribute(&cus, hipDeviceAttributeMultiprocessorCount, dev);
        hipFuncSetAttribute((const void*)fwd_megakernel, hipFuncAttributeMaxDynamicSharedMemorySize, LDS_BYTES);
        hipOccupancyMaxActiveBlocksPerMultiprocessor(&per_cu, (const void*)fwd_megakernel, 512, LDS_BYTES);
        if (per_cu < 1) { fprintf(stderr, "kernel_launch: occupancy query says %d blocks per CU\n", per_cu); grid_blocks = -1; return; }
        grid_blocks = cus;
    }
    if (grid_blocks < 0) return;
    Params p{};
    for (int i = 0; i < 25; ++i) p.in[i] = (const float*)d_in[i];
    p.out = (float*)d_out; p.ws = (unsigned char*)d_ws;
    void* args[] = {&p};
    hipError_t e = hipLaunchCooperativeKernel((const void*)fwd_megakernel, dim3(grid_blocks), dim3(512), args, LDS_BYTES, stream);
    if (e != hipSuccess) fprintf(stderr, "cooperative launch failed: %s (grid %d)\n", hipGetErrorString(e), grid_blocks);
}
```

```cpp
#include <hip/hip_runtime.h>
#include <hip/hip_cooperative_groups.h>
#include <cstdio>
namespace cg = cooperative_groups;
namespace pg8 {
#define PG8_LAS __attribute__((address_space(3)))
typedef unsigned short bf16_t;
typedef short bf16x8 __attribute__((ext_vector_type(8)));
typedef float f32x4 __attribute__((ext_vector_type(4)));
typedef unsigned u32x4 __attribute__((ext_vector_type(4)));
constexpr int BM = 256, BK = 64, HALF = 128, HTB = HALF * BK * 2  , STAGE_BYTES = 8 * HTB, NXCD = 8, WGM = 8;

__host__ __device__ __forceinline__ int lds_byte(int r, int c) { const int st = (r >> 4) * 2 + (c >> 5), rr = r & 15, cc = c & 31, ob = rr * 64 + cc * 2; return st * 1024 + (ob ^ (((ob >> 9) & 1) << 5)); }
__host__ __device__ __forceinline__ void stage_rc(int b, int& R, int& C) { const int st = b / 1024, sb = b % 1024, swz = sb ^ (((sb >> 9) & 1) << 5); R = (st >> 1) * 16 + swz / 64; C = (st & 1) * 32 + (swz % 64) / 2; }
__host__ __device__ __forceinline__ int perm32(int rho) { const int n = rho >> 4, i = rho & 15; return 8 * (i >> 2) + 4 * n + (i & 3); }

struct Unit { int pm, pn; };
struct Gemm { const bf16_t* A; const bf16_t* Bt; int M, N, K; };

struct StaticOrder {
    int nM, nN, nwg, G, c;
    __host__ __device__ void init(int M, int N, int G_, int c_) { nM = M / BM; nN = N / BM; nwg = nM * nN; G = G_; c = c_; }
    __host__ __device__ bool next(int i, Unit& u) const {
        const long L = (long)i * G + c; if (L >= nwg) return false;
        int wgid = (int)L; { const int q = nwg / NXCD, r = nwg % NXCD, xcd = wgid % NXCD, off = wgid / NXCD; wgid = (xcd < r ? xcd * (q + 1) : r * (q + 1) + (xcd - r) * q) + off; }
        const int nig = WGM * nN, gid = wgid / nig, fm = gid * WGM, gsz = (nM - fm) < WGM ? (nM - fm) : WGM;
        u.pm = fm + ((wgid % nig) % gsz); u.pn = (wgid % nig) / gsz; return true;
    }
    __device__ __forceinline__ void a_ready(const Unit&) const {}
    __device__ __forceinline__ void done(const Unit&) const {}
};

struct SkipOrder : StaticOrder {
    int skip_from, skip_n;
    __device__ __forceinline__ bool next(int i, Unit& u) const {
        if (!StaticOrder::next(i, u)) return false;
        if (u.pn >= skip_from) u.pn += skip_n;
        return true;
    }
};

__device__ __forceinline__ unsigned cvt_pk_bf16(float lo, float hi) { unsigned r; asm volatile("v_cvt_pk_bf16_f32 %0, %1, %2" : "=v"(r) : "v"(lo), "v"(hi)); return r; }

struct EpiZ {
    static constexpr bool PERM = true, AFTER_DRAIN = false;
    bf16_t* O; int ldc; int skip_from, skip_n; float* colsq; int colsq_ld;
    __device__ __forceinline__ void operator()(const f32x4 (&acc)[2][2][4][2], const Unit& u, int wr, int wc, int fr, int fq) const {
        const int row0 = u.pm * BM + wr * 64 + fr; const int ct = (u.pn >= skip_from + skip_n) ? (u.pn - skip_n) : u.pn;
        const int col0 = ct * BM + wc * 32 + 8 * fq;
#pragma unroll
        for (int ai = 0; ai < 2; ++ai)
#pragma unroll
            for (int m = 0; m < 4; ++m) { bf16_t* rowp = O + (size_t)(row0 + ai * HALF + m * 16) * ldc + col0;
#pragma unroll
                for (int bj = 0; bj < 2; ++bj) { const f32x4 v0 = acc[ai][bj][m][0], v1 = acc[ai][bj][m][1];
                    u32x4 w; w.x = cvt_pk_bf16(v0[0], v0[1]); w.y = cvt_pk_bf16(v0[2], v0[3]); w.z = cvt_pk_bf16(v1[0], v1[1]); w.w = cvt_pk_bf16(v1[2], v1[3]);
                    *(u32x4*)(rowp + bj * HALF) = w; } }
        if (colsq) {
#pragma unroll
            for (int bj = 0; bj < 2; ++bj)
#pragma unroll
                for (int n = 0; n < 2; ++n) {
                    f32x4 ss = {0.f, 0.f, 0.f, 0.f};
#pragma unroll
                    for (int ai = 0; ai < 2; ++ai)
#pragma unroll
                        for (int m = 0; m < 4; ++m) ss += acc[ai][bj][m][n] * acc[ai][bj][m][n];
#pragma unroll
                    for (int o = 1; o < 16; o <<= 1) { ss[0] += __shfl_xor(ss[0], o); ss[1] += __shfl_xor(ss[1], o); ss[2] += __shfl_xor(ss[2], o); ss[3] += __shfl_xor(ss[3], o); }
                    if (fr == 0) *(f32x4*)(colsq + (size_t)(2 * u.pm + wr) * colsq_ld + ct * BM + bj * HALF + wc * 32 + 8 * fq + 4 * n) = ss;
                }
        }
    }
};
struct EpiRes {
    static constexpr bool PERM = false, AFTER_DRAIN = false;
    const float* xin; float* out;
    __device__ __forceinline__ void operator()(const f32x4 (&acc)[2][2][4][2], const Unit& u, int wr, int wc, int fr, int fq) const {
        const int row0 = u.pm * BM + wr * 64 + fr, col0 = u.pn * BM + wc * 32 + 4 * fq;
#pragma unroll
        for (int ai = 0; ai < 2; ++ai)
#pragma unroll
            for (int m = 0; m < 4; ++m) { const size_t ro = (size_t)(row0 + ai * HALF + m * 16) * 1024 + col0;
#pragma unroll
                for (int bj = 0; bj < 2; ++bj)
#pragma unroll
                    for (int n = 0; n < 2; ++n) { const f32x4 xv = *(const f32x4*)(xin + ro + bj * HALF + n * 16);
                        *(f32x4*)(out + ro + bj * HALF + n * 16) = acc[ai][bj][m][n] + xv; } }
    }
};

template <class Epi, class Sched>
__device__ __forceinline__ void gemm_phase(PG8_LAS unsigned char* lds, const Gemm g, const Sched& S, const Epi& E) {
    int tid = threadIdx.x; asm volatile("" : "+v"(tid));
    const int wid = __builtin_amdgcn_readfirstlane(tid >> 6), lane = tid & 63, wr = wid >> 2, wc = wid & 3, fr = lane & 15, fq = lane >> 4;
    const int K = g.K, nt = K / BK;
    const char* gA = (const char*)g.A; const char* gB = (const char*)g.Bt; asm volatile("" : "+s"(gA), "+s"(gB));
    unsigned voffA[2], voffB[2];
#pragma unroll
    for (int i = 0; i < 2; ++i) { int R, C; stage_rc(tid * 16 + i * 8192, R, C); const int Rb = Epi::PERM ? ((R & ~31) + perm32(R & 31)) : R;
        voffA[i] = (unsigned)(R * K + C) * 2u; voffB[i] = (unsigned)(Rb * K + C) * 2u; }
    const size_t kstep = (size_t)(BK * 2);
    const size_t hstep = (size_t)HALF * K * 2;
    const size_t tstep = 2 * hstep;
    const unsigned ldsw = (unsigned)wid * 1024u;
    const int aoff = lds_byte(wr * 64 + fr, fq * 8), boff = lds_byte(wc * 32 + fr, fq * 8);
#define PG8_SA(b, h) (((b) * 2 + (h)) * HTB)
#define PG8_SB(b, h) ((4 + (b) * 2 + (h)) * HTB)
#define PG8_STAGE(bufoff, gbase, voff) do { _Pragma("unroll") for (int _i = 0; _i < 2; ++_i) \
        __builtin_amdgcn_global_load_lds((const unsigned*)((const char*)(gbase) + (voff)[_i]), (PG8_LAS unsigned*)(lds + (bufoff) + ldsw + _i * 8192), 16, 0, 0); } while (0)
#define PG8_LDA(dst, b, h) do { _Pragma("unroll") for (int m = 0; m < 4; ++m) _Pragma("unroll") for (int k = 0; k < 2; ++k) dst[m][k] = *(const PG8_LAS bf16x8*)(lds + PG8_SA(b, h) + aoff + m * 2048 + k * 1024); } while (0)
#define PG8_LDB(dst, b, h) do { _Pragma("unroll") for (int n = 0; n < 2; ++n) _Pragma("unroll") for (int k = 0; k < 2; ++k) dst[n][k] = *(const PG8_LAS bf16x8*)(lds + PG8_SB(b, h) + boff + n * 2048 + k * 1024); } while (0)
#define PG8_MMA(ai, bj, At, Bt) do { __builtin_amdgcn_s_setprio(1); _Pragma("unroll") for (int m = 0; m < 4; ++m) _Pragma("unroll") for (int n = 0; n < 2; ++n) _Pragma("unroll") for (int k = 0; k < 2; ++k) \
        acc[ai][bj][m][n] = __builtin_amdgcn_mfma_f32_16x16x32_bf16(Bt[n][k], At[m][k], acc[ai][bj][m][n], 0, 0, 0); __builtin_amdgcn_s_setprio(0); } while (0)
#define PG8_WAIT_V(n) asm volatile("s_waitcnt vmcnt(" #n ")" ::: "memory")
#define PG8_WAIT_L(n) asm volatile("s_waitcnt lgkmcnt(" #n ")" ::: "memory")
#define PG8_BAR __builtin_amdgcn_s_barrier()
#define PG8_SCHED __builtin_amdgcn_sched_barrier(0)
    Unit cur, nxt; int ui = 0;
    if (!S.next(0, cur)) return;
    f32x4 acc[2][2][4][2];
#pragma unroll
    for (int a = 0; a < 2; ++a)
#pragma unroll
        for (int b = 0; b < 2; ++b)
#pragma unroll
            for (int m = 0; m < 4; ++m)
#pragma unroll
                for (int n = 0; n < 2; ++n) acc[a][b][m][n] = (f32x4){0.f, 0.f, 0.f, 0.f};
    bf16x8 At[4][2], B0[2][2], B1[2][2];
    const char* cA = gA + (size_t)cur.pm * tstep; const char* cB = gB + (size_t)cur.pn * tstep;
    S.a_ready(cur);
    PG8_STAGE(PG8_SB(0, 0), cB, voffB); PG8_STAGE(PG8_SA(0, 0), cA, voffA); PG8_STAGE(PG8_SB(0, 1), cB + hstep, voffB); PG8_STAGE(PG8_SA(0, 1), cA + hstep, voffA);
    if (wr == 1) PG8_BAR;
    PG8_WAIT_V(4); PG8_BAR;
    PG8_STAGE(PG8_SB(1, 0), cB + kstep, voffB); PG8_STAGE(PG8_SA(1, 0), cA + kstep, voffA); PG8_STAGE(PG8_SB(1, 1), cB + hstep + kstep, voffB);
    PG8_WAIT_V(6); PG8_BAR;
    for (;;) {
        const bool has_next = S.next(ui + 1, nxt);
        const char* nA = has_next ? gA + (size_t)nxt.pm * tstep : cA; const char* nB = has_next ? gB + (size_t)nxt.pn * tstep : cB;
        for (int t = 0; t < nt; t += 2) {
            const bool last = (t == nt - 2);
            const char* a1 = cA + (size_t)(t + 1) * kstep;
            const char* a2 = last ? nA : cA + (size_t)(t + 2) * kstep; const char* b2 = last ? nB : cB + (size_t)(t + 2) * kstep;
            const char* a3 = a2 + kstep; const char* b3 = b2 + kstep;
            if (last && has_next) S.a_ready(nxt);
            PG8_LDB(B0, 0, 0); PG8_SCHED; PG8_LDA(At, 0, 0); PG8_STAGE(PG8_SA(1, 1), a1 + hstep, voffA);
            PG8_WAIT_L(8); PG8_BAR; PG8_WAIT_L(0); PG8_MMA(0, 0, At, B0); PG8_BAR; PG8_SCHED;
            PG8_LDB(B1, 0, 1); PG8_STAGE(PG8_SB(0, 0), b2, voffB);
            PG8_BAR; PG8_WAIT_L(0); PG8_MMA(0, 1, At, B1); PG8_BAR;
            PG8_LDA(At, 0, 1); PG8_STAGE(PG8_SA(0, 0), a2, voffA);
            PG8_BAR; PG8_WAIT_L(0); PG8_MMA(1, 0, At, B0); PG8_BAR; PG8_SCHED;
            PG8_STAGE(PG8_SB(0, 1), b2 + hstep, voffB);
            PG8_WAIT_V(6); PG8_BAR; PG8_MMA(1, 1, At, B1); PG8_BAR;
            PG8_LDB(B0, 1, 0); PG8_SCHED; PG8_LDA(At, 1, 0); PG8_STAGE(PG8_SA(0, 1), a2 + hstep, voffA);
            PG8_WAIT_L(8); PG8_BAR; PG8_WAIT_L(0); PG8_MMA(0, 0, At, B0); PG8_BAR; PG8_SCHED;
            PG8_LDB(B1, 1, 1); PG8_STAGE(PG8_SB(1, 0), b3, voffB);
            PG8_BAR; PG8_WAIT_L(0); PG8_MMA(0, 1, At, B1); PG8_BAR;
            PG8_LDA(At, 1, 1); PG8_STAGE(PG8_SA(1, 0), a3, voffA);
            PG8_BAR; PG8_WAIT_L(0); PG8_MMA(1, 0, At, B0); PG8_BAR; PG8_SCHED;
            PG8_STAGE(PG8_SB(1, 1), b3 + hstep, voffB);
            PG8_WAIT_V(6); PG8_BAR; PG8_MMA(1, 1, At, B1); PG8_BAR;
        }
        if constexpr (!Epi::AFTER_DRAIN) { E(acc, cur, wr, wc, fr, fq); S.done(cur); }
        if (!has_next) break;
#pragma unroll
        for (int a = 0; a < 2; ++a)
#pragma unroll
            for (int b = 0; b < 2; ++b)
#pragma unroll
                for (int m = 0; m < 4; ++m)
#pragma unroll
                    for (int n = 0; n < 2; ++n) acc[a][b][m][n] = (f32x4){0.f, 0.f, 0.f, 0.f};
        cur = nxt; cA = nA; cB = nB; ++ui;
    }
    PG8_WAIT_V(0);
    if (wr == 0) PG8_BAR;
    PG8_BAR;
    if constexpr (Epi::AFTER_DRAIN) { E.fused(acc, cur, wr, wc, fr, fq, lds, wid, lane); S.done(cur); }
#undef PG8_SA
#undef PG8_SB
#undef PG8_STAGE
#undef PG8_LDA
#undef PG8_LDB
#undef PG8_MMA
#undef PG8_WAIT_V
#undef PG8_WAIT_L
#undef PG8_BAR
#undef PG8_SCHED
}
}

#define XB_TMO      128
#define XB_XCNT(j)  (256  + 64 * (j))
#define XB_XSUB(j)  (1280 + 64 * (j))
#define XB_XGEN(j)  (2304 + 64 * (j))
#define XB_TOP      3328
#define XB_TOPGEN   3392
#define XCD_BAR_WORDS 3456
#define XB_SPIN_CAP (1u << 18)
#define LAS __attribute__((address_space(3)))

__device__ __forceinline__ unsigned xb_ld(unsigned* p)              { return __hip_atomic_load(p, __ATOMIC_RELAXED, __HIP_MEMORY_SCOPE_AGENT); }
__device__ __forceinline__ unsigned xb_add(unsigned* p, unsigned v) { return __hip_atomic_fetch_add(p, v, __ATOMIC_RELAXED, __HIP_MEMORY_SCOPE_AGENT); }
__device__ __forceinline__ unsigned xb_xcc_id() { return (unsigned)__builtin_amdgcn_s_getreg((3 << 11) | 20) & 0xFu; }
#define XB_SPIN(cond, bar) do { unsigned _sp = 0; while (cond) { __builtin_amdgcn_s_sleep(1); \
    if ((++_sp & 255u) == 0u) { if (xb_ld(&(bar)[XB_TMO])) break; if (_sp > XB_SPIN_CAP) { atomicAdd(&(bar)[XB_TMO], 1u); break; } } } } while (0)

struct XcdBarrier {
    unsigned* bar; unsigned x;
    volatile LAS unsigned* st;
};

__device__ __forceinline__ XcdBarrier xcd_barrier_post(unsigned* bar, volatile LAS unsigned* st) {
    XcdBarrier b; b.bar = bar; b.x = xb_xcc_id(); b.st = st;
    if (threadIdx.x == 0) (void)xb_add(&bar[XB_XCNT(b.x)], 1u);
    return b;
}
__device__ __forceinline__ void xcd_barrier_complete(unsigned* bar, unsigned x, unsigned& nloc, unsigned& nx) {
    const unsigned G = gridDim.x * gridDim.y * gridDim.z;
    unsigned sum, cnt, mine, sp = 0u;
    for (;;) {
        sum = 0u; cnt = 0u; mine = 0u;
#pragma unroll
        for (unsigned j = 0; j < 16; ++j) { const unsigned c = xb_ld(&bar[XB_XCNT(j)]); sum += c; cnt += (c > 0u) ? 1u : 0u; mine = (j == x) ? c : mine; }
        if (sum == G) break;
        __builtin_amdgcn_s_sleep(1);
        if ((++sp & 255u) == 0u) { if (xb_ld(&bar[XB_TMO])) break; if (sp > XB_SPIN_CAP) { atomicAdd(&bar[XB_TMO], 1u); break; } }
    }
    nloc = mine > 0u ? mine : 1u; nx = cnt > 0u ? cnt : 1u;
}

__device__ __forceinline__ void xcd_barrier(const XcdBarrier& b) {
    asm volatile("s_waitcnt vmcnt(0)" ::: "memory");
    __syncthreads();
    if (threadIdx.x == 0) {
        unsigned* bar = b.bar;
        __builtin_amdgcn_s_waitcnt(0);
        unsigned nloc = b.st[0], nx = b.st[1];
        if (nloc == 0u) { xcd_barrier_complete(bar, b.x, nloc, nx); b.st[0] = nloc; b.st[1] = nx; }
        const unsigned old = xb_add(&bar[XB_XSUB(b.x)], 1u);
        const unsigned gen = old / nloc;
        if (old + 1u == (gen + 1u) * nloc) {
            __builtin_amdgcn_fence(__ATOMIC_RELEASE, "agent");
            asm volatile("s_waitcnt vmcnt(0)" ::: "memory");
            const unsigned og = xb_add(&bar[XB_TOP], 1u);
            const unsigned tg = og / nx;
            if (og + 1u == (tg + 1u) * nx) xb_add(&bar[XB_TOPGEN], 1u);
            else XB_SPIN(xb_ld(&bar[XB_TOPGEN]) == tg, bar);
            __builtin_amdgcn_fence(__ATOMIC_ACQUIRE, "agent");
            xb_add(&bar[XB_XGEN(b.x)], 1u);
            asm volatile("s_waitcnt vmcnt(0)" ::: "memory");
        } else {
            XB_SPIN(xb_ld(&bar[XB_XGEN(b.x)]) == gen, bar);
            __builtin_amdgcn_fence(__ATOMIC_ACQUIRE, "agent");
            asm volatile("s_waitcnt vmcnt(0)" ::: "memory");
        }
    }
    __syncthreads();
}

using pg8::bf16_t; using pg8::bf16x8; using pg8::f32x4;
typedef unsigned u32x2_t __attribute__((ext_vector_type(2)));
typedef unsigned u32x4_t __attribute__((ext_vector_type(4)));

constexpr int DM = 1024, SEG = 16384, LDZ = 8192, LDY = 2560;
constexpr float EPS = 1e-6f;
constexpr int LDS_BYTES = 131072 + 64;
constexpr size_t WS_WIN_E = 0;
constexpr size_t WS_WIN_O = WS_WIN_E + (size_t)9216 * 1024 * 2;
constexpr size_t WS_WOUT_E = WS_WIN_O + (size_t)6144 * 1024 * 2;
constexpr size_t WS_WOUT_O = WS_WOUT_E + (size_t)1024 * 2560 * 2;
constexpr size_t WS_WKV = WS_WOUT_O + (size_t)1024 * 2560 * 2;
constexpr size_t WS_LRUW = WS_WKV + (size_t)2 * 1024 * 1024 * 2;
constexpr size_t WS_SGUW = WS_LRUW + (size_t)2 * 2 * 8 * 128 * 128 * 2;
constexpr size_t WS_MEMN = WS_SGUW + (size_t)8 * 128 * 128 * 2;
constexpr size_t WS_MK = WS_MEMN + (size_t)2 * 1536 * 1024 * 2;
constexpr size_t WS_MVT = WS_MK + (size_t)2 * 1536 * 512 * 2;
constexpr size_t WS_H = WS_MVT + (size_t)2 * 512 * 1536 * 2;
constexpr size_t WS_Z = WS_H + (size_t)SEG * 1024 * 2;
constexpr size_t WS_VT = WS_Z + (size_t)SEG * LDZ * 2;
constexpr size_t WS_Y = WS_VT + (size_t)1024 * SEG * 2;
constexpr size_t WS_AGG = WS_Y + (size_t)SEG * LDY * 2;
constexpr size_t WS_CARRY = WS_AGG + (size_t)2 * 128 * 1024 * 2 * 4;
constexpr size_t WS_RSTD = WS_CARRY + (size_t)2 * 128 * 1024 * 4;
constexpr size_t WS_PART = WS_RSTD + (size_t)SEG * 4;
constexpr size_t WS_BAR = WS_PART + (size_t)8 * SEG * 4;
constexpr size_t WS_END = WS_BAR + 16384;

struct Params { const float* in[25]; float* out; unsigned char* ws; };

__device__ __forceinline__ float bf2f(unsigned short b) { return __uint_as_float(((unsigned)b) << 16); }
__device__ __forceinline__ unsigned short f2bf(float f) { unsigned u = __float_as_uint(f); u += 0x7FFFu + ((u >> 16) & 1u); return (unsigned short)(u >> 16); }
__device__ __forceinline__ float bflo(unsigned w) { return __uint_as_float(w << 16); }
__device__ __forceinline__ float bfhi(unsigned w) { return __uint_as_float(w & 0xffff0000u); }
__device__ __forceinline__ unsigned pk2(float lo, float hi) { return pg8::cvt_pk_bf16(lo, hi); }
__device__ __forceinline__ float frcp(float x) { return __builtin_amdgcn_rcpf(x); }
__device__ __forceinline__ float silu(float x) { return x * frcp(1.0f + __expf(-x)); }
__device__ __forceinline__ float sigm(float x) { return frcp(1.0f + __expf(-x)); }
__device__ __forceinline__ float wave_sum(float v) {
#pragma unroll
    for (int o = 1; o < 64; o <<= 1) v += __shfl_xor(v, o);
    return v;
}
__device__ __forceinline__ f32x4 mfma16(bf16x8 a, bf16x8 b, f32x4 c) { return __builtin_amdgcn_mfma_f32_16x16x32_bf16(a, b, c, 0, 0, 0); }
__device__ __forceinline__ bf16x8 ld8(const bf16_t* p) { return *(const bf16x8*)p; }
__device__ __forceinline__ bf16x8 pack8(const float (&v)[8]) {
    u32x4_t w; w.x = pk2(v[0], v[1]); w.y = pk2(v[2], v[3]); w.z = pk2(v[4], v[5]); w.w = pk2(v[6], v[7]);
    return __builtin_bit_cast(bf16x8, w);
}

__device__ __forceinline__ void transpose_tile(const float* src, int R, int C, bf16_t* dst, int tile, float* lds) {
    const int ntc = C >> 6, tr = tile / ntc, tc = tile - tr * ntc, r0 = tr * 64, c0 = tc * 64;
    const int tx = threadIdx.x & 63, ty = threadIdx.x >> 6;
#pragma unroll
    for (int i = 0; i < 8; ++i) { const int r = ty + 8 * i; lds[r * 65 + tx] = src[(size_t)(r0 + r) * C + c0 + tx]; }
    __syncthreads();
#pragma unroll
    for (int i = 0; i < 8; ++i) { const int c = ty + 8 * i; dst[(size_t)(c0 + c) * R + r0 + tx] = f2bf(lds[tx * 65 + c]); }
    __syncthreads();
}

__device__ __forceinline__ void rms_row_bf16(const float* xrow, const float* g, bf16_t* orow, int lane) {
    const f32x4* xr = (const f32x4*)xrow + lane; f32x4 v[4]; float s = 0.f;
#pragma unroll
    for (int j = 0; j < 4; ++j) { v[j] = xr[64 * j]; s += (v[j].x * v[j].x + v[j].y * v[j].y) + (v[j].z * v[j].z + v[j].w * v[j].w); }
    const float rstd = __builtin_amdgcn_rsqf(wave_sum(s) * (1.0f / 1024.0f) + EPS);
    const f32x4* gr = (const f32x4*)g + lane; u32x2_t* o8 = (u32x2_t*)orow + lane;
#pragma unroll
    for (int j = 0; j < 4; ++j) { const f32x4 gg = gr[64 * j]; u32x2_t o; o.x = pk2(v[j].x * rstd * gg.x, v[j].y * rstd * gg.y); o.y = pk2(v[j].z * rstd * gg.z, v[j].w * rstd * gg.w); o8[64 * j] = o; }
}
__device__ __forceinline__ void rms_row_f32(float* xrow, const float* g, int lane) {
    f32x4* xr = (f32x4*)xrow + lane; f32x4 v[4]; float s = 0.f;
#pragma unroll
    for (int j = 0; j < 4; ++j) { v[j] = xr[64 * j]; s += (v[j].x * v[j].x + v[j].y * v[j].y) + (v[j].z * v[j].z + v[j].w * v[j].w); }
    const float rstd = __builtin_amdgcn_rsqf(wave_sum(s) * (1.0f / 1024.0f) + EPS);
    const f32x4* gr = (const f32x4*)g + lane;
#pragma unroll
    for (int j = 0; j < 4; ++j) { const f32x4 gg = gr[64 * j]; f32x4 o; o.x = v[j].x * rstd * gg.x; o.y = v[j].y * rstd * gg.y; o.z = v[j].z * rstd * gg.z; o.w = v[j].w * rstd * gg.w; xr[64 * j] = o; }
}

__device__ __forceinline__ void conv_even_item(const bf16_t* z, const float* cw, const float* cb, bf16_t* y, int t, int T, int lane) {
    const int s = t & (T - 1);
#pragma unroll
    for (int half = 0; half < 2; ++half) {
        const int c0 = half * 512 + lane * 8;
        const bf16_t* zr = z + (size_t)t * LDZ + c0;
        const u32x4_t bg = *(const u32x4_t*)(zr), ga = *(const u32x4_t*)(zr + 3072);
        const u32x4_t cg1 = *(const u32x4_t*)(zr + 1024), xv1 = *(const u32x4_t*)(zr + 2048);
        u32x4_t cg0 = {0, 0, 0, 0}, xv0 = {0, 0, 0, 0}, cg2 = {0, 0, 0, 0}, xv2 = {0, 0, 0, 0};
        if (s > 0) { cg0 = *(const u32x4_t*)(zr - LDZ + 1024); xv0 = *(const u32x4_t*)(zr - LDZ + 2048); }
        if (s < T - 1) { cg2 = *(const u32x4_t*)(zr + LDZ + 1024); xv2 = *(const u32x4_t*)(zr + LDZ + 2048); }
        float w0[8], w1[8], w2[8], bb[8];
#pragma unroll
        for (int e = 0; e < 8; e += 4) {
            const f32x4 a = *(const f32x4*)(cw + c0 + e), b = *(const f32x4*)(cw + 1024 + c0 + e), c = *(const f32x4*)(cw + 2048 + c0 + e), d = *(const f32x4*)(cb + c0 + e);
#pragma unroll
            for (int k = 0; k < 4; ++k) { w0[e + k] = a[k]; w1[e + k] = b[k]; w2[e + k] = c[k]; bb[e + k] = d[k]; }
        }
        float o[8];
#pragma unroll
        for (int k = 0; k < 4; ++k) {
            const float p0l = bflo(cg0[k]) * bflo(xv0[k]), p0h = bfhi(cg0[k]) * bfhi(xv0[k]);
            const float p1l = bflo(cg1[k]) * bflo(xv1[k]), p1h = bfhi(cg1[k]) * bfhi(xv1[k]);
            const float p2l = bflo(cg2[k]) * bflo(xv2[k]), p2h = bfhi(cg2[k]) * bfhi(xv2[k]);
            const float cl = bb[2 * k] + w0[2 * k] * p0l + w1[2 * k] * p1l + w2[2 * k] * p2l;
            const float ch = bb[2 * k + 1] + w0[2 * k + 1] * p0h + w1[2 * k + 1] * p1h + w2[2 * k + 1] * p2h;
            o[2 * k] = bflo(bg[k]) * cl * silu(bflo(ga[k]));
            o[2 * k + 1] = bfhi(bg[k]) * ch * silu(bfhi(ga[k]));
        }
        u32x4_t w; w.x = pk2(o[0], o[1]); w.y = pk2(o[2], o[3]); w.z = pk2(o[4], o[5]); w.w = pk2(o[6], o[7]);
        *(u32x4_t*)(y + (size_t)t * LDY + c0) = w;
    }
}

__device__ __forceinline__ void conv_odd_item(const bf16_t* z, const float* cw, const float* cb, bf16_t* xc, int t, int T, int lane) {
    const int s = t & (T - 1);
#pragma unroll
    for (int half = 0; half < 2; ++half) {
        const int c0 = half * 512 + lane * 8;
        const bf16_t* zr = z + (size_t)t * LDZ + c0;
        float acc[8];
#pragma unroll
        for (int e = 0; e < 8; e += 4) { const f32x4 d = *(const f32x4*)(cb + c0 + e); acc[e] = d[0]; acc[e + 1] = d[1]; acc[e + 2] = d[2]; acc[e + 3] = d[3]; }
#pragma unroll
        for (int j = 0; j < 4; ++j) {
            const int sj = s + j - 2;
            if (sj >= 0 && sj < T) {
                const u32x4_t xv = *(const u32x4_t*)(zr + (ptrdiff_t)(j - 2) * LDZ);
                const f32x4 wa = *(const f32x4*)(cw + j * 1024 + c0), wb = *(const f32x4*)(cw + j * 1024 + c0 + 4);
                acc[0] += wa[0] * bflo(xv[0]); acc[1] += wa[1] * bfhi(xv[0]); acc[2] += wa[2] * bflo(xv[1]); acc[3] += wa[3] * bfhi(xv[1]);
                acc[4] += wb[0] * bflo(xv[2]); acc[5] += wb[1] * bfhi(xv[2]); acc[6] += wb[2] * bflo(xv[3]); acc[7] += wb[3] * bfhi(xv[3]);
            }
        }
        u32x4_t w; w.x = pk2(acc[0], acc[1]); w.y = pk2(acc[2], acc[3]); w.z = pk2(acc[4], acc[5]); w.w = pk2(acc[6], acc[7]);
        *(u32x4_t*)(xc + (size_t)t * 1024 + c0) = w;
    }
}
__device__ __forceinline__ void rstd_item(const float* part, float* rstd, int tg, int lane) {
    const float* p = part + tg * 64 + lane; float s = 0.f;
#pragma unroll
    for (int i = 0; i < 8; ++i) s += p[(size_t)i * SEG];
    rstd[tg * 64 + lane] = __builtin_amdgcn_rsqf(s * (1.0f / 1024.0f) + EPS);
}

__device__ __forceinline__ void na_item(const bf16_t* z, const bf16_t* vT, bf16_t* y, const LAS float* rpbL, int item, int T, int lane) {
    const int g = item & 3, h = (item >> 2) & 15, R = item >> 6;
    const int rows = T >> 6, seq = R / rows, r = R - seq * rows, seq_base = seq * T;
    int rstart = r - 4; rstart = rstart < 0 ? 0 : rstart; rstart = rstart > rows - 8 ? rows - 8 : rstart;
    const int wb = (g == 0) ? 0 : (g == 1) ? 8 : (g == 2) ? 24 : 32;
    const int fr = lane & 15, fq = lane >> 4;
    const int tok = seq_base + r * 64 + g * 16 + fr;
    const bf16_t* qp = z + (size_t)tok * LDZ + 4096 + h * 64 + fq * 8;
    const bf16x8 q0 = ld8(qp), q1 = ld8(qp + 32);
    const int kcolA = wb + (fr >> 2) * 8 + (fr & 3);
    const bf16_t* kp0 = z + (size_t)(seq_base + rstart * 64 + kcolA) * LDZ + 5120 + h * 64 + fq * 8;
    bf16x8 kf[8][4];
#pragma unroll
    for (int kr = 0; kr < 8; ++kr) { const bf16_t* kp = kp0 + (size_t)kr * 64 * LDZ; kf[kr][0] = ld8(kp); kf[kr][1] = ld8(kp + 32); kf[kr][2] = ld8(kp + 4 * LDZ); kf[kr][3] = ld8(kp + 4 * LDZ + 32); }
    const int qc = g * 16 + fr;
    int cstart = qc - 8; cstart = cstart < 0 ? 0 : cstart; cstart = cstart > 48 ? 48 : cstart;
    int dcs[8]; bool oks[8];
#pragma unroll
    for (int e = 0; e < 8; ++e) { const int kc = wb + fq * 8 + e; oks[e] = (kc >= cstart) && (kc < cstart + 16); int dc = kc - qc; dc = dc < -15 ? -15 : dc; dc = dc > 15 ? 15 : dc; dcs[e] = dc + 15; }
    const LAS float* bp0 = rpbL + (h * 15 + rstart - r + 7) * 31;
    float s[8][8];
    float mx = -1e30f;
#pragma unroll
    for (int kr = 0; kr < 8; ++kr) {
        f32x4 a0 = {0.f, 0.f, 0.f, 0.f}, a1 = {0.f, 0.f, 0.f, 0.f};
        a0 = mfma16(kf[kr][0], q0, a0); a0 = mfma16(kf[kr][1], q1, a0);
        a1 = mfma16(kf[kr][2], q0, a1); a1 = mfma16(kf[kr][3], q1, a1);
#pragma unroll
        for (int e = 0; e < 8; ++e) {
            const float sc = (e < 4 ? a0[e & 3] : a1[e & 3]) * 0.125f + bp0[kr * 31 + dcs[e]];
            s[kr][e] = oks[e] ? sc : -1e30f;
            mx = fmaxf(mx, s[kr][e]);
        }
    }
    const bf16_t* vp0 = vT + (size_t)(h * 64 + fr) * SEG + seq_base + rstart * 64 + wb + fq * 8;
    bf16x8 vf[8][4];
#pragma unroll
    for (int kr = 0; kr < 8; ++kr)
#pragma unroll
        for (int dt = 0; dt < 4; ++dt) vf[kr][dt] = ld8(vp0 + kr * 64 + (size_t)dt * 16 * SEG);
    u32x2_t gr[4];
#pragma unroll
    for (int dt = 0; dt < 4; ++dt) gr[dt] = *(const u32x2_t*)(z + (size_t)tok * LDZ + 6144 + h * 64 + dt * 16 + fq * 4);
    mx = fmaxf(mx, __shfl_xor(mx, 16)); mx = fmaxf(mx, __shfl_xor(mx, 32));
    float sum = 0.f;
#pragma unroll
    for (int kr = 0; kr < 8; ++kr)
#pragma unroll
        for (int e = 0; e < 8; ++e) { const float p = __expf(s[kr][e] - mx); s[kr][e] = p; sum += p; }
    sum += __shfl_xor(sum, 16); sum += __shfl_xor(sum, 32);
    f32x4 o[4];
#pragma unroll
    for (int dt = 0; dt < 4; ++dt) o[dt] = (f32x4){0.f, 0.f, 0.f, 0.f};
#pragma unroll
    for (int kr = 0; kr < 8; ++kr) {
        const bf16x8 pf = pack8(s[kr]);
#pragma unroll
        for (int dt = 0; dt < 4; ++dt) o[dt] = mfma16(vf[kr][dt], pf, o[dt]);
    }
    const float inv = frcp(sum);
#pragma unroll
    for (int dt = 0; dt < 4; ++dt) {
        const int d4 = dt * 16 + fq * 4;
        u32x2_t ow;
        ow.x = pk2(o[dt][0] * inv * silu(bflo(gr[dt].x)), o[dt][1] * inv * silu(bfhi(gr[dt].x)));
        ow.y = pk2(o[dt][2] * inv * silu(bflo(gr[dt].y)), o[dt][3] * inv * silu(bfhi(gr[dt].y)));
        *(u32x2_t*)(y + (size_t)tok * LDY + 1024 + h * 64 + d4) = ow;
    }
}

__device__ __forceinline__ void mem_unit(const bf16_t* z, int qcol, int gcol, const bf16_t* mk, const bf16_t* mvT, bf16_t* y, int unit, int seg, LAS unsigned char* lds, int tid) {
    const int h = unit & 3, range = unit >> 2, tokr = range * 256;
    const int mb = seg < 2 ? seg : 2 + (tokr >> 12);
    const int lane = tid & 63, wid = tid >> 6, fr = lane & 15, fq = lane >> 4;
    __syncthreads();
#pragma unroll
    for (int i = 0; i < 8; ++i) {
        const int idx = tid + 512 * i, rho = idx >> 4, c = idx & 15, f = (rho & 3) | (((rho >> 3) & 3) << 2);
        const u32x4_t v = *(const u32x4_t*)(mk + (size_t)(mb * 256 + rho) * 512 + h * 128 + c * 8);
        *(LAS u32x4_t*)(lds + rho * 256 + ((c ^ f) << 4)) = v;
    }
#pragma unroll
    for (int i = 0; i < 8; ++i) {
        const int idx = tid + 512 * i, d = idx >> 5, c = idx & 31;
        const u32x4_t v = *(const u32x4_t*)(mvT + (size_t)(h * 128 + d) * 1536 + mb * 256 + c * 8);
        *(LAS u32x4_t*)(lds + 65536 + d * 512 + ((c ^ (d & 15)) << 4)) = v;
    }
    __syncthreads();
    const int mrowA = (fr >> 2) * 8 + (fr & 3);
    const LAS unsigned char* kbase = lds + mrowA * 256 + ((fq ^ (fr & 3)) << 4);
    const LAS unsigned char* vbase = lds + 65536 + fr * 512 + ((fq ^ (fr & 3)) << 4);
    const int hi = fr >> 2;
#pragma unroll 1
    for (int gi = 0; gi < 2; ++gi) {
        const int tok = tokr + (wid + 8 * gi) * 16 + fr;
        const bf16_t* qp = z + (size_t)tok * LDZ + qcol + h * 128 + fq * 8;
        bf16x8 q[4];
#pragma unroll
        for (int ks = 0; ks < 4; ++ks) q[ks] = ld8(qp + ks * 32);
        u32x2_t gr[8];
#pragma unroll
        for (int dt = 0; dt < 8; ++dt) gr[dt] = *(const u32x2_t*)(z + (size_t)tok * LDZ + gcol + h * 128 + dt * 16 + fq * 4);
        float s[8][8];
        float mx = -1e30f;
#pragma unroll
        for (int kb = 0; kb < 8; ++kb) {
            f32x4 a0 = {0.f, 0.f, 0.f, 0.f}, a1 = {0.f, 0.f, 0.f, 0.f};
#pragma unroll
            for (int ks = 0; ks < 4; ++ks) {
                const LAS unsigned char* kp = kbase + kb * 8192 + ((ks ^ hi) << 6);
                a0 = mfma16(*(const LAS bf16x8*)kp, q[ks], a0); a1 = mfma16(*(const LAS bf16x8*)(kp + 1024), q[ks], a1);
            }
#pragma unroll
            for (int e = 0; e < 8; ++e) { s[kb][e] = (e < 4 ? a0[e & 3] : a1[e & 3]) * 0.08838834764831845f; mx = fmaxf(mx, s[kb][e]); }
        }
        mx = fmaxf(mx, __shfl_xor(mx, 16)); mx = fmaxf(mx, __shfl_xor(mx, 32));
        float sum = 0.f;
#pragma unroll
        for (int kb = 0; kb < 8; ++kb)
#pragma unroll
            for (int e = 0; e < 8; ++e) { const float p = __expf(s[kb][e] - mx); s[kb][e] = p; sum += p; }
        sum += __shfl_xor(sum, 16); sum += __shfl_xor(sum, 32);
        f32x4 o[8];
#pragma unroll
        for (int dt = 0; dt < 8; ++dt) o[dt] = (f32x4){0.f, 0.f, 0.f, 0.f};
#pragma unroll
        for (int kb = 0; kb < 8; ++kb) {
            const bf16x8 pf = pack8(s[kb]);
            const LAS unsigned char* vp = vbase + (((kb ^ hi) & 7) << 6);
#pragma unroll
            for (int dt = 0; dt < 8; ++dt) o[dt] = mfma16(*(const LAS bf16x8*)(vp + dt * 8192), pf, o[dt]);
        }
        const float inv = frcp(sum);
#pragma unroll
        for (int dt = 0; dt < 8; ++dt) {
            const int d4 = dt * 16 + fq * 4;
            u32x2_t ow;
            ow.x = pk2(o[dt][0] * inv * silu(bflo(gr[dt].x)), o[dt][1] * inv * silu(bfhi(gr[dt].x)));
            ow.y = pk2(o[dt][2] * inv * silu(bflo(gr[dt].y)), o[dt][3] * inv * silu(bfhi(gr[dt].y)));
            *(u32x2_t*)(y + (size_t)tok * LDY + 2048 + h * 128 + d4) = ow;
        }
    }
}

template <int CTRL> __device__ __forceinline__ float dppf(float oldv, float src) {
    return __int_as_float(__builtin_amdgcn_update_dpp(__float_as_int(oldv), __float_as_int(src), CTRL, 0xf, 0xf, false));
}
template <int DIR> __device__ __forceinline__ void scan16(float& A, float& B) {
    constexpr int BASE = DIR == 0 ? 0x110 : 0x100;
    { const float ap = dppf<BASE + 1>(1.f, A), bp = dppf<BASE + 1>(0.f, B); B = A * bp + B; A = A * ap; }
    { const float ap = dppf<BASE + 2>(1.f, A), bp = dppf<BASE + 2>(0.f, B); B = A * bp + B; A = A * ap; }
    { const float ap = dppf<BASE + 4>(1.f, A), bp = dppf<BASE + 4>(0.f, B); B = A * bp + B; A = A * ap; }
    { const float ap = dppf<BASE + 8>(1.f, A), bp = dppf<BASE + 8>(0.f, B); B = A * bp + B; A = A * ap; }
}
struct LruW { bf16x8 Wa[4], Wi[4]; float ba[4], bi[4], c8[4]; };
struct LruX { bf16x8 x[2][4]; u32x2_t xr[2]; };
__device__ __forceinline__ void lru_loadw(LruW& W, const bf16_t* lruw, const float* ba_, const float* bi_, const float* lam_, int dir, int blk, int w, int ch4, int lane) {
    const int fr = lane & 15, fq = lane >> 4;
    const bf16_t* wa = lruw + ((size_t)((0 * 2 + dir) * 8 + blk) * 128 + w * 16 + fr) * 128 + fq * 8;
    const bf16_t* wi = lruw + ((size_t)((1 * 2 + dir) * 8 + blk) * 128 + w * 16 + fr) * 128 + fq * 8;
#pragma unroll
    for (int ks = 0; ks < 4; ++ks) { W.Wa[ks] = ld8(wa + ks * 32); W.Wi[ks] = ld8(wi + ks * 32); }
    const f32x4 a = *(const f32x4*)(ba_ + dir * 1024 + ch4), b = *(const f32x4*)(bi_ + dir * 1024 + ch4), l = *(const f32x4*)(lam_ + dir * 1024 + ch4);
#pragma unroll
    for (int jj = 0; jj < 4; ++jj) { W.ba[jj] = a[jj]; W.bi[jj] = b[jj]; W.c8[jj] = -8.0f * log1pf(__expf(-l[jj])); }
}
__device__ __forceinline__ void lru_loadx(LruX& X, const bf16_t* xc, int tok0, int blk, int ch4, int lane) {
    const int fr = lane & 15, fq = lane >> 4;
#pragma unroll
    for (int t = 0; t < 2; ++t) {
        const bf16_t* xp = xc + (size_t)(tok0 + t * 16 + fr) * 1024;
#pragma unroll
        for (int ks = 0; ks < 4; ++ks) X.x[t][ks] = ld8(xp + blk * 128 + fq * 8 + ks * 32);
        X.xr[t] = *(const u32x2_t*)(xp + ch4);
    }
}
template <int DIR, bool FINAL> __device__ __forceinline__ void lru_tile(const bf16x8 (&Xf)[4], const u32x2_t xr, const LruW& W, int lane, float (&hin)[4], float (&arun)[4], float (&hout)[4]) {
    f32x4 accR = {0.f, 0.f, 0.f, 0.f}, accI = {0.f, 0.f, 0.f, 0.f};
#pragma unroll
    for (int ks = 0; ks < 4; ++ks) { accR = mfma16(W.Wa[ks], Xf[ks], accR); accI = mfma16(W.Wi[ks], Xf[ks], accI); }
    const float xv[4] = {bflo(xr.x), bfhi(xr.x), bflo(xr.y), bfhi(xr.y)};
    const int src = (lane & 48) + (DIR == 0 ? 15 : 0);
#pragma unroll
    for (int jj = 0; jj < 4; ++jj) {
        const float rg = sigm(accR[jj] + W.ba[jj]), ig = sigm(accI[jj] + W.bi[jj]);
        float A = __expf(W.c8[jj] * rg);
        float B = __builtin_amdgcn_sqrtf(fmaxf(1.0f - A * A, 0.f)) * (ig * xv[jj]);
        scan16<DIR>(A, B);
        const float hval = A * hin[jj] + B;
        hout[jj] = hval;
        hin[jj] = __shfl(hval, src);
        if (!FINAL) arun[jj] *= __shfl(A, src);
    }
}
template <bool FINAL> __device__ __forceinline__ void lru_item(const bf16_t* xc, const bf16_t* z, const bf16_t* lruw, const float* ba_, const float* bi_, const float* lam_,
                                                               float* agg, const float* carry, bf16_t* y, int item, int lane) {
    const int cgi = item & 63, chunk = item >> 6, blk = cgi >> 3, w = cgi & 7;
    const int fr = lane & 15, fq = lane >> 4;
    const int ch4 = blk * 128 + w * 16 + fq * 4;
    const int tokc = chunk * 128;
    LruX X[2]; LruW W0;
    lru_loadw(W0, lruw, ba_, bi_, lam_, 0, blk, w, ch4, lane);
    lru_loadx(X[0], xc, tokc, blk, ch4, lane);
    unsigned hf[8][2];
    float hin[4], arun[4];
#pragma unroll
    for (int jj = 0; jj < 4; ++jj) { hin[jj] = FINAL ? carry[(size_t)(0 * 128 + chunk) * 1024 + ch4 + jj] : 0.f; arun[jj] = 1.f; }
#pragma unroll
    for (int bi = 0; bi < 8; ++bi) {
        __builtin_amdgcn_sched_barrier(0);
        const int slot = bi < 4 ? (bi & 1) : ((bi + 1) & 1);
        const int pair = bi < 4 ? bi : 7 - bi;
        if (bi + 1 < 8 && bi + 1 != 4) {
            const int nslot = (bi + 1) < 4 ? ((bi + 1) & 1) : ((bi + 2) & 1);
            const int npair = (bi + 1) < 4 ? (bi + 1) : 7 - (bi + 1);
            lru_loadx(X[nslot], xc, tokc + npair * 32, blk, ch4, lane);
        }
        if (bi == 4) {
            lru_loadw(W0, lruw, ba_, bi_, lam_, 1, blk, w, ch4, lane);
            if (!FINAL && fr == 0) {
#pragma unroll
                for (int jj = 0; jj < 4; ++jj) { float2 v; v.x = arun[jj]; v.y = hin[jj]; *(float2*)(agg + ((size_t)(0 * 128 + chunk) * 1024 + ch4 + jj) * 2) = v; }
            }
#pragma unroll
            for (int jj = 0; jj < 4; ++jj) { hin[jj] = FINAL ? carry[(size_t)(1 * 128 + chunk) * 1024 + ch4 + jj] : 0.f; arun[jj] = 1.f; }
        }
#pragma unroll
        for (int k = 0; k < 2; ++k) {
            const int t = bi < 4 ? k : 1 - k;
            const int tt = 2 * pair + t;
            float hv[4];
            if (bi < 4) lru_tile<0, FINAL>(X[slot].x[t], X[slot].xr[t], W0, lane, hin, arun, hv);
            else lru_tile<1, FINAL>(X[slot].x[t], X[slot].xr[t], W0, lane, hin, arun, hv);
            if (FINAL) {
                if (bi < 4) {
                    hf[tt][0] = pk2(hv[0], hv[1]); hf[tt][1] = pk2(hv[2], hv[3]);
                } else {
                    const int tok = tokc + tt * 16 + fr;
                    const u32x2_t gr = *(const u32x2_t*)(z + (size_t)tok * LDZ + 1024 + ch4);
                    const float gc[4] = {bflo(gr.x), bfhi(gr.x), bflo(gr.y), bfhi(gr.y)};
                    const float hfv[4] = {bflo(hf[tt][0]), bfhi(hf[tt][0]), bflo(hf[tt][1]), bfhi(hf[tt][1])};
                    float o[4];
#pragma unroll
                    for (int jj = 0; jj < 4; ++jj) o[jj] = (hfv[jj] + hv[jj]) * silu(gc[jj]);
                    u32x2_t ow; ow.x = pk2(o[0], o[1]); ow.y = pk2(o[2], o[3]);
                    *(u32x2_t*)(y + (size_t)tok * LDY + ch4) = ow;
                }
            }
        }
    }
    if (!FINAL && fr == 0) {
#pragma unroll
        for (int jj = 0; jj < 4; ++jj) { float2 v; v.x = arun[jj]; v.y = hin[jj]; *(float2*)(agg + ((size_t)(1 * 128 + chunk) * 1024 + ch4 + jj) * 2) = v; }
    }
}
__device__ __forceinline__ void carry_phase(const float* agg, float* carry, int nseq, int gtid, int gthreads) {
    const int nc = 128 / nseq;
    for (int idx = gtid; idx < 2 * nseq * 1024; idx += gthreads) {
        const int ch = idx & 1023, rest = idx >> 10, dir = rest & 1, sq = rest >> 1, base = sq * nc;
        float h = 0.f;
#pragma unroll 8
        for (int c = 0; c < nc; ++c) {
            const int C = base + (dir == 0 ? c : nc - 1 - c);
            const size_t o = (size_t)(dir * 128 + C) * 1024 + ch;
            const float2 ah = *(const float2*)(agg + o * 2);
            carry[o] = h;
            h = ah.x * h + ah.y;
        }
    }
}

__device__ __forceinline__ void sgu_item(const bf16_t* vT, const float* rstd, const bf16_t* z, const bf16_t* sguw, const float* sgu_g, const float* sgu_b, bf16_t* y, int item, int lane) {
    const int dd = item & 7, g = (item >> 3) & 7, n = item >> 6;
    const int fr = lane & 15, fq = lane >> 4;
    const int tokc = n * 128;
    const bf16_t* ap = vT + (size_t)(g * 128 + dd * 16 + fr) * SEG + tokc + fq * 8;
    bf16x8 Af[4];
#pragma unroll
    for (int ks = 0; ks < 4; ++ks) {
        const u32x4_t raw = *(const u32x4_t*)(ap + ks * 32);
        const f32x4 r0 = *(const f32x4*)(rstd + tokc + ks * 32 + fq * 8), r1 = *(const f32x4*)(rstd + tokc + ks * 32 + fq * 8 + 4);
        u32x4_t w;
        w.x = pk2(bflo(raw.x) * r0[0], bfhi(raw.x) * r0[1]); w.y = pk2(bflo(raw.y) * r0[2], bfhi(raw.y) * r0[3]);
        w.z = pk2(bflo(raw.z) * r1[0], bfhi(raw.z) * r1[1]); w.w = pk2(bflo(raw.w) * r1[2], bfhi(raw.w) * r1[3]);
        Af[ks] = __builtin_bit_cast(bf16x8, w);
    }
    const int ch4 = g * 128 + dd * 16 + fq * 4;
    const f32x4 g4 = *(const f32x4*)(sgu_g + ch4);
#pragma unroll
    for (int pt = 0; pt < 8; ++pt) {
        const int p = pt * 16 + fr;
        const bf16_t* bp = sguw + (size_t)(g * 128 + p) * 128 + fq * 8;
        f32x4 acc = {0.f, 0.f, 0.f, 0.f};
#pragma unroll
        for (int ks = 0; ks < 4; ++ks) acc = mfma16(Af[ks], ld8(bp + ks * 32), acc);
        const int tok = tokc + p;
        const float bsv = sgu_b[g * 128 + p];
        const u32x2_t ur = *(const u32x2_t*)(z + (size_t)tok * LDZ + 2048 + ch4), gr = *(const u32x2_t*)(z + (size_t)tok * LDZ + 3072 + ch4);
        const float uu[4] = {bflo(ur.x), bfhi(ur.x), bflo(ur.y), bfhi(ur.y)}, gd[4] = {bflo(gr.x), bfhi(gr.x), bflo(gr.y), bfhi(gr.y)};
        float o[4];
#pragma unroll
        for (int jj = 0; jj < 4; ++jj) o[jj] = uu[jj] * (acc[jj] * g4[jj] + bsv) * silu(gd[jj]);
        u32x2_t ow; ow.x = pk2(o[0], o[1]); ow.y = pk2(o[2], o[3]);
        *(u32x2_t*)(y + (size_t)tok * LDY + 1024 + ch4) = ow;
    }
}

__global__ void __launch_bounds__(512, 2) fwd_megakernel(Params P) {
    extern __shared__ __attribute__((aligned(16))) unsigned char shm[];
    cg::grid_group grid = cg::this_grid();
    PG8_LAS unsigned char* lds = (PG8_LAS unsigned char*)shm;
    const int G = gridDim.x, NW = G * 8;
#define FRESH_TID() int tid = threadIdx.x; asm volatile("" : "+v"(tid)); const int lane = tid & 63, wid = tid >> 6, gw = blockIdx.x * 8 + wid; (void)lane; (void)gw
    unsigned char* ws = P.ws;
    bf16_t* WIN_E = (bf16_t*)(ws + WS_WIN_E); bf16_t* WIN_O = (bf16_t*)(ws + WS_WIN_O);
    bf16_t* WOUT_E = (bf16_t*)(ws + WS_WOUT_E); bf16_t* WOUT_O = (bf16_t*)(ws + WS_WOUT_O);
    bf16_t* WKV = (bf16_t*)(ws + WS_WKV); bf16_t* LRUW = (bf16_t*)(ws + WS_LRUW); bf16_t* SGUW = (bf16_t*)(ws + WS_SGUW);
    bf16_t* MEMN = (bf16_t*)(ws + WS_MEMN); bf16_t* MK = (bf16_t*)(ws + WS_MK); bf16_t* MVT = (bf16_t*)(ws + WS_MVT);
    bf16_t* H = (bf16_t*)(ws + WS_H); bf16_t* Z = (bf16_t*)(ws + WS_Z); bf16_t* VT = (bf16_t*)(ws + WS_VT); bf16_t* Y = (bf16_t*)(ws + WS_Y);
    float* AGG = (float*)(ws + WS_AGG); float* CARRY = (float*)(ws + WS_CARRY); float* RSTD = (float*)(ws + WS_RSTD); float* PART = (float*)(ws + WS_PART);

    unsigned* BAR = (unsigned*)(ws + WS_BAR);
    volatile LAS unsigned* xst = (volatile LAS unsigned*)(lds + 131072);
    {
        FRESH_TID();
        if (tid < 2) xst[tid] = 0u;
        if (blockIdx.x == 0) for (int i = tid; i < XCD_BAR_WORDS; i += 512) BAR[i] = 0u;
        float* scr = (float*)shm;
        constexpr int I0 = 16 * 144, I1 = 16 * 96, I2 = 40 * 16, I3 = 40 * 16, I4 = 256, I5 = 256, I6 = 64, I7 = 64;
        constexpr int NIT = I0 + I1 + I2 + I3 + I4 + I5 + I6 + I7;
        for (int it = blockIdx.x; it < NIT; it += G) {
            int r = it;
            if (r < I0) { transpose_tile(P.in[7], 1024, 9216, WIN_E, r, scr); continue; } r -= I0;
            if (r < I1) { transpose_tile(P.in[12], 1024, 6144, WIN_O, r, scr); continue; } r -= I1;
            if (r < I2) { transpose_tile(P.in[11], 2560, 1024, WOUT_E, r, scr); continue; } r -= I2;
            if (r < I3) { transpose_tile(P.in[23], 2560, 1024, WOUT_O, r, scr); continue; } r -= I3;
            if (r < I4) { transpose_tile(P.in[6], 1024, 1024, WKV, r, scr); continue; } r -= I4;
            if (r < I5) { transpose_tile(P.in[6] + (size_t)1024 * 1024, 1024, 1024, WKV + (size_t)1024 * 1024, r, scr); continue; } r -= I5;
            if (r < I6) { const int m = r >> 2; transpose_tile(P.in[15] + (size_t)m * 16384, 128, 128, LRUW + (size_t)m * 16384, r & 3, scr); continue; } r -= I6;
            { const int m = r >> 2; transpose_tile(P.in[17] + (size_t)m * 16384, 128, 128, LRUW + (size_t)(16 + m) * 16384, r & 3, scr); }
        }
        for (int i = blockIdx.x * 512 + tid; i < 8 * 128 * 128; i += G * 512) SGUW[i] = f2bf(P.in[21][i]);
        for (int it = gw; it < 2 * 1536; it += NW) {
            const int l = it / 1536, row = it - l * 1536;
            const float* src = row < 512 ? P.in[2] + (size_t)row * 1024 : P.in[3] + (size_t)(row - 512) * 1024;
            rms_row_bf16(src, P.in[5] + l * 1024, MEMN + ((size_t)l * 1536 + row) * 1024, lane);
        }
    }

    grid.sync();
    const XcdBarrier xb = xcd_barrier_post(BAR, xst);
    for (int seg = 0; seg < 3; ++seg) {
        const float* xin = seg < 2 ? P.in[0] + (size_t)seg * SEG * 1024 : P.in[1];
        float* xout = P.out + (size_t)seg * SEG * 1024;
        const int T = seg < 2 ? 16384 : 4096, nseq = seg < 2 ? 1 : 4;

        { FRESH_TID();
        for (int it = gw; it < SEG; it += NW) rms_row_bf16(xin + (size_t)it * 1024, P.in[4], H + (size_t)it * 1024, lane); }
        xcd_barrier(xb);

        {
            pg8::Gemm g; g.A = H; g.Bt = WIN_E; g.M = SEG; g.N = 8192; g.K = 1024;
            pg8::SkipOrder S; S.init(SEG, 8192, G, blockIdx.x); S.skip_from = 24; S.skip_n = 4;
            pg8::EpiZ E; E.O = Z; E.ldc = LDZ; E.skip_from = 24; E.skip_n = 4; E.colsq = nullptr; E.colsq_ld = 0;
            pg8::gemm_phase(lds, g, S, E);
        }
        {
            pg8::Gemm g; g.A = WIN_E + (size_t)6144 * 1024; g.Bt = H; g.M = 1024; g.N = SEG; g.K = 1024;
            pg8::SkipOrder S; S.init(1024, SEG, G, blockIdx.x); S.skip_from = 1 << 20; S.skip_n = 0;
            pg8::EpiZ E; E.O = VT; E.ldc = SEG; E.skip_from = 1 << 20; E.skip_n = 0; E.colsq = nullptr; E.colsq_ld = 0;
            pg8::gemm_phase(lds, g, S, E);
        }
        if (seg == 0) {
#pragma unroll 1
            for (int l = 0; l < 2; ++l) {
                {
                    pg8::Gemm g; g.A = MEMN + (size_t)l * 1536 * 1024; g.Bt = WKV + (size_t)l * 1024 * 1024; g.M = 1536; g.N = 512; g.K = 1024;
                    pg8::SkipOrder S; S.init(1536, 512, G, (blockIdx.x + G - (32 * l) % G) % G); S.skip_from = 1 << 20; S.skip_n = 0;
                    pg8::EpiZ E; E.O = MK + (size_t)l * 1536 * 512; E.ldc = 512; E.skip_from = 1 << 20; E.skip_n = 0; E.colsq = nullptr; E.colsq_ld = 0;
                    pg8::gemm_phase(lds, g, S, E);
                }
                {
                    pg8::Gemm g; g.A = WKV + (size_t)l * 1024 * 1024 + (size_t)512 * 1024; g.Bt = MEMN + (size_t)l * 1536 * 1024; g.M = 512; g.N = 1536; g.K = 1024;
                    pg8::SkipOrder S; S.init(512, 1536, G, (blockIdx.x + G - (32 * l + 16) % G) % G); S.skip_from = 1 << 20; S.skip_n = 0;
                    pg8::EpiZ E; E.O = MVT + (size_t)l * 512 * 1536; E.ldc = 1536; E.skip_from = 1 << 20; E.skip_n = 0; E.colsq = nullptr; E.colsq_ld = 0;
                    pg8::gemm_phase(lds, g, S, E);
                }
            }
        }
        xcd_barrier(xb);

        { FRESH_TID();
        for (int u = blockIdx.x; u < 256; u += G) mem_unit(Z, 7168, 7680, MK, MVT, Y, u, seg, lds, tid);
        __syncthreads();
        LAS float* rpbL = (LAS float*)lds;
        for (int i = tid; i < 16 * 15 * 31; i += 512) rpbL[i] = P.in[10][i];
        __syncthreads();
        for (int it = gw; it < 16384 + 16384; it += NW) {
            if (it < 16384) na_item(Z, VT, Y, rpbL, it, T, lane);
            else conv_even_item(Z, P.in[8], P.in[9], Y, it - 16384, T, lane);
        } }
        xcd_barrier(xb);

        {
            pg8::Gemm g; g.A = Y; g.Bt = WOUT_E; g.M = SEG; g.N = 1024; g.K = 2560;
            pg8::StaticOrder S; S.init(SEG, 1024, G, blockIdx.x);
            pg8::EpiRes E; E.xin = xin; E.out = xout;
            pg8::gemm_phase(lds, g, S, E);
        }
        xcd_barrier(xb);

        { FRESH_TID();
        for (int it = gw; it < SEG; it += NW) rms_row_bf16(xout + (size_t)it * 1024, P.in[4] + 1024, H + (size_t)it * 1024, lane); }
        xcd_barrier(xb);

        {
            pg8::Gemm g; g.A = H; g.Bt = WIN_O; g.M = SEG; g.N = 5120; g.K = 1024;
            pg8::SkipOrder S; S.init(SEG, 5120, G, blockIdx.x); S.skip_from = 12; S.skip_n = 4;
            pg8::EpiZ E; E.O = Z; E.ldc = LDZ; E.skip_from = 12; E.skip_n = 4; E.colsq = nullptr; E.colsq_ld = 0;
            pg8::gemm_phase(lds, g, S, E);
        }
        {
            pg8::Gemm g; g.A = WIN_O + (size_t)3072 * 1024; g.Bt = H; g.M = 1024; g.N = SEG; g.K = 1024;
            pg8::SkipOrder S; S.init(1024, SEG, G, blockIdx.x); S.skip_from = 1 << 20; S.skip_n = 0;
            pg8::EpiZ E; E.O = VT; E.ldc = SEG; E.skip_from = 1 << 20; E.skip_n = 0; E.colsq = PART; E.colsq_ld = SEG;
            pg8::gemm_phase(lds, g, S, E);
        }
        xcd_barrier(xb);

        { FRESH_TID();
        for (int it = gw; it < SEG + 256; it += NW) {
            if (it < SEG) conv_odd_item(Z, P.in[13], P.in[14], H, it, T, lane);
            else rstd_item(PART, RSTD, it - SEG, lane);
        } }
        xcd_barrier(xb);

        { FRESH_TID();
        for (int u = blockIdx.x; u < 256; u += G) mem_unit(Z, 4096, 4608, MK + (size_t)1536 * 512, MVT + (size_t)512 * 1536, Y, u, seg, lds, tid);
        for (int it = gw; it < 8192 + 8192; it += NW) {
            if (it < 8192) lru_item<false>(H, Z, LRUW, P.in[16], P.in[18], P.in[19], AGG, CARRY, Y, it, lane);
            else sgu_item(VT, RSTD, Z, SGUW, P.in[20], P.in[22], Y, it - 8192, lane);
        } }
        xcd_barrier(xb);

        { FRESH_TID(); carry_phase(AGG, CARRY, nseq, blockIdx.x * 512 + tid, G * 512); }
        xcd_barrier(xb);

        { FRESH_TID();
        for (int it = gw; it < 8192; it += NW) lru_item<true>(H, Z, LRUW, P.in[16], P.in[18], P.in[19], AGG, CARRY, Y, it, lane); }
        xcd_barrier(xb);

        {
            pg8::Gemm g; g.A = Y; g.Bt = WOUT_O; g.M = SEG; g.N = 1024; g.K = 2560;
            pg8::StaticOrder S; S.init(SEG, 1024, G, blockIdx.x);
            pg8::EpiRes E; E.xin = xout; E.out = xout;
            pg8::gemm_phase(lds, g, S, E);
        }
        xcd_barrier(xb);

        { FRESH_TID();
        for (int it = gw; it < SEG; it += NW) rms_row_f32(xout + (size_t)it * 1024, P.in[24], lane); }
    }
}

extern "C" void kernel_launch(void* const* d_in, const int* in_sizes, int n_in, void* d_out, int out_size, void* d_ws, size_t ws_size, hipStream_t stream) {
    static int grid_blocks = 0;
    if (grid_blocks == 0) {
        if (n_in != 25 || ws_size < WS_END) { fprintf(stderr, "kernel_launch: need 25 inputs and %zu bytes of workspace; got %d, %zu\n", (size_t)WS_END, n_in, ws_size); grid_blocks = -1; return; }
        int dev = 0, cus = 0, per_cu = 0;
        hipGetDevice(&dev);
        hipDeviceGetAttribute(&cus, hipDeviceAttributeMultiprocessorCount, dev);
        hipFuncSetAttribute((const void*)fwd_megakernel, hipFuncAttributeMaxDynamicSharedMemorySize, LDS_BYTES);
        hipOccupancyMaxActiveBlocksPerMultiprocessor(&per_cu, (const void*)fwd_megakernel, 512, LDS_BYTES);
        if (per_cu < 1) { fprintf(stderr, "kernel_launch: occupancy query says %d blocks per CU\n", per_cu); grid_blocks = -1; return; }
        grid_blocks = cus;
    }
    if (grid_blocks < 0) return;
    Params p{};
    for (int i = 0; i < 25; ++i) p.in[i] = (const float*)d_in[i];
    p.out = (float*)d_out; p.ws = (unsigned char*)d_ws;
    void* args[] = {&p};
    hipError_t e = hipLaunchCooperativeKernel((const void*)fwd_megakernel, dim3(grid_blocks), dim3(512), args, LDS_BYTES, stream);
    if (e != hipSuccess) fprintf(stderr, "cooperative launch failed: %s (grid %d)\n", hipGetErrorString(e), grid_blocks);
}
```

```cpp
#include <hip/hip_runtime.h>
#include <hip/hip_cooperative_groups.h>
#include <cstdio>
namespace cg = cooperative_groups;
namespace pg8 {
#define PG8_LAS __attribute__((address_space(3)))
typedef unsigned short bf16_t;
typedef short bf16x8 __attribute__((ext_vector_type(8)));
typedef float f32x4 __attribute__((ext_vector_type(4)));
typedef unsigned u32x4 __attribute__((ext_vector_type(4)));
constexpr int BM = 256, BK = 64, HALF = 128, HTB = HALF * BK * 2  , STAGE_BYTES = 8 * HTB, NXCD = 8, WGM = 8;

__host__ __device__ __forceinline__ int lds_byte(int r, int c) { const int st = (r >> 4) * 2 + (c >> 5), rr = r & 15, cc = c & 31, ob = rr * 64 + cc * 2; return st * 1024 + (ob ^ (((ob >> 9) & 1) << 5)); }
__host__ __device__ __forceinline__ void stage_rc(int b, int& R, int& C) { const int st = b / 1024, sb = b % 1024, swz = sb ^ (((sb >> 9) & 1) << 5); R = (st >> 1) * 16 + swz / 64; C = (st & 1) * 32 + (swz % 64) / 2; }
__host__ __device__ __forceinline__ int perm32(int rho) { const int n = rho >> 4, i = rho & 15; return 8 * (i >> 2) + 4 * n + (i & 3); }

struct Unit { int pm, pn; };
struct Gemm { const bf16_t* A; const bf16_t* Bt; int M, N, K; };

struct StaticOrder {
    int nM, nN, nwg, G, c;
    __host__ __device__ void init(int M, int N, int G_, int c_) { nM = M / BM; nN = N / BM; nwg = nM * nN; G = G_; c = c_; }
    __host__ __device__ bool next(int i, Unit& u) const {
        const long L = (long)i * G + c; if (L >= nwg) return false;
        int wgid = (int)L; { const int q = nwg / NXCD, r = nwg % NXCD, xcd = wgid % NXCD, off = wgid / NXCD; wgid = (xcd < r ? xcd * (q + 1) : r * (q + 1) + (xcd - r) * q) + off; }
        const int nig = WGM * nN, gid = wgid / nig, fm = gid * WGM, gsz = (nM - fm) < WGM ? (nM - fm) : WGM;
        u.pm = fm + ((wgid % nig) % gsz); u.pn = (wgid % nig) / gsz; return true;
    }
    __device__ __forceinline__ void a_ready(const Unit&) const {}
    __device__ __forceinline__ void done(const Unit&) const {}
};

struct SkipOrder : StaticOrder {
    int skip_from, skip_n;
    __device__ __forceinline__ bool next(int i, Unit& u) const {
        if (!StaticOrder::next(i, u)) return false;
        if (u.pn >= skip_from) u.pn += skip_n;
        return true;
    }
};

__device__ __forceinline__ unsigned cvt_pk_bf16(float lo, float hi) { unsigned r; asm volatile("v_cvt_pk_bf16_f32 %0, %1, %2" : "=v"(r) : "v"(lo), "v"(hi)); return r; }

struct EpiZ {
    static constexpr bool PERM = true, AFTER_DRAIN = false;
    bf16_t* O; int ldc; int skip_from, skip_n; float* colsq; int colsq_ld;
    __device__ __forceinline__ void operator()(const f32x4 (&acc)[2][2][4][2], const Unit& u, int wr, int wc, int fr, int fq) const {
        const int row0 = u.pm * BM + wr * 64 + fr; const int ct = (u.pn >= skip_from + skip_n) ? (u.pn - skip_n) : u.pn;
        const int col0 = ct * BM + wc * 32 + 8 * fq;
#pragma unroll
        for (int ai = 0; ai < 2; ++ai)
#pragma unroll
            for (int m = 0; m < 4; ++m) { bf16_t* rowp = O + (size_t)(row0 + ai * HALF + m * 16) * ldc + col0;
#pragma unroll
                for (int bj = 0; bj < 2; ++bj) { const f32x4 v0 = acc[ai][bj][m][0], v1 = acc[ai][bj][m][1];
                    u32x4 w; w.x = cvt_pk_bf16(v0[0], v0[1]); w.y = cvt_pk_bf16(v0[2], v0[3]); w.z = cvt_pk_bf16(v1[0], v1[1]); w.w = cvt_pk_bf16(v1[2], v1[3]);
                    *(u32x4*)(rowp + bj * HALF) = w; } }
        if (colsq) {
#pragma unroll
            for (int bj = 0; bj < 2; ++bj)
#pragma unroll
                for (int n = 0; n < 2; ++n) {
                    f32x4 ss = {0.f, 0.f, 0.f, 0.f};
#pragma unroll
                    for (int ai = 0; ai < 2; ++ai)
#pragma unroll
                        for (int m = 0; m < 4; ++m) ss += acc[ai][bj][m][n] * acc[ai][bj][m][n];
#pragma unroll
                    for (int o = 1; o < 16; o <<= 1) { ss[0] += __shfl_xor(ss[0], o); ss[1] += __shfl_xor(ss[1], o); ss[2] += __shfl_xor(ss[2], o); ss[3] += __shfl_xor(ss[3], o); }
                    if (fr == 0) *(f32x4*)(colsq + (size_t)(2 * u.pm + wr) * colsq_ld + ct * BM + bj * HALF + wc * 32 + 8 * fq + 4 * n) = ss;
                }
        }
    }
};
struct EpiRes {
    static constexpr bool PERM = false, AFTER_DRAIN = false;
    const float* xin; float* out;
    __device__ __forceinline__ void operator()(const f32x4 (&acc)[2][2][4][2], const Unit& u, int wr, int wc, int fr, int fq) const {
        const int row0 = u.pm * BM + wr * 64 + fr, col0 = u.pn * BM + wc * 32 + 4 * fq;
#pragma unroll
        for (int ai = 0; ai < 2; ++ai)
#pragma unroll
            for (int m = 0; m < 4; ++m) { const size_t ro = (size_t)(row0 + ai * HALF + m * 16) * 1024 + col0;
#pragma unroll
                for (int bj = 0; bj < 2; ++bj)
#pragma unroll
                    for (int n = 0; n < 2; ++n) { const f32x4 xv = *(const f32x4*)(xin + ro + bj * HALF + n * 16);
                        *(f32x4*)(out + ro + bj * HALF + n * 16) = acc[ai][bj][m][n] + xv; } }
    }
};

template <class Epi, class Sched>
__device__ __forceinline__ void gemm_phase(PG8_LAS unsigned char* lds, const Gemm g, const Sched& S, const Epi& E) {
    int tid = threadIdx.x; asm volatile("" : "+v"(tid));
    const int wid = __builtin_amdgcn_readfirstlane(tid >> 6), lane = tid & 63, wr = wid >> 2, wc = wid & 3, fr = lane & 15, fq = lane >> 4;
    const int K = g.K, nt = K / BK;
    const char* gA = (const char*)g.A; const char* gB = (const char*)g.Bt; asm volatile("" : "+s"(gA), "+s"(gB));
    unsigned voffA[2], voffB[2];
#pragma unroll
    for (int i = 0; i < 2; ++i) { int R, C; stage_rc(tid * 16 + i * 8192, R, C); const int Rb = Epi::PERM ? ((R & ~31) + perm32(R & 31)) : R;
        voffA[i] = (unsigned)(R * K + C) * 2u; voffB[i] = (unsigned)(Rb * K + C) * 2u; }
    const size_t kstep = (size_t)(BK * 2);
    const size_t hstep = (size_t)HALF * K * 2;
    const size_t tstep = 2 * hstep;
    const unsigned ldsw = (unsigned)wid * 1024u;
    const int aoff = lds_byte(wr * 64 + fr, fq * 8), boff = lds_byte(wc * 32 + fr, fq * 8);
#define PG8_SA(b, h) (((b) * 2 + (h)) * HTB)
#define PG8_SB(b, h) ((4 + (b) * 2 + (h)) * HTB)
#define PG8_STAGE(bufoff, gbase, voff) do { _Pragma("unroll") for (int _i = 0; _i < 2; ++_i) \
        __builtin_amdgcn_global_load_lds((const unsigned*)((const char*)(gbase) + (voff)[_i]), (PG8_LAS unsigned*)(lds + (bufoff) + ldsw + _i * 8192), 16, 0, 0); } while (0)
#define PG8_LDA(dst, b, h) do { _Pragma("unroll") for (int m = 0; m < 4; ++m) _Pragma("unroll") for (int k = 0; k < 2; ++k) dst[m][k] = *(const PG8_LAS bf16x8*)(lds + PG8_SA(b, h) + aoff + m * 2048 + k * 1024); } while (0)
#define PG8_LDB(dst, b, h) do { _Pragma("unroll") for (int n = 0; n < 2; ++n) _Pragma("unroll") for (int k = 0; k < 2; ++k) dst[n][k] = *(const PG8_LAS bf16x8*)(lds + PG8_SB(b, h) + boff + n * 2048 + k * 1024); } while (0)
#define PG8_MMA(ai, bj, At, Bt) do { __builtin_amdgcn_s_setprio(1); _Pragma("unroll") for (int m = 0; m < 4; ++m) _Pragma("unroll") for (int n = 0; n < 2; ++n) _Pragma("unroll") for (int k = 0; k < 2; ++k) \
        acc[ai][bj][m][n] = __builtin_amdgcn_mfma_f32_16x16x32_bf16(Bt[n][k], At[m][k], acc[ai][bj][m][n], 0, 0, 0); __builtin_amdgcn_s_setprio(0); } while (0)
#define PG8_WAIT_V(n) asm volatile("s_waitcnt vmcnt(" #n ")" ::: "memory")
#define PG8_WAIT_L(n) asm volatile("s_waitcnt lgkmcnt(" #n ")" ::: "memory")
#define PG8_BAR __builtin_amdgcn_s_barrier()
#define PG8_SCHED __builtin_amdgcn_sched_barrier(0)
    Unit cur, nxt; int ui = 0;
    if (!S.next(0, cur)) return;
    f32x4 acc[2][2][4][2];
#pragma unroll
    for (int a = 0; a < 2; ++a)
#pragma unroll
        for (int b = 0; b < 2; ++b)
#pragma unroll
            for (int m = 0; m < 4; ++m)
#pragma unroll
                for (int n = 0; n < 2; ++n) acc[a][b][m][n] = (f32x4){0.f, 0.f, 0.f, 0.f};
    bf16x8 At[4][2], B0[2][2], B1[2][2];
    const char* cA = gA + (size_t)cur.pm * tstep; const char* cB = gB + (size_t)cur.pn * tstep;
    S.a_ready(cur);
    PG8_STAGE(PG8_SB(0, 0), cB, voffB); PG8_STAGE(PG8_SA(0, 0), cA, voffA); PG8_STAGE(PG8_SB(0, 1), cB + hstep, voffB); PG8_STAGE(PG8_SA(0, 1), cA + hstep, voffA);
    if (wr == 1) PG8_BAR;
    PG8_WAIT_V(4); PG8_BAR;
    PG8_STAGE(PG8_SB(1, 0), cB + kstep, voffB); PG8_STAGE(PG8_SA(1, 0), cA + kstep, voffA); PG8_STAGE(PG8_SB(1, 1), cB + hstep + kstep, voffB);
    PG8_WAIT_V(6); PG8_BAR;
    for (;;) {
        const bool has_next = S.next(ui + 1, nxt);
        const char* nA = has_next ? gA + (size_t)nxt.pm * tstep : cA; const char* nB = has_next ? gB + (size_t)nxt.pn * tstep : cB;
        for (int t = 0; t < nt; t += 2) {
            const bool last = (t == nt - 2);
            const char* a1 = cA + (size_t)(t + 1) * kstep;
            const char* a2 = last ? nA : cA + (size_t)(t + 2) * kstep; const char* b2 = last ? nB : cB + (size_t)(t + 2) * kstep;
            const char* a3 = a2 + kstep; const char* b3 = b2 + kstep;
            if (last && has_next) S.a_ready(nxt);
            PG8_LDB(B0, 0, 0); PG8_SCHED; PG8_LDA(At, 0, 0); PG8_STAGE(PG8_SA(1, 1), a1 + hstep, voffA);
            PG8_WAIT_L(8); PG8_BAR; PG8_WAIT_L(0); PG8_MMA(0, 0, At, B0); PG8_BAR; PG8_SCHED;
            PG8_LDB(B1, 0, 1); PG8_STAGE(PG8_SB(0, 0), b2, voffB);
            PG8_BAR; PG8_WAIT_L(0); PG8_MMA(0, 1, At, B1); PG8_BAR;
            PG8_LDA(At, 0, 1); PG8_STAGE(PG8_SA(0, 0), a2, voffA);
            PG8_BAR; PG8_WAIT_L(0); PG8_MMA(1, 0, At, B0); PG8_BAR; PG8_SCHED;
            PG8_STAGE(PG8_SB(0, 1), b2 + hstep, voffB);
            PG8_WAIT_V(6); PG8_BAR; PG8_MMA(1, 1, At, B1); PG8_BAR;
            PG8_LDB(B0, 1, 0); PG8_SCHED; PG8_LDA(At, 1, 0); PG8_STAGE(PG8_SA(0, 1), a2 + hstep, voffA);
            PG8_WAIT_L(8); PG8_BAR; PG8_WAIT_L(0); PG8_MMA(0, 0, At, B0); PG8_BAR; PG8_SCHED;
            PG8_LDB(B1, 1, 1); PG8_STAGE(PG8_SB(1, 0), b3, voffB);
            PG8_BAR; PG8_WAIT_L(0); PG8_MMA(0, 1, At, B1); PG8_BAR;
            PG8_LDA(At, 1, 1); PG8_STAGE(PG8_SA(1, 0), a3, voffA);
            PG8_BAR; PG8_WAIT_L(0); PG8_MMA(1, 0, At, B0); PG8_BAR; PG8_SCHED;
            PG8_STAGE(PG8_SB(1, 1), b3 + hstep, voffB);
            PG8_WAIT_V(6); PG8_BAR; PG8_MMA(1, 1, At, B1); PG8_BAR;
        }
        if constexpr (!Epi::AFTER_DRAIN) { E(acc, cur, wr, wc, fr, fq); S.done(cur); }
        if (!has_next) break;
#pragma unroll
        for (int a = 0; a < 2; ++a)
#pragma unroll
            for (int b = 0; b < 2; ++b)
#pragma unroll
                for (int m = 0; m < 4; ++m)
#pragma unroll
                    for (int n = 0; n < 2; ++n) acc[a][b][m][n] = (f32x4){0.f, 0.f, 0.f, 0.f};
        cur = nxt; cA = nA; cB = nB; ++ui;
    }
    PG8_WAIT_V(0);
    if (wr == 0) PG8_BAR;
    PG8_BAR;
    if constexpr (Epi::AFTER_DRAIN) { E.fused(acc, cur, wr, wc, fr, fq, lds, wid, lane); S.done(cur); }
#undef PG8_SA
#undef PG8_SB
#undef PG8_STAGE
#undef PG8_LDA
#undef PG8_LDB
#undef PG8_MMA
#undef PG8_WAIT_V
#undef PG8_WAIT_L
#undef PG8_BAR
#undef PG8_SCHED
}
}

#define XB_TMO      128
#define XB_XCNT(j)  (256  + 64 * (j))
#define XB_XSUB(j)  (1280 + 64 * (j))
#define XB_XGEN(j)  (2304 + 64 * (j))
#define XB_TOP      3328
#define XB_TOPGEN   3392
#define XCD_BAR_WORDS 3456
#define XB_SPIN_CAP (1u << 18)
#define LAS __attribute__((address_space(3)))

__device__ __forceinline__ unsigned xb_ld(unsigned* p)              { return __hip_atomic_load(p, __ATOMIC_RELAXED, __HIP_MEMORY_SCOPE_AGENT); }
__device__ __forceinline__ unsigned xb_add(unsigned* p, unsigned v) { return __hip_atomic_fetch_add(p, v, __ATOMIC_RELAXED, __HIP_MEMORY_SCOPE_AGENT); }
__device__ __forceinline__ unsigned xb_xcc_id() { return (unsigned)__builtin_amdgcn_s_getreg((3 << 11) | 20) & 0xFu; }
#define XB_SPIN(cond, bar) do { unsigned _sp = 0; while (cond) { __builtin_amdgcn_s_sleep(1); \
    if ((++_sp & 255u) == 0u) { if (xb_ld(&(bar)[XB_TMO])) break; if (_sp > XB_SPIN_CAP) { atomicAdd(&(bar)[XB_TMO], 1u); break; } } } } while (0)

struct XcdBarrier {
    unsigned* bar; unsigned x;
    volatile LAS unsigned* st;
};

__device__ __forceinline__ XcdBarrier xcd_barrier_post(unsigned* bar, volatile LAS unsigned* st) {
    XcdBarrier b; b.bar = bar; b.x = xb_xcc_id(); b.st = st;
    if (threadIdx.x == 0) (void)xb_add(&bar[XB_XCNT(b.x)], 1u);
    return b;
}
__device__ __forceinline__ void xcd_barrier_complete(unsigned* bar, unsigned x, unsigned& nloc, unsigned& nx) {
    const unsigned G = gridDim.x * gridDim.y * gridDim.z;
    unsigned sum, cnt, mine, sp = 0u;
    for (;;) {
        sum = 0u; cnt = 0u; mine = 0u;
#pragma unroll
        for (unsigned j = 0; j < 16; ++j) { const unsigned c = xb_ld(&bar[XB_XCNT(j)]); sum += c; cnt += (c > 0u) ? 1u : 0u; mine = (j == x) ? c : mine; }
        if (sum == G) break;
        __builtin_amdgcn_s_sleep(1);
        if ((++sp & 255u) == 0u) { if (xb_ld(&bar[XB_TMO])) break; if (sp > XB_SPIN_CAP) { atomicAdd(&bar[XB_TMO], 1u); break; } }
    }
    nloc = mine > 0u ? mine : 1u; nx = cnt > 0u ? cnt : 1u;
}

__device__ __forceinline__ void xcd_barrier(const XcdBarrier& b) {
    asm volatile("s_waitcnt vmcnt(0)" ::: "memory");
    __syncthreads();
    if (threadIdx.x == 0) {
        unsigned* bar = b.bar;
        __builtin_amdgcn_s_waitcnt(0);
        unsigned nloc = b.st[0], nx = b.st[1];
        if (nloc == 0u) { xcd_barrier_complete(bar, b.x, nloc, nx); b.st[0] = nloc; b.st[1] = nx; }
        const unsigned old = xb_add(&bar[XB_XSUB(b.x)], 1u);
        const unsigned gen = old / nloc;
        if (old + 1u == (gen + 1u) * nloc) {
            __builtin_amdgcn_fence(__ATOMIC_RELEASE, "agent");
            asm volatile("s_waitcnt vmcnt(0)" ::: "memory");
            const unsigned og = xb_add(&bar[XB_TOP], 1u);
            const unsigned tg = og / nx;
            if (og + 1u == (tg + 1u) * nx) xb_add(&bar[XB_TOPGEN], 1u);
            else XB_SPIN(xb_ld(&bar[XB_TOPGEN]) == tg, bar);
            __builtin_amdgcn_fence(__ATOMIC_ACQUIRE, "agent");
            xb_add(&bar[XB_XGEN(b.x)], 1u);
            asm volatile("s_waitcnt vmcnt(0)" ::: "memory");
        } else {
            XB_SPIN(xb_ld(&bar[XB_XGEN(b.x)]) == gen, bar);
            __builtin_amdgcn_fence(__ATOMIC_ACQUIRE, "agent");
            asm volatile("s_waitcnt vmcnt(0)" ::: "memory");
        }
    }
    __syncthreads();
}

using pg8::bf16_t; using pg8::bf16x8; using pg8::f32x4;
typedef unsigned u32x2_t __attribute__((ext_vector_type(2)));
typedef unsigned u32x4_t __attribute__((ext_vector_type(4)));

constexpr int DM = 1024, SEG = 16384, LDZ = 8192, LDY = 2560;
constexpr float EPS = 1e-6f;
constexpr int LDS_BYTES = 131072 + 64;
constexpr size_t WS_WIN_E = 0;
constexpr size_t WS_WIN_O = WS_WIN_E + (size_t)9216 * 1024 * 2;
constexpr size_t WS_WOUT_E = WS_WIN_O + (size_t)6144 * 1024 * 2;
constexpr size_t WS_WOUT_O = WS_WOUT_E + (size_t)1024 * 2560 * 2;
constexpr size_t WS_WKV = WS_WOUT_O + (size_t)1024 * 2560 * 2;
constexpr size_t WS_LRUW = WS_WKV + (size_t)2 * 1024 * 1024 * 2;
constexpr size_t WS_SGUW = WS_LRUW + (size_t)2 * 2 * 8 * 128 * 128 * 2;
constexpr size_t WS_MEMN = WS_SGUW + (size_t)8 * 128 * 128 * 2;
constexpr size_t WS_MK = WS_MEMN + (size_t)2 * 1536 * 1024 * 2;
constexpr size_t WS_MVT = WS_MK + (size_t)2 * 1536 * 512 * 2;
constexpr size_t WS_H = WS_MVT + (size_t)2 * 512 * 1536 * 2;
constexpr size_t WS_Z = WS_H + (size_t)SEG * 1024 * 2;
constexpr size_t WS_VT = WS_Z + (size_t)SEG * LDZ * 2;
constexpr size_t WS_Y = WS_VT + (size_t)1024 * SEG * 2;
constexpr size_t WS_AGG = WS_Y + (size_t)SEG * LDY * 2;
constexpr size_t WS_CARRY = WS_AGG + (size_t)2 * 128 * 1024 * 2 * 4;
constexpr size_t WS_RSTD = WS_CARRY + (size_t)2 * 128 * 1024 * 4;
constexpr size_t WS_PART = WS_RSTD + (size_t)SEG * 4;
constexpr size_t WS_BAR = WS_PART + (size_t)8 * SEG * 4;
constexpr size_t WS_LAB = WS_BAR + 16384;
constexpr size_t WS_END = WS_LAB + (size_t)2 * SEG * 1024 * 4;

struct Params { const float* in[25]; float* out; unsigned char* ws; };

__device__ __forceinline__ float bf2f(unsigned short b) { return __uint_as_float(((unsigned)b) << 16); }
__device__ __forceinline__ unsigned short f2bf(float f) { unsigned u = __float_as_uint(f); u += 0x7FFFu + ((u >> 16) & 1u); return (unsigned short)(u >> 16); }
__device__ __forceinline__ float bflo(unsigned w) { return __uint_as_float(w << 16); }
__device__ __forceinline__ float bfhi(unsigned w) { return __uint_as_float(w & 0xffff0000u); }
__device__ __forceinline__ unsigned pk2(float lo, float hi) { return pg8::cvt_pk_bf16(lo, hi); }
__device__ __forceinline__ float frcp(float x) { return __builtin_amdgcn_rcpf(x); }
__device__ __forceinline__ float silu(float x) { return x * frcp(1.0f + __expf(-x)); }
__device__ __forceinline__ float sigm(float x) { return frcp(1.0f + __expf(-x)); }
__device__ __forceinline__ float wave_sum(float v) {
#pragma unroll
    for (int o = 1; o < 64; o <<= 1) v += __shfl_xor(v, o);
    return v;
}
__device__ __forceinline__ f32x4 mfma16(bf16x8 a, bf16x8 b, f32x4 c) { return __builtin_amdgcn_mfma_f32_16x16x32_bf16(a, b, c, 0, 0, 0); }
__device__ __forceinline__ bf16x8 ld8(const bf16_t* p) { return *(const bf16x8*)p; }
__device__ __forceinline__ bf16x8 pack8(const float (&v)[8]) {
    u32x4_t w; w.x = pk2(v[0], v[1]); w.y = pk2(v[2], v[3]); w.z = pk2(v[4], v[5]); w.w = pk2(v[6], v[7]);
    return __builtin_bit_cast(bf16x8, w);
}

__device__ __forceinline__ void transpose_tile(const float* src, int R, int C, bf16_t* dst, int tile, float* lds) {
    const int ntc = C >> 6, tr = tile / ntc, tc = tile - tr * ntc, r0 = tr * 64, c0 = tc * 64;
    const int tx = threadIdx.x & 63, ty = threadIdx.x >> 6;
#pragma unroll
    for (int i = 0; i < 8; ++i) { const int r = ty + 8 * i; lds[r * 65 + tx] = src[(size_t)(r0 + r) * C + c0 + tx]; }
    __syncthreads();
#pragma unroll
    for (int i = 0; i < 8; ++i) { const int c = ty + 8 * i; dst[(size_t)(c0 + c) * R + r0 + tx] = f2bf(lds[tx * 65 + c]); }
    __syncthreads();
}

__device__ __forceinline__ void rms_row_bf16(const float* xrow, const float* g, bf16_t* orow, int lane) {
    const f32x4* xr = (const f32x4*)xrow + lane; f32x4 v[4]; float s = 0.f;
#pragma unroll
    for (int j = 0; j < 4; ++j) { v[j] = xr[64 * j]; s += (v[j].x * v[j].x + v[j].y * v[j].y) + (v[j].z * v[j].z + v[j].w * v[j].w); }
    const float rstd = __builtin_amdgcn_rsqf(wave_sum(s) * (1.0f / 1024.0f) + EPS);
    const f32x4* gr = (const f32x4*)g + lane; u32x2_t* o8 = (u32x2_t*)orow + lane;
#pragma unroll
    for (int j = 0; j < 4; ++j) { const f32x4 gg = gr[64 * j]; u32x2_t o; o.x = pk2(v[j].x * rstd * gg.x, v[j].y * rstd * gg.y); o.y = pk2(v[j].z * rstd * gg.z, v[j].w * rstd * gg.w); o8[64 * j] = o; }
}
__device__ __forceinline__ void rms_row_f32(float* xrow, const float* g, int lane) {
    f32x4* xr = (f32x4*)xrow + lane; f32x4 v[4]; float s = 0.f;
#pragma unroll
    for (int j = 0; j < 4; ++j) { v[j] = xr[64 * j]; s += (v[j].x * v[j].x + v[j].y * v[j].y) + (v[j].z * v[j].z + v[j].w * v[j].w); }
    const float rstd = __builtin_amdgcn_rsqf(wave_sum(s) * (1.0f / 1024.0f) + EPS);
    const f32x4* gr = (const f32x4*)g + lane;
#pragma unroll
    for (int j = 0; j < 4; ++j) { const f32x4 gg = gr[64 * j]; f32x4 o; o.x = v[j].x * rstd * gg.x; o.y = v[j].y * rstd * gg.y; o.z = v[j].z * rstd * gg.z; o.w = v[j].w * rstd * gg.w; xr[64 * j] = o; }
}

__device__ __forceinline__ void conv_even_item(const bf16_t* z, const float* cw, const float* cb, bf16_t* y, int t, int T, int lane) {
    const int s = t & (T - 1);
#pragma unroll
    for (int half = 0; half < 2; ++half) {
        const int c0 = half * 512 + lane * 8;
        const bf16_t* zr = z + (size_t)t * LDZ + c0;
        const u32x4_t bg = *(const u32x4_t*)(zr), ga = *(const u32x4_t*)(zr + 3072);
        const u32x4_t cg1 = *(const u32x4_t*)(zr + 1024), xv1 = *(const u32x4_t*)(zr + 2048);
        u32x4_t cg0 = {0, 0, 0, 0}, xv0 = {0, 0, 0, 0}, cg2 = {0, 0, 0, 0}, xv2 = {0, 0, 0, 0};
        if (s > 0) { cg0 = *(const u32x4_t*)(zr - LDZ + 1024); xv0 = *(const u32x4_t*)(zr - LDZ + 2048); }
        if (s < T - 1) { cg2 = *(const u32x4_t*)(zr + LDZ + 1024); xv2 = *(const u32x4_t*)(zr + LDZ + 2048); }
        float w0[8], w1[8], w2[8], bb[8];
#pragma unroll
        for (int e = 0; e < 8; e += 4) {
            const f32x4 a = *(const f32x4*)(cw + c0 + e), b = *(const f32x4*)(cw + 1024 + c0 + e), c = *(const f32x4*)(cw + 2048 + c0 + e), d = *(const f32x4*)(cb + c0 + e);
#pragma unroll
            for (int k = 0; k < 4; ++k) { w0[e + k] = a[k]; w1[e + k] = b[k]; w2[e + k] = c[k]; bb[e + k] = d[k]; }
        }
        float o[8];
#pragma unroll
        for (int k = 0; k < 4; ++k) {
            const float p0l = bflo(cg0[k]) * bflo(xv0[k]), p0h = bfhi(cg0[k]) * bfhi(xv0[k]);
            const float p1l = bflo(cg1[k]) * bflo(xv1[k]), p1h = bfhi(cg1[k]) * bfhi(xv1[k]);
            const float p2l = bflo(cg2[k]) * bflo(xv2[k]), p2h = bfhi(cg2[k]) * bfhi(xv2[k]);
            const float cl = bb[2 * k] + w0[2 * k] * p0l + w1[2 * k] * p1l + w2[2 * k] * p2l;
            const float ch = bb[2 * k + 1] + w0[2 * k + 1] * p0h + w1[2 * k + 1] * p1h + w2[2 * k + 1] * p2h;
            o[2 * k] = bflo(bg[k]) * cl * silu(bflo(ga[k]));
            o[2 * k + 1] = bfhi(bg[k]) * ch * silu(bfhi(ga[k]));
        }
        u32x4_t w; w.x = pk2(o[0], o[1]); w.y = pk2(o[2], o[3]); w.z = pk2(o[4], o[5]); w.w = pk2(o[6], o[7]);
        *(u32x4_t*)(y + (size_t)t * LDY + c0) = w;
    }
}

__device__ __forceinline__ void conv_odd_item(const bf16_t* z, const float* cw, const float* cb, bf16_t* xc, int t, int T, int lane) {
    const int s = t & (T - 1);
#pragma unroll
    for (int half = 0; half < 2; ++half) {
        const int c0 = half * 512 + lane * 8;
        const bf16_t* zr = z + (size_t)t * LDZ + c0;
        float acc[8];
#pragma unroll
        for (int e = 0; e < 8; e += 4) { const f32x4 d = *(const f32x4*)(cb + c0 + e); acc[e] = d[0]; acc[e + 1] = d[1]; acc[e + 2] = d[2]; acc[e + 3] = d[3]; }
#pragma unroll
        for (int j = 0; j < 4; ++j) {
            const int sj = s + j - 2;
            if (sj >= 0 && sj < T) {
                const u32x4_t xv = *(const u32x4_t*)(zr + (ptrdiff_t)(j - 2) * LDZ);
                const f32x4 wa = *(const f32x4*)(cw + j * 1024 + c0), wb = *(const f32x4*)(cw + j * 1024 + c0 + 4);
                acc[0] += wa[0] * bflo(xv[0]); acc[1] += wa[1] * bfhi(xv[0]); acc[2] += wa[2] * bflo(xv[1]); acc[3] += wa[3] * bfhi(xv[1]);
                acc[4] += wb[0] * bflo(xv[2]); acc[5] += wb[1] * bfhi(xv[2]); acc[6] += wb[2] * bflo(xv[3]); acc[7] += wb[3] * bfhi(xv[3]);
            }
        }
        u32x4_t w; w.x = pk2(acc[0], acc[1]); w.y = pk2(acc[2], acc[3]); w.z = pk2(acc[4], acc[5]); w.w = pk2(acc[6], acc[7]);
        *(u32x4_t*)(xc + (size_t)t * 1024 + c0) = w;
    }
}
__device__ __forceinline__ void rstd_item(const float* part, float* rstd, int tg, int lane) {
    const float* p = part + tg * 64 + lane; float s = 0.f;
#pragma unroll
    for (int i = 0; i < 8; ++i) s += p[(size_t)i * SEG];
    rstd[tg * 64 + lane] = __builtin_amdgcn_rsqf(s * (1.0f / 1024.0f) + EPS);
}

__device__ __forceinline__ void na_item(const bf16_t* z, const bf16_t* vT, bf16_t* y, const LAS float* rpbL, int item, int T, int lane) {
    const int g = item & 3, h = (item >> 2) & 15, R = item >> 6;
    const int rows = T >> 6, seq = R / rows, r = R - seq * rows, seq_base = seq * T;
    int rstart = r - 4; rstart = rstart < 0 ? 0 : rstart; rstart = rstart > rows - 8 ? rows - 8 : rstart;
    const int wb = (g == 0) ? 0 : (g == 1) ? 8 : (g == 2) ? 24 : 32;
    const int fr = lane & 15, fq = lane >> 4;
    const int tok = seq_base + r * 64 + g * 16 + fr;
    const bf16_t* qp = z + (size_t)tok * LDZ + 4096 + h * 64 + fq * 8;
    const bf16x8 q0 = ld8(qp), q1 = ld8(qp + 32);
    const int kcolA = wb + (fr >> 2) * 8 + (fr & 3);
    const bf16_t* kp0 = z + (size_t)(seq_base + rstart * 64 + kcolA) * LDZ + 5120 + h * 64 + fq * 8;
    bf16x8 kf[8][4];
#pragma unroll
    for (int kr = 0; kr < 8; ++kr) { const bf16_t* kp = kp0 + (size_t)kr * 64 * LDZ; kf[kr][0] = ld8(kp); kf[kr][1] = ld8(kp + 32); kf[kr][2] = ld8(kp + 4 * LDZ); kf[kr][3] = ld8(kp + 4 * LDZ + 32); }
    const int qc = g * 16 + fr;
    int cstart = qc - 8; cstart = cstart < 0 ? 0 : cstart; cstart = cstart > 48 ? 48 : cstart;
    int dcs[8]; bool oks[8];
#pragma unroll
    for (int e = 0; e < 8; ++e) { const int kc = wb + fq * 8 + e; oks[e] = (kc >= cstart) && (kc < cstart + 16); int dc = kc - qc; dc = dc < -15 ? -15 : dc; dc = dc > 15 ? 15 : dc; dcs[e] = dc + 15; }
    const LAS float* bp0 = rpbL + (h * 15 + rstart - r + 7) * 31;
    float s[8][8];
    float mx = -1e30f;
#pragma unroll
    for (int kr = 0; kr < 8; ++kr) {
        f32x4 a0 = {0.f, 0.f, 0.f, 0.f}, a1 = {0.f, 0.f, 0.f, 0.f};
        a0 = mfma16(kf[kr][0], q0, a0); a0 = mfma16(kf[kr][1], q1, a0);
        a1 = mfma16(kf[kr][2], q0, a1); a1 = mfma16(kf[kr][3], q1, a1);
#pragma unroll
        for (int e = 0; e < 8; ++e) {
            const float sc = (e < 4 ? a0[e & 3] : a1[e & 3]) * 0.125f + bp0[kr * 31 + dcs[e]];
            s[kr][e] = oks[e] ? sc : -1e30f;
            mx = fmaxf(mx, s[kr][e]);
        }
    }
    const bf16_t* vp0 = vT + (size_t)(h * 64 + fr) * SEG + seq_base + rstart * 64 + wb + fq * 8;
    bf16x8 vf[8][4];
#pragma unroll
    for (int kr = 0; kr < 8; ++kr)
#pragma unroll
        for (int dt = 0; dt < 4; ++dt) vf[kr][dt] = ld8(vp0 + kr * 64 + (size_t)dt * 16 * SEG);
    u32x2_t gr[4];
#pragma unroll
    for (int dt = 0; dt < 4; ++dt) gr[dt] = *(const u32x2_t*)(z + (size_t)tok * LDZ + 6144 + h * 64 + dt * 16 + fq * 4);
    mx = fmaxf(mx, __shfl_xor(mx, 16)); mx = fmaxf(mx, __shfl_xor(mx, 32));
    float sum = 0.f;
#pragma unroll
    for (int kr = 0; kr < 8; ++kr)
#pragma unroll
        for (int e = 0; e < 8; ++e) { const float p = __expf(s[kr][e] - mx); s[kr][e] = p; sum += p; }
    sum += __shfl_xor(sum, 16); sum += __shfl_xor(sum, 32);
    f32x4 o[4];
#pragma unroll
    for (int dt = 0; dt < 4; ++dt) o[dt] = (f32x4){0.f, 0.f, 0.f, 0.f};
#pragma unroll
    for (int kr = 0; kr < 8; ++kr) {
        const bf16x8 pf = pack8(s[kr]);
#pragma unroll
        for (int dt = 0; dt < 4; ++dt) o[dt] = mfma16(vf[kr][dt], pf, o[dt]);
    }
    const float inv = frcp(sum);
#pragma unroll
    for (int dt = 0; dt < 4; ++dt) {
        const int d4 = dt * 16 + fq * 4;
        u32x2_t ow;
        ow.x = pk2(o[dt][0] * inv * silu(bflo(gr[dt].x)), o[dt][1] * inv * silu(bfhi(gr[dt].x)));
        ow.y = pk2(o[dt][2] * inv * silu(bflo(gr[dt].y)), o[dt][3] * inv * silu(bfhi(gr[dt].y)));
        *(u32x2_t*)(y + (size_t)tok * LDY + 1024 + h * 64 + d4) = ow;
    }
}

__device__ __forceinline__ void mem_unit(const bf16_t* z, int qcol, int gcol, const bf16_t* mk, const bf16_t* mvT, bf16_t* y, int unit, int seg, LAS unsigned char* lds, int tid) {
    const int h = unit & 3, range = unit >> 2, tokr = range * 256;
    const int mb = seg < 2 ? seg : 2 + (tokr >> 12);
    const int lane = tid & 63, wid = tid >> 6, fr = lane & 15, fq = lane >> 4;
    __syncthreads();
#pragma unroll
    for (int i = 0; i < 8; ++i) {
        const int idx = tid + 512 * i, rho = idx >> 4, c = idx & 15, f = (rho & 3) | (((rho >> 3) & 3) << 2);
        const u32x4_t v = *(const u32x4_t*)(mk + (size_t)(mb * 256 + rho) * 512 + h * 128 + c * 8);
        *(LAS u32x4_t*)(lds + rho * 256 + ((c ^ f) << 4)) = v;
    }
#pragma unroll
    for (int i = 0; i < 8; ++i) {
        const int idx = tid + 512 * i, d = idx >> 5, c = idx & 31;
        const u32x4_t v = *(const u32x4_t*)(mvT + (size_t)(h * 128 + d) * 1536 + mb * 256 + c * 8);
        *(LAS u32x4_t*)(lds + 65536 + d * 512 + ((c ^ (d & 15)) << 4)) = v;
    }
    __syncthreads();
    const int mrowA = (fr >> 2) * 8 + (fr & 3);
    const LAS unsigned char* kbase = lds + mrowA * 256 + ((fq ^ (fr & 3)) << 4);
    const LAS unsigned char* vbase = lds + 65536 + fr * 512 + ((fq ^ (fr & 3)) << 4);
    const int hi = fr >> 2;
#pragma unroll 1
    for (int gi = 0; gi < 2; ++gi) {
        const int tok = tokr + (wid + 8 * gi) * 16 + fr;
        const bf16_t* qp = z + (size_t)tok * LDZ + qcol + h * 128 + fq * 8;
        bf16x8 q[4];
#pragma unroll
        for (int ks = 0; ks < 4; ++ks) q[ks] = ld8(qp + ks * 32);
        u32x2_t gr[8];
#pragma unroll
        for (int dt = 0; dt < 8; ++dt) gr[dt] = *(const u32x2_t*)(z + (size_t)tok * LDZ + gcol + h * 128 + dt * 16 + fq * 4);
        float s[8][8];
        float mx = -1e30f;
#pragma unroll
        for (int kb = 0; kb < 8; ++kb) {
            f32x4 a0 = {0.f, 0.f, 0.f, 0.f}, a1 = {0.f, 0.f, 0.f, 0.f};
#pragma unroll
            for (int ks = 0; ks < 4; ++ks) {
                const LAS unsigned char* kp = kbase + kb * 8192 + ((ks ^ hi) << 6);
                a0 = mfma16(*(const LAS bf16x8*)kp, q[ks], a0); a1 = mfma16(*(const LAS bf16x8*)(kp + 1024), q[ks], a1);
            }
#pragma unroll
            for (int e = 0; e < 8; ++e) { s[kb][e] = (e < 4 ? a0[e & 3] : a1[e & 3]) * 0.08838834764831845f; mx = fmaxf(mx, s[kb][e]); }
        }
        mx = fmaxf(mx, __shfl_xor(mx, 16)); mx = fmaxf(mx, __shfl_xor(mx, 32));
        float sum = 0.f;
#pragma unroll
        for (int kb = 0; kb < 8; ++kb)
#pragma unroll
            for (int e = 0; e < 8; ++e) { const float p = __expf(s[kb][e] - mx); s[kb][e] = p; sum += p; }
        sum += __shfl_xor(sum, 16); sum += __shfl_xor(sum, 32);
        f32x4 o[8];
#pragma unroll
        for (int dt = 0; dt < 8; ++dt) o[dt] = (f32x4){0.f, 0.f, 0.f, 0.f};
#pragma unroll
        for (int kb = 0; kb < 8; ++kb) {
            const bf16x8 pf = pack8(s[kb]);
            const LAS unsigned char* vp = vbase + (((kb ^ hi) & 7) << 6);
#pragma unroll
            for (int dt = 0; dt < 8; ++dt) o[dt] = mfma16(*(const LAS bf16x8*)(vp + dt * 8192), pf, o[dt]);
        }
        const float inv = frcp(sum);
#pragma unroll
        for (int dt = 0; dt < 8; ++dt) {
            const int d4 = dt * 16 + fq * 4;
            u32x2_t ow;
            ow.x = pk2(o[dt][0] * inv * silu(bflo(gr[dt].x)), o[dt][1] * inv * silu(bfhi(gr[dt].x)));
            ow.y = pk2(o[dt][2] * inv * silu(bflo(gr[dt].y)), o[dt][3] * inv * silu(bfhi(gr[dt].y)));
            *(u32x2_t*)(y + (size_t)tok * LDY + 2048 + h * 128 + d4) = ow;
        }
    }
}

template <int CTRL> __device__ __forceinline__ float dppf(float oldv, float src) {
    return __int_as_float(__builtin_amdgcn_update_dpp(__float_as_int(oldv), __float_as_int(src), CTRL, 0xf, 0xf, false));
}
template <int DIR> __device__ __forceinline__ void scan16(float& A, float& B) {
    constexpr int BASE = DIR == 0 ? 0x110 : 0x100;
    { const float ap = dppf<BASE + 1>(1.f, A), bp = dppf<BASE + 1>(0.f, B); B = A * bp + B; A = A * ap; }
    { const float ap = dppf<BASE + 2>(1.f, A), bp = dppf<BASE + 2>(0.f, B); B = A * bp + B; A = A * ap; }
    { const float ap = dppf<BASE + 4>(1.f, A), bp = dppf<BASE + 4>(0.f, B); B = A * bp + B; A = A * ap; }
    { const float ap = dppf<BASE + 8>(1.f, A), bp = dppf<BASE + 8>(0.f, B); B = A * bp + B; A = A * ap; }
}
struct LruW { bf16x8 Wa[4], Wi[4]; float ba[4], bi[4], c8[4]; };
struct LruX { bf16x8 x[2][4]; u32x2_t xr[2]; };
__device__ __forceinline__ void lru_loadw(LruW& W, const bf16_t* lruw, const float* ba_, const float* bi_, const float* lam_, int dir, int blk, int w, int ch4, int lane) {
    const int fr = lane & 15, fq = lane >> 4;
    const bf16_t* wa = lruw + ((size_t)((0 * 2 + dir) * 8 + blk) * 128 + w * 16 + fr) * 128 + fq * 8;
    const bf16_t* wi = lruw + ((size_t)((1 * 2 + dir) * 8 + blk) * 128 + w * 16 + fr) * 128 + fq * 8;
#pragma unroll
    for (int ks = 0; ks < 4; ++ks) { W.Wa[ks] = ld8(wa + ks * 32); W.Wi[ks] = ld8(wi + ks * 32); }
    const f32x4 a = *(const f32x4*)(ba_ + dir * 1024 + ch4), b = *(const f32x4*)(bi_ + dir * 1024 + ch4), l = *(const f32x4*)(lam_ + dir * 1024 + ch4);
#pragma unroll
    for (int jj = 0; jj < 4; ++jj) { W.ba[jj] = a[jj]; W.bi[jj] = b[jj]; W.c8[jj] = -8.0f * log1pf(__expf(-l[jj])); }
}
__device__ __forceinline__ void lru_loadx(LruX& X, const bf16_t* xc, int tok0, int blk, int ch4, int lane) {
    const int fr = lane & 15, fq = lane >> 4;
#pragma unroll
    for (int t = 0; t < 2; ++t) {
        const bf16_t* xp = xc + (size_t)(tok0 + t * 16 + fr) * 1024;
#pragma unroll
        for (int ks = 0; ks < 4; ++ks) X.x[t][ks] = ld8(xp + blk * 128 + fq * 8 + ks * 32);
        X.xr[t] = *(const u32x2_t*)(xp + ch4);
    }
}
template <int DIR, bool FINAL> __device__ __forceinline__ void lru_tile(const bf16x8 (&Xf)[4], const u32x2_t xr, const LruW& W, int lane, float (&hin)[4], float (&arun)[4], float (&hout)[4], unsigned (&lab)[4]) {
    f32x4 accR = {0.f, 0.f, 0.f, 0.f}, accI = {0.f, 0.f, 0.f, 0.f};
#pragma unroll
    for (int ks = 0; ks < 4; ++ks) { accR = mfma16(W.Wa[ks], Xf[ks], accR); accI = mfma16(W.Wi[ks], Xf[ks], accI); }
    const float xv[4] = {bflo(xr.x), bfhi(xr.x), bflo(xr.y), bfhi(xr.y)};
    const int src = (lane & 48) + (DIR == 0 ? 15 : 0);
#pragma unroll
    for (int jj = 0; jj < 4; ++jj) {
        const float rg = sigm(accR[jj] + W.ba[jj]), ig = sigm(accI[jj] + W.bi[jj]);
        const float la = W.c8[jj] * rg;
        float A = __expf(la);
        float B = __builtin_amdgcn_sqrtf(fmaxf(1.0f - A * A, 0.f)) * (ig * xv[jj]);
        lab[jj] = __builtin_bit_cast(unsigned, __builtin_amdgcn_cvt_pkrtz(la, B));
        scan16<DIR>(A, B);
        const float hval = A * hin[jj] + B;
        hout[jj] = hval;
        hin[jj] = __shfl(hval, src);
        if (!FINAL) arun[jj] *= __shfl(A, src);
    }
}
template <bool FINAL> __device__ __forceinline__ void lru_item(const bf16_t* xc, const bf16_t* z, const bf16_t* lruw, const float* ba_, const float* bi_, const float* lam_,
                                                               float* agg, const float* carry, bf16_t* y, unsigned* labuf, int item, int lane) {
    const int cgi = item & 63, chunk = item >> 6, blk = cgi >> 3, w = cgi & 7;
    const int fr = lane & 15, fq = lane >> 4;
    const int ch4 = blk * 128 + w * 16 + fq * 4;
    const int tokc = chunk * 128;
    LruX X[2]; LruW W0;
    lru_loadw(W0, lruw, ba_, bi_, lam_, 0, blk, w, ch4, lane);
    lru_loadx(X[0], xc, tokc, blk, ch4, lane);
    unsigned hf[8][2];
    float hin[4], arun[4];
#pragma unroll
    for (int jj = 0; jj < 4; ++jj) { hin[jj] = FINAL ? carry[(size_t)(0 * 128 + chunk) * 1024 + ch4 + jj] : 0.f; arun[jj] = 1.f; }
#pragma unroll
    for (int bi = 0; bi < 8; ++bi) {
        __builtin_amdgcn_sched_barrier(0);
        const int slot = bi < 4 ? (bi & 1) : ((bi + 1) & 1);
        const int pair = bi < 4 ? bi : 7 - bi;
        if (bi + 1 < 8 && bi + 1 != 4) {
            const int nslot = (bi + 1) < 4 ? ((bi + 1) & 1) : ((bi + 2) & 1);
            const int npair = (bi + 1) < 4 ? (bi + 1) : 7 - (bi + 1);
            lru_loadx(X[nslot], xc, tokc + npair * 32, blk, ch4, lane);
        }
        if (bi == 4) {
            lru_loadw(W0, lruw, ba_, bi_, lam_, 1, blk, w, ch4, lane);
            if (!FINAL && fr == 0) {
#pragma unroll
                for (int jj = 0; jj < 4; ++jj) { float2 v; v.x = arun[jj]; v.y = hin[jj]; *(float2*)(agg + ((size_t)(0 * 128 + chunk) * 1024 + ch4 + jj) * 2) = v; }
            }
#pragma unroll
            for (int jj = 0; jj < 4; ++jj) { hin[jj] = FINAL ? carry[(size_t)(1 * 128 + chunk) * 1024 + ch4 + jj] : 0.f; arun[jj] = 1.f; }
        }
#pragma unroll
        for (int k = 0; k < 2; ++k) {
            const int t = bi < 4 ? k : 1 - k;
            const int tt = 2 * pair + t;
            float hv[4]; unsigned lab[4];
            if (bi < 4) lru_tile<0, FINAL>(X[slot].x[t], X[slot].xr[t], W0, lane, hin, arun, hv, lab);
            else lru_tile<1, FINAL>(X[slot].x[t], X[slot].xr[t], W0, lane, hin, arun, hv, lab);
            if (!FINAL) { u32x4_t lw; lw.x = lab[0]; lw.y = lab[1]; lw.z = lab[2]; lw.w = lab[3];
                *(u32x4_t*)(labuf + ((((size_t)(bi < 4 ? 0 : 1) * 128 + chunk) * 64 + cgi) * 8 + (2 * pair + t)) * 256 + lane * 4) = lw; }
            if (FINAL) {
                if (bi < 4) {
                    hf[tt][0] = pk2(hv[0], hv[1]); hf[tt][1] = pk2(hv[2], hv[3]);
                } else {
                    const int tok = tokc + tt * 16 + fr;
                    const u32x2_t gr = *(const u32x2_t*)(z + (size_t)tok * LDZ + 1024 + ch4);
                    const float gc[4] = {bflo(gr.x), bfhi(gr.x), bflo(gr.y), bfhi(gr.y)};
                    const float hfv[4] = {bflo(hf[tt][0]), bfhi(hf[tt][0]), bflo(hf[tt][1]), bfhi(hf[tt][1])};
                    float o[4];
#pragma unroll
                    for (int jj = 0; jj < 4; ++jj) o[jj] = (hfv[jj] + hv[jj]) * silu(gc[jj]);
                    u32x2_t ow; ow.x = pk2(o[0], o[1]); ow.y = pk2(o[2], o[3]);
                    *(u32x2_t*)(y + (size_t)tok * LDY + ch4) = ow;
                }
            }
        }
    }
    if (!FINAL && fr == 0) {
#pragma unroll
        for (int jj = 0; jj < 4; ++jj) { float2 v; v.x = arun[jj]; v.y = hin[jj]; *(float2*)(agg + ((size_t)(1 * 128 + chunk) * 1024 + ch4 + jj) * 2) = v; }
    }
}
__device__ __forceinline__ void lru_final_item(const unsigned* labuf, const bf16_t* z, const float* carry, bf16_t* y, int item, int lane) {
    typedef _Float16 h2_t __attribute__((ext_vector_type(2)));
    const int cgi = item & 63, chunk = item >> 6;
    const int fr = lane & 15, fq = lane >> 4;
    const int ch4 = cgi * 16 + fq * 4, tokc = chunk * 128;
    u32x4_t L[2][8]; u32x2_t gr[8];
#pragma unroll
    for (int d = 0; d < 2; ++d)
#pragma unroll
        for (int tt = 0; tt < 8; ++tt) L[d][tt] = *(const u32x4_t*)(labuf + ((((size_t)d * 128 + chunk) * 64 + cgi) * 8 + tt) * 256 + lane * 4);
#pragma unroll
    for (int tt = 0; tt < 8; ++tt) gr[tt] = *(const u32x2_t*)(z + (size_t)(tokc + tt * 16 + fr) * LDZ + 1024 + ch4);
    float hf[8][4];
    {
        float hin[4];
#pragma unroll
        for (int jj = 0; jj < 4; ++jj) hin[jj] = carry[(size_t)(0 * 128 + chunk) * 1024 + ch4 + jj];
        const int src = (lane & 48) + 15;
#pragma unroll
        for (int tt = 0; tt < 8; ++tt)
#pragma unroll
            for (int jj = 0; jj < 4; ++jj) {
                const unsigned wv = L[0][tt][jj]; const h2_t v = __builtin_bit_cast(h2_t, wv);
                float A = __expf((float)v.x), B = (float)v.y;
                scan16<0>(A, B);
                const float hval = A * hin[jj] + B;
                hf[tt][jj] = hval; hin[jj] = __shfl(hval, src);
            }
    }
    {
        float hin[4];
#pragma unroll
        for (int jj = 0; jj < 4; ++jj) hin[jj] = carry[(size_t)(1 * 128 + chunk) * 1024 + ch4 + jj];
        const int src = (lane & 48);
#pragma unroll
        for (int s = 0; s < 8; ++s) {
            const int tt = 7 - s;
            float o[4];
#pragma unroll
            for (int jj = 0; jj < 4; ++jj) {
                const unsigned wv = L[1][tt][jj]; const h2_t v = __builtin_bit_cast(h2_t, wv);
                float A = __expf((float)v.x), B = (float)v.y;
                scan16<1>(A, B);
                const float hval = A * hin[jj] + B;
                hin[jj] = __shfl(hval, src);
                o[jj] = hf[tt][jj] + hval;
            }
            const float gc[4] = {bflo(gr[tt].x), bfhi(gr[tt].x), bflo(gr[tt].y), bfhi(gr[tt].y)};
            u32x2_t ow; ow.x = pk2(o[0] * silu(gc[0]), o[1] * silu(gc[1])); ow.y = pk2(o[2] * silu(gc[2]), o[3] * silu(gc[3]));
            *(u32x2_t*)(y + (size_t)(tokc + tt * 16 + fr) * LDY + ch4) = ow;
        }
    }
}
__device__ __forceinline__ void carry_phase(const float* agg, float* carry, int nseq, int gtid, int gthreads) {
    const int nc = 128 / nseq;
    for (int idx = gtid; idx < 2 * nseq * 1024; idx += gthreads) {
        const int ch = idx & 1023, rest = idx >> 10, dir = rest & 1, sq = rest >> 1, base = sq * nc;
        float h = 0.f;
#pragma unroll 8
        for (int c = 0; c < nc; ++c) {
            const int C = base + (dir == 0 ? c : nc - 1 - c);
            const size_t o = (size_t)(dir * 128 + C) * 1024 + ch;
            const float2 ah = *(const float2*)(agg + o * 2);
            carry[o] = h;
            h = ah.x * h + ah.y;
        }
    }
}

__device__ __forceinline__ void sgu_item(const bf16_t* vT, const float* rstd, const bf16_t* z, const bf16_t* sguw, const float* sgu_g, const float* sgu_b, bf16_t* y, int item, int lane) {
    const int dd = item & 7, g = (item >> 3) & 7, n = item >> 6;
    const int fr = lane & 15, fq = lane >> 4;
    const int tokc = n * 128;
    const bf16_t* ap = vT + (size_t)(g * 128 + dd * 16 + fr) * SEG + tokc + fq * 8;
    bf16x8 Af[4];
#pragma unroll
    for (int ks = 0; ks < 4; ++ks) {
        const u32x4_t raw = *(const u32x4_t*)(ap + ks * 32);
        const f32x4 r0 = *(const f32x4*)(rstd + tokc + ks * 32 + fq * 8), r1 = *(const f32x4*)(rstd + tokc + ks * 32 + fq * 8 + 4);
        u32x4_t w;
        w.x = pk2(bflo(raw.x) * r0[0], bfhi(raw.x) * r0[1]); w.y = pk2(bflo(raw.y) * r0[2], bfhi(raw.y) * r0[3]);
        w.z = pk2(bflo(raw.z) * r1[0], bfhi(raw.z) * r1[1]); w.w = pk2(bflo(raw.w) * r1[2], bfhi(raw.w) * r1[3]);
        Af[ks] = __builtin_bit_cast(bf16x8, w);
    }
    const int ch4 = g * 128 + dd * 16 + fq * 4;
    const f32x4 g4 = *(const f32x4*)(sgu_g + ch4);
#pragma unroll
    for (int pt = 0; pt < 8; ++pt) {
        const int p = pt * 16 + fr;
        const bf16_t* bp = sguw + (size_t)(g * 128 + p) * 128 + fq * 8;
        f32x4 acc = {0.f, 0.f, 0.f, 0.f};
#pragma unroll
        for (int ks = 0; ks < 4; ++ks) acc = mfma16(Af[ks], ld8(bp + ks * 32), acc);
        const int tok = tokc + p;
        const float bsv = sgu_b[g * 128 + p];
        const u32x2_t ur = *(const u32x2_t*)(z + (size_t)tok * LDZ + 2048 + ch4), gr = *(const u32x2_t*)(z + (size_t)tok * LDZ + 3072 + ch4);
        const float uu[4] = {bflo(ur.x), bfhi(ur.x), bflo(ur.y), bfhi(ur.y)}, gd[4] = {bflo(gr.x), bfhi(gr.x), bflo(gr.y), bfhi(gr.y)};
        float o[4];
#pragma unroll
        for (int jj = 0; jj < 4; ++jj) o[jj] = uu[jj] * (acc[jj] * g4[jj] + bsv) * silu(gd[jj]);
        u32x2_t ow; ow.x = pk2(o[0], o[1]); ow.y = pk2(o[2], o[3]);
        *(u32x2_t*)(y + (size_t)tok * LDY + 1024 + ch4) = ow;
    }
}

__global__ void __launch_bounds__(512, 2) fwd_megakernel(Params P) {
    extern __shared__ __attribute__((aligned(16))) unsigned char shm[];
    cg::grid_group grid = cg::this_grid();
    PG8_LAS unsigned char* lds = (PG8_LAS unsigned char*)shm;
    const int G = gridDim.x, NW = G * 8;
#define FRESH_TID() int tid = threadIdx.x; asm volatile("" : "+v"(tid)); const int lane = tid & 63, wid = tid >> 6, gw = blockIdx.x * 8 + wid; (void)lane; (void)gw
    unsigned char* ws = P.ws;
    bf16_t* WIN_E = (bf16_t*)(ws + WS_WIN_E); bf16_t* WIN_O = (bf16_t*)(ws + WS_WIN_O);
    bf16_t* WOUT_E = (bf16_t*)(ws + WS_WOUT_E); bf16_t* WOUT_O = (bf16_t*)(ws + WS_WOUT_O);
    bf16_t* WKV = (bf16_t*)(ws + WS_WKV); bf16_t* LRUW = (bf16_t*)(ws + WS_LRUW); bf16_t* SGUW = (bf16_t*)(ws + WS_SGUW);
    bf16_t* MEMN = (bf16_t*)(ws + WS_MEMN); bf16_t* MK = (bf16_t*)(ws + WS_MK); bf16_t* MVT = (bf16_t*)(ws + WS_MVT);
    bf16_t* H = (bf16_t*)(ws + WS_H); bf16_t* Z = (bf16_t*)(ws + WS_Z); bf16_t* VT = (bf16_t*)(ws + WS_VT); bf16_t* Y = (bf16_t*)(ws + WS_Y);
    float* AGG = (float*)(ws + WS_AGG); float* CARRY = (float*)(ws + WS_CARRY); float* RSTD = (float*)(ws + WS_RSTD); float* PART = (float*)(ws + WS_PART); unsigned* LAB = (unsigned*)(ws + WS_LAB);

    unsigned* BAR = (unsigned*)(ws + WS_BAR);
    volatile LAS unsigned* xst = (volatile LAS unsigned*)(lds + 131072);
    {
        FRESH_TID();
        if (tid < 2) xst[tid] = 0u;
        if (blockIdx.x == 0) for (int i = tid; i < XCD_BAR_WORDS; i += 512) BAR[i] = 0u;
        float* scr = (float*)shm;
        constexpr int I0 = 16 * 144, I1 = 16 * 96, I2 = 40 * 16, I3 = 40 * 16, I4 = 256, I5 = 256, I6 = 64, I7 = 64;
        constexpr int NIT = I0 + I1 + I2 + I3 + I4 + I5 + I6 + I7;
        for (int it = blockIdx.x; it < NIT; it += G) {
            int r = it;
            if (r < I0) { transpose_tile(P.in[7], 1024, 9216, WIN_E, r, scr); continue; } r -= I0;
            if (r < I1) { transpose_tile(P.in[12], 1024, 6144, WIN_O, r, scr); continue; } r -= I1;
            if (r < I2) { transpose_tile(P.in[11], 2560, 1024, WOUT_E, r, scr); continue; } r -= I2;
            if (r < I3) { transpose_tile(P.in[23], 2560, 1024, WOUT_O, r, scr); continue; } r -= I3;
            if (r < I4) { transpose_tile(P.in[6], 1024, 1024, WKV, r, scr); continue; } r -= I4;
            if (r < I5) { transpose_tile(P.in[6] + (size_t)1024 * 1024, 1024, 1024, WKV + (size_t)1024 * 1024, r, scr); continue; } r -= I5;
            if (r < I6) { const int m = r >> 2; transpose_tile(P.in[15] + (size_t)m * 16384, 128, 128, LRUW + (size_t)m * 16384, r & 3, scr); continue; } r -= I6;
            { const int m = r >> 2; transpose_tile(P.in[17] + (size_t)m * 16384, 128, 128, LRUW + (size_t)(16 + m) * 16384, r & 3, scr); }
        }
        for (int i = blockIdx.x * 512 + tid; i < 8 * 128 * 128; i += G * 512) SGUW[i] = f2bf(P.in[21][i]);
        for (int it = gw; it < 2 * 1536; it += NW) {
            const int l = it / 1536, row = it - l * 1536;
            const float* src = row < 512 ? P.in[2] + (size_t)row * 1024 : P.in[3] + (size_t)(row - 512) * 1024;
            rms_row_bf16(src, P.in[5] + l * 1024, MEMN + ((size_t)l * 1536 + row) * 1024, lane);
        }
    }

    grid.sync();
    const XcdBarrier xb = xcd_barrier_post(BAR, xst);
    for (int seg = 0; seg < 3; ++seg) {
        const float* xin = seg < 2 ? P.in[0] + (size_t)seg * SEG * 1024 : P.in[1];
        float* xout = P.out + (size_t)seg * SEG * 1024;
        const int T = seg < 2 ? 16384 : 4096, nseq = seg < 2 ? 1 : 4;

        { FRESH_TID();
        for (int it = gw; it < SEG; it += NW) rms_row_bf16(xin + (size_t)it * 1024, P.in[4], H + (size_t)it * 1024, lane); }
        xcd_barrier(xb);

        {
            pg8::Gemm g; g.A = H; g.Bt = WIN_E; g.M = SEG; g.N = 8192; g.K = 1024;
            pg8::SkipOrder S; S.init(SEG, 8192, G, blockIdx.x); S.skip_from = 24; S.skip_n = 4;
            pg8::EpiZ E; E.O = Z; E.ldc = LDZ; E.skip_from = 24; E.skip_n = 4; E.colsq = nullptr; E.colsq_ld = 0;
            pg8::gemm_phase(lds, g, S, E);
        }
        {
            pg8::Gemm g; g.A = WIN_E + (size_t)6144 * 1024; g.Bt = H; g.M = 1024; g.N = SEG; g.K = 1024;
            pg8::SkipOrder S; S.init(1024, SEG, G, blockIdx.x); S.skip_from = 1 << 20; S.skip_n = 0;
            pg8::EpiZ E; E.O = VT; E.ldc = SEG; E.skip_from = 1 << 20; E.skip_n = 0; E.colsq = nullptr; E.colsq_ld = 0;
            pg8::gemm_phase(lds, g, S, E);
        }
        if (seg == 0) {
#pragma unroll 1
            for (int l = 0; l < 2; ++l) {
                {
                    pg8::Gemm g; g.A = MEMN + (size_t)l * 1536 * 1024; g.Bt = WKV + (size_t)l * 1024 * 1024; g.M = 1536; g.N = 512; g.K = 1024;
                    pg8::SkipOrder S; S.init(1536, 512, G, (blockIdx.x + G - (32 * l) % G) % G); S.skip_from = 1 << 20; S.skip_n = 0;
                    pg8::EpiZ E; E.O = MK + (size_t)l * 1536 * 512; E.ldc = 512; E.skip_from = 1 << 20; E.skip_n = 0; E.colsq = nullptr; E.colsq_ld = 0;
                    pg8::gemm_phase(lds, g, S, E);
                }
                {
                    pg8::Gemm g; g.A = WKV + (size_t)l * 1024 * 1024 + (size_t)512 * 1024; g.Bt = MEMN + (size_t)l * 1536 * 1024; g.M = 512; g.N = 1536; g.K = 1024;
                    pg8::SkipOrder S; S.init(512, 1536, G, (blockIdx.x + G - (32 * l + 16) % G) % G); S.skip_from = 1 << 20; S.skip_n = 0;
                    pg8::EpiZ E; E.O = MVT + (size_t)l * 512 * 1536; E.ldc = 1536; E.skip_from = 1 << 20; E.skip_n = 0; E.colsq = nullptr; E.colsq_ld = 0;
                    pg8::gemm_phase(lds, g, S, E);
                }
            }
        }
        xcd_barrier(xb);

        { FRESH_TID();
        for (int u = blockIdx.x; u < 256; u += G) mem_unit(Z, 7168, 7680, MK, MVT, Y, u, seg, lds, tid);
        __syncthreads();
        LAS float* rpbL = (LAS float*)lds;
        for (int i = tid; i < 16 * 15 * 31; i += 512) rpbL[i] = P.in[10][i];
        __syncthreads();
        if (G == 256) {
            const int xcd = blockIdx.x & 7, lw = (blockIdx.x >> 3) * 8 + wid;
#pragma unroll 1
            for (int k = 0; k < 8; ++k) { const int li = k * 256 + lw; na_item(Z, VT, Y, rpbL, (xcd * 32 + (li >> 6)) * 64 + (li & 63), T, lane); }
        } else {
#pragma unroll 1
            for (int it = gw; it < 16384; it += NW) na_item(Z, VT, Y, rpbL, it, T, lane);
        }
        for (int it = gw; it < 16384; it += NW) conv_even_item(Z, P.in[8], P.in[9], Y, it, T, lane);
        }
        xcd_barrier(xb);

        {
            pg8::Gemm g; g.A = Y; g.Bt = WOUT_E; g.M = SEG; g.N = 1024; g.K = 2560;
            pg8::StaticOrder S; S.init(SEG, 1024, G, blockIdx.x);
            pg8::EpiRes E; E.xin = xin; E.out = xout;
            pg8::gemm_phase(lds, g, S, E);
        }
        xcd_barrier(xb);

        { FRESH_TID();
        for (int it = gw; it < SEG; it += NW) rms_row_bf16(xout + (size_t)it * 1024, P.in[4] + 1024, H + (size_t)it * 1024, lane); }
        xcd_barrier(xb);

        {
            pg8::Gemm g; g.A = H; g.Bt = WIN_O; g.M = SEG; g.N = 5120; g.K = 1024;
            pg8::SkipOrder S; S.init(SEG, 5120, G, blockIdx.x); S.skip_from = 12; S.skip_n = 4;
            pg8::EpiZ E; E.O = Z; E.ldc = LDZ; E.skip_from = 12; E.skip_n = 4; E.colsq = nullptr; E.colsq_ld = 0;
            pg8::gemm_phase(lds, g, S, E);
        }
        {
            pg8::Gemm g; g.A = WIN_O + (size_t)3072 * 1024; g.Bt = H; g.M = 1024; g.N = SEG; g.K = 1024;
            pg8::SkipOrder S; S.init(1024, SEG, G, blockIdx.x); S.skip_from = 1 << 20; S.skip_n = 0;
            pg8::EpiZ E; E.O = VT; E.ldc = SEG; E.skip_from = 1 << 20; E.skip_n = 0; E.colsq = PART; E.colsq_ld = SEG;
            pg8::gemm_phase(lds, g, S, E);
        }
        xcd_barrier(xb);

        { FRESH_TID();
        for (int it = gw; it < SEG + 256; it += NW) {
            if (it < SEG) conv_odd_item(Z, P.in[13], P.in[14], H, it, T, lane);
            else rstd_item(PART, RSTD, it - SEG, lane);
        } }
        xcd_barrier(xb);

        { FRESH_TID();
        for (int u = blockIdx.x; u < 256; u += G) mem_unit(Z, 4096, 4608, MK + (size_t)1536 * 512, MVT + (size_t)512 * 1536, Y, u, seg, lds, tid);
        for (int it = gw; it < 8192 + 8192; it += NW) {
            if (it < 8192) lru_item<false>(H, Z, LRUW, P.in[16], P.in[18], P.in[19], AGG, CARRY, Y, LAB, it, lane);
            else sgu_item(VT, RSTD, Z, SGUW, P.in[20], P.in[22], Y, it - 8192, lane);
        } }
        xcd_barrier(xb);

        { FRESH_TID(); carry_phase(AGG, CARRY, nseq, blockIdx.x * 512 + tid, G * 512); }
        xcd_barrier(xb);

        { FRESH_TID();
        for (int it = gw; it < 8192; it += NW) lru_final_item(LAB, Z, CARRY, Y, it, lane); }
        xcd_barrier(xb);

        {
            pg8::Gemm g; g.A = Y; g.Bt = WOUT_O; g.M = SEG; g.N = 1024; g.K = 2560;
            pg8::StaticOrder S; S.init(SEG, 1024, G, blockIdx.x);
            pg8::EpiRes E; E.xin = xout; E.out = xout;
            pg8::gemm_phase(lds, g, S, E);
        }
        xcd_barrier(xb);

        { FRESH_TID();
        for (int it = gw; it < SEG; it += NW) rms_row_f32(xout + (size_t)it * 1024, P.in[24], lane); }
    }
}

extern "C" void kernel_launch(void* const* d_in, const int* in_sizes, int n_in, void* d_out, int out_size, void* d_ws, size_t ws_size, hipStream_t stream) {
    static int grid_blocks = 0;
    if (grid_blocks == 0) {
        if (n_in != 25 || ws_size < WS_END) { fprintf(stderr, "kernel_launch: need 25 inputs and %zu bytes of workspace; got %d, %zu\n", (size_t)WS_END, n_in, ws_size); grid_blocks = -1; return; }
        int dev = 0, cus = 0, per_cu = 0;
        hipGetDevice(&dev);
        hipDeviceGetAttribute(&cus, hipDeviceAttributeMultiprocessorCount, dev);
        hipFuncSetAttribute((const void*)fwd_megakernel, hipFuncAttributeMaxDynamicSharedMemorySize, LDS_BYTES);
        hipOccupancyMaxActiveBlocksPerMultiprocessor(&per_cu, (const void*)fwd_megakernel, 512, LDS_BYTES);
        if (per_cu < 1) { fprintf(stderr, "kernel_launch: occupancy query says %d blocks per CU\n", per_cu); grid_blocks = -1; return; }
        grid_blocks = cus;
    }
    if (grid_blocks < 0) return;
    Params p{};
    for (int i = 0; i < 25; ++i) p.in[i] = (const float*)d_in[i];
    p.out = (float*)d_out; p.ws = (unsigned char*)d_ws;
    void* args[] = {&p};
    hipError_t e = hipLaunchCooperativeKernel((const void*)fwd_megakernel, dim3(grid_blocks), dim3(512), args, LDS_BYTES, stream);
    if (e != hipSuccess) fprintf(stderr, "cooperative launch failed: %s (grid %d)\n", hipGetErrorString(e), grid_blocks);
}
```

```cpp
#include <hip/hip_runtime.h>
#include <hip/hip_cooperative_groups.h>
#include <cstdio>
namespace cg = cooperative_groups;
namespace pg8 {
#define PG8_LAS __attribute__((address_space(3)))
typedef unsigned short bf16_t;
typedef short bf16x8 __attribute__((ext_vector_type(8)));
typedef float f32x4 __attribute__((ext_vector_type(4)));
typedef unsigned u32x4 __attribute__((ext_vector_type(4)));
constexpr int BM = 256, BK = 64, HALF = 128, HTB = HALF * BK * 2  , STAGE_BYTES = 8 * HTB, NXCD = 8, WGM = 8;

__host__ __device__ __forceinline__ int lds_byte(int r, int c) { const int st = (r >> 4) * 2 + (c >> 5), rr = r & 15, cc = c & 31, ob = rr * 64 + cc * 2; return st * 1024 + (ob ^ (((ob >> 9) & 1) << 5)); }
__host__ __device__ __forceinline__ void stage_rc(int b, int& R, int& C) { const int st = b / 1024, sb = b % 1024, swz = sb ^ (((sb >> 9) & 1) << 5); R = (st >> 1) * 16 + swz / 64; C = (st & 1) * 32 + (swz % 64) / 2; }
__host__ __device__ __forceinline__ int perm32(int rho) { const int n = rho >> 4, i = rho & 15; return 8 * (i >> 2) + 4 * n + (i & 3); }

struct Unit { int pm, pn, sel; };
struct Gemm { const bf16_t* A; const bf16_t* Bt; int M, N, K; const bf16_t* A1; const bf16_t* Bt1; };

struct StaticOrder {
    int nM, nN, nwg, G, c;
    __host__ __device__ void init(int M, int N, int G_, int c_) { nM = M / BM; nN = N / BM; nwg = nM * nN; G = G_; c = c_; }
    __host__ __device__ void map(int wgid, Unit& u) const {
        { const int q = nwg / NXCD, r = nwg % NXCD, xcd = wgid % NXCD, off = wgid / NXCD; wgid = (xcd < r ? xcd * (q + 1) : r * (q + 1) + (xcd - r) * q) + off; }
        const int nig = WGM * nN, gid = wgid / nig, fm = gid * WGM, gsz = (nM - fm) < WGM ? (nM - fm) : WGM;
        u.pm = fm + ((wgid % nig) % gsz); u.pn = (wgid % nig) / gsz; u.sel = 0;
    }
    __host__ __device__ bool next(int i, Unit& u) const {
        const long L = (long)i * G + c; if (L >= nwg) return false;
        map((int)L, u); return true;
    }
    __device__ __forceinline__ void a_ready(const Unit&) const {}
    __device__ __forceinline__ void done(const Unit&) const {}
};

struct SkipOrder : StaticOrder {
    int skip_from, skip_n;
    __device__ __forceinline__ bool next(int i, Unit& u) const {
        if (!StaticOrder::next(i, u)) return false;
        if (u.pn >= skip_from) u.pn += skip_n;
        return true;
    }
};
struct DualOrder {
    StaticOrder S0, S1; int skip_from, skip_n, G, c;
    __device__ __forceinline__ bool next(int i, Unit& u) const {
        const long L = (long)i * G + c;
        if (L < S0.nwg) { S0.map((int)L, u); if (u.pn >= skip_from) u.pn += skip_n; return true; }
        if (L - S0.nwg < S1.nwg) { S1.map((int)(L - S0.nwg), u); u.sel = 1; return true; }
        return false;
    }
    __device__ __forceinline__ void a_ready(const Unit&) const {}
    __device__ __forceinline__ void done(const Unit&) const {}
};

__device__ __forceinline__ unsigned cvt_pk_bf16(float lo, float hi) { unsigned r; asm volatile("v_cvt_pk_bf16_f32 %0, %1, %2" : "=v"(r) : "v"(lo), "v"(hi)); return r; }

struct EpiZ {
    static constexpr bool PERM = true, AFTER_DRAIN = false;
    bf16_t* O; int ldc; int skip_from, skip_n; float* colsq; int colsq_ld; bf16_t* O1; int ldc1; float* colsq1;
    __device__ __forceinline__ void operator()(const f32x4 (&acc)[2][2][4][2], const Unit& u, int wr, int wc, int fr, int fq) const {
        const int row0 = u.pm * BM + wr * 64 + fr; const int ct = u.sel ? u.pn : ((u.pn >= skip_from + skip_n) ? (u.pn - skip_n) : u.pn);
        const int col0 = ct * BM + wc * 32 + 8 * fq;
        bf16_t* const O = u.sel ? this->O1 : this->O; const int ldc = u.sel ? this->ldc1 : this->ldc; float* const colsq = u.sel ? this->colsq1 : this->colsq;
#pragma unroll
        for (int ai = 0; ai < 2; ++ai)
#pragma unroll
            for (int m = 0; m < 4; ++m) { bf16_t* rowp = O + (size_t)(row0 + ai * HALF + m * 16) * ldc + col0;
#pragma unroll
                for (int bj = 0; bj < 2; ++bj) { const f32x4 v0 = acc[ai][bj][m][0], v1 = acc[ai][bj][m][1];
                    u32x4 w; w.x = cvt_pk_bf16(v0[0], v0[1]); w.y = cvt_pk_bf16(v0[2], v0[3]); w.z = cvt_pk_bf16(v1[0], v1[1]); w.w = cvt_pk_bf16(v1[2], v1[3]);
                    *(u32x4*)(rowp + bj * HALF) = w; } }
        if (colsq) {
#pragma unroll
            for (int bj = 0; bj < 2; ++bj)
#pragma unroll
                for (int n = 0; n < 2; ++n) {
                    f32x4 ss = {0.f, 0.f, 0.f, 0.f};
#pragma unroll
                    for (int ai = 0; ai < 2; ++ai)
#pragma unroll
                        for (int m = 0; m < 4; ++m) ss += acc[ai][bj][m][n] * acc[ai][bj][m][n];
#pragma unroll
                    for (int o = 1; o < 16; o <<= 1) { ss[0] += __shfl_xor(ss[0], o); ss[1] += __shfl_xor(ss[1], o); ss[2] += __shfl_xor(ss[2], o); ss[3] += __shfl_xor(ss[3], o); }
                    if (fr == 0) *(f32x4*)(colsq + (size_t)(2 * u.pm + wr) * colsq_ld + ct * BM + bj * HALF + wc * 32 + 8 * fq + 4 * n) = ss;
                }
        }
    }
};
struct EpiRes {
    static constexpr bool PERM = false, AFTER_DRAIN = false;
    const float* xin; float* out;
    __device__ __forceinline__ void operator()(const f32x4 (&acc)[2][2][4][2], const Unit& u, int wr, int wc, int fr, int fq) const {
        const int row0 = u.pm * BM + wr * 64 + fr, col0 = u.pn * BM + wc * 32 + 4 * fq;
#pragma unroll
        for (int ai = 0; ai < 2; ++ai)
#pragma unroll
            for (int m = 0; m < 4; ++m) { const size_t ro = (size_t)(row0 + ai * HALF + m * 16) * 1024 + col0;
#pragma unroll
                for (int bj = 0; bj < 2; ++bj)
#pragma unroll
                    for (int n = 0; n < 2; ++n) { const f32x4 xv = *(const f32x4*)(xin + ro + bj * HALF + n * 16);
                        *(f32x4*)(out + ro + bj * HALF + n * 16) = acc[ai][bj][m][n] + xv; } }
    }
};

template <class Epi, class Sched>
__device__ __forceinline__ void gemm_phase(PG8_LAS unsigned char* lds, const Gemm g, const Sched& S, const Epi& E) {
    int tid = threadIdx.x; asm volatile("" : "+v"(tid));
    const int wid = __builtin_amdgcn_readfirstlane(tid >> 6), lane = tid & 63, wr = wid >> 2, wc = wid & 3, fr = lane & 15, fq = lane >> 4;
    const int K = g.K, nt = K / BK;
    const char* gA = (const char*)g.A; const char* gB = (const char*)g.Bt; const char* gA1 = (const char*)g.A1; const char* gB1 = (const char*)g.Bt1; asm volatile("" : "+s"(gA), "+s"(gB), "+s"(gA1), "+s"(gB1));
    unsigned voffA[2], voffB[2];
#pragma unroll
    for (int i = 0; i < 2; ++i) { int R, C; stage_rc(tid * 16 + i * 8192, R, C); const int Rb = Epi::PERM ? ((R & ~31) + perm32(R & 31)) : R;
        voffA[i] = (unsigned)(R * K + C) * 2u; voffB[i] = (unsigned)(Rb * K + C) * 2u; }
    const size_t kstep = (size_t)(BK * 2);
    const size_t hstep = (size_t)HALF * K * 2;
    const size_t tstep = 2 * hstep;
    const unsigned ldsw = (unsigned)wid * 1024u;
    const int aoff = lds_byte(wr * 64 + fr, fq * 8), boff = lds_byte(wc * 32 + fr, fq * 8);
#define PG8_SA(b, h) (((b) * 2 + (h)) * HTB)
#define PG8_SB(b, h) ((4 + (b) * 2 + (h)) * HTB)
#define PG8_STAGE(bufoff, gbase, voff) do { _Pragma("unroll") for (int _i = 0; _i < 2; ++_i) \
        __builtin_amdgcn_global_load_lds((const unsigned*)((const char*)(gbase) + (voff)[_i]), (PG8_LAS unsigned*)(lds + (bufoff) + ldsw + _i * 8192), 16, 0, 0); } while (0)
#define PG8_LDA(dst, b, h) do { _Pragma("unroll") for (int m = 0; m < 4; ++m) _Pragma("unroll") for (int k = 0; k < 2; ++k) dst[m][k] = *(const PG8_LAS bf16x8*)(lds + PG8_SA(b, h) + aoff + m * 2048 + k * 1024); } while (0)
#define PG8_LDB(dst, b, h) do { _Pragma("unroll") for (int n = 0; n < 2; ++n) _Pragma("unroll") for (int k = 0; k < 2; ++k) dst[n][k] = *(const PG8_LAS bf16x8*)(lds + PG8_SB(b, h) + boff + n * 2048 + k * 1024); } while (0)
#define PG8_MMA(ai, bj, At, Bt) do { __builtin_amdgcn_s_setprio(1); _Pragma("unroll") for (int m = 0; m < 4; ++m) _Pragma("unroll") for (int n = 0; n < 2; ++n) _Pragma("unroll") for (int k = 0; k < 2; ++k) \
        acc[ai][bj][m][n] = __builtin_amdgcn_mfma_f32_16x16x32_bf16(Bt[n][k], At[m][k], acc[ai][bj][m][n], 0, 0, 0); __builtin_amdgcn_s_setprio(0); } while (0)
#define PG8_WAIT_V(n) asm volatile("s_waitcnt vmcnt(" #n ")" ::: "memory")
#define PG8_WAIT_L(n) asm volatile("s_waitcnt lgkmcnt(" #n ")" ::: "memory")
#define PG8_BAR __builtin_amdgcn_s_barrier()
#define PG8_SCHED __builtin_amdgcn_sched_barrier(0)
    Unit cur, nxt; int ui = 0;
    if (!S.next(0, cur)) return;
    f32x4 acc[2][2][4][2];
#pragma unroll
    for (int a = 0; a < 2; ++a)
#pragma unroll
        for (int b = 0; b < 2; ++b)
#pragma unroll
            for (int m = 0; m < 4; ++m)
#pragma unroll
                for (int n = 0; n < 2; ++n) acc[a][b][m][n] = (f32x4){0.f, 0.f, 0.f, 0.f};
    bf16x8 At[4][2], B0[2][2], B1[2][2];
    const char* cA = (cur.sel ? gA1 : gA) + (size_t)cur.pm * tstep; const char* cB = (cur.sel ? gB1 : gB) + (size_t)cur.pn * tstep;
    S.a_ready(cur);
    PG8_STAGE(PG8_SB(0, 0), cB, voffB); PG8_STAGE(PG8_SA(0, 0), cA, voffA); PG8_STAGE(PG8_SB(0, 1), cB + hstep, voffB); PG8_STAGE(PG8_SA(0, 1), cA + hstep, voffA);
    if (wr == 1) PG8_BAR;
    PG8_WAIT_V(4); PG8_BAR;
    PG8_STAGE(PG8_SB(1, 0), cB + kstep, voffB); PG8_STAGE(PG8_SA(1, 0), cA + kstep, voffA); PG8_STAGE(PG8_SB(1, 1), cB + hstep + kstep, voffB);
    PG8_WAIT_V(6); PG8_BAR;
    for (;;) {
        const bool has_next = S.next(ui + 1, nxt);
        const char* nA = has_next ? (nxt.sel ? gA1 : gA) + (size_t)nxt.pm * tstep : cA; const char* nB = has_next ? (nxt.sel ? gB1 : gB) + (size_t)nxt.pn * tstep : cB;
        for (int t = 0; t < nt; t += 2) {
            const bool last = (t == nt - 2);
            const char* a1 = cA + (size_t)(t + 1) * kstep;
            const char* a2 = last ? nA : cA + (size_t)(t + 2) * kstep; const char* b2 = last ? nB : cB + (size_t)(t + 2) * kstep;
            const char* a3 = a2 + kstep; const char* b3 = b2 + kstep;
            if (last && has_next) S.a_ready(nxt);
            PG8_LDB(B0, 0, 0); PG8_SCHED; PG8_LDA(At, 0, 0); PG8_STAGE(PG8_SA(1, 1), a1 + hstep, voffA);
            PG8_WAIT_L(8); PG8_BAR; PG8_WAIT_L(0); PG8_MMA(0, 0, At, B0); PG8_BAR; PG8_SCHED;
            PG8_LDB(B1, 0, 1); PG8_STAGE(PG8_SB(0, 0), b2, voffB);
            PG8_BAR; PG8_WAIT_L(0); PG8_MMA(0, 1, At, B1); PG8_BAR;
            PG8_LDA(At, 0, 1); PG8_STAGE(PG8_SA(0, 0), a2, voffA);
            PG8_BAR; PG8_WAIT_L(0); PG8_MMA(1, 0, At, B0); PG8_BAR; PG8_SCHED;
            PG8_STAGE(PG8_SB(0, 1), b2 + hstep, voffB);
            PG8_WAIT_V(6); PG8_BAR; PG8_MMA(1, 1, At, B1); PG8_BAR;
            PG8_LDB(B0, 1, 0); PG8_SCHED; PG8_LDA(At, 1, 0); PG8_STAGE(PG8_SA(0, 1), a2 + hstep, voffA);
            PG8_WAIT_L(8); PG8_BAR; PG8_WAIT_L(0); PG8_MMA(0, 0, At, B0); PG8_BAR; PG8_SCHED;
            PG8_LDB(B1, 1, 1); PG8_STAGE(PG8_SB(1, 0), b3, voffB);
            PG8_BAR; PG8_WAIT_L(0); PG8_MMA(0, 1, At, B1); PG8_BAR;
            PG8_LDA(At, 1, 1); PG8_STAGE(PG8_SA(1, 0), a3, voffA);
            PG8_BAR; PG8_WAIT_L(0); PG8_MMA(1, 0, At, B0); PG8_BAR; PG8_SCHED;
            PG8_STAGE(PG8_SB(1, 1), b3 + hstep, voffB);
            PG8_WAIT_V(6); PG8_BAR; PG8_MMA(1, 1, At, B1); PG8_BAR;
        }
        if constexpr (!Epi::AFTER_DRAIN) { E(acc, cur, wr, wc, fr, fq); S.done(cur); }
        if (!has_next) break;
#pragma unroll
        for (int a = 0; a < 2; ++a)
#pragma unroll
            for (int b = 0; b < 2; ++b)
#pragma unroll
                for (int m = 0; m < 4; ++m)
#pragma unroll
                    for (int n = 0; n < 2; ++n) acc[a][b][m][n] = (f32x4){0.f, 0.f, 0.f, 0.f};
        cur = nxt; cA = nA; cB = nB; ++ui;
    }
    PG8_WAIT_V(0);
    if (wr == 0) PG8_BAR;
    PG8_BAR;
    if constexpr (Epi::AFTER_DRAIN) { E.fused(acc, cur, wr, wc, fr, fq, lds, wid, lane); S.done(cur); }
#undef PG8_SA
#undef PG8_SB
#undef PG8_STAGE
#undef PG8_LDA
#undef PG8_LDB
#undef PG8_MMA
#undef PG8_WAIT_V
#undef PG8_WAIT_L
#undef PG8_BAR
#undef PG8_SCHED
}
}

#define XB_TMO      128
#define XB_XCNT(j)  (256  + 64 * (j))
#define XB_XSUB(j)  (1280 + 64 * (j))
#define XB_XGEN(j)  (2304 + 64 * (j))
#define XB_TOP      3328
#define XB_TOPGEN   3392
#define XCD_BAR_WORDS 3456
#define XB_SPIN_CAP (1u << 18)
#define LAS __attribute__((address_space(3)))

__device__ __forceinline__ unsigned xb_ld(unsigned* p)              { return __hip_atomic_load(p, __ATOMIC_RELAXED, __HIP_MEMORY_SCOPE_AGENT); }
__device__ __forceinline__ unsigned xb_add(unsigned* p, unsigned v) { return __hip_atomic_fetch_add(p, v, __ATOMIC_RELAXED, __HIP_MEMORY_SCOPE_AGENT); }
__device__ __forceinline__ unsigned xb_xcc_id() { return (unsigned)__builtin_amdgcn_s_getreg((3 << 11) | 20) & 0xFu; }
#define XB_SPIN(cond, bar) do { unsigned _sp = 0; while (cond) { __builtin_amdgcn_s_sleep(1); \
    if ((++_sp & 255u) == 0u) { if (xb_ld(&(bar)[XB_TMO])) break; if (_sp > XB_SPIN_CAP) { atomicAdd(&(bar)[XB_TMO], 1u); break; } } } } while (0)

struct XcdBarrier {
    unsigned* bar; unsigned x;
    volatile LAS unsigned* st;
};

__device__ __forceinline__ XcdBarrier xcd_barrier_post(unsigned* bar, volatile LAS unsigned* st) {
    XcdBarrier b; b.bar = bar; b.x = xb_xcc_id(); b.st = st;
    if (threadIdx.x == 0) (void)xb_add(&bar[XB_XCNT(b.x)], 1u);
    return b;
}
__device__ __forceinline__ void xcd_barrier_complete(unsigned* bar, unsigned x, unsigned& nloc, unsigned& nx) {
    const unsigned G = gridDim.x * gridDim.y * gridDim.z;
    unsigned sum, cnt, mine, sp = 0u;
    for (;;) {
        sum = 0u; cnt = 0u; mine = 0u;
#pragma unroll
        for (unsigned j = 0; j < 16; ++j) { const unsigned c = xb_ld(&bar[XB_XCNT(j)]); sum += c; cnt += (c > 0u) ? 1u : 0u; mine = (j == x) ? c : mine; }
        if (sum == G) break;
        __builtin_amdgcn_s_sleep(1);
        if ((++sp & 255u) == 0u) { if (xb_ld(&bar[XB_TMO])) break; if (sp > XB_SPIN_CAP) { atomicAdd(&bar[XB_TMO], 1u); break; } }
    }
    nloc = mine > 0u ? mine : 1u; nx = cnt > 0u ? cnt : 1u;
}

__device__ __forceinline__ void xcd_barrier(const XcdBarrier& b) {
    asm volatile("s_waitcnt vmcnt(0)" ::: "memory");
    __syncthreads();
    if (threadIdx.x == 0) {
        unsigned* bar = b.bar;
        __builtin_amdgcn_s_waitcnt(0);
        unsigned nloc = b.st[0], nx = b.st[1];
        if (nloc == 0u) { xcd_barrier_complete(bar, b.x, nloc, nx); b.st[0] = nloc; b.st[1] = nx; }
        const unsigned old = xb_add(&bar[XB_XSUB(b.x)], 1u);
        const unsigned gen = old / nloc;
        if (old + 1u == (gen + 1u) * nloc) {
            __builtin_amdgcn_fence(__ATOMIC_RELEASE, "agent");
            asm volatile("s_waitcnt vmcnt(0)" ::: "memory");
            const unsigned og = xb_add(&bar[XB_TOP], 1u);
            const unsigned tg = og / nx;
            if (og + 1u == (tg + 1u) * nx) xb_add(&bar[XB_TOPGEN], 1u);
            else XB_SPIN(xb_ld(&bar[XB_TOPGEN]) == tg, bar);
            __builtin_amdgcn_fence(__ATOMIC_ACQUIRE, "agent");
            xb_add(&bar[XB_XGEN(b.x)], 1u);
            asm volatile("s_waitcnt vmcnt(0)" ::: "memory");
        } else {
            XB_SPIN(xb_ld(&bar[XB_XGEN(b.x)]) == gen, bar);
            __builtin_amdgcn_fence(__ATOMIC_ACQUIRE, "agent");
            asm volatile("s_waitcnt vmcnt(0)" ::: "memory");
        }
    }
    __syncthreads();
}

using pg8::bf16_t; using pg8::bf16x8; using pg8::f32x4;
typedef unsigned u32x2_t __attribute__((ext_vector_type(2)));
typedef unsigned u32x4_t __attribute__((ext_vector_type(4)));

constexpr int DM = 1024, SEG = 16384, LDZ = 8192, LDY = 2560;
constexpr float EPS = 1e-6f;
constexpr int XST_OFF = 9 * 16384 + 2048;
constexpr int LDS_BYTES = XST_OFF + 64;
constexpr size_t WS_WIN_E = 0;
constexpr size_t WS_WIN_O = WS_WIN_E + (size_t)9216 * 1024 * 2;
constexpr size_t WS_WOUT_E = WS_WIN_O + (size_t)6144 * 1024 * 2;
constexpr size_t WS_WOUT_O = WS_WOUT_E + (size_t)1024 * 2560 * 2;
constexpr size_t WS_WKV = WS_WOUT_O + (size_t)1024 * 2560 * 2;
constexpr size_t WS_LRUW = WS_WKV + (size_t)2 * 1024 * 1024 * 2;
constexpr size_t WS_SGUW = WS_LRUW + (size_t)2 * 2 * 8 * 128 * 128 * 2;
constexpr size_t WS_MEMN = WS_SGUW + (size_t)8 * 128 * 128 * 2;
constexpr size_t WS_MK = WS_MEMN + (size_t)2 * 1536 * 1024 * 2;
constexpr size_t WS_MVT = WS_MK + (size_t)2 * 1536 * 512 * 2;
constexpr size_t WS_H = WS_MVT + (size_t)2 * 512 * 1536 * 2;
constexpr size_t WS_Z = WS_H + (size_t)SEG * 1024 * 2;
constexpr size_t WS_VT = WS_Z + (size_t)SEG * LDZ * 2;
constexpr size_t WS_Y = WS_VT + (size_t)1024 * SEG * 2;
constexpr size_t WS_AGG = WS_Y + (size_t)SEG * LDY * 2;
constexpr size_t WS_CARRY = WS_AGG + (size_t)2 * 128 * 1024 * 2 * 4;
constexpr size_t WS_RSTD = WS_CARRY + (size_t)2 * 128 * 1024 * 4;
constexpr size_t WS_PART = WS_RSTD + (size_t)SEG * 4;
constexpr size_t WS_BAR = WS_PART + (size_t)8 * SEG * 4;
constexpr size_t WS_LAB = WS_BAR + 16384;
constexpr size_t WS_END = WS_LAB + (size_t)2 * SEG * 1024 * 4;

struct Params { const float* in[25]; float* out; unsigned char* ws; };

__device__ __forceinline__ float bf2f(unsigned short b) { return __uint_as_float(((unsigned)b) << 16); }
__device__ __forceinline__ unsigned short f2bf(float f) { unsigned u = __float_as_uint(f); u += 0x7FFFu + ((u >> 16) & 1u); return (unsigned short)(u >> 16); }
__device__ __forceinline__ float bflo(unsigned w) { return __uint_as_float(w << 16); }
__device__ __forceinline__ float bfhi(unsigned w) { return __uint_as_float(w & 0xffff0000u); }
__device__ __forceinline__ unsigned pk2(float lo, float hi) { return pg8::cvt_pk_bf16(lo, hi); }
__device__ __forceinline__ float frcp(float x) { return __builtin_amdgcn_rcpf(x); }
__device__ __forceinline__ float silu(float x) { return x * frcp(1.0f + __expf(-x)); }
__device__ __forceinline__ float sigm(float x) { return frcp(1.0f + __expf(-x)); }
__device__ __forceinline__ float wave_sum(float v) {
#pragma unroll
    for (int o = 1; o < 64; o <<= 1) v += __shfl_xor(v, o);
    return v;
}
__device__ __forceinline__ f32x4 mfma16(bf16x8 a, bf16x8 b, f32x4 c) { return __builtin_amdgcn_mfma_f32_16x16x32_bf16(a, b, c, 0, 0, 0); }
__device__ __forceinline__ bf16x8 ld8(const bf16_t* p) { return *(const bf16x8*)p; }
__device__ __forceinline__ bf16x8 pack8(const float (&v)[8]) {
    u32x4_t w; w.x = pk2(v[0], v[1]); w.y = pk2(v[2], v[3]); w.z = pk2(v[4], v[5]); w.w = pk2(v[6], v[7]);
    return __builtin_bit_cast(bf16x8, w);
}

__device__ __forceinline__ void transpose_item(const float* W, int K, int N, bf16_t* WT, LAS float* scr, int item, int lane) {
    const int nblk = N >> 5, kb = item / nblk, nb = item - kb * nblk, k0 = 64 * kb, n0 = 32 * nb;
#pragma unroll 8
    for (int i = 0; i < 32; ++i) { const int kk = 2 * i + (lane >> 5); scr[kk * 33 + (lane & 31)] = W[(size_t)(k0 + kk) * N + n0 + (lane & 31)]; }
    asm volatile("s_waitcnt lgkmcnt(0)" ::: "memory");
    const int c = lane & 7;
#pragma unroll
    for (int j = 0; j < 4; ++j) { const int n = (lane >> 3) + 8 * j; const LAS float* s = scr + (8 * c) * 33 + n;
        u32x4_t o; o.x = pk2(s[0 * 33], s[1 * 33]); o.y = pk2(s[2 * 33], s[3 * 33]); o.z = pk2(s[4 * 33], s[5 * 33]); o.w = pk2(s[6 * 33], s[7 * 33]);
        *(u32x4_t*)(WT + (size_t)(n0 + n) * K + k0 + 8 * c) = o; }
    asm volatile("s_waitcnt lgkmcnt(0)" ::: "memory");
}

__device__ __forceinline__ void rms_row_bf16(const float* xrow, const float* g, bf16_t* orow, int lane) {
    const f32x4* xr = (const f32x4*)xrow + lane; f32x4 v[4]; float s = 0.f;
#pragma unroll
    for (int j = 0; j < 4; ++j) { v[j] = xr[64 * j]; s += (v[j].x * v[j].x + v[j].y * v[j].y) + (v[j].z * v[j].z + v[j].w * v[j].w); }
    const float rstd = __builtin_amdgcn_rsqf(wave_sum(s) * (1.0f / 1024.0f) + EPS);
    const f32x4* gr = (const f32x4*)g + lane; u32x2_t* o8 = (u32x2_t*)orow + lane;
#pragma unroll
    for (int j = 0; j < 4; ++j) { const f32x4 gg = gr[64 * j]; u32x2_t o; o.x = pk2(v[j].x * rstd * gg.x, v[j].y * rstd * gg.y); o.y = pk2(v[j].z * rstd * gg.z, v[j].w * rstd * gg.w); o8[64 * j] = o; }
}
__device__ __forceinline__ void rms_row_f32(float* xrow, const float* g, int lane) {
    f32x4* xr = (f32x4*)xrow + lane; f32x4 v[4]; float s = 0.f;
#pragma unroll
    for (int j = 0; j < 4; ++j) { v[j] = xr[64 * j]; s += (v[j].x * v[j].x + v[j].y * v[j].y) + (v[j].z * v[j].z + v[j].w * v[j].w); }
    const float rstd = __builtin_amdgcn_rsqf(wave_sum(s) * (1.0f / 1024.0f) + EPS);
    const f32x4* gr = (const f32x4*)g + lane;
#pragma unroll
    for (int j = 0; j < 4; ++j) { const f32x4 gg = gr[64 * j]; f32x4 o; o.x = v[j].x * rstd * gg.x; o.y = v[j].y * rstd * gg.y; o.z = v[j].z * rstd * gg.z; o.w = v[j].w * rstd * gg.w; xr[64 * j] = o; }
}

__device__ __forceinline__ void rms_rows4_bf16(const float* xrow, const float* g, bf16_t* orow, int lane) {
    f32x4 v[4][4]; float s[4];
#pragma unroll
    for (int r = 0; r < 4; ++r)
#pragma unroll
        for (int j = 0; j < 4; ++j) v[r][j] = ((const f32x4*)(xrow + (size_t)r * 1024))[lane + 64 * j];
    f32x4 gg[4];
#pragma unroll
    for (int j = 0; j < 4; ++j) gg[j] = ((const f32x4*)g)[lane + 64 * j];
#pragma unroll
    for (int r = 0; r < 4; ++r) { s[r] = 0.f;
#pragma unroll
        for (int j = 0; j < 4; ++j) s[r] += (v[r][j].x * v[r][j].x + v[r][j].y * v[r][j].y) + (v[r][j].z * v[r][j].z + v[r][j].w * v[r][j].w); }
#pragma unroll
    for (int o = 1; o < 64; o <<= 1) {
#pragma unroll
        for (int r = 0; r < 4; ++r) s[r] += __shfl_xor(s[r], o); }
#pragma unroll
    for (int r = 0; r < 4; ++r) { const float rstd = __builtin_amdgcn_rsqf(s[r] * (1.0f / 1024.0f) + EPS);
        u32x2_t* o8 = (u32x2_t*)(orow + (size_t)r * 1024) + lane;
#pragma unroll
        for (int j = 0; j < 4; ++j) { u32x2_t o; o.x = pk2(v[r][j].x * rstd * gg[j].x, v[r][j].y * rstd * gg[j].y); o.y = pk2(v[r][j].z * rstd * gg[j].z, v[r][j].w * rstd * gg[j].w); o8[64 * j] = o; } }
}
__device__ __forceinline__ void rms_rows4_f32(float* xrow, const float* g, int lane) {
    f32x4 v[4][4]; float s[4];
#pragma unroll
    for (int r = 0; r < 4; ++r)
#pragma unroll
        for (int j = 0; j < 4; ++j) v[r][j] = ((const f32x4*)(xrow + (size_t)r * 1024))[lane + 64 * j];
    f32x4 gg[4];
#pragma unroll
    for (int j = 0; j < 4; ++j) gg[j] = ((const f32x4*)g)[lane + 64 * j];
#pragma unroll
    for (int r = 0; r < 4; ++r) { s[r] = 0.f;
#pragma unroll
        for (int j = 0; j < 4; ++j) s[r] += (v[r][j].x * v[r][j].x + v[r][j].y * v[r][j].y) + (v[r][j].z * v[r][j].z + v[r][j].w * v[r][j].w); }
#pragma unroll
    for (int o = 1; o < 64; o <<= 1) {
#pragma unroll
        for (int r = 0; r < 4; ++r) s[r] += __shfl_xor(s[r], o); }
#pragma unroll
    for (int r = 0; r < 4; ++r) { const float rstd = __builtin_amdgcn_rsqf(s[r] * (1.0f / 1024.0f) + EPS);
        f32x4* xo = (f32x4*)(xrow + (size_t)r * 1024) + lane;
#pragma unroll
        for (int j = 0; j < 4; ++j) { f32x4 o; o.x = v[r][j].x * rstd * gg[j].x; o.y = v[r][j].y * rstd * gg[j].y; o.z = v[r][j].z * rstd * gg[j].z; o.w = v[r][j].w * rstd * gg[j].w; xo[64 * j] = o; } }
}

__device__ __forceinline__ void conv_even_item(const bf16_t* z, const float* cw, const float* cb, bf16_t* y, int t0, int T, int lane) {
    const int s = t0 & (T - 1);
#pragma unroll
    for (int half = 0; half < 2; ++half) {
        const int c0 = half * 512 + lane * 8;
        const bf16_t* zr = z + (size_t)t0 * LDZ + c0;
        u32x4_t cg[4], xv[4], bg[2], ga[2];
#pragma unroll
        for (int i = 0; i < 4; ++i) { cg[i] = (u32x4_t){0u, 0u, 0u, 0u}; xv[i] = (u32x4_t){0u, 0u, 0u, 0u}; }
        if (s > 0) { cg[0] = *(const u32x4_t*)(zr - LDZ + 1024); xv[0] = *(const u32x4_t*)(zr - LDZ + 2048); }
        cg[1] = *(const u32x4_t*)(zr + 1024); xv[1] = *(const u32x4_t*)(zr + 2048);
        cg[2] = *(const u32x4_t*)(zr + LDZ + 1024); xv[2] = *(const u32x4_t*)(zr + LDZ + 2048);
        if (s + 2 < T) { cg[3] = *(const u32x4_t*)(zr + 2 * LDZ + 1024); xv[3] = *(const u32x4_t*)(zr + 2 * LDZ + 2048); }
        bg[0] = *(const u32x4_t*)(zr); ga[0] = *(const u32x4_t*)(zr + 3072);
        bg[1] = *(const u32x4_t*)(zr + LDZ); ga[1] = *(const u32x4_t*)(zr + LDZ + 3072);
        float w0[8], w1[8], w2[8], bb[8];
#pragma unroll
        for (int e = 0; e < 8; e += 4) {
            const f32x4 a = *(const f32x4*)(cw + c0 + e), b = *(const f32x4*)(cw + 1024 + c0 + e), c = *(const f32x4*)(cw + 2048 + c0 + e), d = *(const f32x4*)(cb + c0 + e);
#pragma unroll
            for (int k = 0; k < 4; ++k) { w0[e + k] = a[k]; w1[e + k] = b[k]; w2[e + k] = c[k]; bb[e + k] = d[k]; }
        }
        float p[4][8];
#pragma unroll
        for (int i = 0; i < 4; ++i)
#pragma unroll
            for (int k = 0; k < 4; ++k) { p[i][2 * k] = bflo(cg[i][k]) * bflo(xv[i][k]); p[i][2 * k + 1] = bfhi(cg[i][k]) * bfhi(xv[i][k]); }
#pragma unroll
        for (int tt = 0; tt < 2; ++tt) {
            float o[8];
#pragma unroll
            for (int k = 0; k < 4; ++k) {
                const float cl = bb[2 * k] + w0[2 * k] * p[tt][2 * k] + w1[2 * k] * p[tt + 1][2 * k] + w2[2 * k] * p[tt + 2][2 * k];
                const float ch = bb[2 * k + 1] + w0[2 * k + 1] * p[tt][2 * k + 1] + w1[2 * k + 1] * p[tt + 1][2 * k + 1] + w2[2 * k + 1] * p[tt + 2][2 * k + 1];
                o[2 * k] = bflo(bg[tt][k]) * cl * silu(bflo(ga[tt][k]));
                o[2 * k + 1] = bfhi(bg[tt][k]) * ch * silu(bfhi(ga[tt][k]));
            }
            u32x4_t w; w.x = pk2(o[0], o[1]); w.y = pk2(o[2], o[3]); w.z = pk2(o[4], o[5]); w.w = pk2(o[6], o[7]);
            *(u32x4_t*)(y + (size_t)(t0 + tt) * LDY + c0) = w;
        }
    }
}

__device__ __forceinline__ void conv_odd_item(const bf16_t* z, const float* cw, const float* cb, bf16_t* xc, int t, int T, int lane) {
    const int s = t & (T - 1);
#pragma unroll
    for (int half = 0; half < 2; ++half) {
        const int c0 = half * 512 + lane * 8;
        const bf16_t* zr = z + (size_t)t * LDZ + c0;
        float acc[8];
#pragma unroll
        for (int e = 0; e < 8; e += 4) { const f32x4 d = *(const f32x4*)(cb + c0 + e); acc[e] = d[0]; acc[e + 1] = d[1]; acc[e + 2] = d[2]; acc[e + 3] = d[3]; }
#pragma unroll
        for (int j = 0; j < 4; ++j) {
            const int sj = s + j - 2;
            if (sj >= 0 && sj < T) {
                const u32x4_t xv = *(const u32x4_t*)(zr + (ptrdiff_t)(j - 2) * LDZ);
                const f32x4 wa = *(const f32x4*)(cw + j * 1024 + c0), wb = *(const f32x4*)(cw + j * 1024 + c0 + 4);
                acc[0] += wa[0] * bflo(xv[0]); acc[1] += wa[1] * bfhi(xv[0]); acc[2] += wa[2] * bflo(xv[1]); acc[3] += wa[3] * bfhi(xv[1]);
                acc[4] += wb[0] * bflo(xv[2]); acc[5] += wb[1] * bfhi(xv[2]); acc[6] += wb[2] * bflo(xv[3]); acc[7] += wb[3] * bfhi(xv[3]);
            }
        }
        u32x4_t w; w.x = pk2(acc[0], acc[1]); w.y = pk2(acc[2], acc[3]); w.z = pk2(acc[4], acc[5]); w.w = pk2(acc[6], acc[7]);
        *(u32x4_t*)(xc + (size_t)t * 1024 + c0) = w;
    }
}
__device__ __forceinline__ void rstd_item(const float* part, float* rstd, int tg, int lane) {
    const float* p = part + tg * 64 + lane; float s = 0.f;
#pragma unroll
    for (int i = 0; i < 8; ++i) s += p[(size_t)i * SEG];
    rstd[tg * 64 + lane] = __builtin_amdgcn_rsqf(s * (1.0f / 1024.0f) + EPS);
}

constexpr int NA_RING = 9 * 16384, NA_RPB = NA_RING, NA_LDS_END = NA_RING + 2048;
__device__ __forceinline__ int na_fk(int key) { return ((key >> 1) & 1) | (((key >> 3) & 3) << 1); }
__device__ __forceinline__ void na_stage_row(const bf16_t* z, const bf16_t* vT, LAS unsigned char* slot, int tokr, int h, int lt, int nth) {
    for (int idx = lt; idx < 512; idx += nth) {
        const int rw = idx >> 3, c = idx & 7;
        const u32x4_t kv = *(const u32x4_t*)(z + (size_t)(tokr + rw) * LDZ + 5120 + h * 64 + c * 8);
        const u32x4_t vv = *(const u32x4_t*)(vT + (size_t)(h * 64 + rw) * SEG + tokr + c * 8);
        *(LAS u32x4_t*)(slot + rw * 128 + ((c ^ na_fk(rw)) << 4)) = kv;
        *(LAS u32x4_t*)(slot + 8192 + rw * 128 + ((c ^ ((rw >> 1) & 7)) << 4)) = vv;
    }
}
__device__ __forceinline__ void na_block(const bf16_t* z, const bf16_t* vT, bf16_t* y, const float* rpb, int unit, int T, LAS unsigned char* lds, int tid) {
    const int h = unit & 15, R0 = (unit >> 4) * 16;
    const int rows = T >> 6, seq = R0 / rows, rr0 = R0 - seq * rows, seq_base = seq * T;
    const int lane = tid & 63, wid = tid >> 6, fr = lane & 15, fq = lane >> 4;
    LAS float* rpbL = (LAS float*)(lds + NA_RPB);
    __syncthreads();
    for (int i = tid; i < 465; i += 512) rpbL[i] = rpb[h * 465 + i];
    int rs0 = rr0 - 4; rs0 = rs0 < 0 ? 0 : rs0; rs0 = rs0 > rows - 8 ? rows - 8 : rs0;
#pragma unroll 1
    for (int kr = 0; kr < 8; ++kr) { const int a = rs0 + kr; na_stage_row(z, vT, lds + (a % 9) * 16384, seq_base + a * 64, h, tid, 512); }
    __syncthreads();
    const int g = wid & 3;
    const int wb = (g == 0) ? 0 : (g == 1) ? 8 : (g == 2) ? 24 : 32;
    const int keyA = wb + (fr >> 2) * 8 + (fr & 3);
    const int offK0 = keyA * 128 + (((0 + fq) ^ na_fk(keyA)) << 4), offK1 = keyA * 128 + (((4 + fq) ^ na_fk(keyA)) << 4);
    const int offV = 8192 + fr * 128 + ((((wb >> 3) + fq) ^ ((fr >> 1) & 7)) << 4);
    const int qc = g * 16 + fr;
    int cstart = qc - 8; cstart = cstart < 0 ? 0 : cstart; cstart = cstart > 48 ? 48 : cstart;
    int dcs[8]; bool oks[8];
#pragma unroll
    for (int e = 0; e < 8; ++e) { const int kc = wb + fq * 8 + e; oks[e] = (kc >= cstart) && (kc < cstart + 16); int dc = kc - qc; dc = dc < -15 ? -15 : dc; dc = dc > 15 ? 15 : dc; dcs[e] = dc + 15; }
    const bf16_t* zt = z + (size_t)(seq_base + rr0 * 64 + g * 16 + fr) * LDZ;
    bf16x8 q0 = ld8(zt + 4096 + h * 64 + fq * 8), q1 = ld8(zt + 4096 + h * 64 + fq * 8 + 32);
    u32x2_t gr[4];
#pragma unroll
    for (int dt = 0; dt < 4; ++dt) gr[dt] = *(const u32x2_t*)(zt + 6144 + h * 64 + dt * 16 + fq * 4);
#pragma unroll 1
    for (int i = 0; i < 16; ++i) {
        const int rr = rr0 + i;
        int rs = rr - 4; rs = rs < 0 ? 0 : rs; rs = rs > rows - 8 ? rows - 8 : rs;
        int rsn = rr - 3; rsn = rsn < 0 ? 0 : rsn; rsn = rsn > rows - 8 ? rows - 8 : rsn;
        if (wid >= 4) {
            if (i < 15 && rsn > rs) { const int a = rsn + 7; na_stage_row(z, vT, lds + (a % 9) * 16384, seq_base + a * 64, h, tid - 256, 256); }
        } else {
            const bf16_t* ztc = zt + (size_t)i * 64 * LDZ;
            bf16x8 q0n = q0, q1n = q1; u32x2_t grn[4];
#pragma unroll
            for (int dt = 0; dt < 4; ++dt) grn[dt] = gr[dt];
            if (i < 15) {
                const bf16_t* ztn = ztc + (size_t)64 * LDZ;
                q0n = ld8(ztn + 4096 + h * 64 + fq * 8); q1n = ld8(ztn + 4096 + h * 64 + fq * 8 + 32);
#pragma unroll
                for (int dt = 0; dt < 4; ++dt) grn[dt] = *(const u32x2_t*)(ztn + 6144 + h * 64 + dt * 16 + fq * 4);
            }
            const LAS float* bp0 = rpbL + (rs - rr + 7) * 31;
            float s[8][8];
            float mx = -1e30f;
            int slot = rs % 9;
#pragma unroll
            for (int kr = 0; kr < 8; ++kr) {
                const LAS unsigned char* sb = lds + slot * 16384;
                slot = (slot == 8) ? 0 : slot + 1;
                const bf16x8 k00 = *(const LAS bf16x8*)(sb + offK0), k01 = *(const LAS bf16x8*)(sb + offK1);
                const bf16x8 k10 = *(const LAS bf16x8*)(sb + offK0 + 512), k11 = *(const LAS bf16x8*)(sb + offK1 + 512);
                f32x4 a0 = {0.f, 0.f, 0.f, 0.f}, a1 = {0.f, 0.f, 0.f, 0.f};
                a0 = mfma16(k00, q0, a0); a0 = mfma16(k01, q1, a0);
                a1 = mfma16(k10, q0, a1); a1 = mfma16(k11, q1, a1);
#pragma unroll
                for (int e = 0; e < 8; ++e) {
                    const float sc = (e < 4 ? a0[e & 3] : a1[e & 3]) * 0.125f + bp0[kr * 31 + dcs[e]];
                    s[kr][e] = oks[e] ? sc : -1e30f;
                    mx = fmaxf(mx, s[kr][e]);
                }
            }
            mx = fmaxf(mx, __shfl_xor(mx, 16)); mx = fmaxf(mx, __shfl_xor(mx, 32));
            float sum = 0.f;
#pragma unroll
            for (int kr = 0; kr < 8; ++kr)
#pragma unroll
                for (int e = 0; e < 8; ++e) { const float p = __expf(s[kr][e] - mx); s[kr][e] = p; sum += p; }
            sum += __shfl_xor(sum, 16); sum += __shfl_xor(sum, 32);
            f32x4 o[4];
#pragma unroll
            for (int dt = 0; dt < 4; ++dt) o[dt] = (f32x4){0.f, 0.f, 0.f, 0.f};
            slot = rs % 9;
#pragma unroll
            for (int kr = 0; kr < 8; ++kr) {
                const LAS unsigned char* sb = lds + slot * 16384 + offV;
                slot = (slot == 8) ? 0 : slot + 1;
                const bf16x8 pf = pack8(s[kr]);
#pragma unroll
                for (int dt = 0; dt < 4; ++dt) o[dt] = mfma16(*(const LAS bf16x8*)(sb + dt * 2048), pf, o[dt]);
            }
            const float inv = frcp(sum);
            bf16_t* yt = y + (size_t)(seq_base + rr * 64 + g * 16 + fr) * LDY + 1024 + h * 64;
#pragma unroll
            for (int dt = 0; dt < 4; ++dt) {
                u32x2_t ow;
                ow.x = pk2(o[dt][0] * inv * silu(bflo(gr[dt].x)), o[dt][1] * inv * silu(bfhi(gr[dt].x)));
                ow.y = pk2(o[dt][2] * inv * silu(bflo(gr[dt].y)), o[dt][3] * inv * silu(bfhi(gr[dt].y)));
                *(u32x2_t*)(yt + dt * 16 + fq * 4) = ow;
            }
            q0 = q0n; q1 = q1n;
#pragma unroll
            for (int dt = 0; dt < 4; ++dt) gr[dt] = grn[dt];
        }
        __syncthreads();
    }
}

__device__ __forceinline__ void mem_unit(const bf16_t* z, int qcol, int gcol, const bf16_t* mk, const bf16_t* mvT, bf16_t* y, int unit, int seg, LAS unsigned char* lds, int tid) {
    const int h = unit & 3, range = unit >> 2, tokr = range * 256;
    const int mb = seg < 2 ? seg : 2 + (tokr >> 12);
    const int lane = tid & 63, wid = tid >> 6, fr = lane & 15, fq = lane >> 4;
    __syncthreads();
#pragma unroll
    for (int i = 0; i < 8; ++i) {
        const int idx = tid + 512 * i, rho = idx >> 4, c = idx & 15, f = (rho & 3) | (((rho >> 3) & 3) << 2);
        const u32x4_t v = *(const u32x4_t*)(mk + (size_t)(mb * 256 + rho) * 512 + h * 128 + c * 8);
        *(LAS u32x4_t*)(lds + rho * 256 + ((c ^ f) << 4)) = v;
    }
#pragma unroll
    for (int i = 0; i < 8; ++i) {
        const int idx = tid + 512 * i, d = idx >> 5, c = idx & 31;
        const u32x4_t v = *(const u32x4_t*)(mvT + (size_t)(h * 128 + d) * 1536 + mb * 256 + c * 8);
        *(LAS u32x4_t*)(lds + 65536 + d * 512 + ((c ^ (d & 15)) << 4)) = v;
    }
    __syncthreads();
    const int mrowA = (fr >> 2) * 8 + (fr & 3);
    const LAS unsigned char* kbase = lds + mrowA * 256 + ((fq ^ (fr & 3)) << 4);
    const LAS unsigned char* vbase = lds + 65536 + fr * 512 + ((fq ^ (fr & 3)) << 4);
    const int hi = fr >> 2;
#pragma unroll 1
    for (int gi = 0; gi < 2; ++gi) {
        const int tok = tokr + (wid + 8 * gi) * 16 + fr;
        const bf16_t* qp = z + (size_t)tok * LDZ + qcol + h * 128 + fq * 8;
        bf16x8 q[4];
#pragma unroll
        for (int ks = 0; ks < 4; ++ks) q[ks] = ld8(qp + ks * 32);
        u32x2_t gr[8];
#pragma unroll
        for (int dt = 0; dt < 8; ++dt) gr[dt] = *(const u32x2_t*)(z + (size_t)tok * LDZ + gcol + h * 128 + dt * 16 + fq * 4);
        float s[8][8];
        float mx = -1e30f;
#pragma unroll
        for (int kb = 0; kb < 8; ++kb) {
            f32x4 a0 = {0.f, 0.f, 0.f, 0.f}, a1 = {0.f, 0.f, 0.f, 0.f};
#pragma unroll
            for (int ks = 0; ks < 4; ++ks) {
                const LAS unsigned char* kp = kbase + kb * 8192 + ((ks ^ hi) << 6);
                a0 = mfma16(*(const LAS bf16x8*)kp, q[ks], a0); a1 = mfma16(*(const LAS bf16x8*)(kp + 1024), q[ks], a1);
            }
#pragma unroll
            for (int e = 0; e < 8; ++e) { s[kb][e] = (e < 4 ? a0[e & 3] : a1[e & 3]) * 0.08838834764831845f; mx = fmaxf(mx, s[kb][e]); }
        }
        mx = fmaxf(mx, __shfl_xor(mx, 16)); mx = fmaxf(mx, __shfl_xor(mx, 32));
        float sum = 0.f;
#pragma unroll
        for (int kb = 0; kb < 8; ++kb)
#pragma unroll
            for (int e = 0; e < 8; ++e) { const float p = __expf(s[kb][e] - mx); s[kb][e] = p; sum += p; }
        sum += __shfl_xor(sum, 16); sum += __shfl_xor(sum, 32);
        f32x4 o[8];
#pragma unroll
        for (int dt = 0; dt < 8; ++dt) o[dt] = (f32x4){0.f, 0.f, 0.f, 0.f};
#pragma unroll
        for (int kb = 0; kb < 8; ++kb) {
            const bf16x8 pf = pack8(s[kb]);
            const LAS unsigned char* vp = vbase + (((kb ^ hi) & 7) << 6);
#pragma unroll
            for (int dt = 0; dt < 8; ++dt) o[dt] = mfma16(*(const LAS bf16x8*)(vp + dt * 8192), pf, o[dt]);
        }
        const float inv = frcp(sum);
#pragma unroll
        for (int dt = 0; dt < 8; ++dt) {
            const int d4 = dt * 16 + fq * 4;
            u32x2_t ow;
            ow.x = pk2(o[dt][0] * inv * silu(bflo(gr[dt].x)), o[dt][1] * inv * silu(bfhi(gr[dt].x)));
            ow.y = pk2(o[dt][2] * inv * silu(bflo(gr[dt].y)), o[dt][3] * inv * silu(bfhi(gr[dt].y)));
            *(u32x2_t*)(y + (size_t)tok * LDY + 2048 + h * 128 + d4) = ow;
        }
    }
}

template <int CTRL> __device__ __forceinline__ float dppf(float oldv, float src) {
    return __int_as_float(__builtin_amdgcn_update_dpp(__float_as_int(oldv), __float_as_int(src), CTRL, 0xf, 0xf, false));
}
#define SCAN_STEP(SH) \
    "v_fmac_f32_dpp %4, %4, %0 " SH " row_mask:0xf bank_mask:0xf\n" \
    "v_fmac_f32_dpp %5, %5, %1 " SH " row_mask:0xf bank_mask:0xf\n" \
    "v_fmac_f32_dpp %6, %6, %2 " SH " row_mask:0xf bank_mask:0xf\n" \
    "v_fmac_f32_dpp %7, %7, %3 " SH " row_mask:0xf bank_mask:0xf\n" \
    "v_mul_f32_dpp %0, %0, %0 " SH " row_mask:0xf bank_mask:0xf\n" \
    "v_mul_f32_dpp %1, %1, %1 " SH " row_mask:0xf bank_mask:0xf\n" \
    "v_mul_f32_dpp %2, %2, %2 " SH " row_mask:0xf bank_mask:0xf\n" \
    "v_mul_f32_dpp %3, %3, %3 " SH " row_mask:0xf bank_mask:0xf\n"
template <int DIR> __device__ __forceinline__ void scan16x4(float (&A)[4], float (&B)[4]) {
    if (DIR == 0)
        asm volatile("s_nop 1\n" SCAN_STEP("row_shr:1") SCAN_STEP("row_shr:2") SCAN_STEP("row_shr:4") SCAN_STEP("row_shr:8")
                     : "+v"(A[0]), "+v"(A[1]), "+v"(A[2]), "+v"(A[3]), "+v"(B[0]), "+v"(B[1]), "+v"(B[2]), "+v"(B[3]));
    else
        asm volatile("s_nop 1\n" SCAN_STEP("row_shl:1") SCAN_STEP("row_shl:2") SCAN_STEP("row_shl:4") SCAN_STEP("row_shl:8")
                     : "+v"(A[0]), "+v"(A[1]), "+v"(A[2]), "+v"(A[3]), "+v"(B[0]), "+v"(B[1]), "+v"(B[2]), "+v"(B[3]));
}
template <int DIR> __device__ __forceinline__ void bcast4(const float (&v)[4], float (&o)[4]) {
    if (DIR == 0)
        asm volatile("s_nop 1\n"
                     "v_mov_b32_dpp %0, %4 row_newbcast:15 row_mask:0xf bank_mask:0xf\n" "v_mov_b32_dpp %1, %5 row_newbcast:15 row_mask:0xf bank_mask:0xf\n"
                     "v_mov_b32_dpp %2, %6 row_newbcast:15 row_mask:0xf bank_mask:0xf\n" "v_mov_b32_dpp %3, %7 row_newbcast:15 row_mask:0xf bank_mask:0xf\n"
                     : "=&v"(o[0]), "=&v"(o[1]), "=&v"(o[2]), "=&v"(o[3]) : "v"(v[0]), "v"(v[1]), "v"(v[2]), "v"(v[3]));
    else
        asm volatile("s_nop 1\n"
                     "v_mov_b32_dpp %0, %4 row_newbcast:0 row_mask:0xf bank_mask:0xf\n" "v_mov_b32_dpp %1, %5 row_newbcast:0 row_mask:0xf bank_mask:0xf\n"
                     "v_mov_b32_dpp %2, %6 row_newbcast:0 row_mask:0xf bank_mask:0xf\n" "v_mov_b32_dpp %3, %7 row_newbcast:0 row_mask:0xf bank_mask:0xf\n"
                     : "=&v"(o[0]), "=&v"(o[1]), "=&v"(o[2]), "=&v"(o[3]) : "v"(v[0]), "v"(v[1]), "v"(v[2]), "v"(v[3]));
}
struct LruW { bf16x8 Wa[4], Wi[4]; float ba[4], bi[4], c8[4]; };
struct LruX { bf16x8 x[2][4]; u32x2_t xr[2]; };
__device__ __forceinline__ void lru_loadw(LruW& W, const bf16_t* lruw, const float* ba_, const float* bi_, const float* lam_, int dir, int blk, int w, int ch4, int lane) {
    const int fr = lane & 15, fq = lane >> 4;
    const bf16_t* wa = lruw + ((size_t)((0 * 2 + dir) * 8 + blk) * 128 + w * 16 + fr) * 128 + fq * 8;
    const bf16_t* wi = lruw + ((size_t)((1 * 2 + dir) * 8 + blk) * 128 + w * 16 + fr) * 128 + fq * 8;
#pragma unroll
    for (int ks = 0; ks < 4; ++ks) { W.Wa[ks] = ld8(wa + ks * 32); W.Wi[ks] = ld8(wi + ks * 32); }
    const f32x4 a = *(const f32x4*)(ba_ + dir * 1024 + ch4), b = *(const f32x4*)(bi_ + dir * 1024 + ch4), l = *(const f32x4*)(lam_ + dir * 1024 + ch4);
#pragma unroll
    for (int jj = 0; jj < 4; ++jj) { W.ba[jj] = -1.4426950408889634f * a[jj]; W.bi[jj] = -1.4426950408889634f * b[jj]; W.c8[jj] = -8.0f * 1.4426950408889634f * log1pf(__expf(-l[jj])); }
}
__device__ __forceinline__ void conv_tile_to_lds(const bf16_t* z, const float* cw, const float* cb, LAS unsigned char* xl, int chunk, int blk, int T, int tid) {
    const int c = tid & 15, ch0 = blk * 128 + c * 8;
    float w[4][8], bb[8];
#pragma unroll
    for (int j = 0; j < 4; ++j) { const f32x4 a = *(const f32x4*)(cw + j * 1024 + ch0), b = *(const f32x4*)(cw + j * 1024 + ch0 + 4);
#pragma unroll
        for (int e = 0; e < 4; ++e) { w[j][e] = a[e]; w[j][4 + e] = b[e]; } }
    { const f32x4 a = *(const f32x4*)(cb + ch0), b = *(const f32x4*)(cb + ch0 + 4);
#pragma unroll
        for (int e = 0; e < 4; ++e) { bb[e] = a[e]; bb[4 + e] = b[e]; } }
#pragma unroll
    for (int i = 0; i < 4; ++i) {
        const int r = (tid >> 4) + 32 * i, t = chunk * 128 + r, s = t & (T - 1);
        float acc[8];
#pragma unroll
        for (int e = 0; e < 8; ++e) acc[e] = bb[e];
#pragma unroll
        for (int j = 0; j < 4; ++j) {
            const int sj = s + j - 2;
            u32x4_t xv = {0u, 0u, 0u, 0u};
            if (sj >= 0 && sj < T) xv = *(const u32x4_t*)(z + (size_t)(t + j - 2) * LDZ + ch0);
            acc[0] += w[j][0] * bflo(xv[0]); acc[1] += w[j][1] * bfhi(xv[0]); acc[2] += w[j][2] * bflo(xv[1]); acc[3] += w[j][3] * bfhi(xv[1]);
            acc[4] += w[j][4] * bflo(xv[2]); acc[5] += w[j][5] * bfhi(xv[2]); acc[6] += w[j][6] * bflo(xv[3]); acc[7] += w[j][7] * bfhi(xv[3]);
        }
        u32x4_t o; o.x = pk2(acc[0], acc[1]); o.y = pk2(acc[2], acc[3]); o.z = pk2(acc[4], acc[5]); o.w = pk2(acc[6], acc[7]);
        *(LAS u32x4_t*)(xl + r * 256 + ((c ^ (r & 15)) << 4)) = o;
    }
}
__device__ __forceinline__ void lru_loadx(LruX& X, const LAS unsigned char* xl, int r0, int w, int lane) {
    const int fr = lane & 15, fq = lane >> 4;
#pragma unroll
    for (int t = 0; t < 2; ++t) {
        const int r = r0 + t * 16 + fr;
        const LAS unsigned char* rp = xl + r * 256;
#pragma unroll
        for (int ks = 0; ks < 4; ++ks) X.x[t][ks] = *(const LAS bf16x8*)(rp + (((ks * 4 + fq) ^ fr) << 4));
        X.xr[t] = *(const LAS u32x2_t*)(rp + (((w * 2 + (fq >> 1)) ^ fr) << 4) + (fq & 1) * 8);
    }
}
template <int DIR, bool FINAL> __device__ __forceinline__ void lru_tile(const bf16x8 (&Xf)[4], const u32x2_t xr, const LruW& W, int lane, float (&hin)[4], float (&arun)[4], float (&hout)[4], unsigned (&lab)[4]) {
    f32x4 accR = {0.f, 0.f, 0.f, 0.f}, accI = {0.f, 0.f, 0.f, 0.f};
#pragma unroll
    for (int ks = 0; ks < 4; ++ks) { accR = mfma16(W.Wa[ks], Xf[ks], accR); accI = mfma16(W.Wi[ks], Xf[ks], accI); }
    const float xv[4] = {bflo(xr.x), bfhi(xr.x), bflo(xr.y), bfhi(xr.y)};
    const int src = (lane & 48) + (DIR == 0 ? 15 : 0);
    float A[4], B[4];
    typedef float f32x2 __attribute__((ext_vector_type(2)));
#pragma unroll
    for (int p = 0; p < 2; ++p) {
        const f32x2 ar = {accR[2 * p], accR[2 * p + 1]}, ai = {accI[2 * p], accI[2 * p + 1]};
        const f32x2 bar = {W.ba[2 * p], W.ba[2 * p + 1]}, bai = {W.bi[2 * p], W.bi[2 * p + 1]}, c8v = {W.c8[2 * p], W.c8[2 * p + 1]}, xvv = {xv[2 * p], xv[2 * p + 1]};
        const f32x2 tr = ar * (-1.4426950408889634f) + bar, ti = ai * (-1.4426950408889634f) + bai;
        f32x2 er, ei; er.x = __builtin_amdgcn_exp2f(tr.x); er.y = __builtin_amdgcn_exp2f(tr.y); ei.x = __builtin_amdgcn_exp2f(ti.x); ei.y = __builtin_amdgcn_exp2f(ti.y);
        er = er + 1.0f; ei = ei + 1.0f;
        f32x2 rg, ig; rg.x = frcp(er.x); rg.y = frcp(er.y); ig.x = frcp(ei.x); ig.y = frcp(ei.y);
        const f32x2 la = c8v * rg;
        f32x2 Av; Av.x = __builtin_amdgcn_exp2f(la.x); Av.y = __builtin_amdgcn_exp2f(la.y);
        f32x2 om = 1.0f - Av * Av;
        f32x2 sq; sq.x = __builtin_amdgcn_sqrtf(fmaxf(om.x, 0.f)); sq.y = __builtin_amdgcn_sqrtf(fmaxf(om.y, 0.f));
        const f32x2 Bv = sq * (ig * xvv);
        A[2 * p] = Av.x; A[2 * p + 1] = Av.y; B[2 * p] = Bv.x; B[2 * p + 1] = Bv.y;
        lab[2 * p] = __builtin_bit_cast(unsigned, __builtin_amdgcn_cvt_pkrtz(la.x, Bv.x));
        lab[2 * p + 1] = __builtin_bit_cast(unsigned, __builtin_amdgcn_cvt_pkrtz(la.y, Bv.y));
    }
    scan16x4<DIR>(A, B);
#pragma unroll
    for (int jj = 0; jj < 4; ++jj) hout[jj] = A[jj] * hin[jj] + B[jj];
    bcast4<DIR>(hout, hin);
    if (!FINAL) { float At[4]; bcast4<DIR>(A, At);
#pragma unroll
        for (int jj = 0; jj < 4; ++jj) arun[jj] *= At[jj]; }
}
template <bool FINAL> __device__ __forceinline__ void lru_item(const LAS unsigned char* xl, const bf16_t* z, const bf16_t* lruw, const float* ba_, const float* bi_, const float* lam_,
                                                               float* agg, const float* carry, bf16_t* y, unsigned* labuf, int item, int lane) {
    const int cgi = item & 63, chunk = item >> 6, blk = cgi >> 3, w = cgi & 7;
    const int fr = lane & 15, fq = lane >> 4;
    const int ch4 = blk * 128 + w * 16 + fq * 4;
    const int tokc = chunk * 128;
    LruX X[2]; LruW W0;
    lru_loadw(W0, lruw, ba_, bi_, lam_, 0, blk, w, ch4, lane);
    lru_loadx(X[0], xl, 0, w, lane);
    unsigned hf[8][2];
    float hin[4], arun[4];
#pragma unroll
    for (int jj = 0; jj < 4; ++jj) { hin[jj] = FINAL ? carry[(size_t)(0 * 128 + chunk) * 1024 + ch4 + jj] : 0.f; arun[jj] = 1.f; }
#pragma unroll
    for (int bi = 0; bi < 8; ++bi) {
        __builtin_amdgcn_sched_barrier(0);
        const int slot = bi < 4 ? (bi & 1) : ((bi + 1) & 1);
        const int pair = bi < 4 ? bi : 7 - bi;
        if (bi + 1 < 8 && bi + 1 != 4) {
            const int nslot = (bi + 1) < 4 ? ((bi + 1) & 1) : ((bi + 2) & 1);
            const int npair = (bi + 1) < 4 ? (bi + 1) : 7 - (bi + 1);
            lru_loadx(X[nslot], xl, npair * 32, w, lane);
        }
        if (bi == 4) {
            lru_loadw(W0, lruw, ba_, bi_, lam_, 1, blk, w, ch4, lane);
            if (!FINAL && fr == 0) {
#pragma unroll
                for (int jj = 0; jj < 4; ++jj) { float2 v; v.x = arun[jj]; v.y = hin[jj]; *(float2*)(agg + ((size_t)(0 * 128 + chunk) * 1024 + ch4 + jj) * 2) = v; }
            }
#pragma unroll
            for (int jj = 0; jj < 4; ++jj) { hin[jj] = FINAL ? carry[(size_t)(1 * 128 + chunk) * 1024 + ch4 + jj] : 0.f; arun[jj] = 1.f; }
        }
#pragma unroll
        for (int k = 0; k < 2; ++k) {
            const int t = bi < 4 ? k : 1 - k;
            const int tt = 2 * pair + t;
            float hv[4]; unsigned lab[4];
            if (bi < 4) lru_tile<0, FINAL>(X[slot].x[t], X[slot].xr[t], W0, lane, hin, arun, hv, lab);
            else lru_tile<1, FINAL>(X[slot].x[t], X[slot].xr[t], W0, lane, hin, arun, hv, lab);
            if (!FINAL) { u32x4_t lw; lw.x = lab[0]; lw.y = lab[1]; lw.z = lab[2]; lw.w = lab[3];
                *(u32x4_t*)(labuf + ((((size_t)(bi < 4 ? 0 : 1) * 128 + chunk) * 64 + cgi) * 8 + (2 * pair + t)) * 256 + lane * 4) = lw; }
            if (FINAL) {
                if (bi < 4) {
                    hf[tt][0] = pk2(hv[0], hv[1]); hf[tt][1] = pk2(hv[2], hv[3]);
                } else {
                    const int tok = tokc + tt * 16 + fr;
                    const u32x2_t gr = *(const u32x2_t*)(z + (size_t)tok * LDZ + 1024 + ch4);
                    const float gc[4] = {bflo(gr.x), bfhi(gr.x), bflo(gr.y), bfhi(gr.y)};
                    const float hfv[4] = {bflo(hf[tt][0]), bfhi(hf[tt][0]), bflo(hf[tt][1]), bfhi(hf[tt][1])};
                    float o[4];
#pragma unroll
                    for (int jj = 0; jj < 4; ++jj) o[jj] = (hfv[jj] + hv[jj]) * silu(gc[jj]);
                    u32x2_t ow; ow.x = pk2(o[0], o[1]); ow.y = pk2(o[2], o[3]);
                    *(u32x2_t*)(y + (size_t)tok * LDY + ch4) = ow;
                }
            }
        }
    }
    if (!FINAL && fr == 0) {
#pragma unroll
        for (int jj = 0; jj < 4; ++jj) { float2 v; v.x = arun[jj]; v.y = hin[jj]; *(float2*)(agg + ((size_t)(1 * 128 + chunk) * 1024 + ch4 + jj) * 2) = v; }
    }
}
struct LruF { u32x4_t L[2][8]; u32x2_t gr[8]; };
__device__ __forceinline__ void lru_final_load(LruF& F, const unsigned* labuf, const bf16_t* z, int item, int lane) {
    const int cgi = item & 63, chunk = item >> 6, fr = lane & 15, fq = lane >> 4;
    const int ch4 = cgi * 16 + fq * 4, tokc = chunk * 128;
#pragma unroll
    for (int d = 0; d < 2; ++d)
#pragma unroll
        for (int tt = 0; tt < 8; ++tt) F.L[d][tt] = *(const u32x4_t*)(labuf + ((((size_t)d * 128 + chunk) * 64 + cgi) * 8 + tt) * 256 + lane * 4);
#pragma unroll
    for (int tt = 0; tt < 8; ++tt) F.gr[tt] = *(const u32x2_t*)(z + (size_t)(tokc + tt * 16 + fr) * LDZ + 1024 + ch4);
}
template <bool WAVEC> __device__ __forceinline__ void lru_final_compute(const LruF& F, const float* carry, float hcv, bf16_t* y, int item, int lane) {
    typedef _Float16 h2_t __attribute__((ext_vector_type(2)));
    const int cgi = item & 63, chunk = item >> 6;
    const int fr = lane & 15, fq = lane >> 4;
    const int ch4 = cgi * 16 + fq * 4, tokc = chunk * 128;
    float hf[8][4];
    {
        float hin[4];
#pragma unroll
        for (int jj = 0; jj < 4; ++jj) hin[jj] = WAVEC ? __shfl(hcv, fq * 4 + jj) : carry[(size_t)(0 * 128 + chunk) * 1024 + ch4 + jj];
#pragma unroll
        for (int tt = 0; tt < 8; ++tt) {
            float A[4], B[4];
#pragma unroll
            for (int jj = 0; jj < 4; ++jj) {
                const unsigned wv = F.L[0][tt][jj]; const h2_t v = __builtin_bit_cast(h2_t, wv);
                A[jj] = __builtin_amdgcn_exp2f((float)v.x); B[jj] = (float)v.y;
            }
            scan16x4<0>(A, B);
#pragma unroll
            for (int jj = 0; jj < 4; ++jj) hf[tt][jj] = A[jj] * hin[jj] + B[jj];
            bcast4<0>(hf[tt], hin);
        }
    }
    {
        float hin[4];
#pragma unroll
        for (int jj = 0; jj < 4; ++jj) hin[jj] = WAVEC ? __shfl(hcv, 16 + fq * 4 + jj) : carry[(size_t)(1 * 128 + chunk) * 1024 + ch4 + jj];
#pragma unroll
        for (int s = 0; s < 8; ++s) {
            const int tt = 7 - s;
            float o[4], A[4], B[4];
#pragma unroll
            for (int jj = 0; jj < 4; ++jj) {
                const unsigned wv = F.L[1][tt][jj]; const h2_t v = __builtin_bit_cast(h2_t, wv);
                A[jj] = __builtin_amdgcn_exp2f((float)v.x); B[jj] = (float)v.y;
            }
            scan16x4<1>(A, B);
            float hb[4];
#pragma unroll
            for (int jj = 0; jj < 4; ++jj) { hb[jj] = A[jj] * hin[jj] + B[jj]; o[jj] = hf[tt][jj] + hb[jj]; }
            bcast4<1>(hb, hin);
            const float gc[4] = {bflo(F.gr[tt].x), bfhi(F.gr[tt].x), bflo(F.gr[tt].y), bfhi(F.gr[tt].y)};
            u32x2_t ow; ow.x = pk2(o[0] * silu(gc[0]), o[1] * silu(gc[1])); ow.y = pk2(o[2] * silu(gc[2]), o[3] * silu(gc[3]));
            *(u32x2_t*)(y + (size_t)(tokc + tt * 16 + fr) * LDY + ch4) = ow;
        }
    }
}
__device__ __forceinline__ void wave_carries(const float* agg, int cgi, int chunk0, int nseq, int lane, float (&hc)[4]) {
    const int q = lane >> 4, ch = cgi * 16 + (lane & 15);
    const bool up = (lane & 16) != 0;
#pragma unroll
    for (int dir = 0; dir < 2; ++dir) {
        float A = 1.f, h = 0.f, Ap = 1.f, Hp = 0.f;
#pragma unroll 8
        for (int step = 0; step < 32; ++step) {
            const int cc = dir == 0 ? step : 31 - step;
            if (cc == chunk0) { Ap = A; Hp = h; }
            const float2 ah = *(const float2*)(agg + ((size_t)(dir * 128 + 32 * q + cc) * 1024 + ch) * 2);
            h = ah.x * h + ah.y; A *= ah.x;
        }
        float Aq[4], Hq[4], Apk[4], Hpk[4];
#pragma unroll
        for (int k = 0; k < 4; ++k) { const int src = k * 16 + (lane & 15); Aq[k] = __shfl(A, src); Hq[k] = __shfl(h, src); Apk[k] = __shfl(Ap, src); Hpk[k] = __shfl(Hp, src); }
        float S[4];
        if (dir == 0) { S[0] = 0.f; S[1] = Hq[0]; S[2] = Aq[1] * S[1] + Hq[1]; S[3] = Aq[2] * S[2] + Hq[2]; }
        else { S[3] = 0.f; S[2] = Hq[3]; S[1] = Aq[2] * S[2] + Hq[2]; S[0] = Aq[1] * S[1] + Hq[1]; }
#pragma unroll
        for (int k = 0; k < 4; ++k) { const float v = Apk[k] * (nseq == 1 ? S[k] : 0.f) + Hpk[k]; if (dir == 0) hc[k] = v; else hc[k] = up ? v : hc[k]; }
    }
}
__device__ __forceinline__ void carry_phase(const float* agg, float* carry, int nseq, int gtid, int gthreads) {
    const int nc = 128 / nseq;
    for (int idx = gtid; idx < 2 * nseq * 1024; idx += gthreads) {
        const int ch = idx & 1023, rest = idx >> 10, dir = rest & 1, sq = rest >> 1, base = sq * nc;
        float h = 0.f;
#pragma unroll 8
        for (int c = 0; c < nc; ++c) {
            const int C = base + (dir == 0 ? c : nc - 1 - c);
            const size_t o = (size_t)(dir * 128 + C) * 1024 + ch;
            const float2 ah = *(const float2*)(agg + o * 2);
            carry[o] = h;
            h = ah.x * h + ah.y;
        }
    }
}

__device__ __forceinline__ void sgu_item2(const bf16_t* vT, const LAS float* rstd, const LAS unsigned char* wsl, const bf16_t* z, const float* sgu_g, const float* sgu_b, bf16_t* y,
                                          int n, int g, int qd, int lane) {
    const int fr = lane & 15, fq = lane >> 4;
    const int tokc = n * 128, chq = g * 128 + qd * 32;
    bf16x8 Af[2][4];
#pragma unroll
    for (int t = 0; t < 2; ++t) {
        const bf16_t* ap = vT + (size_t)(chq + (fr >> 2) * 8 + (fr & 3) + 4 * t) * SEG + tokc + fq * 8;
#pragma unroll
        for (int ks = 0; ks < 4; ++ks) {
            const u32x4_t raw = *(const u32x4_t*)(ap + ks * 32);
            const f32x4 r0 = *(const LAS f32x4*)(rstd + ks * 32 + fq * 8), r1 = *(const LAS f32x4*)(rstd + ks * 32 + fq * 8 + 4);
            u32x4_t w;
            w.x = pk2(bflo(raw.x) * r0[0], bfhi(raw.x) * r0[1]); w.y = pk2(bflo(raw.y) * r0[2], bfhi(raw.y) * r0[3]);
            w.z = pk2(bflo(raw.z) * r1[0], bfhi(raw.z) * r1[1]); w.w = pk2(bflo(raw.w) * r1[2], bfhi(raw.w) * r1[3]);
            Af[t][ks] = __builtin_bit_cast(bf16x8, w);
        }
    }
    const int ch8 = chq + fq * 8;
    const f32x4 g0 = *(const f32x4*)(sgu_g + ch8), g1 = *(const f32x4*)(sgu_g + ch8 + 4);
#pragma unroll 2
    for (int pt = 0; pt < 8; ++pt) {
        const int p = pt * 16 + fr, tok = tokc + p;
        const u32x4_t ur = *(const u32x4_t*)(z + (size_t)tok * LDZ + 2048 + ch8), gr = *(const u32x4_t*)(z + (size_t)tok * LDZ + 3072 + ch8);
        const float bsv = sgu_b[g * 128 + p];
        const LAS unsigned char* bp = wsl + p * 256;
        f32x4 a0 = {0.f, 0.f, 0.f, 0.f}, a1 = {0.f, 0.f, 0.f, 0.f};
#pragma unroll
        for (int ks = 0; ks < 4; ++ks) { const bf16x8 Bf = *(const LAS bf16x8*)(bp + (((ks * 4 + fq) ^ fr) << 4)); a0 = mfma16(Af[0][ks], Bf, a0); a1 = mfma16(Af[1][ks], Bf, a1); }
        float o[8];
#pragma unroll
        for (int k = 0; k < 2; ++k) {
            o[2 * k] = bflo(ur[k]) * (a0[2 * k] * g0[2 * k] + bsv) * silu(bflo(gr[k]));
            o[2 * k + 1] = bfhi(ur[k]) * (a0[2 * k + 1] * g0[2 * k + 1] + bsv) * silu(bfhi(gr[k]));
            o[4 + 2 * k] = bflo(ur[2 + k]) * (a1[2 * k] * g1[2 * k] + bsv) * silu(bflo(gr[2 + k]));
            o[4 + 2 * k + 1] = bfhi(ur[2 + k]) * (a1[2 * k + 1] * g1[2 * k + 1] + bsv) * silu(bfhi(gr[2 + k]));
        }
        u32x4_t ow; ow.x = pk2(o[0], o[1]); ow.y = pk2(o[2], o[3]); ow.z = pk2(o[4], o[5]); ow.w = pk2(o[6], o[7]);
        *(u32x4_t*)(y + (size_t)tok * LDY + 1024 + ch8) = ow;
    }
}

__device__ __forceinline__ void sgu_item(const bf16_t* vT, const LAS float* rstd, const bf16_t* z, const bf16_t* sguw, const float* sgu_g, const float* sgu_b, bf16_t* y, int item, int lane) {
    const int dd = item & 7, g = (item >> 3) & 7, n = item >> 6;
    const int fr = lane & 15, fq = lane >> 4;
    const int tokc = n * 128;
    const bf16_t* ap = vT + (size_t)(g * 128 + dd * 16 + fr) * SEG + tokc + fq * 8;
    bf16x8 Af[4];
#pragma unroll
    for (int ks = 0; ks < 4; ++ks) {
        const u32x4_t raw = *(const u32x4_t*)(ap + ks * 32);
        const f32x4 r0 = *(const LAS f32x4*)(rstd + ks * 32 + fq * 8), r1 = *(const LAS f32x4*)(rstd + ks * 32 + fq * 8 + 4);
        u32x4_t w;
        w.x = pk2(bflo(raw.x) * r0[0], bfhi(raw.x) * r0[1]); w.y = pk2(bflo(raw.y) * r0[2], bfhi(raw.y) * r0[3]);
        w.z = pk2(bflo(raw.z) * r1[0], bfhi(raw.z) * r1[1]); w.w = pk2(bflo(raw.w) * r1[2], bfhi(raw.w) * r1[3]);
        Af[ks] = __builtin_bit_cast(bf16x8, w);
    }
    const int ch4 = g * 128 + dd * 16 + fq * 4;
    const f32x4 g4 = *(const f32x4*)(sgu_g + ch4);
#pragma unroll
    for (int pt = 0; pt < 8; ++pt) {
        const int p = pt * 16 + fr;
        const bf16_t* bp = sguw + (size_t)(g * 128 + p) * 128 + fq * 8;
        f32x4 acc = {0.f, 0.f, 0.f, 0.f};
#pragma unroll
        for (int ks = 0; ks < 4; ++ks) acc = mfma16(Af[ks], ld8(bp + ks * 32), acc);
        const int tok = tokc + p;
        const float bsv = sgu_b[g * 128 + p];
        const u32x2_t ur = *(const u32x2_t*)(z + (size_t)tok * LDZ + 2048 + ch4), gr = *(const u32x2_t*)(z + (size_t)tok * LDZ + 3072 + ch4);
        const float uu[4] = {bflo(ur.x), bfhi(ur.x), bflo(ur.y), bfhi(ur.y)}, gd[4] = {bflo(gr.x), bfhi(gr.x), bflo(gr.y), bfhi(gr.y)};
        float o[4];
#pragma unroll
        for (int jj = 0; jj < 4; ++jj) o[jj] = uu[jj] * (acc[jj] * g4[jj] + bsv) * silu(gd[jj]);
        u32x2_t ow; ow.x = pk2(o[0], o[1]); ow.y = pk2(o[2], o[3]);
        *(u32x2_t*)(y + (size_t)tok * LDY + 1024 + ch4) = ow;
    }
}

__global__ void __launch_bounds__(512, 2) fwd_megakernel(Params P) {
    extern __shared__ __attribute__((aligned(16))) unsigned char shm[];
    cg::grid_group grid = cg::this_grid();
    PG8_LAS unsigned char* lds = (PG8_LAS unsigned char*)shm;
    const int G = gridDim.x, NW = G * 8;
#define FRESH_TID() int tid = threadIdx.x; asm volatile("" : "+v"(tid)); const int lane = tid & 63, wid = tid >> 6, gw = blockIdx.x * 8 + wid; (void)lane; (void)gw
    unsigned char* ws = P.ws;
    bf16_t* WIN_E = (bf16_t*)(ws + WS_WIN_E); bf16_t* WIN_O = (bf16_t*)(ws + WS_WIN_O);
    bf16_t* WOUT_E = (bf16_t*)(ws + WS_WOUT_E); bf16_t* WOUT_O = (bf16_t*)(ws + WS_WOUT_O);
    bf16_t* WKV = (bf16_t*)(ws + WS_WKV); bf16_t* LRUW = (bf16_t*)(ws + WS_LRUW); bf16_t* SGUW = (bf16_t*)(ws + WS_SGUW);
    bf16_t* MEMN = (bf16_t*)(ws + WS_MEMN); bf16_t* MK = (bf16_t*)(ws + WS_MK); bf16_t* MVT = (bf16_t*)(ws + WS_MVT);
    bf16_t* H = (bf16_t*)(ws + WS_H); bf16_t* Z = (bf16_t*)(ws + WS_Z); bf16_t* VT = (bf16_t*)(ws + WS_VT); bf16_t* Y = (bf16_t*)(ws + WS_Y);
    float* AGG = (float*)(ws + WS_AGG); float* CARRY = (float*)(ws + WS_CARRY); float* RSTD = (float*)(ws + WS_RSTD); float* PART = (float*)(ws + WS_PART); unsigned* LAB = (unsigned*)(ws + WS_LAB);

    unsigned* BAR = (unsigned*)(ws + WS_BAR);
    volatile LAS unsigned* xst = (volatile LAS unsigned*)(lds + XST_OFF);
    {
        FRESH_TID();
        if (tid < 2) xst[tid] = 0u;
        if (blockIdx.x == 0) for (int i = tid; i < XCD_BAR_WORDS; i += 512) BAR[i] = 0u;
        LAS float* scr = (LAS float*)(lds + wid * 16384);
        constexpr int I0 = 16 * 288, I1 = 16 * 192, I2 = 40 * 32, I3 = 40 * 32, I4 = 16 * 32, I5 = 16 * 32, I6 = 16 * 8, I7 = 16 * 8;
        constexpr int NIT = I0 + I1 + I2 + I3 + I4 + I5 + I6 + I7;
#pragma unroll 1
        for (int it = gw; it < NIT; it += NW) {
            int r = it;
            if (r < I0) { transpose_item(P.in[7], 1024, 9216, WIN_E, scr, r, lane); continue; } r -= I0;
            if (r < I1) { transpose_item(P.in[12], 1024, 6144, WIN_O, scr, r, lane); continue; } r -= I1;
            if (r < I2) { transpose_item(P.in[11], 2560, 1024, WOUT_E, scr, r, lane); continue; } r -= I2;
            if (r < I3) { transpose_item(P.in[23], 2560, 1024, WOUT_O, scr, r, lane); continue; } r -= I3;
            if (r < I4) { transpose_item(P.in[6], 1024, 1024, WKV, scr, r, lane); continue; } r -= I4;
            if (r < I5) { transpose_item(P.in[6] + (size_t)1024 * 1024, 1024, 1024, WKV + (size_t)1024 * 1024, scr, r, lane); continue; } r -= I5;
            if (r < I6) { const int m = r >> 3; transpose_item(P.in[15] + (size_t)m * 16384, 128, 128, LRUW + (size_t)m * 16384, scr, r & 7, lane); continue; } r -= I6;
            { const int m = r >> 3; transpose_item(P.in[17] + (size_t)m * 16384, 128, 128, LRUW + (size_t)(16 + m) * 16384, scr, r & 7, lane); }
        }
        for (int i = blockIdx.x * 512 + tid; i < 8 * 128 * 128; i += G * 512) SGUW[i] = f2bf(P.in[21][i]);
        for (int it = gw; it < 2 * 1536; it += NW) {
            const int l = it / 1536, row = it - l * 1536;
            const float* src = row < 512 ? P.in[2] + (size_t)row * 1024 : P.in[3] + (size_t)(row - 512) * 1024;
            rms_row_bf16(src, P.in[5] + l * 1024, MEMN + ((size_t)l * 1536 + row) * 1024, lane);
        }
        for (int it = gw; it < SEG / 4; it += NW) rms_rows4_bf16(P.in[0] + (size_t)it * 4096, P.in[4], H + (size_t)it * 4096, lane);
    }

    grid.sync();
    const XcdBarrier xb = xcd_barrier_post(BAR, xst);
    for (int seg = 0; seg < 3; ++seg) {
        const float* xin = seg < 2 ? P.in[0] + (size_t)seg * SEG * 1024 : P.in[1];
        float* xout = P.out + (size_t)seg * SEG * 1024;
        const int T = seg < 2 ? 16384 : 4096, nseq = seg < 2 ? 1 : 4;

        {
            pg8::Gemm g; g.A = H; g.Bt = WIN_E; g.M = SEG; g.N = 8192; g.K = 1024; g.A1 = WIN_E + (size_t)6144 * 1024; g.Bt1 = H;
            pg8::DualOrder S; S.S0.init(SEG, 8192, G, blockIdx.x); S.S1.init(1024, SEG, G, blockIdx.x); S.skip_from = 24; S.skip_n = 4; S.G = G; S.c = blockIdx.x;
            pg8::EpiZ E; E.O = Z; E.ldc = LDZ; E.skip_from = 24; E.skip_n = 4; E.colsq = nullptr; E.colsq_ld = 0; E.O1 = VT; E.ldc1 = SEG; E.colsq1 = nullptr;
            pg8::gemm_phase(lds, g, S, E);
        }
        if (seg == 0) {
#pragma unroll 1
            for (int l = 0; l < 2; ++l) {
                {
                    pg8::Gemm g; g.A = MEMN + (size_t)l * 1536 * 1024; g.Bt = WKV + (size_t)l * 1024 * 1024; g.M = 1536; g.N = 512; g.K = 1024; g.A1 = g.A; g.Bt1 = g.Bt;
                    pg8::SkipOrder S; S.init(1536, 512, G, (blockIdx.x + G - (32 * l) % G) % G); S.skip_from = 1 << 20; S.skip_n = 0;
                    pg8::EpiZ E; E.O = MK + (size_t)l * 1536 * 512; E.ldc = 512; E.skip_from = 1 << 20; E.skip_n = 0; E.colsq = nullptr; E.colsq_ld = 0; E.O1 = E.O; E.ldc1 = 512; E.colsq1 = nullptr;
                    pg8::gemm_phase(lds, g, S, E);
                }
                {
                    pg8::Gemm g; g.A = WKV + (size_t)l * 1024 * 1024 + (size_t)512 * 1024; g.Bt = MEMN + (size_t)l * 1536 * 1024; g.M = 512; g.N = 1536; g.K = 1024; g.A1 = g.A; g.Bt1 = g.Bt;
                    pg8::SkipOrder S; S.init(512, 1536, G, (blockIdx.x + G - (32 * l + 16) % G) % G); S.skip_from = 1 << 20; S.skip_n = 0;
                    pg8::EpiZ E; E.O = MVT + (size_t)l * 512 * 1536; E.ldc = 1536; E.skip_from = 1 << 20; E.skip_n = 0; E.colsq = nullptr; E.colsq_ld = 0; E.O1 = E.O; E.ldc1 = 1536; E.colsq1 = nullptr;
                    pg8::gemm_phase(lds, g, S, E);
                }
            }
        }
        xcd_barrier(xb);

        { FRESH_TID();
        for (int u = blockIdx.x; u < 256; u += G) mem_unit(Z, 7168, 7680, MK, MVT, Y, u, seg, lds, tid);
#pragma unroll 1
        for (int u = blockIdx.x; u < 256; u += G) na_block(Z, VT, Y, P.in[10], u, T, lds, tid);
        for (int it = gw; it < 8192; it += NW) conv_even_item(Z, P.in[8], P.in[9], Y, 2 * it, T, lane);
        }
        xcd_barrier(xb);

        {
            pg8::Gemm g; g.A = Y; g.Bt = WOUT_E; g.M = SEG; g.N = 1024; g.K = 2560; g.A1 = g.A; g.Bt1 = g.Bt;
            pg8::StaticOrder S; S.init(SEG, 1024, G, blockIdx.x);
            pg8::EpiRes E; E.xin = xin; E.out = xout;
            pg8::gemm_phase(lds, g, S, E);
        }
        xcd_barrier(xb);

        { FRESH_TID();
        for (int it = gw; it < SEG / 4; it += NW) rms_rows4_bf16(xout + (size_t)it * 4096, P.in[4] + 1024, H + (size_t)it * 4096, lane); }
        xcd_barrier(xb);

        {
            pg8::Gemm g; g.A = H; g.Bt = WIN_O; g.M = SEG; g.N = 5120; g.K = 1024; g.A1 = WIN_O + (size_t)3072 * 1024; g.Bt1 = H;
            pg8::DualOrder S; S.S0.init(SEG, 5120, G, blockIdx.x); S.S1.init(1024, SEG, G, blockIdx.x); S.skip_from = 12; S.skip_n = 4; S.G = G; S.c = blockIdx.x;
            pg8::EpiZ E; E.O = Z; E.ldc = LDZ; E.skip_from = 12; E.skip_n = 4; E.colsq = nullptr; E.colsq_ld = SEG; E.O1 = VT; E.ldc1 = SEG; E.colsq1 = PART;
            pg8::gemm_phase(lds, g, S, E);
        }
        xcd_barrier(xb);

        { FRESH_TID();
        for (int u = blockIdx.x; u < 256; u += G) mem_unit(Z, 4096, 4608, MK + (size_t)1536 * 512, MVT + (size_t)512 * 1536, Y, u, seg, lds, tid);
#pragma unroll 1
        for (int u0 = blockIdx.x; u0 < 1024; u0 += 4 * G) {
            __syncthreads();
#pragma unroll 1
            for (int k = 0; k < 4; ++k) { const int u = u0 + k * G; if (u < 1024) conv_tile_to_lds(Z, P.in[13], P.in[14], lds + k * 32768, u >> 3, u & 7, T, tid); }
            __syncthreads();
#pragma unroll 1
            for (int k = 0; k < 4; ++k) { const int u = u0 + k * G; if (u < 1024) lru_item<false>(lds + k * 32768, Z, LRUW, P.in[16], P.in[18], P.in[19], AGG, CARRY, Y, LAB, (u >> 3) * 64 + (u & 7) * 8 + wid, lane); }
        }
#pragma unroll 1
        for (int u0 = blockIdx.x; u0 < 1024; u0 += 2 * G) {
            __syncthreads();
            LAS float* rsL = (LAS float*)lds;
            if (tid < 256) { const int u = u0 + (tid >> 7) * G;
              if (u < 1024) { const float* pp = PART + (u >> 3) * 128 + (tid & 127); float s = 0.f;
#pragma unroll
                for (int i = 0; i < 8; ++i) s += pp[(size_t)i * SEG];
                rsL[tid] = __builtin_amdgcn_rsqf(s * (1.0f / 1024.0f) + EPS); } }
#pragma unroll
            for (int s2 = 0; s2 < 2; ++s2) { const int u = u0 + s2 * G;
              if (u < 1024) { const int g = u & 7;
#pragma unroll
                for (int i = 0; i < 4; ++i) { const int idx = tid + 512 * i, p = idx >> 4, c = idx & 15;
                    *(LAS u32x4_t*)(lds + 4096 + s2 * 32768 + p * 256 + ((c ^ (p & 15)) << 4)) = *(const u32x4_t*)(SGUW + (size_t)(g * 128 + p) * 128 + c * 8); } } }
            __syncthreads();
            { const int s2 = wid >> 2, u = u0 + s2 * G;
              if (u < 1024) sgu_item2(VT, rsL + s2 * 128, lds + 4096 + s2 * 32768, Z, P.in[20], P.in[22], Y, u >> 3, u & 7, wid & 3, lane); }
        } }
        xcd_barrier(xb);

        if (G == 256) {
            FRESH_TID();
            float hc[4];
            LruF F[2];
            lru_final_load(F[0], LAB, Z, gw, lane);
            wave_carries(AGG, gw & 63, gw >> 6, nseq, lane, hc);
#pragma unroll
            for (int k = 0; k < 4; ++k) {
                if (k < 3) lru_final_load(F[(k + 1) & 1], LAB, Z, gw + 2048 * (k + 1), lane);
                lru_final_compute<true>(F[k & 1], CARRY, hc[k], Y, gw + 2048 * k, lane);
            }
        } else {
            { FRESH_TID(); carry_phase(AGG, CARRY, nseq, blockIdx.x * 512 + tid, G * 512); }
            xcd_barrier(xb);
            { FRESH_TID();
#pragma unroll 1
            for (int it = gw; it < 8192; it += NW) { LruF F1; lru_final_load(F1, LAB, Z, it, lane); lru_final_compute<false>(F1, CARRY, 0.f, Y, it, lane); } }
        }
        if (seg < 2) { FRESH_TID();
            const float* xnx = seg == 0 ? P.in[0] + (size_t)SEG * 1024 : P.in[1];
            for (int it = gw; it < SEG / 4; it += NW) rms_rows4_bf16(xnx + (size_t)it * 4096, P.in[4], H + (size_t)it * 4096, lane); }
        xcd_barrier(xb);

        {
            pg8::Gemm g; g.A = Y; g.Bt = WOUT_O; g.M = SEG; g.N = 1024; g.K = 2560; g.A1 = g.A; g.Bt1 = g.Bt;
            pg8::StaticOrder S; S.init(SEG, 1024, G, blockIdx.x);
            pg8::EpiRes E; E.xin = xout; E.out = xout;
            pg8::gemm_phase(lds, g, S, E);
        }
        xcd_barrier(xb);

        { FRESH_TID();
        for (int it = gw; it < SEG / 4; it += NW) rms_rows4_f32(xout + (size_t)it * 4096, P.in[24], lane); }
    }
}

extern "C" void kernel_launch(void* const* d_in, const int* in_sizes, int n_in, void* d_out, int out_size, void* d_ws, size_t ws_size, hipStream_t stream) {
    static int grid_blocks = 0;
    if (grid_blocks == 0) {
        if (n_in != 25 || ws_size < WS_END) { fprintf(stderr, "kernel_launch: need 25 inputs and %zu bytes of workspace; got %d, %zu\n", (size_t)WS_END, n_in, ws_size); grid_blocks = -1; return; }
        int dev = 0, cus = 0, per_cu = 0;
        hipGetDevice(&dev);
        hipDeviceGetAttribute(&cus, hipDeviceAttributeMultiprocessorCount, dev);
        hipFuncSetAttribute((const void*)fwd_megakernel, hipFuncAttributeMaxDynamicSharedMemorySize, LDS_BYTES);
        hipOccupancyMaxActiveBlocksPerMultiprocessor(&per_cu, (const void*)fwd_megakernel, 512, LDS_BYTES);
        if (per_cu < 1) { fprintf(stderr, "kernel_launch: occupancy query says %d blocks per CU\n", per_cu); grid_blocks = -1; return; }
        grid_blocks = cus;
    }
    if (grid_blocks < 0) return;
    Params p{};
    for (int i = 0; i < 25; ++i) p.in[i] = (const float*)d_in[i];
    p.out = (float*)d_out; p.ws = (unsigned char*)d_ws;
    void* args[] = {&p};
    hipError_t e = hipLaunchCooperativeKernel((const void*)fwd_megakernel, dim3(grid_blocks), dim3(512), args, LDS_BYTES, stream);
    if (e != hipSuccess) fprintf(stderr, "cooperative launch failed: %s (grid %d)\n", hipGetErrorString(e), grid_blocks);
}
```

```cpp
#include <hip/hip_runtime.h>
#include <hip/hip_cooperative_groups.h>
#include <cstdio>
namespace cg = cooperative_groups;
namespace pg8 {
#define PG8_LAS __attribute__((address_space(3)))
typedef unsigned short bf16_t;
typedef short bf16x8 __attribute__((ext_vector_type(8)));
typedef float f32x4 __attribute__((ext_vector_type(4)));
typedef unsigned u32x4 __attribute__((ext_vector_type(4)));
constexpr int BM = 256, BK = 64, HALF = 128, HTB = HALF * BK * 2  , STAGE_BYTES = 8 * HTB, NXCD = 8, WGM = 8;

__host__ __device__ __forceinline__ int lds_byte(int r, int c) { const int st = (r >> 4) * 2 + (c >> 5), rr = r & 15, cc = c & 31, ob = rr * 64 + cc * 2; return st * 1024 + (ob ^ (((ob >> 9) & 1) << 5)); }
__host__ __device__ __forceinline__ void stage_rc(int b, int& R, int& C) { const int st = b / 1024, sb = b % 1024, swz = sb ^ (((sb >> 9) & 1) << 5); R = (st >> 1) * 16 + swz / 64; C = (st & 1) * 32 + (swz % 64) / 2; }
__host__ __device__ __forceinline__ int perm32(int rho) { const int n = rho >> 4, i = rho & 15; return 8 * (i >> 2) + 4 * n + (i & 3); }

struct Unit { int pm, pn, sel; };
struct Gemm { const bf16_t* A; const bf16_t* Bt; int M, N, K; const bf16_t* A1; const bf16_t* Bt1; };

struct StaticOrder {
    int nM, nN, nwg, G, c;
    __host__ __device__ void init(int M, int N, int G_, int c_) { nM = M / BM; nN = N / BM; nwg = nM * nN; G = G_; c = c_; }
    __host__ __device__ void map(int wgid, Unit& u) const {
        { const int q = nwg / NXCD, r = nwg % NXCD, xcd = wgid % NXCD, off = wgid / NXCD; wgid = (xcd < r ? xcd * (q + 1) : r * (q + 1) + (xcd - r) * q) + off; }
        const int nig = WGM * nN, gid = wgid / nig, fm = gid * WGM, gsz = (nM - fm) < WGM ? (nM - fm) : WGM;
        u.pm = fm + ((wgid % nig) % gsz); u.pn = (wgid % nig) / gsz; u.sel = 0;
    }
    __host__ __device__ bool next(int i, Unit& u) const {
        const long L = (long)i * G + c; if (L >= nwg) return false;
        map((int)L, u); return true;
    }
    __device__ __forceinline__ void a_ready(const Unit&) const {}
    __device__ __forceinline__ void done(const Unit&) const {}
};

struct SkipOrder : StaticOrder {
    int skip_from, skip_n;
    __device__ __forceinline__ bool next(int i, Unit& u) const {
        if (!StaticOrder::next(i, u)) return false;
        if (u.pn >= skip_from) u.pn += skip_n;
        return true;
    }
};
struct DualOrder {
    StaticOrder S0, S1; int skip_from, skip_n, G, c;
    __device__ __forceinline__ bool next(int i, Unit& u) const {
        const long L = (long)i * G + c;
        if (L < S0.nwg) { S0.map((int)L, u); if (u.pn >= skip_from) u.pn += skip_n; return true; }
        if (L - S0.nwg < S1.nwg) { S1.map((int)(L - S0.nwg), u); u.sel = 1; return true; }
        return false;
    }
    __device__ __forceinline__ void a_ready(const Unit&) const {}
    __device__ __forceinline__ void done(const Unit&) const {}
};

__device__ __forceinline__ unsigned cvt_pk_bf16(float lo, float hi) { unsigned r; asm volatile("v_cvt_pk_bf16_f32 %0, %1, %2" : "=v"(r) : "v"(lo), "v"(hi)); return r; }

struct EpiZ {
    static constexpr bool PERM = true, AFTER_DRAIN = false;
    bf16_t* O; int ldc; int skip_from, skip_n; float* colsq; int colsq_ld; bf16_t* O1; int ldc1; float* colsq1;
    __device__ __forceinline__ void operator()(const f32x4 (&acc)[2][2][4][2], const Unit& u, int wr, int wc, int fr, int fq) const {
        const int row0 = u.pm * BM + wr * 64 + fr; const int ct = u.sel ? u.pn : ((u.pn >= skip_from + skip_n) ? (u.pn - skip_n) : u.pn);
        const int col0 = ct * BM + wc * 32 + 8 * fq;
        bf16_t* const O = u.sel ? this->O1 : this->O; const int ldc = u.sel ? this->ldc1 : this->ldc; float* const colsq = u.sel ? this->colsq1 : this->colsq;
#pragma unroll
        for (int ai = 0; ai < 2; ++ai)
#pragma unroll
            for (int m = 0; m < 4; ++m) { bf16_t* rowp = O + (size_t)(row0 + ai * HALF + m * 16) * ldc + col0;
#pragma unroll
                for (int bj = 0; bj < 2; ++bj) { const f32x4 v0 = acc[ai][bj][m][0], v1 = acc[ai][bj][m][1];
                    u32x4 w; w.x = cvt_pk_bf16(v0[0], v0[1]); w.y = cvt_pk_bf16(v0[2], v0[3]); w.z = cvt_pk_bf16(v1[0], v1[1]); w.w = cvt_pk_bf16(v1[2], v1[3]);
                    *(u32x4*)(rowp + bj * HALF) = w; } }
        if (colsq) {
#pragma unroll
            for (int bj = 0; bj < 2; ++bj)
#pragma unroll
                for (int n = 0; n < 2; ++n) {
                    f32x4 ss = {0.f, 0.f, 0.f, 0.f};
#pragma unroll
                    for (int ai = 0; ai < 2; ++ai)
#pragma unroll
                        for (int m = 0; m < 4; ++m) ss += acc[ai][bj][m][n] * acc[ai][bj][m][n];
#pragma unroll
                    for (int o = 1; o < 16; o <<= 1) { ss[0] += __shfl_xor(ss[0], o); ss[1] += __shfl_xor(ss[1], o); ss[2] += __shfl_xor(ss[2], o); ss[3] += __shfl_xor(ss[3], o); }
                    if (fr == 0) *(f32x4*)(colsq + (size_t)(2 * u.pm + wr) * colsq_ld + ct * BM + bj * HALF + wc * 32 + 8 * fq + 4 * n) = ss;
                }
        }
    }
};
struct EpiRes {
    static constexpr bool PERM = false, AFTER_DRAIN = false;
    const float* xin; float* out;
    __device__ __forceinline__ void operator()(const f32x4 (&acc)[2][2][4][2], const Unit& u, int wr, int wc, int fr, int fq) const {
        const int row0 = u.pm * BM + wr * 64 + fr, col0 = u.pn * BM + wc * 32 + 4 * fq;
#pragma unroll
        for (int ai = 0; ai < 2; ++ai)
#pragma unroll
            for (int m = 0; m < 4; ++m) { const size_t ro = (size_t)(row0 + ai * HALF + m * 16) * 1024 + col0;
#pragma unroll
                for (int bj = 0; bj < 2; ++bj)
#pragma unroll
                    for (int n = 0; n < 2; ++n) { const f32x4 xv = *(const f32x4*)(xin + ro + bj * HALF + n * 16);
                        *(f32x4*)(out + ro + bj * HALF + n * 16) = acc[ai][bj][m][n] + xv; } }
    }
};

template <class Epi, class Sched>
__device__ __forceinline__ void gemm_phase(PG8_LAS unsigned char* lds, const Gemm g, const Sched& S, const Epi& E) {
    int tid = threadIdx.x; asm volatile("" : "+v"(tid));
    const int wid = __builtin_amdgcn_readfirstlane(tid >> 6), lane = tid & 63, wr = wid >> 2, wc = wid & 3, fr = lane & 15, fq = lane >> 4;
    const int K = g.K, nt = K / BK;
    const char* gA = (const char*)g.A; const char* gB = (const char*)g.Bt; const char* gA1 = (const char*)g.A1; const char* gB1 = (const char*)g.Bt1; asm volatile("" : "+s"(gA), "+s"(gB), "+s"(gA1), "+s"(gB1));
    unsigned voffA[2], voffB[2];
#pragma unroll
    for (int i = 0; i < 2; ++i) { int R, C; stage_rc(tid * 16 + i * 8192, R, C); const int Rb = Epi::PERM ? ((R & ~31) + perm32(R & 31)) : R;
        voffA[i] = (unsigned)(R * K + C) * 2u; voffB[i] = (unsigned)(Rb * K + C) * 2u; }
    const size_t kstep = (size_t)(BK * 2);
    const size_t hstep = (size_t)HALF * K * 2;
    const size_t tstep = 2 * hstep;
    const unsigned ldsw = (unsigned)wid * 1024u;
    const int aoff = lds_byte(wr * 64 + fr, fq * 8), boff = lds_byte(wc * 32 + fr, fq * 8);
#define PG8_SA(b, h) (((b) * 2 + (h)) * HTB)
#define PG8_SB(b, h) ((4 + (b) * 2 + (h)) * HTB)
#define PG8_STAGE(bufoff, gbase, voff) do { _Pragma("unroll") for (int _i = 0; _i < 2; ++_i) \
        __builtin_amdgcn_global_load_lds((const unsigned*)((const char*)(gbase) + (voff)[_i]), (PG8_LAS unsigned*)(lds + (bufoff) + ldsw + _i * 8192), 16, 0, 0); } while (0)
#define PG8_LDA(dst, b, h) do { _Pragma("unroll") for (int m = 0; m < 4; ++m) _Pragma("unroll") for (int k = 0; k < 2; ++k) dst[m][k] = *(const PG8_LAS bf16x8*)(lds + PG8_SA(b, h) + aoff + m * 2048 + k * 1024); } while (0)
#define PG8_LDB(dst, b, h) do { _Pragma("unroll") for (int n = 0; n < 2; ++n) _Pragma("unroll") for (int k = 0; k < 2; ++k) dst[n][k] = *(const PG8_LAS bf16x8*)(lds + PG8_SB(b, h) + boff + n * 2048 + k * 1024); } while (0)
#define PG8_MMA(ai, bj, At, Bt) do { __builtin_amdgcn_s_setprio(1); _Pragma("unroll") for (int m = 0; m < 4; ++m) _Pragma("unroll") for (int n = 0; n < 2; ++n) _Pragma("unroll") for (int k = 0; k < 2; ++k) \
        acc[ai][bj][m][n] = __builtin_amdgcn_mfma_f32_16x16x32_bf16(Bt[n][k], At[m][k], acc[ai][bj][m][n], 0, 0, 0); __builtin_amdgcn_s_setprio(0); } while (0)
#define PG8_WAIT_V(n) asm volatile("s_waitcnt vmcnt(" #n ")" ::: "memory")
#define PG8_WAIT_L(n) asm volatile("s_waitcnt lgkmcnt(" #n ")" ::: "memory")
#define PG8_BAR __builtin_amdgcn_s_barrier()
#define PG8_SCHED __builtin_amdgcn_sched_barrier(0)
    Unit cur, nxt; int ui = 0;
    if (!S.next(0, cur)) return;
    f32x4 acc[2][2][4][2];
#pragma unroll
    for (int a = 0; a < 2; ++a)
#pragma unroll
        for (int b = 0; b < 2; ++b)
#pragma unroll
            for (int m = 0; m < 4; ++m)
#pragma unroll
                for (int n = 0; n < 2; ++n) acc[a][b][m][n] = (f32x4){0.f, 0.f, 0.f, 0.f};
    bf16x8 At[4][2], B0[2][2], B1[2][2];
    const char* cA = (cur.sel ? gA1 : gA) + (size_t)cur.pm * tstep; const char* cB = (cur.sel ? gB1 : gB) + (size_t)cur.pn * tstep;
    S.a_ready(cur);
    PG8_STAGE(PG8_SB(0, 0), cB, voffB); PG8_STAGE(PG8_SA(0, 0), cA, voffA); PG8_STAGE(PG8_SB(0, 1), cB + hstep, voffB); PG8_STAGE(PG8_SA(0, 1), cA + hstep, voffA);
    if (wr == 1) PG8_BAR;
    PG8_WAIT_V(4); PG8_BAR;
    PG8_STAGE(PG8_SB(1, 0), cB + kstep, voffB); PG8_STAGE(PG8_SA(1, 0), cA + kstep, voffA); PG8_STAGE(PG8_SB(1, 1), cB + hstep + kstep, voffB);
    PG8_WAIT_V(6); PG8_BAR;
    for (;;) {
        const bool has_next = S.next(ui + 1, nxt);
        const char* nA = has_next ? (nxt.sel ? gA1 : gA) + (size_t)nxt.pm * tstep : cA; const char* nB = has_next ? (nxt.sel ? gB1 : gB) + (size_t)nxt.pn * tstep : cB;
        for (int t = 0; t < nt; t += 2) {
            const bool last = (t == nt - 2);
            const char* a1 = cA + (size_t)(t + 1) * kstep;
            const char* a2 = last ? nA : cA + (size_t)(t + 2) * kstep; const char* b2 = last ? nB : cB + (size_t)(t + 2) * kstep;
            const char* a3 = a2 + kstep; const char* b3 = b2 + kstep;
            if (last && has_next) S.a_ready(nxt);
            PG8_LDB(B0, 0, 0); PG8_SCHED; PG8_LDA(At, 0, 0); PG8_STAGE(PG8_SA(1, 1), a1 + hstep, voffA);
            PG8_WAIT_L(8); PG8_BAR; PG8_WAIT_L(0); PG8_MMA(0, 0, At, B0); PG8_BAR; PG8_SCHED;
            PG8_LDB(B1, 0, 1); PG8_STAGE(PG8_SB(0, 0), b2, voffB);
            PG8_BAR; PG8_WAIT_L(0); PG8_MMA(0, 1, At, B1); PG8_BAR;
            PG8_LDA(At, 0, 1); PG8_STAGE(PG8_SA(0, 0), a2, voffA);
            PG8_BAR; PG8_WAIT_L(0); PG8_MMA(1, 0, At, B0); PG8_BAR; PG8_SCHED;
            PG8_STAGE(PG8_SB(0, 1), b2 + hstep, voffB);
            PG8_WAIT_V(6); PG8_BAR; PG8_MMA(1, 1, At, B1); PG8_BAR;
            PG8_LDB(B0, 1, 0); PG8_SCHED; PG8_LDA(At, 1, 0); PG8_STAGE(PG8_SA(0, 1), a2 + hstep, voffA);
            PG8_WAIT_L(8); PG8_BAR; PG8_WAIT_L(0); PG8_MMA(0, 0, At, B0); PG8_BAR; PG8_SCHED;
            PG8_LDB(B1, 1, 1); PG8_STAGE(PG8_SB(1, 0), b3, voffB);
            PG8_BAR; PG8_WAIT_L(0); PG8_MMA(0, 1, At, B1); PG8_BAR;
            PG8_LDA(At, 1, 1); PG8_STAGE(PG8_SA(1, 0), a3, voffA);
            PG8_BAR; PG8_WAIT_L(0); PG8_MMA(1, 0, At, B0); PG8_BAR; PG8_SCHED;
            PG8_STAGE(PG8_SB(1, 1), b3 + hstep, voffB);
            PG8_WAIT_V(6); PG8_BAR; PG8_MMA(1, 1, At, B1); PG8_BAR;
        }
        if constexpr (!Epi::AFTER_DRAIN) { E(acc, cur, wr, wc, fr, fq); S.done(cur); }
        if (!has_next) break;
#pragma unroll
        for (int a = 0; a < 2; ++a)
#pragma unroll
            for (int b = 0; b < 2; ++b)
#pragma unroll
                for (int m = 0; m < 4; ++m)
#pragma unroll
                    for (int n = 0; n < 2; ++n) acc[a][b][m][n] = (f32x4){0.f, 0.f, 0.f, 0.f};
        cur = nxt; cA = nA; cB = nB; ++ui;
    }
    PG8_WAIT_V(0);
    if (wr == 0) PG8_BAR;
    PG8_BAR;
    if constexpr (Epi::AFTER_DRAIN) { E.fused(acc, cur, wr, wc, fr, fq, lds, wid, lane); S.done(cur); }
#undef PG8_SA
#undef PG8_SB
#undef PG8_STAGE
#undef PG8_LDA
#undef PG8_LDB
#undef PG8_MMA
#undef PG8_WAIT_V
#undef PG8_WAIT_L
#undef PG8_BAR
#undef PG8_SCHED
}
}

#define XB_TMO      128
#define XB_XCNT(j)  (256  + 64 * (j))
#define XB_XSUB(j)  (1280 + 64 * (j))
#define XB_XGEN(j)  (2304 + 64 * (j))
#define XB_TOP      3328
#define XB_TOPGEN   3392
#define XCD_BAR_WORDS 3456
#define XB_SPIN_CAP (1u << 18)
#define LAS __attribute__((address_space(3)))

__device__ __forceinline__ unsigned xb_ld(unsigned* p)              { return __hip_atomic_load(p, __ATOMIC_RELAXED, __HIP_MEMORY_SCOPE_AGENT); }
__device__ __forceinline__ unsigned xb_add(unsigned* p, unsigned v) { return __hip_atomic_fetch_add(p, v, __ATOMIC_RELAXED, __HIP_MEMORY_SCOPE_AGENT); }
__device__ __forceinline__ unsigned xb_xcc_id() { return (unsigned)__builtin_amdgcn_s_getreg((3 << 11) | 20) & 0xFu; }
#define XB_SPIN(cond, bar) do { unsigned _sp = 0; while (cond) { __builtin_amdgcn_s_sleep(1); \
    if ((++_sp & 255u) == 0u) { if (xb_ld(&(bar)[XB_TMO])) break; if (_sp > XB_SPIN_CAP) { atomicAdd(&(bar)[XB_TMO], 1u); break; } } } } while (0)

struct XcdBarrier {
    unsigned* bar; unsigned x;
    volatile LAS unsigned* st;
};

__device__ __forceinline__ XcdBarrier xcd_barrier_post(unsigned* bar, volatile LAS unsigned* st) {
    XcdBarrier b; b.bar = bar; b.x = xb_xcc_id(); b.st = st;
    if (threadIdx.x == 0) (void)xb_add(&bar[XB_XCNT(b.x)], 1u);
    return b;
}
__device__ __forceinline__ void xcd_barrier_complete(unsigned* bar, unsigned x, unsigned& nloc, unsigned& nx) {
    const unsigned G = gridDim.x * gridDim.y * gridDim.z;
    unsigned sum, cnt, mine, sp = 0u;
    for (;;) {
        sum = 0u; cnt = 0u; mine = 0u;
#pragma unroll
        for (unsigned j = 0; j < 16; ++j) { const unsigned c = xb_ld(&bar[XB_XCNT(j)]); sum += c; cnt += (c > 0u) ? 1u : 0u; mine = (j == x) ? c : mine; }
        if (sum == G) break;
        __builtin_amdgcn_s_sleep(1);
        if ((++sp & 255u) == 0u) { if (xb_ld(&bar[XB_TMO])) break; if (sp > XB_SPIN_CAP) { atomicAdd(&bar[XB_TMO], 1u); break; } }
    }
    nloc = mine > 0u ? mine : 1u; nx = cnt > 0u ? cnt : 1u;
}

__device__ __forceinline__ void xcd_barrier(const XcdBarrier& b) {
    asm volatile("s_waitcnt vmcnt(0)" ::: "memory");
    __syncthreads();
    if (threadIdx.x == 0) {
        unsigned* bar = b.bar;
        __builtin_amdgcn_s_waitcnt(0);
        unsigned nloc = b.st[0], nx = b.st[1];
        if (nloc == 0u) { xcd_barrier_complete(bar, b.x, nloc, nx); b.st[0] = nloc; b.st[1] = nx; }
        const unsigned old = xb_add(&bar[XB_XSUB(b.x)], 1u);
        const unsigned gen = old / nloc;
        if (old + 1u == (gen + 1u) * nloc) {
            __builtin_amdgcn_fence(__ATOMIC_RELEASE, "agent");
            asm volatile("s_waitcnt vmcnt(0)" ::: "memory");
            const unsigned og = xb_add(&bar[XB_TOP], 1u);
            const unsigned tg = og / nx;
            if (og + 1u == (tg + 1u) * nx) xb_add(&bar[XB_TOPGEN], 1u);
            else XB_SPIN(xb_ld(&bar[XB_TOPGEN]) == tg, bar);
            __builtin_amdgcn_fence(__ATOMIC_ACQUIRE, "agent");
            xb_add(&bar[XB_XGEN(b.x)], 1u);
            asm volatile("s_waitcnt vmcnt(0)" ::: "memory");
        } else {
            XB_SPIN(xb_ld(&bar[XB_XGEN(b.x)]) == gen, bar);
            __builtin_amdgcn_fence(__ATOMIC_ACQUIRE, "agent");
            asm volatile("s_waitcnt vmcnt(0)" ::: "memory");
        }
    }
    __syncthreads();
}

using pg8::bf16_t; using pg8::bf16x8; using pg8::f32x4;
typedef unsigned u32x2_t __attribute__((ext_vector_type(2)));
typedef unsigned u32x4_t __attribute__((ext_vector_type(4)));

constexpr int DM = 1024, SEG = 16384, LDZ = 8192, LDY = 2560;
constexpr float EPS = 1e-6f;
constexpr int XST_OFF = 9 * 16384 + 2048;
constexpr int LDS_BYTES = XST_OFF + 64;
constexpr size_t WS_WIN_E = 0;
constexpr size_t WS_WIN_O = WS_WIN_E + (size_t)9216 * 1024 * 2;
constexpr size_t WS_WOUT_E = WS_WIN_O + (size_t)6144 * 1024 * 2;
constexpr size_t WS_WOUT_O = WS_WOUT_E + (size_t)1024 * 2560 * 2;
constexpr size_t WS_WKV = WS_WOUT_O + (size_t)1024 * 2560 * 2;
constexpr size_t WS_LRUW = WS_WKV + (size_t)2 * 1024 * 1024 * 2;
constexpr size_t WS_SGUW = WS_LRUW + (size_t)2 * 2 * 8 * 128 * 128 * 2;
constexpr size_t WS_MEMN = WS_SGUW + (size_t)8 * 128 * 128 * 2;
constexpr size_t WS_MK = WS_MEMN + (size_t)2 * 1536 * 1024 * 2;
constexpr size_t WS_MVT = WS_MK + (size_t)2 * 1536 * 512 * 2;
constexpr size_t WS_H = WS_MVT + (size_t)2 * 512 * 1536 * 2;
constexpr size_t WS_Z = WS_H + (size_t)SEG * 1024 * 2;
constexpr size_t WS_VT = WS_Z + (size_t)SEG * LDZ * 2;
constexpr size_t WS_Y = WS_VT + (size_t)1024 * SEG * 2;
constexpr size_t WS_AGG = WS_Y + (size_t)SEG * LDY * 2;
constexpr size_t WS_CARRY = WS_AGG + (size_t)2 * 128 * 1024 * 2 * 4;
constexpr size_t WS_RSTD = WS_CARRY + (size_t)2 * 128 * 1024 * 4;
constexpr size_t WS_PART = WS_RSTD + (size_t)SEG * 4;
constexpr size_t WS_BAR = WS_PART + (size_t)8 * SEG * 4;
constexpr size_t WS_LAB = WS_BAR + 16384;
constexpr size_t WS_END = WS_LAB + (size_t)2 * SEG * 1024 * 4;

struct Params { const float* in[25]; float* out; unsigned char* ws; };

__device__ __forceinline__ float bf2f(unsigned short b) { return __uint_as_float(((unsigned)b) << 16); }
__device__ __forceinline__ unsigned short f2bf(float f) { unsigned u = __float_as_uint(f); u += 0x7FFFu + ((u >> 16) & 1u); return (unsigned short)(u >> 16); }
__device__ __forceinline__ float bflo(unsigned w) { return __uint_as_float(w << 16); }
__device__ __forceinline__ float bfhi(unsigned w) { return __uint_as_float(w & 0xffff0000u); }
__device__ __forceinline__ unsigned pk2(float lo, float hi) { return pg8::cvt_pk_bf16(lo, hi); }
__device__ __forceinline__ float frcp(float x) { return __builtin_amdgcn_rcpf(x); }
__device__ __forceinline__ float silu(float x) { return x * frcp(1.0f + __expf(-x)); }
__device__ __forceinline__ float sigm(float x) { return frcp(1.0f + __expf(-x)); }
__device__ __forceinline__ float wave_sum(float v) {
#pragma unroll
    for (int o = 1; o < 64; o <<= 1) v += __shfl_xor(v, o);
    return v;
}
__device__ __forceinline__ f32x4 mfma16(bf16x8 a, bf16x8 b, f32x4 c) { return __builtin_amdgcn_mfma_f32_16x16x32_bf16(a, b, c, 0, 0, 0); }
__device__ __forceinline__ bf16x8 ld8(const bf16_t* p) { return *(const bf16x8*)p; }
__device__ __forceinline__ bf16x8 pack8(const float (&v)[8]) {
    u32x4_t w; w.x = pk2(v[0], v[1]); w.y = pk2(v[2], v[3]); w.z = pk2(v[4], v[5]); w.w = pk2(v[6], v[7]);
    return __builtin_bit_cast(bf16x8, w);
}

__device__ __forceinline__ void transpose_item(const float* W, int K, int N, bf16_t* WT, LAS float* scr, int item, int lane) {
    const int nblk = N >> 5, kb = item / nblk, nb = item - kb * nblk, k0 = 64 * kb, n0 = 32 * nb;
#pragma unroll 8
    for (int i = 0; i < 32; ++i) { const int kk = 2 * i + (lane >> 5); scr[kk * 33 + (lane & 31)] = W[(size_t)(k0 + kk) * N + n0 + (lane & 31)]; }
    asm volatile("s_waitcnt lgkmcnt(0)" ::: "memory");
    const int c = lane & 7;
#pragma unroll
    for (int j = 0; j < 4; ++j) { const int n = (lane >> 3) + 8 * j; const LAS float* s = scr + (8 * c) * 33 + n;
        u32x4_t o; o.x = pk2(s[0 * 33], s[1 * 33]); o.y = pk2(s[2 * 33], s[3 * 33]); o.z = pk2(s[4 * 33], s[5 * 33]); o.w = pk2(s[6 * 33], s[7 * 33]);
        *(u32x4_t*)(WT + (size_t)(n0 + n) * K + k0 + 8 * c) = o; }
    asm volatile("s_waitcnt lgkmcnt(0)" ::: "memory");
}

__device__ __forceinline__ void rms_row_bf16(const float* xrow, const float* g, bf16_t* orow, int lane) {
    const f32x4* xr = (const f32x4*)xrow + lane; f32x4 v[4]; float s = 0.f;
#pragma unroll
    for (int j = 0; j < 4; ++j) { v[j] = xr[64 * j]; s += (v[j].x * v[j].x + v[j].y * v[j].y) + (v[j].z * v[j].z + v[j].w * v[j].w); }
    const float rstd = __builtin_amdgcn_rsqf(wave_sum(s) * (1.0f / 1024.0f) + EPS);
    const f32x4* gr = (const f32x4*)g + lane; u32x2_t* o8 = (u32x2_t*)orow + lane;
#pragma unroll
    for (int j = 0; j < 4; ++j) { const f32x4 gg = gr[64 * j]; u32x2_t o; o.x = pk2(v[j].x * rstd * gg.x, v[j].y * rstd * gg.y); o.y = pk2(v[j].z * rstd * gg.z, v[j].w * rstd * gg.w); o8[64 * j] = o; }
}
__device__ __forceinline__ void rms_row_f32(float* xrow, const float* g, int lane) {
    f32x4* xr = (f32x4*)xrow + lane; f32x4 v[4]; float s = 0.f;
#pragma unroll
    for (int j = 0; j < 4; ++j) { v[j] = xr[64 * j]; s += (v[j].x * v[j].x + v[j].y * v[j].y) + (v[j].z * v[j].z + v[j].w * v[j].w); }
    const float rstd = __builtin_amdgcn_rsqf(wave_sum(s) * (1.0f / 1024.0f) + EPS);
    const f32x4* gr = (const f32x4*)g + lane;
#pragma unroll
    for (int j = 0; j < 4; ++j) { const f32x4 gg = gr[64 * j]; f32x4 o; o.x = v[j].x * rstd * gg.x; o.y = v[j].y * rstd * gg.y; o.z = v[j].z * rstd * gg.z; o.w = v[j].w * rstd * gg.w; xr[64 * j] = o; }
}

__device__ __forceinline__ void rms_rows4_bf16(const float* xrow, const float* g, bf16_t* orow, int lane) {
    f32x4 v[4][4]; float s[4];
#pragma unroll
    for (int r = 0; r < 4; ++r)
#pragma unroll
        for (int j = 0; j < 4; ++j) v[r][j] = ((const f32x4*)(xrow + (size_t)r * 1024))[lane + 64 * j];
    f32x4 gg[4];
#pragma unroll
    for (int j = 0; j < 4; ++j) gg[j] = ((const f32x4*)g)[lane + 64 * j];
#pragma unroll
    for (int r = 0; r < 4; ++r) { s[r] = 0.f;
#pragma unroll
        for (int j = 0; j < 4; ++j) s[r] += (v[r][j].x * v[r][j].x + v[r][j].y * v[r][j].y) + (v[r][j].z * v[r][j].z + v[r][j].w * v[r][j].w); }
#pragma unroll
    for (int o = 1; o < 64; o <<= 1) {
#pragma unroll
        for (int r = 0; r < 4; ++r) s[r] += __shfl_xor(s[r], o); }
#pragma unroll
    for (int r = 0; r < 4; ++r) { const float rstd = __builtin_amdgcn_rsqf(s[r] * (1.0f / 1024.0f) + EPS);
        u32x2_t* o8 = (u32x2_t*)(orow + (size_t)r * 1024) + lane;
#pragma unroll
        for (int j = 0; j < 4; ++j) { u32x2_t o; o.x = pk2(v[r][j].x * rstd * gg[j].x, v[r][j].y * rstd * gg[j].y); o.y = pk2(v[r][j].z * rstd * gg[j].z, v[r][j].w * rstd * gg[j].w); o8[64 * j] = o; } }
}
__device__ __forceinline__ void rms_rows4_f32(float* xrow, const float* g, int lane) {
    f32x4 v[4][4]; float s[4];
#pragma unroll
    for (int r = 0; r < 4; ++r)
#pragma unroll
        for (int j = 0; j < 4; ++j) v[r][j] = ((const f32x4*)(xrow + (size_t)r * 1024))[lane + 64 * j];
    f32x4 gg[4];
#pragma unroll
    for (int j = 0; j < 4; ++j) gg[j] = ((const f32x4*)g)[lane + 64 * j];
#pragma unroll
    for (int r = 0; r < 4; ++r) { s[r] = 0.f;
#pragma unroll
        for (int j = 0; j < 4; ++j) s[r] += (v[r][j].x * v[r][j].x + v[r][j].y * v[r][j].y) + (v[r][j].z * v[r][j].z + v[r][j].w * v[r][j].w); }
#pragma unroll
    for (int o = 1; o < 64; o <<= 1) {
#pragma unroll
        for (int r = 0; r < 4; ++r) s[r] += __shfl_xor(s[r], o); }
#pragma unroll
    for (int r = 0; r < 4; ++r) { const float rstd = __builtin_amdgcn_rsqf(s[r] * (1.0f / 1024.0f) + EPS);
        f32x4* xo = (f32x4*)(xrow + (size_t)r * 1024) + lane;
#pragma unroll
        for (int j = 0; j < 4; ++j) { f32x4 o; o.x = v[r][j].x * rstd * gg[j].x; o.y = v[r][j].y * rstd * gg[j].y; o.z = v[r][j].z * rstd * gg[j].z; o.w = v[r][j].w * rstd * gg[j].w; xo[64 * j] = o; } }
}

__device__ __forceinline__ void conv_even_item(const bf16_t* z, const float* cw, const float* cb, bf16_t* y, int t0, int T, int lane) {
    const int s = t0 & (T - 1);
#pragma unroll
    for (int half = 0; half < 2; ++half) {
        const int c0 = half * 512 + lane * 8;
        const bf16_t* zr = z + (size_t)t0 * LDZ + c0;
        u32x4_t cg[4], xv[4], bg[2], ga[2];
#pragma unroll
        for (int i = 0; i < 4; ++i) { cg[i] = (u32x4_t){0u, 0u, 0u, 0u}; xv[i] = (u32x4_t){0u, 0u, 0u, 0u}; }
        if (s > 0) { cg[0] = *(const u32x4_t*)(zr - LDZ + 1024); xv[0] = *(const u32x4_t*)(zr - LDZ + 2048); }
        cg[1] = *(const u32x4_t*)(zr + 1024); xv[1] = *(const u32x4_t*)(zr + 2048);
        cg[2] = *(const u32x4_t*)(zr + LDZ + 1024); xv[2] = *(const u32x4_t*)(zr + LDZ + 2048);
        if (s + 2 < T) { cg[3] = *(const u32x4_t*)(zr + 2 * LDZ + 1024); xv[3] = *(const u32x4_t*)(zr + 2 * LDZ + 2048); }
        bg[0] = *(const u32x4_t*)(zr); ga[0] = *(const u32x4_t*)(zr + 3072);
        bg[1] = *(const u32x4_t*)(zr + LDZ); ga[1] = *(const u32x4_t*)(zr + LDZ + 3072);
        float w0[8], w1[8], w2[8], bb[8];
#pragma unroll
        for (int e = 0; e < 8; e += 4) {
            const f32x4 a = *(const f32x4*)(cw + c0 + e), b = *(const f32x4*)(cw + 1024 + c0 + e), c = *(const f32x4*)(cw + 2048 + c0 + e), d = *(const f32x4*)(cb + c0 + e);
#pragma unroll
            for (int k = 0; k < 4; ++k) { w0[e + k] = a[k]; w1[e + k] = b[k]; w2[e + k] = c[k]; bb[e + k] = d[k]; }
        }
        float p[4][8];
#pragma unroll
        for (int i = 0; i < 4; ++i)
#pragma unroll
            for (int k = 0; k < 4; ++k) { p[i][2 * k] = bflo(cg[i][k]) * bflo(xv[i][k]); p[i][2 * k + 1] = bfhi(cg[i][k]) * bfhi(xv[i][k]); }
#pragma unroll
        for (int tt = 0; tt < 2; ++tt) {
            float o[8];
#pragma unroll
            for (int k = 0; k < 4; ++k) {
                const float cl = bb[2 * k] + w0[2 * k] * p[tt][2 * k] + w1[2 * k] * p[tt + 1][2 * k] + w2[2 * k] * p[tt + 2][2 * k];
                const float ch = bb[2 * k + 1] + w0[2 * k + 1] * p[tt][2 * k + 1] + w1[2 * k + 1] * p[tt + 1][2 * k + 1] + w2[2 * k + 1] * p[tt + 2][2 * k + 1];
                o[2 * k] = bflo(bg[tt][k]) * cl * silu(bflo(ga[tt][k]));
                o[2 * k + 1] = bfhi(bg[tt][k]) * ch * silu(bfhi(ga[tt][k]));
            }
            u32x4_t w; w.x = pk2(o[0], o[1]); w.y = pk2(o[2], o[3]); w.z = pk2(o[4], o[5]); w.w = pk2(o[6], o[7]);
            *(u32x4_t*)(y + (size_t)(t0 + tt) * LDY + c0) = w;
        }
    }
}

__device__ __forceinline__ void conv_odd_item(const bf16_t* z, const float* cw, const float* cb, bf16_t* xc, int t, int T, int lane) {
    const int s = t & (T - 1);
#pragma unroll
    for (int half = 0; half < 2; ++half) {
        const int c0 = half * 512 + lane * 8;
        const bf16_t* zr = z + (size_t)t * LDZ + c0;
        float acc[8];
#pragma unroll
        for (int e = 0; e < 8; e += 4) { const f32x4 d = *(const f32x4*)(cb + c0 + e); acc[e] = d[0]; acc[e + 1] = d[1]; acc[e + 2] = d[2]; acc[e + 3] = d[3]; }
#pragma unroll
        for (int j = 0; j < 4; ++j) {
            const int sj = s + j - 2;
            if (sj >= 0 && sj < T) {
                const u32x4_t xv = *(const u32x4_t*)(zr + (ptrdiff_t)(j - 2) * LDZ);
                const f32x4 wa = *(const f32x4*)(cw + j * 1024 + c0), wb = *(const f32x4*)(cw + j * 1024 + c0 + 4);
                acc[0] += wa[0] * bflo(xv[0]); acc[1] += wa[1] * bfhi(xv[0]); acc[2] += wa[2] * bflo(xv[1]); acc[3] += wa[3] * bfhi(xv[1]);
                acc[4] += wb[0] * bflo(xv[2]); acc[5] += wb[1] * bfhi(xv[2]); acc[6] += wb[2] * bflo(xv[3]); acc[7] += wb[3] * bfhi(xv[3]);
            }
        }
        u32x4_t w; w.x = pk2(acc[0], acc[1]); w.y = pk2(acc[2], acc[3]); w.z = pk2(acc[4], acc[5]); w.w = pk2(acc[6], acc[7]);
        *(u32x4_t*)(xc + (size_t)t * 1024 + c0) = w;
    }
}
__device__ __forceinline__ void rstd_item(const float* part, float* rstd, int tg, int lane) {
    const float* p = part + tg * 64 + lane; float s = 0.f;
#pragma unroll
    for (int i = 0; i < 8; ++i) s += p[(size_t)i * SEG];
    rstd[tg * 64 + lane] = __builtin_amdgcn_rsqf(s * (1.0f / 1024.0f) + EPS);
}

constexpr int NA_RING = 9 * 16384, NA_RPB = NA_RING, NA_LDS_END = NA_RING + 2048;
__device__ __forceinline__ int na_fk(int key) { return ((key >> 1) & 1) | (((key >> 3) & 3) << 1); }
__device__ __forceinline__ void na_stage_row(const bf16_t* z, const bf16_t* vT, LAS unsigned char* slot, int tokr, int h, int lt, int nth) {
    for (int idx = lt; idx < 512; idx += nth) {
        const int rw = idx >> 3, c = idx & 7;
        const u32x4_t kv = *(const u32x4_t*)(z + (size_t)(tokr + rw) * LDZ + 5120 + h * 64 + c * 8);
        const u32x4_t vv = *(const u32x4_t*)(vT + (size_t)(h * 64 + rw) * SEG + tokr + c * 8);
        *(LAS u32x4_t*)(slot + rw * 128 + ((c ^ na_fk(rw)) << 4)) = kv;
        *(LAS u32x4_t*)(slot + 8192 + rw * 128 + ((c ^ ((rw >> 1) & 7)) << 4)) = vv;
    }
}
__device__ __forceinline__ void na_block(const bf16_t* z, const bf16_t* vT, bf16_t* y, const float* rpb, int unit, int T, LAS unsigned char* lds, int tid) {
    const int h = unit & 15, R0 = (unit >> 4) * 16;
    const int rows = T >> 6, seq = R0 / rows, rr0 = R0 - seq * rows, seq_base = seq * T;
    const int lane = tid & 63, wid = tid >> 6, fr = lane & 15, fq = lane >> 4;
    LAS float* rpbL = (LAS float*)(lds + NA_RPB);
    __syncthreads();
    for (int i = tid; i < 465; i += 512) rpbL[i] = rpb[h * 465 + i];
    int rs0 = rr0 - 4; rs0 = rs0 < 0 ? 0 : rs0; rs0 = rs0 > rows - 8 ? rows - 8 : rs0;
    {
        const int rw = tid >> 3, c = tid & 7;
        u32x4_t kv[8], vv[8];
#pragma unroll
        for (int kr = 0; kr < 8; ++kr) { const int tokr = seq_base + (rs0 + kr) * 64;
            kv[kr] = *(const u32x4_t*)(z + (size_t)(tokr + rw) * LDZ + 5120 + h * 64 + c * 8);
            vv[kr] = *(const u32x4_t*)(vT + (size_t)(h * 64 + rw) * SEG + tokr + c * 8); }
#pragma unroll
        for (int kr = 0; kr < 8; ++kr) { LAS unsigned char* slot = lds + ((rs0 + kr) % 9) * 16384;
            *(LAS u32x4_t*)(slot + rw * 128 + ((c ^ na_fk(rw)) << 4)) = kv[kr];
            *(LAS u32x4_t*)(slot + 8192 + rw * 128 + ((c ^ ((rw >> 1) & 7)) << 4)) = vv[kr]; }
    }
    __syncthreads();
    const int g = wid & 3;
    const int wb = (g == 0) ? 0 : (g == 1) ? 8 : (g == 2) ? 24 : 32;
    const int keyA = wb + (fr >> 2) * 8 + (fr & 3);
    const int offK0 = keyA * 128 + (((0 + fq) ^ na_fk(keyA)) << 4), offK1 = keyA * 128 + (((4 + fq) ^ na_fk(keyA)) << 4);
    const int offV = 8192 + fr * 128 + ((((wb >> 3) + fq) ^ ((fr >> 1) & 7)) << 4);
    const int qc = g * 16 + fr;
    int cstart = qc - 8; cstart = cstart < 0 ? 0 : cstart; cstart = cstart > 48 ? 48 : cstart;
    int dcs[8]; bool oks[8];
#pragma unroll
    for (int e = 0; e < 8; ++e) { const int kc = wb + fq * 8 + e; oks[e] = (kc >= cstart) && (kc < cstart + 16); int dc = kc - qc; dc = dc < -15 ? -15 : dc; dc = dc > 15 ? 15 : dc; dcs[e] = dc + 15; }
    const bf16_t* zt = z + (size_t)(seq_base + rr0 * 64 + g * 16 + fr) * LDZ;
    bf16x8 q0 = ld8(zt + 4096 + h * 64 + fq * 8), q1 = ld8(zt + 4096 + h * 64 + fq * 8 + 32);
    u32x2_t gr[4];
#pragma unroll
    for (int dt = 0; dt < 4; ++dt) gr[dt] = *(const u32x2_t*)(zt + 6144 + h * 64 + dt * 16 + fq * 4);
#pragma unroll 1
    for (int i = 0; i < 16; ++i) {
        const int rr = rr0 + i;
        int rs = rr - 4; rs = rs < 0 ? 0 : rs; rs = rs > rows - 8 ? rows - 8 : rs;
        int rsn = rr - 3; rsn = rsn < 0 ? 0 : rsn; rsn = rsn > rows - 8 ? rows - 8 : rsn;
        if (wid >= 4) {
            if (i < 15 && rsn > rs) { const int a = rsn + 7; na_stage_row(z, vT, lds + (a % 9) * 16384, seq_base + a * 64, h, tid - 256, 256); }
        } else {
            const bf16_t* ztc = zt + (size_t)i * 64 * LDZ;
            bf16x8 q0n = q0, q1n = q1; u32x2_t grn[4];
#pragma unroll
            for (int dt = 0; dt < 4; ++dt) grn[dt] = gr[dt];
            if (i < 15) {
                const bf16_t* ztn = ztc + (size_t)64 * LDZ;
                q0n = ld8(ztn + 4096 + h * 64 + fq * 8); q1n = ld8(ztn + 4096 + h * 64 + fq * 8 + 32);
#pragma unroll
                for (int dt = 0; dt < 4; ++dt) grn[dt] = *(const u32x2_t*)(ztn + 6144 + h * 64 + dt * 16 + fq * 4);
            }
            const LAS float* bp0 = rpbL + (rs - rr + 7) * 31;
            float s[8][8];
            float mx = -1e30f;
            int slot = rs % 9;
#pragma unroll
            for (int kr = 0; kr < 8; ++kr) {
                const LAS unsigned char* sb = lds + slot * 16384;
                slot = (slot == 8) ? 0 : slot + 1;
                const bf16x8 k00 = *(const LAS bf16x8*)(sb + offK0), k01 = *(const LAS bf16x8*)(sb + offK1);
                const bf16x8 k10 = *(const LAS bf16x8*)(sb + offK0 + 512), k11 = *(const LAS bf16x8*)(sb + offK1 + 512);
                f32x4 a0 = {0.f, 0.f, 0.f, 0.f}, a1 = {0.f, 0.f, 0.f, 0.f};
                a0 = mfma16(k00, q0, a0); a0 = mfma16(k01, q1, a0);
                a1 = mfma16(k10, q0, a1); a1 = mfma16(k11, q1, a1);
#pragma unroll
                for (int e = 0; e < 8; ++e) {
                    const float sc = (e < 4 ? a0[e & 3] : a1[e & 3]) * 0.125f + bp0[kr * 31 + dcs[e]];
                    s[kr][e] = oks[e] ? sc : -1e30f;
                    mx = fmaxf(mx, s[kr][e]);
                }
            }
            mx = fmaxf(mx, __shfl_xor(mx, 16)); mx = fmaxf(mx, __shfl_xor(mx, 32));
            float sum = 0.f;
#pragma unroll
            for (int kr = 0; kr < 8; ++kr)
#pragma unroll
                for (int e = 0; e < 8; ++e) { const float p = __expf(s[kr][e] - mx); s[kr][e] = p; sum += p; }
            sum += __shfl_xor(sum, 16); sum += __shfl_xor(sum, 32);
            f32x4 o[4];
#pragma unroll
            for (int dt = 0; dt < 4; ++dt) o[dt] = (f32x4){0.f, 0.f, 0.f, 0.f};
            slot = rs % 9;
#pragma unroll
            for (int kr = 0; kr < 8; ++kr) {
                const LAS unsigned char* sb = lds + slot * 16384 + offV;
                slot = (slot == 8) ? 0 : slot + 1;
                const bf16x8 pf = pack8(s[kr]);
#pragma unroll
                for (int dt = 0; dt < 4; ++dt) o[dt] = mfma16(*(const LAS bf16x8*)(sb + dt * 2048), pf, o[dt]);
            }
            const float inv = frcp(sum);
            bf16_t* yt = y + (size_t)(seq_base + rr * 64 + g * 16 + fr) * LDY + 1024 + h * 64;
#pragma unroll
            for (int dt = 0; dt < 4; ++dt) {
                u32x2_t ow;
                ow.x = pk2(o[dt][0] * inv * silu(bflo(gr[dt].x)), o[dt][1] * inv * silu(bfhi(gr[dt].x)));
                ow.y = pk2(o[dt][2] * inv * silu(bflo(gr[dt].y)), o[dt][3] * inv * silu(bfhi(gr[dt].y)));
                *(u32x2_t*)(yt + dt * 16 + fq * 4) = ow;
            }
            q0 = q0n; q1 = q1n;
#pragma unroll
            for (int dt = 0; dt < 4; ++dt) gr[dt] = grn[dt];
        }
        __syncthreads();
    }
}

__device__ __forceinline__ void mem_unit(const bf16_t* z, int qcol, int gcol, const bf16_t* mk, const bf16_t* mvT, bf16_t* y, int unit, int seg, LAS unsigned char* lds, int tid) {
    const int h = unit & 3, range = unit >> 2, tokr = range * 256;
    const int mb = seg < 2 ? seg : 2 + (tokr >> 12);
    const int lane = tid & 63, wid = tid >> 6, fr = lane & 15, fq = lane >> 4;
    __syncthreads();
    {
        u32x4_t kv[8], vv[8];
#pragma unroll
        for (int i = 0; i < 8; ++i) { const int idx = tid + 512 * i;
            kv[i] = *(const u32x4_t*)(mk + (size_t)(mb * 256 + (idx >> 4)) * 512 + h * 128 + (idx & 15) * 8);
            vv[i] = *(const u32x4_t*)(mvT + (size_t)(h * 128 + (idx >> 5)) * 1536 + mb * 256 + (idx & 31) * 8); }
#pragma unroll
        for (int i = 0; i < 8; ++i) { const int idx = tid + 512 * i;
            { const int rho = idx >> 4, c = idx & 15, f = (rho & 3) | (((rho >> 3) & 3) << 2); *(LAS u32x4_t*)(lds + rho * 256 + ((c ^ f) << 4)) = kv[i]; }
            { const int d = idx >> 5, c = idx & 31; *(LAS u32x4_t*)(lds + 65536 + d * 512 + ((c ^ (d & 15)) << 4)) = vv[i]; } }
    }
    __syncthreads();
    const int mrowA = (fr >> 2) * 8 + (fr & 3);
    const LAS unsigned char* kbase = lds + mrowA * 256 + ((fq ^ (fr & 3)) << 4);
    const LAS unsigned char* vbase = lds + 65536 + fr * 512 + ((fq ^ (fr & 3)) << 4);
    const int hi = fr >> 2;
#pragma unroll 1
    for (int gi = 0; gi < 2; ++gi) {
        const int tok = tokr + (wid + 8 * gi) * 16 + fr;
        const bf16_t* qp = z + (size_t)tok * LDZ + qcol + h * 128 + fq * 8;
        bf16x8 q[4];
#pragma unroll
        for (int ks = 0; ks < 4; ++ks) q[ks] = ld8(qp + ks * 32);
        u32x2_t gr[8];
#pragma unroll
        for (int dt = 0; dt < 8; ++dt) gr[dt] = *(const u32x2_t*)(z + (size_t)tok * LDZ + gcol + h * 128 + dt * 16 + fq * 4);
        float s[8][8];
        float mx = -1e30f;
#pragma unroll
        for (int kb = 0; kb < 8; ++kb) {
            f32x4 a0 = {0.f, 0.f, 0.f, 0.f}, a1 = {0.f, 0.f, 0.f, 0.f};
#pragma unroll
            for (int ks = 0; ks < 4; ++ks) {
                const LAS unsigned char* kp = kbase + kb * 8192 + ((ks ^ hi) << 6);
                a0 = mfma16(*(const LAS bf16x8*)kp, q[ks], a0); a1 = mfma16(*(const LAS bf16x8*)(kp + 1024), q[ks], a1);
            }
#pragma unroll
            for (int e = 0; e < 8; ++e) { s[kb][e] = (e < 4 ? a0[e & 3] : a1[e & 3]) * 0.08838834764831845f; mx = fmaxf(mx, s[kb][e]); }
        }
        mx = fmaxf(mx, __shfl_xor(mx, 16)); mx = fmaxf(mx, __shfl_xor(mx, 32));
        float sum = 0.f;
#pragma unroll
        for (int kb = 0; kb < 8; ++kb)
#pragma unroll
            for (int e = 0; e < 8; ++e) { const float p = __expf(s[kb][e] - mx); s[kb][e] = p; sum += p; }
        sum += __shfl_xor(sum, 16); sum += __shfl_xor(sum, 32);
        f32x4 o[8];
#pragma unroll
        for (int dt = 0; dt < 8; ++dt) o[dt] = (f32x4){0.f, 0.f, 0.f, 0.f};
#pragma unroll
        for (int kb = 0; kb < 8; ++kb) {
            const bf16x8 pf = pack8(s[kb]);
            const LAS unsigned char* vp = vbase + (((kb ^ hi) & 7) << 6);
#pragma unroll
            for (int dt = 0; dt < 8; ++dt) o[dt] = mfma16(*(const LAS bf16x8*)(vp + dt * 8192), pf, o[dt]);
        }
        const float inv = frcp(sum);
#pragma unroll
        for (int dt = 0; dt < 8; ++dt) {
            const int d4 = dt * 16 + fq * 4;
            u32x2_t ow;
            ow.x = pk2(o[dt][0] * inv * silu(bflo(gr[dt].x)), o[dt][1] * inv * silu(bfhi(gr[dt].x)));
            ow.y = pk2(o[dt][2] * inv * silu(bflo(gr[dt].y)), o[dt][3] * inv * silu(bfhi(gr[dt].y)));
            *(u32x2_t*)(y + (size_t)tok * LDY + 2048 + h * 128 + d4) = ow;
        }
    }
}

template <int CTRL> __device__ __forceinline__ float dppf(float oldv, float src) {
    return __int_as_float(__builtin_amdgcn_update_dpp(__float_as_int(oldv), __float_as_int(src), CTRL, 0xf, 0xf, false));
}
#define SCAN_STEP(SH) \
    "v_fmac_f32_dpp %4, %4, %0 " SH " row_mask:0xf bank_mask:0xf\n" \
    "v_fmac_f32_dpp %5, %5, %1 " SH " row_mask:0xf bank_mask:0xf\n" \
    "v_fmac_f32_dpp %6, %6, %2 " SH " row_mask:0xf bank_mask:0xf\n" \
    "v_fmac_f32_dpp %7, %7, %3 " SH " row_mask:0xf bank_mask:0xf\n" \
    "v_mul_f32_dpp %0, %0, %0 " SH " row_mask:0xf bank_mask:0xf\n" \
    "v_mul_f32_dpp %1, %1, %1 " SH " row_mask:0xf bank_mask:0xf\n" \
    "v_mul_f32_dpp %2, %2, %2 " SH " row_mask:0xf bank_mask:0xf\n" \
    "v_mul_f32_dpp %3, %3, %3 " SH " row_mask:0xf bank_mask:0xf\n"
template <int DIR> __device__ __forceinline__ void scan16x4(float (&A)[4], float (&B)[4]) {
    if (DIR == 0)
        asm volatile("s_nop 1\n" SCAN_STEP("row_shr:1") SCAN_STEP("row_shr:2") SCAN_STEP("row_shr:4") SCAN_STEP("row_shr:8")
                     : "+v"(A[0]), "+v"(A[1]), "+v"(A[2]), "+v"(A[3]), "+v"(B[0]), "+v"(B[1]), "+v"(B[2]), "+v"(B[3]));
    else
        asm volatile("s_nop 1\n" SCAN_STEP("row_shl:1") SCAN_STEP("row_shl:2") SCAN_STEP("row_shl:4") SCAN_STEP("row_shl:8")
                     : "+v"(A[0]), "+v"(A[1]), "+v"(A[2]), "+v"(A[3]), "+v"(B[0]), "+v"(B[1]), "+v"(B[2]), "+v"(B[3]));
}
template <int DIR> __device__ __forceinline__ void bcast4(const float (&v)[4], float (&o)[4]) {
    if (DIR == 0)
        asm volatile("s_nop 1\n"
                     "v_mov_b32_dpp %0, %4 row_newbcast:15 row_mask:0xf bank_mask:0xf\n" "v_mov_b32_dpp %1, %5 row_newbcast:15 row_mask:0xf bank_mask:0xf\n"
                     "v_mov_b32_dpp %2, %6 row_newbcast:15 row_mask:0xf bank_mask:0xf\n" "v_mov_b32_dpp %3, %7 row_newbcast:15 row_mask:0xf bank_mask:0xf\n"
                     : "=&v"(o[0]), "=&v"(o[1]), "=&v"(o[2]), "=&v"(o[3]) : "v"(v[0]), "v"(v[1]), "v"(v[2]), "v"(v[3]));
    else
        asm volatile("s_nop 1\n"
                     "v_mov_b32_dpp %0, %4 row_newbcast:0 row_mask:0xf bank_mask:0xf\n" "v_mov_b32_dpp %1, %5 row_newbcast:0 row_mask:0xf bank_mask:0xf\n"
                     "v_mov_b32_dpp %2, %6 row_newbcast:0 row_mask:0xf bank_mask:0xf\n" "v_mov_b32_dpp %3, %7 row_newbcast:0 row_mask:0xf bank_mask:0xf\n"
                     : "=&v"(o[0]), "=&v"(o[1]), "=&v"(o[2]), "=&v"(o[3]) : "v"(v[0]), "v"(v[1]), "v"(v[2]), "v"(v[3]));
}
struct LruW { bf16x8 Wa[4], Wi[4]; float ba[4], bi[4], c8[4]; };
struct LruX { bf16x8 x[2][4]; u32x2_t xr[2]; };
__device__ __forceinline__ void lru_loadw(LruW& W, const bf16_t* lruw, const float* ba_, const float* bi_, const float* lam_, int dir, int blk, int w, int ch4, int lane) {
    const int fr = lane & 15, fq = lane >> 4;
    const bf16_t* wa = lruw + ((size_t)((0 * 2 + dir) * 8 + blk) * 128 + w * 16 + fr) * 128 + fq * 8;
    const bf16_t* wi = lruw + ((size_t)((1 * 2 + dir) * 8 + blk) * 128 + w * 16 + fr) * 128 + fq * 8;
#pragma unroll
    for (int ks = 0; ks < 4; ++ks) { W.Wa[ks] = ld8(wa + ks * 32); W.Wi[ks] = ld8(wi + ks * 32); }
    const f32x4 a = *(const f32x4*)(ba_ + dir * 1024 + ch4), b = *(const f32x4*)(bi_ + dir * 1024 + ch4), l = *(const f32x4*)(lam_ + dir * 1024 + ch4);
#pragma unroll
    for (int jj = 0; jj < 4; ++jj) { W.ba[jj] = -1.4426950408889634f * a[jj]; W.bi[jj] = -1.4426950408889634f * b[jj]; W.c8[jj] = -8.0f * 1.4426950408889634f * log1pf(__expf(-l[jj])); }
}
__device__ __forceinline__ void conv_tile_to_lds(const bf16_t* z, const float* cw, const float* cb, LAS unsigned char* xl, int chunk, int blk, int T, int tid) {
    const int c = tid & 15, ch0 = blk * 128 + c * 8;
    float w[4][8], bb[8];
#pragma unroll
    for (int j = 0; j < 4; ++j) { const f32x4 a = *(const f32x4*)(cw + j * 1024 + ch0), b = *(const f32x4*)(cw + j * 1024 + ch0 + 4);
#pragma unroll
        for (int e = 0; e < 4; ++e) { w[j][e] = a[e]; w[j][4 + e] = b[e]; } }
    { const f32x4 a = *(const f32x4*)(cb + ch0), b = *(const f32x4*)(cb + ch0 + 4);
#pragma unroll
        for (int e = 0; e < 4; ++e) { bb[e] = a[e]; bb[4 + e] = b[e]; } }
    u32x4_t xin[4][4];
#pragma unroll
    for (int i = 0; i < 4; ++i) {
        const int r = (tid >> 4) + 32 * i, t = chunk * 128 + r, s = t & (T - 1);
#pragma unroll
        for (int j = 0; j < 4; ++j) {
            const int sj = s + j - 2;
            xin[i][j] = (u32x4_t){0u, 0u, 0u, 0u};
            if (sj >= 0 && sj < T) xin[i][j] = *(const u32x4_t*)(z + (size_t)(t + j - 2) * LDZ + ch0);
        }
    }
#pragma unroll
    for (int i = 0; i < 4; ++i) {
        const int r = (tid >> 4) + 32 * i;
        float acc[8];
#pragma unroll
        for (int e = 0; e < 8; ++e) acc[e] = bb[e];
#pragma unroll
        for (int j = 0; j < 4; ++j) {
            const u32x4_t xv = xin[i][j];
            acc[0] += w[j][0] * bflo(xv[0]); acc[1] += w[j][1] * bfhi(xv[0]); acc[2] += w[j][2] * bflo(xv[1]); acc[3] += w[j][3] * bfhi(xv[1]);
            acc[4] += w[j][4] * bflo(xv[2]); acc[5] += w[j][5] * bfhi(xv[2]); acc[6] += w[j][6] * bflo(xv[3]); acc[7] += w[j][7] * bfhi(xv[3]);
        }
        u32x4_t o; o.x = pk2(acc[0], acc[1]); o.y = pk2(acc[2], acc[3]); o.z = pk2(acc[4], acc[5]); o.w = pk2(acc[6], acc[7]);
        *(LAS u32x4_t*)(xl + r * 256 + ((c ^ (r & 15)) << 4)) = o;
    }
}
__device__ __forceinline__ void lru_loadx(LruX& X, const LAS unsigned char* xl, int r0, int w, int lane) {
    const int fr = lane & 15, fq = lane >> 4;
#pragma unroll
    for (int t = 0; t < 2; ++t) {
        const int r = r0 + t * 16 + fr;
        const LAS unsigned char* rp = xl + r * 256;
#pragma unroll
        for (int ks = 0; ks < 4; ++ks) X.x[t][ks] = *(const LAS bf16x8*)(rp + (((ks * 4 + fq) ^ fr) << 4));
        X.xr[t] = *(const LAS u32x2_t*)(rp + (((w * 2 + (fq >> 1)) ^ fr) << 4) + (fq & 1) * 8);
    }
}
template <int DIR, bool FINAL> __device__ __forceinline__ void lru_tile(const bf16x8 (&Xf)[4], const u32x2_t xr, const LruW& W, int lane, float (&hin)[4], float (&arun)[4], float (&hout)[4], unsigned (&lab)[4]) {
    f32x4 accR = {0.f, 0.f, 0.f, 0.f}, accI = {0.f, 0.f, 0.f, 0.f};
#pragma unroll
    for (int ks = 0; ks < 4; ++ks) { accR = mfma16(W.Wa[ks], Xf[ks], accR); accI = mfma16(W.Wi[ks], Xf[ks], accI); }
    const float xv[4] = {bflo(xr.x), bfhi(xr.x), bflo(xr.y), bfhi(xr.y)};
    const int src = (lane & 48) + (DIR == 0 ? 15 : 0);
    float A[4], B[4];
    typedef float f32x2 __attribute__((ext_vector_type(2)));
#pragma unroll
    for (int p = 0; p < 2; ++p) {
        const f32x2 ar = {accR[2 * p], accR[2 * p + 1]}, ai = {accI[2 * p], accI[2 * p + 1]};
        const f32x2 bar = {W.ba[2 * p], W.ba[2 * p + 1]}, bai = {W.bi[2 * p], W.bi[2 * p + 1]}, c8v = {W.c8[2 * p], W.c8[2 * p + 1]}, xvv = {xv[2 * p], xv[2 * p + 1]};
        const f32x2 tr = ar * (-1.4426950408889634f) + bar, ti = ai * (-1.4426950408889634f) + bai;
        f32x2 er, ei; er.x = __builtin_amdgcn_exp2f(tr.x); er.y = __builtin_amdgcn_exp2f(tr.y); ei.x = __builtin_amdgcn_exp2f(ti.x); ei.y = __builtin_amdgcn_exp2f(ti.y);
        er = er + 1.0f; ei = ei + 1.0f;
        f32x2 rg, ig; rg.x = frcp(er.x); rg.y = frcp(er.y); ig.x = frcp(ei.x); ig.y = frcp(ei.y);
        const f32x2 la = c8v * rg;
        f32x2 Av; Av.x = __builtin_amdgcn_exp2f(la.x); Av.y = __builtin_amdgcn_exp2f(la.y);
        f32x2 om = 1.0f - Av * Av;
        f32x2 sq; sq.x = __builtin_amdgcn_sqrtf(fmaxf(om.x, 0.f)); sq.y = __builtin_amdgcn_sqrtf(fmaxf(om.y, 0.f));
        const f32x2 Bv = sq * (ig * xvv);
        A[2 * p] = Av.x; A[2 * p + 1] = Av.y; B[2 * p] = Bv.x; B[2 * p + 1] = Bv.y;
        lab[2 * p] = __builtin_bit_cast(unsigned, __builtin_amdgcn_cvt_pkrtz(la.x, Bv.x));
        lab[2 * p + 1] = __builtin_bit_cast(unsigned, __builtin_amdgcn_cvt_pkrtz(la.y, Bv.y));
    }
    scan16x4<DIR>(A, B);
#pragma unroll
    for (int jj = 0; jj < 4; ++jj) hout[jj] = A[jj] * hin[jj] + B[jj];
    bcast4<DIR>(hout, hin);
    if (!FINAL) { float At[4]; bcast4<DIR>(A, At);
#pragma unroll
        for (int jj = 0; jj < 4; ++jj) arun[jj] *= At[jj]; }
}
template <bool FINAL> __device__ __forceinline__ void lru_item(const LAS unsigned char* xl, const bf16_t* z, const bf16_t* lruw, const float* ba_, const float* bi_, const float* lam_,
                                                               float* agg, const float* carry, bf16_t* y, unsigned* labuf, int item, int lane) {
    const int cgi = item & 63, chunk = item >> 6, blk = cgi >> 3, w = cgi & 7;
    const int fr = lane & 15, fq = lane >> 4;
    const int ch4 = blk * 128 + w * 16 + fq * 4;
    const int tokc = chunk * 128;
    LruX X[2]; LruW W0;
    lru_loadw(W0, lruw, ba_, bi_, lam_, 0, blk, w, ch4, lane);
    lru_loadx(X[0], xl, 0, w, lane);
    unsigned hf[8][2];
    float hin[4], arun[4];
#pragma unroll
    for (int jj = 0; jj < 4; ++jj) { hin[jj] = FINAL ? carry[(size_t)(0 * 128 + chunk) * 1024 + ch4 + jj] : 0.f; arun[jj] = 1.f; }
#pragma unroll
    for (int bi = 0; bi < 8; ++bi) {
        __builtin_amdgcn_sched_barrier(0);
        const int slot = bi < 4 ? (bi & 1) : ((bi + 1) & 1);
        const int pair = bi < 4 ? bi : 7 - bi;
        if (bi + 1 < 8 && bi + 1 != 4) {
            const int nslot = (bi + 1) < 4 ? ((bi + 1) & 1) : ((bi + 2) & 1);
            const int npair = (bi + 1) < 4 ? (bi + 1) : 7 - (bi + 1);
            lru_loadx(X[nslot], xl, npair * 32, w, lane);
        }
        if (bi == 4) {
            lru_loadw(W0, lruw, ba_, bi_, lam_, 1, blk, w, ch4, lane);
            if (!FINAL && fr == 0) {
#pragma unroll
                for (int jj = 0; jj < 4; ++jj) { float2 v; v.x = arun[jj]; v.y = hin[jj]; *(float2*)(agg + ((size_t)(0 * 128 + chunk) * 1024 + ch4 + jj) * 2) = v; }
            }
#pragma unroll
            for (int jj = 0; jj < 4; ++jj) { hin[jj] = FINAL ? carry[(size_t)(1 * 128 + chunk) * 1024 + ch4 + jj] : 0.f; arun[jj] = 1.f; }
        }
#pragma unroll
        for (int k = 0; k < 2; ++k) {
            const int t = bi < 4 ? k : 1 - k;
            const int tt = 2 * pair + t;
            float hv[4]; unsigned lab[4];
            if (bi < 4) lru_tile<0, FINAL>(X[slot].x[t], X[slot].xr[t], W0, lane, hin, arun, hv, lab);
            else lru_tile<1, FINAL>(X[slot].x[t], X[slot].xr[t], W0, lane, hin, arun, hv, lab);
            if (!FINAL) { u32x4_t lw; lw.x = lab[0]; lw.y = lab[1]; lw.z = lab[2]; lw.w = lab[3];
                *(u32x4_t*)(labuf + ((((size_t)(bi < 4 ? 0 : 1) * 128 + chunk) * 64 + cgi) * 8 + (2 * pair + t)) * 256 + lane * 4) = lw; }
            if (FINAL) {
                if (bi < 4) {
                    hf[tt][0] = pk2(hv[0], hv[1]); hf[tt][1] = pk2(hv[2], hv[3]);
                } else {
                    const int tok = tokc + tt * 16 + fr;
                    const u32x2_t gr = *(const u32x2_t*)(z + (size_t)tok * LDZ + 1024 + ch4);
                    const float gc[4] = {bflo(gr.x), bfhi(gr.x), bflo(gr.y), bfhi(gr.y)};
                    const float hfv[4] = {bflo(hf[tt][0]), bfhi(hf[tt][0]), bflo(hf[tt][1]), bfhi(hf[tt][1])};
                    float o[4];
#pragma unroll
                    for (int jj = 0; jj < 4; ++jj) o[jj] = (hfv[jj] + hv[jj]) * silu(gc[jj]);
                    u32x2_t ow; ow.x = pk2(o[0], o[1]); ow.y = pk2(o[2], o[3]);
                    *(u32x2_t*)(y + (size_t)tok * LDY + ch4) = ow;
                }
            }
        }
    }
    if (!FINAL && fr == 0) {
#pragma unroll
        for (int jj = 0; jj < 4; ++jj) { float2 v; v.x = arun[jj]; v.y = hin[jj]; *(float2*)(agg + ((size_t)(1 * 128 + chunk) * 1024 + ch4 + jj) * 2) = v; }
    }
}
struct LruF { u32x4_t L[2][8]; u32x2_t gr[8]; };
__device__ __forceinline__ void lru_final_load(LruF& F, const unsigned* labuf, const bf16_t* z, int item, int lane) {
    const int cgi = item & 63, chunk = item >> 6, fr = lane & 15, fq = lane >> 4;
    const int ch4 = cgi * 16 + fq * 4, tokc = chunk * 128;
#pragma unroll
    for (int d = 0; d < 2; ++d)
#pragma unroll
        for (int tt = 0; tt < 8; ++tt) F.L[d][tt] = *(const u32x4_t*)(labuf + ((((size_t)d * 128 + chunk) * 64 + cgi) * 8 + tt) * 256 + lane * 4);
#pragma unroll
    for (int tt = 0; tt < 8; ++tt) F.gr[tt] = *(const u32x2_t*)(z + (size_t)(tokc + tt * 16 + fr) * LDZ + 1024 + ch4);
}
template <bool WAVEC> __device__ __forceinline__ void lru_final_compute(const LruF& F, const float* carry, float hcv, bf16_t* y, int item, int lane) {
    typedef _Float16 h2_t __attribute__((ext_vector_type(2)));
    const int cgi = item & 63, chunk = item >> 6;
    const int fr = lane & 15, fq = lane >> 4;
    const int ch4 = cgi * 16 + fq * 4, tokc = chunk * 128;
    float hf[8][4];
    {
        float hin[4];
#pragma unroll
        for (int jj = 0; jj < 4; ++jj) hin[jj] = WAVEC ? __shfl(hcv, fq * 4 + jj) : carry[(size_t)(0 * 128 + chunk) * 1024 + ch4 + jj];
#pragma unroll
        for (int tt = 0; tt < 8; ++tt) {
            float A[4], B[4];
#pragma unroll
            for (int jj = 0; jj < 4; ++jj) {
                const unsigned wv = F.L[0][tt][jj]; const h2_t v = __builtin_bit_cast(h2_t, wv);
                A[jj] = __builtin_amdgcn_exp2f((float)v.x); B[jj] = (float)v.y;
            }
            scan16x4<0>(A, B);
#pragma unroll
            for (int jj = 0; jj < 4; ++jj) hf[tt][jj] = A[jj] * hin[jj] + B[jj];
            bcast4<0>(hf[tt], hin);
        }
    }
    {
        float hin[4];
#pragma unroll
        for (int jj = 0; jj < 4; ++jj) hin[jj] = WAVEC ? __shfl(hcv, 16 + fq * 4 + jj) : carry[(size_t)(1 * 128 + chunk) * 1024 + ch4 + jj];
#pragma unroll
        for (int s = 0; s < 8; ++s) {
            const int tt = 7 - s;
            float o[4], A[4], B[4];
#pragma unroll
            for (int jj = 0; jj < 4; ++jj) {
                const unsigned wv = F.L[1][tt][jj]; const h2_t v = __builtin_bit_cast(h2_t, wv);
                A[jj] = __builtin_amdgcn_exp2f((float)v.x); B[jj] = (float)v.y;
            }
            scan16x4<1>(A, B);
            float hb[4];
#pragma unroll
            for (int jj = 0; jj < 4; ++jj) { hb[jj] = A[jj] * hin[jj] + B[jj]; o[jj] = hf[tt][jj] + hb[jj]; }
            bcast4<1>(hb, hin);
            const float gc[4] = {bflo(F.gr[tt].x), bfhi(F.gr[tt].x), bflo(F.gr[tt].y), bfhi(F.gr[tt].y)};
            u32x2_t ow; ow.x = pk2(o[0] * silu(gc[0]), o[1] * silu(gc[1])); ow.y = pk2(o[2] * silu(gc[2]), o[3] * silu(gc[3]));
            *(u32x2_t*)(y + (size_t)(tokc + tt * 16 + fr) * LDY + ch4) = ow;
        }
    }
}
__device__ __forceinline__ void wave_carries(const float* agg, int cgi, int chunk0, int nseq, int lane, float (&hc)[4]) {
    const int q = lane >> 4, ch = cgi * 16 + (lane & 15);
    const bool up = (lane & 16) != 0;
#pragma unroll
    for (int dir = 0; dir < 2; ++dir) {
        float A = 1.f, h = 0.f, Ap = 1.f, Hp = 0.f;
#pragma unroll 8
        for (int step = 0; step < 32; ++step) {
            const int cc = dir == 0 ? step : 31 - step;
            if (cc == chunk0) { Ap = A; Hp = h; }
            const float2 ah = *(const float2*)(agg + ((size_t)(dir * 128 + 32 * q + cc) * 1024 + ch) * 2);
            h = ah.x * h + ah.y; A *= ah.x;
        }
        float Aq[4], Hq[4], Apk[4], Hpk[4];
#pragma unroll
        for (int k = 0; k < 4; ++k) { const int src = k * 16 + (lane & 15); Aq[k] = __shfl(A, src); Hq[k] = __shfl(h, src); Apk[k] = __shfl(Ap, src); Hpk[k] = __shfl(Hp, src); }
        float S[4];
        if (dir == 0) { S[0] = 0.f; S[1] = Hq[0]; S[2] = Aq[1] * S[1] + Hq[1]; S[3] = Aq[2] * S[2] + Hq[2]; }
        else { S[3] = 0.f; S[2] = Hq[3]; S[1] = Aq[2] * S[2] + Hq[2]; S[0] = Aq[1] * S[1] + Hq[1]; }
#pragma unroll
        for (int k = 0; k < 4; ++k) { const float v = Apk[k] * (nseq == 1 ? S[k] : 0.f) + Hpk[k]; if (dir == 0) hc[k] = v; else hc[k] = up ? v : hc[k]; }
    }
}
__device__ __forceinline__ void carry_phase(const float* agg, float* carry, int nseq, int gtid, int gthreads) {
    const int nc = 128 / nseq;
    for (int idx = gtid; idx < 2 * nseq * 1024; idx += gthreads) {
        const int ch = idx & 1023, rest = idx >> 10, dir = rest & 1, sq = rest >> 1, base = sq * nc;
        float h = 0.f;
#pragma unroll 8
        for (int c = 0; c < nc; ++c) {
            const int C = base + (dir == 0 ? c : nc - 1 - c);
            const size_t o = (size_t)(dir * 128 + C) * 1024 + ch;
            const float2 ah = *(const float2*)(agg + o * 2);
            carry[o] = h;
            h = ah.x * h + ah.y;
        }
    }
}

__device__ __forceinline__ void sgu_item2(const bf16_t* vT, const LAS float* rstd, const LAS unsigned char* wsl, const bf16_t* z, const float* sgu_g, const float* sgu_b, bf16_t* y,
                                          int n, int g, int qd, int lane) {
    const int fr = lane & 15, fq = lane >> 4;
    const int tokc = n * 128, chq = g * 128 + qd * 32;
    bf16x8 Af[2][4];
#pragma unroll
    for (int t = 0; t < 2; ++t) {
        const bf16_t* ap = vT + (size_t)(chq + (fr >> 2) * 8 + (fr & 3) + 4 * t) * SEG + tokc + fq * 8;
#pragma unroll
        for (int ks = 0; ks < 4; ++ks) {
            const u32x4_t raw = *(const u32x4_t*)(ap + ks * 32);
            const f32x4 r0 = *(const LAS f32x4*)(rstd + ks * 32 + fq * 8), r1 = *(const LAS f32x4*)(rstd + ks * 32 + fq * 8 + 4);
            u32x4_t w;
            w.x = pk2(bflo(raw.x) * r0[0], bfhi(raw.x) * r0[1]); w.y = pk2(bflo(raw.y) * r0[2], bfhi(raw.y) * r0[3]);
            w.z = pk2(bflo(raw.z) * r1[0], bfhi(raw.z) * r1[1]); w.w = pk2(bflo(raw.w) * r1[2], bfhi(raw.w) * r1[3]);
            Af[t][ks] = __builtin_bit_cast(bf16x8, w);
        }
    }
    const int ch8 = chq + fq * 8;
    const f32x4 g0 = *(const f32x4*)(sgu_g + ch8), g1 = *(const f32x4*)(sgu_g + ch8 + 4);
    u32x4_t urv[8], grv[8]; float bsvv[8];
#pragma unroll
    for (int pt = 0; pt < 8; ++pt) { const int p = pt * 16 + fr, tok = tokc + p;
        urv[pt] = *(const u32x4_t*)(z + (size_t)tok * LDZ + 2048 + ch8); grv[pt] = *(const u32x4_t*)(z + (size_t)tok * LDZ + 3072 + ch8); bsvv[pt] = sgu_b[g * 128 + p]; }
#pragma unroll
    for (int pt = 0; pt < 8; ++pt) {
        const int p = pt * 16 + fr, tok = tokc + p;
        const u32x4_t ur = urv[pt], gr = grv[pt];
        const float bsv = bsvv[pt];
        const LAS unsigned char* bp = wsl + p * 256;
        f32x4 a0 = {0.f, 0.f, 0.f, 0.f}, a1 = {0.f, 0.f, 0.f, 0.f};
#pragma unroll
        for (int ks = 0; ks < 4; ++ks) { const bf16x8 Bf = *(const LAS bf16x8*)(bp + (((ks * 4 + fq) ^ fr) << 4)); a0 = mfma16(Af[0][ks], Bf, a0); a1 = mfma16(Af[1][ks], Bf, a1); }
        float o[8];
#pragma unroll
        for (int k = 0; k < 2; ++k) {
            o[2 * k] = bflo(ur[k]) * (a0[2 * k] * g0[2 * k] + bsv) * silu(bflo(gr[k]));
            o[2 * k + 1] = bfhi(ur[k]) * (a0[2 * k + 1] * g0[2 * k + 1] + bsv) * silu(bfhi(gr[k]));
            o[4 + 2 * k] = bflo(ur[2 + k]) * (a1[2 * k] * g1[2 * k] + bsv) * silu(bflo(gr[2 + k]));
            o[4 + 2 * k + 1] = bfhi(ur[2 + k]) * (a1[2 * k + 1] * g1[2 * k + 1] + bsv) * silu(bfhi(gr[2 + k]));
        }
        u32x4_t ow; ow.x = pk2(o[0], o[1]); ow.y = pk2(o[2], o[3]); ow.z = pk2(o[4], o[5]); ow.w = pk2(o[6], o[7]);
        *(u32x4_t*)(y + (size_t)tok * LDY + 1024 + ch8) = ow;
    }
}

__device__ __forceinline__ void sgu_item(const bf16_t* vT, const LAS float* rstd, const bf16_t* z, const bf16_t* sguw, const float* sgu_g, const float* sgu_b, bf16_t* y, int item, int lane) {
    const int dd = item & 7, g = (item >> 3) & 7, n = item >> 6;
    const int fr = lane & 15, fq = lane >> 4;
    const int tokc = n * 128;
    const bf16_t* ap = vT + (size_t)(g * 128 + dd * 16 + fr) * SEG + tokc + fq * 8;
    bf16x8 Af[4];
#pragma unroll
    for (int ks = 0; ks < 4; ++ks) {
        const u32x4_t raw = *(const u32x4_t*)(ap + ks * 32);
        const f32x4 r0 = *(const LAS f32x4*)(rstd + ks * 32 + fq * 8), r1 = *(const LAS f32x4*)(rstd + ks * 32 + fq * 8 + 4);
        u32x4_t w;
        w.x = pk2(bflo(raw.x) * r0[0], bfhi(raw.x) * r0[1]); w.y = pk2(bflo(raw.y) * r0[2], bfhi(raw.y) * r0[3]);
        w.z = pk2(bflo(raw.z) * r1[0], bfhi(raw.z) * r1[1]); w.w = pk2(bflo(raw.w) * r1[2], bfhi(raw.w) * r1[3]);
        Af[ks] = __builtin_bit_cast(bf16x8, w);
    }
    const int ch4 = g * 128 + dd * 16 + fq * 4;
    const f32x4 g4 = *(const f32x4*)(sgu_g + ch4);
#pragma unroll
    for (int pt = 0; pt < 8; ++pt) {
        const int p = pt * 16 + fr;
        const bf16_t* bp = sguw + (size_t)(g * 128 + p) * 128 + fq * 8;
        f32x4 acc = {0.f, 0.f, 0.f, 0.f};
#pragma unroll
        for (int ks = 0; ks < 4; ++ks) acc = mfma16(Af[ks], ld8(bp + ks * 32), acc);
        const int tok = tokc + p;
        const float bsv = sgu_b[g * 128 + p];
        const u32x2_t ur = *(const u32x2_t*)(z + (size_t)tok * LDZ + 2048 + ch4), gr = *(const u32x2_t*)(z + (size_t)tok * LDZ + 3072 + ch4);
        const float uu[4] = {bflo(ur.x), bfhi(ur.x), bflo(ur.y), bfhi(ur.y)}, gd[4] = {bflo(gr.x), bfhi(gr.x), bflo(gr.y), bfhi(gr.y)};
        float o[4];
#pragma unroll
        for (int jj = 0; jj < 4; ++jj) o[jj] = uu[jj] * (acc[jj] * g4[jj] + bsv) * silu(gd[jj]);
        u32x2_t ow; ow.x = pk2(o[0], o[1]); ow.y = pk2(o[2], o[3]);
        *(u32x2_t*)(y + (size_t)tok * LDY + 1024 + ch4) = ow;
    }
}

__global__ void __launch_bounds__(512, 2) fwd_megakernel(Params P) {
    extern __shared__ __attribute__((aligned(16))) unsigned char shm[];
    cg::grid_group grid = cg::this_grid();
    PG8_LAS unsigned char* lds = (PG8_LAS unsigned char*)shm;
    const int G = gridDim.x, NW = G * 8;
#define FRESH_TID() int tid = threadIdx.x; asm volatile("" : "+v"(tid)); const int lane = tid & 63, wid = tid >> 6, gw = blockIdx.x * 8 + wid; (void)lane; (void)gw
    unsigned char* ws = P.ws;
    bf16_t* WIN_E = (bf16_t*)(ws + WS_WIN_E); bf16_t* WIN_O = (bf16_t*)(ws + WS_WIN_O);
    bf16_t* WOUT_E = (bf16_t*)(ws + WS_WOUT_E); bf16_t* WOUT_O = (bf16_t*)(ws + WS_WOUT_O);
    bf16_t* WKV = (bf16_t*)(ws + WS_WKV); bf16_t* LRUW = (bf16_t*)(ws + WS_LRUW); bf16_t* SGUW = (bf16_t*)(ws + WS_SGUW);
    bf16_t* MEMN = (bf16_t*)(ws + WS_MEMN); bf16_t* MK = (bf16_t*)(ws + WS_MK); bf16_t* MVT = (bf16_t*)(ws + WS_MVT);
    bf16_t* H = (bf16_t*)(ws + WS_H); bf16_t* Z = (bf16_t*)(ws + WS_Z); bf16_t* VT = (bf16_t*)(ws + WS_VT); bf16_t* Y = (bf16_t*)(ws + WS_Y);
    float* AGG = (float*)(ws + WS_AGG); float* CARRY = (float*)(ws + WS_CARRY); float* RSTD = (float*)(ws + WS_RSTD); float* PART = (float*)(ws + WS_PART); unsigned* LAB = (unsigned*)(ws + WS_LAB);

    unsigned* BAR = (unsigned*)(ws + WS_BAR);
    volatile LAS unsigned* xst = (volatile LAS unsigned*)(lds + XST_OFF);
    {
        FRESH_TID();
        if (tid < 2) xst[tid] = 0u;
        if (blockIdx.x == 0) for (int i = tid; i < XCD_BAR_WORDS; i += 512) BAR[i] = 0u;
        LAS float* scr = (LAS float*)(lds + wid * 16384);
        constexpr int I0 = 16 * 288, I1 = 16 * 192, I2 = 40 * 32, I3 = 40 * 32, I4 = 16 * 32, I5 = 16 * 32, I6 = 16 * 8, I7 = 16 * 8;
        constexpr int NIT = I0 + I1 + I2 + I3 + I4 + I5 + I6 + I7;
#pragma unroll 1
        for (int it = gw; it < NIT; it += NW) {
            int r = it;
            if (r < I0) { transpose_item(P.in[7], 1024, 9216, WIN_E, scr, r, lane); continue; } r -= I0;
            if (r < I1) { transpose_item(P.in[12], 1024, 6144, WIN_O, scr, r, lane); continue; } r -= I1;
            if (r < I2) { transpose_item(P.in[11], 2560, 1024, WOUT_E, scr, r, lane); continue; } r -= I2;
            if (r < I3) { transpose_item(P.in[23], 2560, 1024, WOUT_O, scr, r, lane); continue; } r -= I3;
            if (r < I4) { transpose_item(P.in[6], 1024, 1024, WKV, scr, r, lane); continue; } r -= I4;
            if (r < I5) { transpose_item(P.in[6] + (size_t)1024 * 1024, 1024, 1024, WKV + (size_t)1024 * 1024, scr, r, lane); continue; } r -= I5;
            if (r < I6) { const int m = r >> 3; transpose_item(P.in[15] + (size_t)m * 16384, 128, 128, LRUW + (size_t)m * 16384, scr, r & 7, lane); continue; } r -= I6;
            { const int m = r >> 3; transpose_item(P.in[17] + (size_t)m * 16384, 128, 128, LRUW + (size_t)(16 + m) * 16384, scr, r & 7, lane); }
        }
        for (int i = blockIdx.x * 512 + tid; i < 8 * 128 * 128; i += G * 512) SGUW[i] = f2bf(P.in[21][i]);
        for (int it = gw; it < 2 * 1536; it += NW) {
            const int l = it / 1536, row = it - l * 1536;
            const float* src = row < 512 ? P.in[2] + (size_t)row * 1024 : P.in[3] + (size_t)(row - 512) * 1024;
            rms_row_bf16(src, P.in[5] + l * 1024, MEMN + ((size_t)l * 1536 + row) * 1024, lane);
        }
        for (int it = gw; it < SEG / 4; it += NW) rms_rows4_bf16(P.in[0] + (size_t)it * 4096, P.in[4], H + (size_t)it * 4096, lane);
    }

    grid.sync();
    const XcdBarrier xb = xcd_barrier_post(BAR, xst);
    for (int seg = 0; seg < 3; ++seg) {
        const float* xin = seg < 2 ? P.in[0] + (size_t)seg * SEG * 1024 : P.in[1];
        float* xout = P.out + (size_t)seg * SEG * 1024;
        const int T = seg < 2 ? 16384 : 4096, nseq = seg < 2 ? 1 : 4;

        {
            pg8::Gemm g; g.A = H; g.Bt = WIN_E; g.M = SEG; g.N = 8192; g.K = 1024; g.A1 = WIN_E + (size_t)6144 * 1024; g.Bt1 = H;
            pg8::DualOrder S; S.S0.init(SEG, 8192, G, blockIdx.x); S.S1.init(1024, SEG, G, blockIdx.x); S.skip_from = 24; S.skip_n = 4; S.G = G; S.c = blockIdx.x;
            pg8::EpiZ E; E.O = Z; E.ldc = LDZ; E.skip_from = 24; E.skip_n = 4; E.colsq = nullptr; E.colsq_ld = 0; E.O1 = VT; E.ldc1 = SEG; E.colsq1 = nullptr;
            pg8::gemm_phase(lds, g, S, E);
        }
        if (seg == 0) {
#pragma unroll 1
            for (int l = 0; l < 2; ++l) {
                {
                    pg8::Gemm g; g.A = MEMN + (size_t)l * 1536 * 1024; g.Bt = WKV + (size_t)l * 1024 * 1024; g.M = 1536; g.N = 512; g.K = 1024; g.A1 = g.A; g.Bt1 = g.Bt;
                    pg8::SkipOrder S; S.init(1536, 512, G, (blockIdx.x + G - (32 * l) % G) % G); S.skip_from = 1 << 20; S.skip_n = 0;
                    pg8::EpiZ E; E.O = MK + (size_t)l * 1536 * 512; E.ldc = 512; E.skip_from = 1 << 20; E.skip_n = 0; E.colsq = nullptr; E.colsq_ld = 0; E.O1 = E.O; E.ldc1 = 512; E.colsq1 = nullptr;
                    pg8::gemm_phase(lds, g, S, E);
                }
                {
                    pg8::Gemm g; g.A = WKV + (size_t)l * 1024 * 1024 + (size_t)512 * 1024; g.Bt = MEMN + (size_t)l * 1536 * 1024; g.M = 512; g.N = 1536; g.K = 1024; g.A1 = g.A; g.Bt1 = g.Bt;
                    pg8::SkipOrder S; S.init(512, 1536, G, (blockIdx.x + G - (32 * l + 16) % G) % G); S.skip_from = 1 << 20; S.skip_n = 0;
                    pg8::EpiZ E; E.O = MVT + (size_t)l * 512 * 1536; E.ldc = 1536; E.skip_from = 1 << 20; E.skip_n = 0; E.colsq = nullptr; E.colsq_ld = 0; E.O1 = E.O; E.ldc1 = 1536; E.colsq1 = nullptr;
                    pg8::gemm_phase(lds, g, S, E);
                }
            }
        }
        xcd_barrier(xb);

        { FRESH_TID();
        for (int u = blockIdx.x; u < 256; u += G) mem_unit(Z, 7168, 7680, MK, MVT, Y, u, seg, lds, tid);
#pragma unroll 1
        for (int u = blockIdx.x; u < 256; u += G) na_block(Z, VT, Y, P.in[10], u, T, lds, tid);
        for (int it = gw; it < 8192; it += NW) conv_even_item(Z, P.in[8], P.in[9], Y, 2 * it, T, lane);
        }
        xcd_barrier(xb);

        {
            pg8::Gemm g; g.A = Y; g.Bt = WOUT_E; g.M = SEG; g.N = 1024; g.K = 2560; g.A1 = g.A; g.Bt1 = g.Bt;
            pg8::StaticOrder S; S.init(SEG, 1024, G, blockIdx.x);
            pg8::EpiRes E; E.xin = xin; E.out = xout;
            pg8::gemm_phase(lds, g, S, E);
        }
        xcd_barrier(xb);

        { FRESH_TID();
        for (int it = gw; it < SEG / 4; it += NW) rms_rows4_bf16(xout + (size_t)it * 4096, P.in[4] + 1024, H + (size_t)it * 4096, lane); }
        xcd_barrier(xb);

        {
            pg8::Gemm g; g.A = H; g.Bt = WIN_O; g.M = SEG; g.N = 5120; g.K = 1024; g.A1 = WIN_O + (size_t)3072 * 1024; g.Bt1 = H;
            pg8::DualOrder S; S.S0.init(SEG, 5120, G, blockIdx.x); S.S1.init(1024, SEG, G, blockIdx.x); S.skip_from = 12; S.skip_n = 4; S.G = G; S.c = blockIdx.x;
            pg8::EpiZ E; E.O = Z; E.ldc = LDZ; E.skip_from = 12; E.skip_n = 4; E.colsq = nullptr; E.colsq_ld = SEG; E.O1 = VT; E.ldc1 = SEG; E.colsq1 = PART;
            pg8::gemm_phase(lds, g, S, E);
        }
        xcd_barrier(xb);

        { FRESH_TID();
        for (int u = blockIdx.x; u < 256; u += G) mem_unit(Z, 4096, 4608, MK + (size_t)1536 * 512, MVT + (size_t)512 * 1536, Y, u, seg, lds, tid);
#pragma unroll 1
        for (int u0 = blockIdx.x; u0 < 1024; u0 += 4 * G) {
            __syncthreads();
#pragma unroll 1
            for (int k = 0; k < 4; ++k) { const int u = u0 + k * G; if (u < 1024) conv_tile_to_lds(Z, P.in[13], P.in[14], lds + k * 32768, u >> 3, u & 7, T, tid); }
            __syncthreads();
#pragma unroll 1
            for (int k = 0; k < 4; ++k) { const int u = u0 + k * G; if (u < 1024) lru_item<false>(lds + k * 32768, Z, LRUW, P.in[16], P.in[18], P.in[19], AGG, CARRY, Y, LAB, (u >> 3) * 64 + (u & 7) * 8 + wid, lane); }
        }
#pragma unroll 1
        for (int u0 = blockIdx.x; u0 < 1024; u0 += 2 * G) {
            __syncthreads();
            LAS float* rsL = (LAS float*)lds;
            if (tid < 256) { const int u = u0 + (tid >> 7) * G;
              if (u < 1024) { const float* pp = PART + (u >> 3) * 128 + (tid & 127); float s = 0.f;
#pragma unroll
                for (int i = 0; i < 8; ++i) s += pp[(size_t)i * SEG];
                rsL[tid] = __builtin_amdgcn_rsqf(s * (1.0f / 1024.0f) + EPS); } }
            u32x4_t wsv[2][4];
#pragma unroll
            for (int s2 = 0; s2 < 2; ++s2) { const int u = u0 + s2 * G;
              if (u < 1024) { const int g = u & 7;
#pragma unroll
                for (int i = 0; i < 4; ++i) { const int idx = tid + 512 * i, p = idx >> 4, c = idx & 15; wsv[s2][i] = *(const u32x4_t*)(SGUW + (size_t)(g * 128 + p) * 128 + c * 8); } } }
#pragma unroll
            for (int s2 = 0; s2 < 2; ++s2) { const int u = u0 + s2 * G;
              if (u < 1024) {
#pragma unroll
                for (int i = 0; i < 4; ++i) { const int idx = tid + 512 * i, p = idx >> 4, c = idx & 15; *(LAS u32x4_t*)(lds + 4096 + s2 * 32768 + p * 256 + ((c ^ (p & 15)) << 4)) = wsv[s2][i]; } } }
            __syncthreads();
            { const int s2 = wid >> 2, u = u0 + s2 * G;
              if (u < 1024) sgu_item2(VT, rsL + s2 * 128, lds + 4096 + s2 * 32768, Z, P.in[20], P.in[22], Y, u >> 3, u & 7, wid & 3, lane); }
        } }
        xcd_barrier(xb);

        if (G == 256) {
            FRESH_TID();
            float hc[4];
            LruF F[2];
            lru_final_load(F[0], LAB, Z, gw, lane);
            wave_carries(AGG, gw & 63, gw >> 6, nseq, lane, hc);
#pragma unroll
            for (int k = 0; k < 4; ++k) {
                if (k < 3) lru_final_load(F[(k + 1) & 1], LAB, Z, gw + 2048 * (k + 1), lane);
                lru_final_compute<true>(F[k & 1], CARRY, hc[k], Y, gw + 2048 * k, lane);
            }
        } else {
            { FRESH_TID(); carry_phase(AGG, CARRY, nseq, blockIdx.x * 512 + tid, G * 512); }
            xcd_barrier(xb);
            { FRESH_TID();
#pragma unroll 1
            for (int it = gw; it < 8192; it += NW) { LruF F1; lru_final_load(F1, LAB, Z, it, lane); lru_final_compute<false>(F1, CARRY, 0.f, Y, it, lane); } }
        }
        if (seg < 2) { FRESH_TID();
            const float* xnx = seg == 0 ? P.in[0] + (size_t)SEG * 1024 : P.in[1];
            for (int it = gw; it < SEG / 4; it += NW) rms_rows4_bf16(xnx + (size_t)it * 4096, P.in[4], H + (size_t)it * 4096, lane); }
        xcd_barrier(xb);

        {
            pg8::Gemm g; g.A = Y; g.Bt = WOUT_O; g.M = SEG; g.N = 1024; g.K = 2560; g.A1 = g.A; g.Bt1 = g.Bt;
            pg8::StaticOrder S; S.init(SEG, 1024, G, blockIdx.x);
            pg8::EpiRes E; E.xin = xout; E.out = xout;
            pg8::gemm_phase(lds, g, S, E);
        }
        xcd_barrier(xb);

        { FRESH_TID();
        for (int it = gw; it < SEG / 4; it += NW) rms_rows4_f32(xout + (size_t)it * 4096, P.in[24], lane); }
    }
}

extern "C" void kernel_launch(void* const* d_in, const int* in_sizes, int n_in, void* d_out, int out_size, void* d_ws, size_t ws_size, hipStream_t stream) {
    static int grid_blocks = 0;
    if (grid_blocks == 0) {
        if (n_in != 25 || ws_size < WS_END) { fprintf(stderr, "kernel_launch: need 25 inputs and %zu bytes of workspace; got %d, %zu\n", (size_t)WS_END, n_in, ws_size); grid_blocks = -1; return; }
        int dev = 0, cus = 0, per_cu = 0;
        hipGetDevice(&dev);
        hipDeviceGetAttribute(&cus, hipDeviceAttributeMultiprocessorCount, dev);
        hipFuncSetAttribute((const void*)fwd_megakernel, hipFuncAttributeMaxDynamicSharedMemorySize, LDS_BYTES);
        hipOccupancyMaxActiveBlocksPerMultiprocessor(&per_cu, (const void*)fwd_megakernel, 512, LDS_BYTES);
        if (per_cu < 1) { fprintf(stderr, "kernel_launch: occupancy query says %d blocks per CU\n", per_cu); grid_blocks = -1; return; }
        grid_blocks = cus;
    }
    if (grid_blocks < 0) return;
    Params p{};
    for (int i = 0; i < 25; ++i) p.in[i] = (const float*)d_in[i];
    p.out = (float*)d_out; p.ws = (unsigned char*)d_ws;
    void* args[] = {&p};
    hipError_t e = hipLaunchCooperativeKernel((const void*)fwd_megakernel, dim3(grid_blocks), dim3(512), args, LDS_BYTES, stream);
    if (e != hipSuccess) fprintf(stderr, "cooperative launch failed: %s (grid %d)\n", hipGetErrorString(e), grid_blocks);
}
```

```cpp
#include <hip/hip_runtime.h>
#include <hip/hip_cooperative_groups.h>
#include <cstdio>
namespace cg = cooperative_groups;
namespace pg8 {
#define PG8_LAS __attribute__((address_space(3)))
typedef unsigned short bf16_t;
typedef short bf16x8 __attribute__((ext_vector_type(8)));
typedef float f32x4 __attribute__((ext_vector_type(4)));
typedef unsigned u32x4 __attribute__((ext_vector_type(4)));
constexpr int BM = 256, BK = 64, HALF = 128, HTB = HALF * BK * 2  , STAGE_BYTES = 8 * HTB, NXCD = 8, WGM = 8;

__host__ __device__ __forceinline__ int lds_byte(int r, int c) { const int st = (r >> 4) * 2 + (c >> 5), rr = r & 15, cc = c & 31, ob = rr * 64 + cc * 2; return st * 1024 + (ob ^ (((ob >> 9) & 1) << 5)); }
__host__ __device__ __forceinline__ void stage_rc(int b, int& R, int& C) { const int st = b / 1024, sb = b % 1024, swz = sb ^ (((sb >> 9) & 1) << 5); R = (st >> 1) * 16 + swz / 64; C = (st & 1) * 32 + (swz % 64) / 2; }
__host__ __device__ __forceinline__ int perm32(int rho) { const int n = rho >> 4, i = rho & 15; return 8 * (i >> 2) + 4 * n + (i & 3); }

struct Unit { int pm, pn, sel; };
struct Gemm { const bf16_t* A; const bf16_t* Bt; int M, N, K; const bf16_t* A1; const bf16_t* Bt1; };

struct StaticOrder {
    int nM, nN, nwg, G, c;
    __host__ __device__ void init(int M, int N, int G_, int c_) { nM = M / BM; nN = N / BM; nwg = nM * nN; G = G_; c = c_; }
    __host__ __device__ void map(int wgid, Unit& u) const {
        { const int q = nwg / NXCD, r = nwg % NXCD, xcd = wgid % NXCD, off = wgid / NXCD; wgid = (xcd < r ? xcd * (q + 1) : r * (q + 1) + (xcd - r) * q) + off; }
        const int nig = WGM * nN, gid = wgid / nig, fm = gid * WGM, gsz = (nM - fm) < WGM ? (nM - fm) : WGM;
        u.pm = fm + ((wgid % nig) % gsz); u.pn = (wgid % nig) / gsz; u.sel = 0;
    }
    __host__ __device__ bool next(int i, Unit& u) const {
        const long L = (long)i * G + c; if (L >= nwg) return false;
        map((int)L, u); return true;
    }
    __device__ __forceinline__ void a_ready(const Unit&) const {}
    __device__ __forceinline__ void done(const Unit&) const {}
};

struct SkipOrder : StaticOrder {
    int skip_from, skip_n;
    __device__ __forceinline__ bool next(int i, Unit& u) const {
        if (!StaticOrder::next(i, u)) return false;
        if (u.pn >= skip_from) u.pn += skip_n;
        return true;
    }
};
struct DualOrder {
    StaticOrder S0, S1; int skip_from, skip_n, G, c;
    __device__ __forceinline__ bool next(int i, Unit& u) const {
        const long L = (long)i * G + c;
        if (L < S0.nwg) { S0.map((int)L, u); if (u.pn >= skip_from) u.pn += skip_n; return true; }
        if (L - S0.nwg < S1.nwg) { S1.map((int)(L - S0.nwg), u); u.sel = 1; return true; }
        return false;
    }
    __device__ __forceinline__ void a_ready(const Unit&) const {}
    __device__ __forceinline__ void done(const Unit&) const {}
};

__device__ __forceinline__ unsigned cvt_pk_bf16(float lo, float hi) { unsigned r; asm volatile("v_cvt_pk_bf16_f32 %0, %1, %2" : "=v"(r) : "v"(lo), "v"(hi)); return r; }

struct EpiZ {
    static constexpr bool PERM = true, AFTER_DRAIN = false;
    bf16_t* O; int ldc; int skip_from, skip_n; float* colsq; int colsq_ld; bf16_t* O1; int ldc1; float* colsq1;
    __device__ __forceinline__ void operator()(const f32x4 (&acc)[2][2][4][2], const Unit& u, int wr, int wc, int fr, int fq) const {
        const int row0 = u.pm * BM + wr * 64 + fr; const int ct = u.sel ? u.pn : ((u.pn >= skip_from + skip_n) ? (u.pn - skip_n) : u.pn);
        const int col0 = ct * BM + wc * 32 + 8 * fq;
        bf16_t* const O = u.sel ? this->O1 : this->O; const int ldc = u.sel ? this->ldc1 : this->ldc; float* const colsq = u.sel ? this->colsq1 : this->colsq;
#pragma unroll
        for (int ai = 0; ai < 2; ++ai)
#pragma unroll
            for (int m = 0; m < 4; ++m) { bf16_t* rowp = O + (size_t)(row0 + ai * HALF + m * 16) * ldc + col0;
#pragma unroll
                for (int bj = 0; bj < 2; ++bj) { const f32x4 v0 = acc[ai][bj][m][0], v1 = acc[ai][bj][m][1];
                    u32x4 w; w.x = cvt_pk_bf16(v0[0], v0[1]); w.y = cvt_pk_bf16(v0[2], v0[3]); w.z = cvt_pk_bf16(v1[0], v1[1]); w.w = cvt_pk_bf16(v1[2], v1[3]);
                    *(u32x4*)(rowp + bj * HALF) = w; } }
        if (colsq) {
#pragma unroll
            for (int bj = 0; bj < 2; ++bj)
#pragma unroll
                for (int n = 0; n < 2; ++n) {
                    f32x4 ss = {0.f, 0.f, 0.f, 0.f};
#pragma unroll
                    for (int ai = 0; ai < 2; ++ai)
#pragma unroll
                        for (int m = 0; m < 4; ++m) ss += acc[ai][bj][m][n] * acc[ai][bj][m][n];
#pragma unroll
                    for (int o = 1; o < 16; o <<= 1) { ss[0] += __shfl_xor(ss[0], o); ss[1] += __shfl_xor(ss[1], o); ss[2] += __shfl_xor(ss[2], o); ss[3] += __shfl_xor(ss[3], o); }
                    if (fr == 0) *(f32x4*)(colsq + (size_t)(2 * u.pm + wr) * colsq_ld + ct * BM + bj * HALF + wc * 32 + 8 * fq + 4 * n) = ss;
                }
        }
    }
};
struct EpiRes {
    static constexpr bool PERM = false, AFTER_DRAIN = false;
    const float* xin; float* out;
    __device__ __forceinline__ void operator()(const f32x4 (&acc)[2][2][4][2], const Unit& u, int wr, int wc, int fr, int fq) const {
        const int row0 = u.pm * BM + wr * 64 + fr, col0 = u.pn * BM + wc * 32 + 4 * fq;
#pragma unroll
        for (int ai = 0; ai < 2; ++ai)
#pragma unroll
            for (int m = 0; m < 4; ++m) { const size_t ro = (size_t)(row0 + ai * HALF + m * 16) * 1024 + col0;
#pragma unroll
                for (int bj = 0; bj < 2; ++bj)
#pragma unroll
                    for (int n = 0; n < 2; ++n) { const f32x4 xv = *(const f32x4*)(xin + ro + bj * HALF + n * 16);
                        *(f32x4*)(out + ro + bj * HALF + n * 16) = acc[ai][bj][m][n] + xv; } }
    }
};

template <class Epi, class Sched>
__device__ __forceinline__ void gemm_phase(PG8_LAS unsigned char* lds, const Gemm g, const Sched& S, const Epi& E) {
    int tid = threadIdx.x; asm volatile("" : "+v"(tid));
    const int wid = __builtin_amdgcn_readfirstlane(tid >> 6), lane = tid & 63, wr = wid >> 2, wc = wid & 3, fr = lane & 15, fq = lane >> 4;
    const int K = g.K, nt = K / BK;
    const char* gA = (const char*)g.A; const char* gB = (const char*)g.Bt; const char* gA1 = (const char*)g.A1; const char* gB1 = (const char*)g.Bt1; asm volatile("" : "+s"(gA), "+s"(gB), "+s"(gA1), "+s"(gB1));
    unsigned voffA[2], voffB[2];
#pragma unroll
    for (int i = 0; i < 2; ++i) { int R, C; stage_rc(tid * 16 + i * 8192, R, C); const int Rb = Epi::PERM ? ((R & ~31) + perm32(R & 31)) : R;
        voffA[i] = (unsigned)(R * K + C) * 2u; voffB[i] = (unsigned)(Rb * K + C) * 2u; }
    const size_t kstep = (size_t)(BK * 2);
    const size_t hstep = (size_t)HALF * K * 2;
    const size_t tstep = 2 * hstep;
    const unsigned ldsw = (unsigned)wid * 1024u;
    const int aoff = lds_byte(wr * 64 + fr, fq * 8), boff = lds_byte(wc * 32 + fr, fq * 8);
#define PG8_SA(b, h) (((b) * 2 + (h)) * HTB)
#define PG8_SB(b, h) ((4 + (b) * 2 + (h)) * HTB)
#define PG8_STAGE(bufoff, gbase, voff) do { _Pragma("unroll") for (int _i = 0; _i < 2; ++_i) \
        __builtin_amdgcn_global_load_lds((const unsigned*)((const char*)(gbase) + (voff)[_i]), (PG8_LAS unsigned*)(lds + (bufoff) + ldsw + _i * 8192), 16, 0, 0); } while (0)
#define PG8_LDA(dst, b, h) do { _Pragma("unroll") for (int m = 0; m < 4; ++m) _Pragma("unroll") for (int k = 0; k < 2; ++k) dst[m][k] = *(const PG8_LAS bf16x8*)(lds + PG8_SA(b, h) + aoff + m * 2048 + k * 1024); } while (0)
#define PG8_LDB(dst, b, h) do { _Pragma("unroll") for (int n = 0; n < 2; ++n) _Pragma("unroll") for (int k = 0; k < 2; ++k) dst[n][k] = *(const PG8_LAS bf16x8*)(lds + PG8_SB(b, h) + boff + n * 2048 + k * 1024); } while (0)
#define PG8_MMA(ai, bj, At, Bt) do { __builtin_amdgcn_s_setprio(1); _Pragma("unroll") for (int m = 0; m < 4; ++m) _Pragma("unroll") for (int n = 0; n < 2; ++n) _Pragma("unroll") for (int k = 0; k < 2; ++k) \
        acc[ai][bj][m][n] = __builtin_amdgcn_mfma_f32_16x16x32_bf16(Bt[n][k], At[m][k], acc[ai][bj][m][n], 0, 0, 0); __builtin_amdgcn_s_setprio(0); } while (0)
#define PG8_WAIT_V(n) asm volatile("s_waitcnt vmcnt(" #n ")" ::: "memory")
#define PG8_WAIT_L(n) asm volatile("s_waitcnt lgkmcnt(" #n ")" ::: "memory")
#define PG8_BAR __builtin_amdgcn_s_barrier()
#define PG8_SCHED __builtin_amdgcn_sched_barrier(0)
    Unit cur, nxt; int ui = 0;
    if (!S.next(0, cur)) return;
    f32x4 acc[2][2][4][2];
#pragma unroll
    for (int a = 0; a < 2; ++a)
#pragma unroll
        for (int b = 0; b < 2; ++b)
#pragma unroll
            for (int m = 0; m < 4; ++m)
#pragma unroll
                for (int n = 0; n < 2; ++n) acc[a][b][m][n] = (f32x4){0.f, 0.f, 0.f, 0.f};
    bf16x8 At[4][2], B0[2][2], B1[2][2];
    const char* cA = (cur.sel ? gA1 : gA) + (size_t)cur.pm * tstep; const char* cB = (cur.sel ? gB1 : gB) + (size_t)cur.pn * tstep;
    S.a_ready(cur);
    PG8_STAGE(PG8_SB(0, 0), cB, voffB); PG8_STAGE(PG8_SA(0, 0), cA, voffA); PG8_STAGE(PG8_SB(0, 1), cB + hstep, voffB); PG8_STAGE(PG8_SA(0, 1), cA + hstep, voffA);
    if (wr == 1) PG8_BAR;
    PG8_WAIT_V(4); PG8_BAR;
    PG8_STAGE(PG8_SB(1, 0), cB + kstep, voffB); PG8_STAGE(PG8_SA(1, 0), cA + kstep, voffA); PG8_STAGE(PG8_SB(1, 1), cB + hstep + kstep, voffB);
    PG8_WAIT_V(6); PG8_BAR;
    for (;;) {
        const bool has_next = S.next(ui + 1, nxt);
        const char* nA = has_next ? (nxt.sel ? gA1 : gA) + (size_t)nxt.pm * tstep : cA; const char* nB = has_next ? (nxt.sel ? gB1 : gB) + (size_t)nxt.pn * tstep : cB;
        for (int t = 0; t < nt; t += 2) {
            const bool last = (t == nt - 2);
            const char* a1 = cA + (size_t)(t + 1) * kstep;
            const char* a2 = last ? nA : cA + (size_t)(t + 2) * kstep; const char* b2 = last ? nB : cB + (size_t)(t + 2) * kstep;
            const char* a3 = a2 + kstep; const char* b3 = b2 + kstep;
            if (last && has_next) S.a_ready(nxt);
            PG8_LDB(B0, 0, 0); PG8_SCHED; PG8_LDA(At, 0, 0); PG8_STAGE(PG8_SA(1, 1), a1 + hstep, voffA);
            PG8_WAIT_L(8); PG8_BAR; PG8_WAIT_L(0); PG8_MMA(0, 0, At, B0); PG8_BAR; PG8_SCHED;
            PG8_LDB(B1, 0, 1); PG8_STAGE(PG8_SB(0, 0), b2, voffB);
            PG8_BAR; PG8_WAIT_L(0); PG8_MMA(0, 1, At, B1); PG8_BAR;
            PG8_LDA(At, 0, 1); PG8_STAGE(PG8_SA(0, 0), a2, voffA);
            PG8_BAR; PG8_WAIT_L(0); PG8_MMA(1, 0, At, B0); PG8_BAR; PG8_SCHED;
            PG8_STAGE(PG8_SB(0, 1), b2 + hstep, voffB);
            PG8_WAIT_V(6); PG8_BAR; PG8_MMA(1, 1, At, B1); PG8_BAR;
            PG8_LDB(B0, 1, 0); PG8_SCHED; PG8_LDA(At, 1, 0); PG8_STAGE(PG8_SA(0, 1), a2 + hstep, voffA);
            PG8_WAIT_L(8); PG8_BAR; PG8_WAIT_L(0); PG8_MMA(0, 0, At, B0); PG8_BAR; PG8_SCHED;
            PG8_LDB(B1, 1, 1); PG8_STAGE(PG8_SB(1, 0), b3, voffB);
            PG8_BAR; PG8_WAIT_L(0); PG8_MMA(0, 1, At, B1); PG8_BAR;
            PG8_LDA(At, 1, 1); PG8_STAGE(PG8_SA(1, 0), a3, voffA);
            PG8_BAR; PG8_WAIT_L(0); PG8_MMA(1, 0, At, B0); PG8_BAR; PG8_SCHED;
            PG8_STAGE(PG8_SB(1, 1), b3 + hstep, voffB);
            PG8_WAIT_V(6); PG8_BAR; PG8_MMA(1, 1, At, B1); PG8_BAR;
        }
        if constexpr (!Epi::AFTER_DRAIN) { E(acc, cur, wr, wc, fr, fq); S.done(cur); }
        if (!has_next) break;
#pragma unroll
        for (int a = 0; a < 2; ++a)
#pragma unroll
            for (int b = 0; b < 2; ++b)
#pragma unroll
                for (int m = 0; m < 4; ++m)
#pragma unroll
                    for (int n = 0; n < 2; ++n) acc[a][b][m][n] = (f32x4){0.f, 0.f, 0.f, 0.f};
        cur = nxt; cA = nA; cB = nB; ++ui;
    }
    PG8_WAIT_V(0);
    if (wr == 0) PG8_BAR;
    PG8_BAR;
    if constexpr (Epi::AFTER_DRAIN) { E.fused(acc, cur, wr, wc, fr, fq, lds, wid, lane); S.done(cur); }
#undef PG8_SA
#undef PG8_SB
#undef PG8_STAGE
#undef PG8_LDA
#undef PG8_LDB
#undef PG8_MMA
#undef PG8_WAIT_V
#undef PG8_WAIT_L
#undef PG8_BAR
#undef PG8_SCHED
}
}

#define XB_TMO      128
#define XB_XCNT(j)  (256  + 64 * (j))
#define XB_XSUB(j)  (1280 + 64 * (j))
#define XB_XGEN(j)  (2304 + 64 * (j))
#define XB_TOP      3328
#define XB_TOPGEN   3392
#define XCD_BAR_WORDS 3456
#define XB_SPIN_CAP (1u << 18)
#define LAS __attribute__((address_space(3)))

__device__ __forceinline__ unsigned xb_ld(unsigned* p)              { return __hip_atomic_load(p, __ATOMIC_RELAXED, __HIP_MEMORY_SCOPE_AGENT); }
__device__ __forceinline__ unsigned xb_add(unsigned* p, unsigned v) { return __hip_atomic_fetch_add(p, v, __ATOMIC_RELAXED, __HIP_MEMORY_SCOPE_AGENT); }
__device__ __forceinline__ unsigned xb_xcc_id() { return (unsigned)__builtin_amdgcn_s_getreg((3 << 11) | 20) & 0xFu; }
#define XB_SPIN(cond, bar) do { unsigned _sp = 0; while (cond) { __builtin_amdgcn_s_sleep(1); \
    if ((++_sp & 255u) == 0u) { if (xb_ld(&(bar)[XB_TMO])) break; if (_sp > XB_SPIN_CAP) { atomicAdd(&(bar)[XB_TMO], 1u); break; } } } } while (0)

struct XcdBarrier {
    unsigned* bar; unsigned x;
    volatile LAS unsigned* st;
};

__device__ __forceinline__ XcdBarrier xcd_barrier_post(unsigned* bar, volatile LAS unsigned* st) {
    XcdBarrier b; b.bar = bar; b.x = xb_xcc_id(); b.st = st;
    if (threadIdx.x == 0) (void)xb_add(&bar[XB_XCNT(b.x)], 1u);
    return b;
}
__device__ __forceinline__ void xcd_barrier_complete(unsigned* bar, unsigned x, unsigned& nloc, unsigned& nx) {
    const unsigned G = gridDim.x * gridDim.y * gridDim.z;
    unsigned sum, cnt, mine, sp = 0u;
    for (;;) {
        sum = 0u; cnt = 0u; mine = 0u;
#pragma unroll
        for (unsigned j = 0; j < 16; ++j) { const unsigned c = xb_ld(&bar[XB_XCNT(j)]); sum += c; cnt += (c > 0u) ? 1u : 0u; mine = (j == x) ? c : mine; }
        if (sum == G) break;
        __builtin_amdgcn_s_sleep(1);
        if ((++sp & 255u) == 0u) { if (xb_ld(&bar[XB_TMO])) break; if (sp > XB_SPIN_CAP) { atomicAdd(&bar[XB_TMO], 1u); break; } }
    }
    nloc = mine > 0u ? mine : 1u; nx = cnt > 0u ? cnt : 1u;
}

__device__ __forceinline__ void xcd_barrier(const XcdBarrier& b) {
    asm volatile("s_waitcnt vmcnt(0)" ::: "memory");
    __syncthreads();
    if (threadIdx.x == 0) {
        unsigned* bar = b.bar;
        __builtin_amdgcn_s_waitcnt(0);
        unsigned nloc = b.st[0], nx = b.st[1];
        if (nloc == 0u) { xcd_barrier_complete(bar, b.x, nloc, nx); b.st[0] = nloc; b.st[1] = nx; }
        const unsigned old = xb_add(&bar[XB_XSUB(b.x)], 1u);
        const unsigned gen = old / nloc;
        if (old + 1u == (gen + 1u) * nloc) {
            __builtin_amdgcn_fence(__ATOMIC_RELEASE, "agent");
            asm volatile("s_waitcnt vmcnt(0)" ::: "memory");
            const unsigned og = xb_add(&bar[XB_TOP], 1u);
            const unsigned tg = og / nx;
            if (og + 1u == (tg + 1u) * nx) xb_add(&bar[XB_TOPGEN], 1u);
            else XB_SPIN(xb_ld(&bar[XB_TOPGEN]) == tg, bar);
            __builtin_amdgcn_fence(__ATOMIC_ACQUIRE, "agent");
            xb_add(&bar[XB_XGEN(b.x)], 1u);
            asm volatile("s_waitcnt vmcnt(0)" ::: "memory");
        } else {
            XB_SPIN(xb_ld(&bar[XB_XGEN(b.x)]) == gen, bar);
            __builtin_amdgcn_fence(__ATOMIC_ACQUIRE, "agent");
            asm volatile("s_waitcnt vmcnt(0)" ::: "memory");
        }
    }
    __syncthreads();
}

using pg8::bf16_t; using pg8::bf16x8; using pg8::f32x4;
typedef unsigned u32x2_t __attribute__((ext_vector_type(2)));
typedef unsigned u32x4_t __attribute__((ext_vector_type(4)));

constexpr int DM = 1024, SEG = 16384, LDZ = 8192, LDY = 2560;
constexpr float EPS = 1e-6f;
constexpr int XST_OFF = 9 * 16384 + 2048;
constexpr int LDS_BYTES = XST_OFF + 64;
constexpr size_t WS_WIN_E = 0;
constexpr size_t WS_WIN_O = WS_WIN_E + (size_t)9216 * 1024 * 2;
constexpr size_t WS_WOUT_E = WS_WIN_O + (size_t)6144 * 1024 * 2;
constexpr size_t WS_WOUT_O = WS_WOUT_E + (size_t)1024 * 2560 * 2;
constexpr size_t WS_WKV = WS_WOUT_O + (size_t)1024 * 2560 * 2;
constexpr size_t WS_LRUW = WS_WKV + (size_t)2 * 1024 * 1024 * 2;
constexpr size_t WS_SGUW = WS_LRUW + (size_t)2 * 2 * 8 * 128 * 128 * 2;
constexpr size_t WS_MEMN = WS_SGUW + (size_t)8 * 128 * 128 * 2;
constexpr size_t WS_MK = WS_MEMN + (size_t)2 * 1536 * 1024 * 2;
constexpr size_t WS_MVT = WS_MK + (size_t)2 * 1536 * 512 * 2;
constexpr size_t WS_H = WS_MVT + (size_t)2 * 512 * 1536 * 2;
constexpr size_t WS_Z = WS_H + (size_t)SEG * 1024 * 2;
constexpr size_t WS_VT = WS_Z + (size_t)SEG * LDZ * 2;
constexpr size_t WS_Y = WS_VT + (size_t)1024 * SEG * 2;
constexpr size_t WS_AGG = WS_Y + (size_t)SEG * LDY * 2;
constexpr size_t WS_CARRY = WS_AGG + (size_t)2 * 128 * 1024 * 2 * 4;
constexpr size_t WS_RSTD = WS_CARRY + (size_t)2 * 128 * 1024 * 4;
constexpr size_t WS_PART = WS_RSTD + (size_t)SEG * 4;
constexpr size_t WS_BAR = WS_PART + (size_t)8 * SEG * 4;
constexpr size_t WS_LAB = WS_BAR + 16384;
constexpr size_t WS_END = WS_LAB + (size_t)2 * SEG * 1024 * 4;

struct Params { const float* in[25]; float* out; unsigned char* ws; };

__device__ __forceinline__ float bf2f(unsigned short b) { return __uint_as_float(((unsigned)b) << 16); }
__device__ __forceinline__ unsigned short f2bf(float f) { unsigned u = __float_as_uint(f); u += 0x7FFFu + ((u >> 16) & 1u); return (unsigned short)(u >> 16); }
__device__ __forceinline__ float bflo(unsigned w) { return __uint_as_float(w << 16); }
__device__ __forceinline__ float bfhi(unsigned w) { return __uint_as_float(w & 0xffff0000u); }
__device__ __forceinline__ unsigned pk2(float lo, float hi) { return pg8::cvt_pk_bf16(lo, hi); }
__device__ __forceinline__ float frcp(float x) { return __builtin_amdgcn_rcpf(x); }
__device__ __forceinline__ float silu(float x) { return x * frcp(1.0f + __expf(-x)); }
__device__ __forceinline__ float sigm(float x) { return frcp(1.0f + __expf(-x)); }
__device__ __forceinline__ float wave_sum(float v) {
#pragma unroll
    for (int o = 1; o < 64; o <<= 1) v += __shfl_xor(v, o);
    return v;
}
__device__ __forceinline__ f32x4 mfma16(bf16x8 a, bf16x8 b, f32x4 c) { return __builtin_amdgcn_mfma_f32_16x16x32_bf16(a, b, c, 0, 0, 0); }
__device__ __forceinline__ bf16x8 ld8(const bf16_t* p) { return *(const bf16x8*)p; }
__device__ __forceinline__ bf16x8 pack8(const float (&v)[8]) {
    u32x4_t w; w.x = pk2(v[0], v[1]); w.y = pk2(v[2], v[3]); w.z = pk2(v[4], v[5]); w.w = pk2(v[6], v[7]);
    return __builtin_bit_cast(bf16x8, w);
}

__device__ __forceinline__ void transpose_item(const float* W, int K, int N, bf16_t* WT, LAS float* scr, int item, int lane) {
    const int nblk = N >> 5, kb = item / nblk, nb = item - kb * nblk, k0 = 64 * kb, n0 = 32 * nb;
#pragma unroll 8
    for (int i = 0; i < 32; ++i) { const int kk = 2 * i + (lane >> 5); scr[kk * 33 + (lane & 31)] = W[(size_t)(k0 + kk) * N + n0 + (lane & 31)]; }
    asm volatile("s_waitcnt lgkmcnt(0)" ::: "memory");
    const int c = lane & 7;
#pragma unroll
    for (int j = 0; j < 4; ++j) { const int n = (lane >> 3) + 8 * j; const LAS float* s = scr + (8 * c) * 33 + n;
        u32x4_t o; o.x = pk2(s[0 * 33], s[1 * 33]); o.y = pk2(s[2 * 33], s[3 * 33]); o.z = pk2(s[4 * 33], s[5 * 33]); o.w = pk2(s[6 * 33], s[7 * 33]);
        *(u32x4_t*)(WT + (size_t)(n0 + n) * K + k0 + 8 * c) = o; }
    asm volatile("s_waitcnt lgkmcnt(0)" ::: "memory");
}

__device__ __forceinline__ void rms_row_bf16(const float* xrow, const float* g, bf16_t* orow, int lane) {
    const f32x4* xr = (const f32x4*)xrow + lane; f32x4 v[4]; float s = 0.f;
#pragma unroll
    for (int j = 0; j < 4; ++j) { v[j] = xr[64 * j]; s += (v[j].x * v[j].x + v[j].y * v[j].y) + (v[j].z * v[j].z + v[j].w * v[j].w); }
    const float rstd = __builtin_amdgcn_rsqf(wave_sum(s) * (1.0f / 1024.0f) + EPS);
    const f32x4* gr = (const f32x4*)g + lane; u32x2_t* o8 = (u32x2_t*)orow + lane;
#pragma unroll
    for (int j = 0; j < 4; ++j) { const f32x4 gg = gr[64 * j]; u32x2_t o; o.x = pk2(v[j].x * rstd * gg.x, v[j].y * rstd * gg.y); o.y = pk2(v[j].z * rstd * gg.z, v[j].w * rstd * gg.w); o8[64 * j] = o; }
}
__device__ __forceinline__ void rms_row_f32(float* xrow, const float* g, int lane) {
    f32x4* xr = (f32x4*)xrow + lane; f32x4 v[4]; float s = 0.f;
#pragma unroll
    for (int j = 0; j < 4; ++j) { v[j] = xr[64 * j]; s += (v[j].x * v[j].x + v[j].y * v[j].y) + (v[j].z * v[j].z + v[j].w * v[j].w); }
    const float rstd = __builtin_amdgcn_rsqf(wave_sum(s) * (1.0f / 1024.0f) + EPS);
    const f32x4* gr = (const f32x4*)g + lane;
#pragma unroll
    for (int j = 0; j < 4; ++j) { const f32x4 gg = gr[64 * j]; f32x4 o; o.x = v[j].x * rstd * gg.x; o.y = v[j].y * rstd * gg.y; o.z = v[j].z * rstd * gg.z; o.w = v[j].w * rstd * gg.w; xr[64 * j] = o; }
}

__device__ __forceinline__ void rms_rows4_bf16(const float* xrow, const float* g, bf16_t* orow, int lane) {
    f32x4 v[4][4]; float s[4];
#pragma unroll
    for (int r = 0; r < 4; ++r)
#pragma unroll
        for (int j = 0; j < 4; ++j) v[r][j] = ((const f32x4*)(xrow + (size_t)r * 1024))[lane + 64 * j];
    f32x4 gg[4];
#pragma unroll
    for (int j = 0; j < 4; ++j) gg[j] = ((const f32x4*)g)[lane + 64 * j];
#pragma unroll
    for (int r = 0; r < 4; ++r) { s[r] = 0.f;
#pragma unroll
        for (int j = 0; j < 4; ++j) s[r] += (v[r][j].x * v[r][j].x + v[r][j].y * v[r][j].y) + (v[r][j].z * v[r][j].z + v[r][j].w * v[r][j].w); }
#pragma unroll
    for (int o = 1; o < 64; o <<= 1) {
#pragma unroll
        for (int r = 0; r < 4; ++r) s[r] += __shfl_xor(s[r], o); }
#pragma unroll
    for (int r = 0; r < 4; ++r) { const float rstd = __builtin_amdgcn_rsqf(s[r] * (1.0f / 1024.0f) + EPS);
        u32x2_t* o8 = (u32x2_t*)(orow + (size_t)r * 1024) + lane;
#pragma unroll
        for (int j = 0; j < 4; ++j) { u32x2_t o; o.x = pk2(v[r][j].x * rstd * gg[j].x, v[r][j].y * rstd * gg[j].y); o.y = pk2(v[r][j].z * rstd * gg[j].z, v[r][j].w * rstd * gg[j].w); o8[64 * j] = o; } }
}
__device__ __forceinline__ void rms_rows4_f32(float* xrow, const float* g, int lane) {
    f32x4 v[4][4]; float s[4];
#pragma unroll
    for (int r = 0; r < 4; ++r)
#pragma unroll
        for (int j = 0; j < 4; ++j) v[r][j] = ((const f32x4*)(xrow + (size_t)r * 1024))[lane + 64 * j];
    f32x4 gg[4];
#pragma unroll
    for (int j = 0; j < 4; ++j) gg[j] = ((const f32x4*)g)[lane + 64 * j];
#pragma unroll
    for (int r = 0; r < 4; ++r) { s[r] = 0.f;
#pragma unroll
        for (int j = 0; j < 4; ++j) s[r] += (v[r][j].x * v[r][j].x + v[r][j].y * v[r][j].y) + (v[r][j].z * v[r][j].z + v[r][j].w * v[r][j].w); }
#pragma unroll
    for (int o = 1; o < 64; o <<= 1) {
#pragma unroll
        for (int r = 0; r < 4; ++r) s[r] += __shfl_xor(s[r], o); }
#pragma unroll
    for (int r = 0; r < 4; ++r) { const float rstd = __builtin_amdgcn_rsqf(s[r] * (1.0f / 1024.0f) + EPS);
        f32x4* xo = (f32x4*)(xrow + (size_t)r * 1024) + lane;
#pragma unroll
        for (int j = 0; j < 4; ++j) { f32x4 o; o.x = v[r][j].x * rstd * gg[j].x; o.y = v[r][j].y * rstd * gg[j].y; o.z = v[r][j].z * rstd * gg[j].z; o.w = v[r][j].w * rstd * gg[j].w; xo[64 * j] = o; } }
}

__device__ __forceinline__ void conv_even_item(const bf16_t* z, const float* cw, const float* cb, bf16_t* y, int t0, int T, int lane) {
    const int s = t0 & (T - 1);
#pragma unroll
    for (int half = 0; half < 2; ++half) {
        const int c0 = half * 512 + lane * 8;
        const bf16_t* zr = z + (size_t)t0 * LDZ + c0;
        u32x4_t cg[4], xv[4], bg[2], ga[2];
#pragma unroll
        for (int i = 0; i < 4; ++i) { cg[i] = (u32x4_t){0u, 0u, 0u, 0u}; xv[i] = (u32x4_t){0u, 0u, 0u, 0u}; }
        if (s > 0) { cg[0] = *(const u32x4_t*)(zr - LDZ + 1024); xv[0] = *(const u32x4_t*)(zr - LDZ + 2048); }
        cg[1] = *(const u32x4_t*)(zr + 1024); xv[1] = *(const u32x4_t*)(zr + 2048);
        cg[2] = *(const u32x4_t*)(zr + LDZ + 1024); xv[2] = *(const u32x4_t*)(zr + LDZ + 2048);
        if (s + 2 < T) { cg[3] = *(const u32x4_t*)(zr + 2 * LDZ + 1024); xv[3] = *(const u32x4_t*)(zr + 2 * LDZ + 2048); }
        bg[0] = *(const u32x4_t*)(zr); ga[0] = *(const u32x4_t*)(zr + 3072);
        bg[1] = *(const u32x4_t*)(zr + LDZ); ga[1] = *(const u32x4_t*)(zr + LDZ + 3072);
        float w0[8], w1[8], w2[8], bb[8];
#pragma unroll
        for (int e = 0; e < 8; e += 4) {
            const f32x4 a = *(const f32x4*)(cw + c0 + e), b = *(const f32x4*)(cw + 1024 + c0 + e), c = *(const f32x4*)(cw + 2048 + c0 + e), d = *(const f32x4*)(cb + c0 + e);
#pragma unroll
            for (int k = 0; k < 4; ++k) { w0[e + k] = a[k]; w1[e + k] = b[k]; w2[e + k] = c[k]; bb[e + k] = d[k]; }
        }
        float p[4][8];
#pragma unroll
        for (int i = 0; i < 4; ++i)
#pragma unroll
            for (int k = 0; k < 4; ++k) { p[i][2 * k] = bflo(cg[i][k]) * bflo(xv[i][k]); p[i][2 * k + 1] = bfhi(cg[i][k]) * bfhi(xv[i][k]); }
#pragma unroll
        for (int tt = 0; tt < 2; ++tt) {
            float o[8];
#pragma unroll
            for (int k = 0; k < 4; ++k) {
                const float cl = bb[2 * k] + w0[2 * k] * p[tt][2 * k] + w1[2 * k] * p[tt + 1][2 * k] + w2[2 * k] * p[tt + 2][2 * k];
                const float ch = bb[2 * k + 1] + w0[2 * k + 1] * p[tt][2 * k + 1] + w1[2 * k + 1] * p[tt + 1][2 * k + 1] + w2[2 * k + 1] * p[tt + 2][2 * k + 1];
                o[2 * k] = bflo(bg[tt][k]) * cl * silu(bflo(ga[tt][k]));
                o[2 * k + 1] = bfhi(bg[tt][k]) * ch * silu(bfhi(ga[tt][k]));
            }
            u32x4_t w; w.x = pk2(o[0], o[1]); w.y = pk2(o[2], o[3]); w.z = pk2(o[4], o[5]); w.w = pk2(o[6], o[7]);
            *(u32x4_t*)(y + (size_t)(t0 + tt) * LDY + c0) = w;
        }
    }
}

__device__ __forceinline__ void conv_odd_item(const bf16_t* z, const float* cw, const float* cb, bf16_t* xc, int t, int T, int lane) {
    const int s = t & (T - 1);
#pragma unroll
    for (int half = 0; half < 2; ++half) {
        const int c0 = half * 512 + lane * 8;
        const bf16_t* zr = z + (size_t)t * LDZ + c0;
        float acc[8];
#pragma unroll
        for (int e = 0; e < 8; e += 4) { const f32x4 d = *(const f32x4*)(cb + c0 + e); acc[e] = d[0]; acc[e + 1] = d[1]; acc[e + 2] = d[2]; acc[e + 3] = d[3]; }
#pragma unroll
        for (int j = 0; j < 4; ++j) {
            const int sj = s + j - 2;
            if (sj >= 0 && sj < T) {
                const u32x4_t xv = *(const u32x4_t*)(zr + (ptrdiff_t)(j - 2) * LDZ);
                const f32x4 wa = *(const f32x4*)(cw + j * 1024 + c0), wb = *(const f32x4*)(cw + j * 1024 + c0 + 4);
                acc[0] += wa[0] * bflo(xv[0]); acc[1] += wa[1] * bfhi(xv[0]); acc[2] += wa[2] * bflo(xv[1]); acc[3] += wa[3] * bfhi(xv[1]);
                acc[4] += wb[0] * bflo(xv[2]); acc[5] += wb[1] * bfhi(xv[2]); acc[6] += wb[2] * bflo(xv[3]); acc[7] += wb[3] * bfhi(xv[3]);
            }
        }
        u32x4_t w; w.x = pk2(acc[0], acc[1]); w.y = pk2(acc[2], acc[3]); w.z = pk2(acc[4], acc[5]); w.w = pk2(acc[6], acc[7]);
        *(u32x4_t*)(xc + (size_t)t * 1024 + c0) = w;
    }
}
__device__ __forceinline__ void rstd_item(const float* part, float* rstd, int tg, int lane) {
    const float* p = part + tg * 64 + lane; float s = 0.f;
#pragma unroll
    for (int i = 0; i < 8; ++i) s += p[(size_t)i * SEG];
    rstd[tg * 64 + lane] = __builtin_amdgcn_rsqf(s * (1.0f / 1024.0f) + EPS);
}

constexpr int NA_RING = 9 * 16384, NA_RPB = NA_RING, NA_LDS_END = NA_RING + 2048;
__device__ __forceinline__ int na_fk(int key) { return ((key >> 1) & 1) | (((key >> 3) & 3) << 1); }
__device__ __forceinline__ void na_stage_row(const bf16_t* z, const bf16_t* vT, LAS unsigned char* slot, int tokr, int h, int lt, int nth) {
    for (int idx = lt; idx < 512; idx += nth) {
        const int rw = idx >> 3, c = idx & 7;
        const u32x4_t kv = *(const u32x4_t*)(z + (size_t)(tokr + rw) * LDZ + 5120 + h * 64 + c * 8);
        const u32x4_t vv = *(const u32x4_t*)(vT + (size_t)(h * 64 + rw) * SEG + tokr + c * 8);
        *(LAS u32x4_t*)(slot + rw * 128 + ((c ^ na_fk(rw)) << 4)) = kv;
        *(LAS u32x4_t*)(slot + 8192 + rw * 128 + ((c ^ ((rw >> 1) & 7)) << 4)) = vv;
    }
}
__device__ __forceinline__ void na_block(const bf16_t* z, const bf16_t* vT, bf16_t* y, const float* rpb, int unit, int T, LAS unsigned char* lds, int tid) {
    const int h = unit & 15, R0 = (unit >> 4) * 16;
    const int rows = T >> 6, seq = R0 / rows, rr0 = R0 - seq * rows, seq_base = seq * T;
    const int lane = tid & 63, wid = tid >> 6, fr = lane & 15, fq = lane >> 4;
    LAS float* rpbL = (LAS float*)(lds + NA_RPB);
    __syncthreads();
    for (int i = tid; i < 465; i += 512) rpbL[i] = rpb[h * 465 + i];
    int rs0 = rr0 - 4; rs0 = rs0 < 0 ? 0 : rs0; rs0 = rs0 > rows - 8 ? rows - 8 : rs0;
    {
        const int rw = tid >> 3, c = tid & 7;
        u32x4_t kv[8], vv[8];
#pragma unroll
        for (int kr = 0; kr < 8; ++kr) { const int tokr = seq_base + (rs0 + kr) * 64;
            kv[kr] = *(const u32x4_t*)(z + (size_t)(tokr + rw) * LDZ + 5120 + h * 64 + c * 8);
            vv[kr] = *(const u32x4_t*)(vT + (size_t)(h * 64 + rw) * SEG + tokr + c * 8); }
#pragma unroll
        for (int kr = 0; kr < 8; ++kr) { LAS unsigned char* slot = lds + ((rs0 + kr) % 9) * 16384;
            *(LAS u32x4_t*)(slot + rw * 128 + ((c ^ na_fk(rw)) << 4)) = kv[kr];
            *(LAS u32x4_t*)(slot + 8192 + rw * 128 + ((c ^ ((rw >> 1) & 7)) << 4)) = vv[kr]; }
    }
    __syncthreads();
    const int g = wid & 3;
    const int wb = (g == 0) ? 0 : (g == 1) ? 8 : (g == 2) ? 24 : 32;
    const int keyA = wb + (fr >> 2) * 8 + (fr & 3);
    const int offK0 = keyA * 128 + (((0 + fq) ^ na_fk(keyA)) << 4), offK1 = keyA * 128 + (((4 + fq) ^ na_fk(keyA)) << 4);
    const int offV = 8192 + fr * 128 + ((((wb >> 3) + fq) ^ ((fr >> 1) & 7)) << 4);
    const int qc = g * 16 + fr;
    int cstart = qc - 8; cstart = cstart < 0 ? 0 : cstart; cstart = cstart > 48 ? 48 : cstart;
    int dcs[8]; bool oks[8];
#pragma unroll
    for (int e = 0; e < 8; ++e) { const int kc = wb + fq * 8 + e; oks[e] = (kc >= cstart) && (kc < cstart + 16); int dc = kc - qc; dc = dc < -15 ? -15 : dc; dc = dc > 15 ? 15 : dc; dcs[e] = dc + 15; }
    const bf16_t* zt = z + (size_t)(seq_base + rr0 * 64 + g * 16 + fr) * LDZ;
    bf16x8 q0 = ld8(zt + 4096 + h * 64 + fq * 8), q1 = ld8(zt + 4096 + h * 64 + fq * 8 + 32);
    u32x2_t gr[4];
#pragma unroll
    for (int dt = 0; dt < 4; ++dt) gr[dt] = *(const u32x2_t*)(zt + 6144 + h * 64 + dt * 16 + fq * 4);
#pragma unroll 1
    for (int i = 0; i < 16; ++i) {
        const int rr = rr0 + i;
        int rs = rr - 4; rs = rs < 0 ? 0 : rs; rs = rs > rows - 8 ? rows - 8 : rs;
        int rsn = rr - 3; rsn = rsn < 0 ? 0 : rsn; rsn = rsn > rows - 8 ? rows - 8 : rsn;
        if (wid >= 4) {
            if (i < 15 && rsn > rs) { const int a = rsn + 7, tokr = seq_base + a * 64, lt = tid - 256; LAS unsigned char* slot = lds + (a % 9) * 16384;
                u32x4_t kv[2], vv[2];
#pragma unroll
                for (int j = 0; j < 2; ++j) { const int idx = lt + 256 * j, rw = idx >> 3, c = idx & 7;
                    kv[j] = *(const u32x4_t*)(z + (size_t)(tokr + rw) * LDZ + 5120 + h * 64 + c * 8); vv[j] = *(const u32x4_t*)(vT + (size_t)(h * 64 + rw) * SEG + tokr + c * 8); }
#pragma unroll
                for (int j = 0; j < 2; ++j) { const int idx = lt + 256 * j, rw = idx >> 3, c = idx & 7;
                    *(LAS u32x4_t*)(slot + rw * 128 + ((c ^ na_fk(rw)) << 4)) = kv[j]; *(LAS u32x4_t*)(slot + 8192 + rw * 128 + ((c ^ ((rw >> 1) & 7)) << 4)) = vv[j]; } }
        } else {
            const bf16_t* ztc = zt + (size_t)i * 64 * LDZ;
            bf16x8 q0n = q0, q1n = q1; u32x2_t grn[4];
#pragma unroll
            for (int dt = 0; dt < 4; ++dt) grn[dt] = gr[dt];
            if (i < 15) {
                const bf16_t* ztn = ztc + (size_t)64 * LDZ;
                q0n = ld8(ztn + 4096 + h * 64 + fq * 8); q1n = ld8(ztn + 4096 + h * 64 + fq * 8 + 32);
#pragma unroll
                for (int dt = 0; dt < 4; ++dt) grn[dt] = *(const u32x2_t*)(ztn + 6144 + h * 64 + dt * 16 + fq * 4);
            }
            const LAS float* bp0 = rpbL + (rs - rr + 7) * 31;
            float s[8][8];
            float mx = -1e30f;
            int slot = rs % 9;
#pragma unroll
            for (int kr = 0; kr < 8; ++kr) {
                const LAS unsigned char* sb = lds + slot * 16384;
                slot = (slot == 8) ? 0 : slot + 1;
                const bf16x8 k00 = *(const LAS bf16x8*)(sb + offK0), k01 = *(const LAS bf16x8*)(sb + offK1);
                const bf16x8 k10 = *(const LAS bf16x8*)(sb + offK0 + 512), k11 = *(const LAS bf16x8*)(sb + offK1 + 512);
                f32x4 a0 = {0.f, 0.f, 0.f, 0.f}, a1 = {0.f, 0.f, 0.f, 0.f};
                a0 = mfma16(k00, q0, a0); a0 = mfma16(k01, q1, a0);
                a1 = mfma16(k10, q0, a1); a1 = mfma16(k11, q1, a1);
#pragma unroll
                for (int e = 0; e < 8; ++e) {
                    const float sc = (e < 4 ? a0[e & 3] : a1[e & 3]) * 0.125f + bp0[kr * 31 + dcs[e]];
                    s[kr][e] = oks[e] ? sc : -1e30f;
                    mx = fmaxf(mx, s[kr][e]);
                }
            }
            mx = fmaxf(mx, __shfl_xor(mx, 16)); mx = fmaxf(mx, __shfl_xor(mx, 32));
            float sum = 0.f;
#pragma unroll
            for (int kr = 0; kr < 8; ++kr)
#pragma unroll
                for (int e = 0; e < 8; ++e) { const float p = __expf(s[kr][e] - mx); s[kr][e] = p; sum += p; }
            sum += __shfl_xor(sum, 16); sum += __shfl_xor(sum, 32);
            f32x4 o[4];
#pragma unroll
            for (int dt = 0; dt < 4; ++dt) o[dt] = (f32x4){0.f, 0.f, 0.f, 0.f};
            slot = rs % 9;
#pragma unroll
            for (int kr = 0; kr < 8; ++kr) {
                const LAS unsigned char* sb = lds + slot * 16384 + offV;
                slot = (slot == 8) ? 0 : slot + 1;
                const bf16x8 pf = pack8(s[kr]);
#pragma unroll
                for (int dt = 0; dt < 4; ++dt) o[dt] = mfma16(*(const LAS bf16x8*)(sb + dt * 2048), pf, o[dt]);
            }
            const float inv = frcp(sum);
            bf16_t* yt = y + (size_t)(seq_base + rr * 64 + g * 16 + fr) * LDY + 1024 + h * 64;
#pragma unroll
            for (int dt = 0; dt < 4; ++dt) {
                u32x2_t ow;
                ow.x = pk2(o[dt][0] * inv * silu(bflo(gr[dt].x)), o[dt][1] * inv * silu(bfhi(gr[dt].x)));
                ow.y = pk2(o[dt][2] * inv * silu(bflo(gr[dt].y)), o[dt][3] * inv * silu(bfhi(gr[dt].y)));
                *(u32x2_t*)(yt + dt * 16 + fq * 4) = ow;
            }
            q0 = q0n; q1 = q1n;
#pragma unroll
            for (int dt = 0; dt < 4; ++dt) gr[dt] = grn[dt];
        }
        __syncthreads();
    }
}

__device__ __forceinline__ void mem_unit(const bf16_t* z, int qcol, int gcol, const bf16_t* mk, const bf16_t* mvT, bf16_t* y, int unit, int seg, LAS unsigned char* lds, int tid) {
    const int h = unit & 3, range = unit >> 2, tokr = range * 256;
    const int mb = seg < 2 ? seg : 2 + (tokr >> 12);
    const int lane = tid & 63, wid = tid >> 6, fr = lane & 15, fq = lane >> 4;
    __syncthreads();
    {
        u32x4_t kv[8], vv[8];
#pragma unroll
        for (int i = 0; i < 8; ++i) { const int idx = tid + 512 * i;
            kv[i] = *(const u32x4_t*)(mk + (size_t)(mb * 256 + (idx >> 4)) * 512 + h * 128 + (idx & 15) * 8);
            vv[i] = *(const u32x4_t*)(mvT + (size_t)(h * 128 + (idx >> 5)) * 1536 + mb * 256 + (idx & 31) * 8); }
#pragma unroll
        for (int i = 0; i < 8; ++i) { const int idx = tid + 512 * i;
            { const int rho = idx >> 4, c = idx & 15, f = (rho & 3) | (((rho >> 3) & 3) << 2); *(LAS u32x4_t*)(lds + rho * 256 + ((c ^ f) << 4)) = kv[i]; }
            { const int d = idx >> 5, c = idx & 31; *(LAS u32x4_t*)(lds + 65536 + d * 512 + ((c ^ (d & 15)) << 4)) = vv[i]; } }
    }
    __syncthreads();
    const int mrowA = (fr >> 2) * 8 + (fr & 3);
    const LAS unsigned char* kbase = lds + mrowA * 256 + ((fq ^ (fr & 3)) << 4);
    const LAS unsigned char* vbase = lds + 65536 + fr * 512 + ((fq ^ (fr & 3)) << 4);
    const int hi = fr >> 2;
#pragma unroll 1
    for (int gi = 0; gi < 2; ++gi) {
        const int tok = tokr + (wid + 8 * gi) * 16 + fr;
        const bf16_t* qp = z + (size_t)tok * LDZ + qcol + h * 128 + fq * 8;
        bf16x8 q[4];
#pragma unroll
        for (int ks = 0; ks < 4; ++ks) q[ks] = ld8(qp + ks * 32);
        u32x2_t gr[8];
#pragma unroll
        for (int dt = 0; dt < 8; ++dt) gr[dt] = *(const u32x2_t*)(z + (size_t)tok * LDZ + gcol + h * 128 + dt * 16 + fq * 4);
        float s[8][8];
        float mx = -1e30f;
#pragma unroll
        for (int kb = 0; kb < 8; ++kb) {
            f32x4 a0 = {0.f, 0.f, 0.f, 0.f}, a1 = {0.f, 0.f, 0.f, 0.f};
#pragma unroll
            for (int ks = 0; ks < 4; ++ks) {
                const LAS unsigned char* kp = kbase + kb * 8192 + ((ks ^ hi) << 6);
                a0 = mfma16(*(const LAS bf16x8*)kp, q[ks], a0); a1 = mfma16(*(const LAS bf16x8*)(kp + 1024), q[ks], a1);
            }
#pragma unroll
            for (int e = 0; e < 8; ++e) { s[kb][e] = (e < 4 ? a0[e & 3] : a1[e & 3]) * 0.08838834764831845f; mx = fmaxf(mx, s[kb][e]); }
        }
        mx = fmaxf(mx, __shfl_xor(mx, 16)); mx = fmaxf(mx, __shfl_xor(mx, 32));
        float sum = 0.f;
#pragma unroll
        for (int kb = 0; kb < 8; ++kb)
#pragma unroll
            for (int e = 0; e < 8; ++e) { const float p = __expf(s[kb][e] - mx); s[kb][e] = p; sum += p; }
        sum += __shfl_xor(sum, 16); sum += __shfl_xor(sum, 32);
        f32x4 o[8];
#pragma unroll
        for (int dt = 0; dt < 8; ++dt) o[dt] = (f32x4){0.f, 0.f, 0.f, 0.f};
#pragma unroll
        for (int kb = 0; kb < 8; ++kb) {
            const bf16x8 pf = pack8(s[kb]);
            const LAS unsigned char* vp = vbase + (((kb ^ hi) & 7) << 6);
#pragma unroll
            for (int dt = 0; dt < 8; ++dt) o[dt] = mfma16(*(const LAS bf16x8*)(vp + dt * 8192), pf, o[dt]);
        }
        const float inv = frcp(sum);
#pragma unroll
        for (int dt = 0; dt < 8; ++dt) {
            const int d4 = dt * 16 + fq * 4;
            u32x2_t ow;
            ow.x = pk2(o[dt][0] * inv * silu(bflo(gr[dt].x)), o[dt][1] * inv * silu(bfhi(gr[dt].x)));
            ow.y = pk2(o[dt][2] * inv * silu(bflo(gr[dt].y)), o[dt][3] * inv * silu(bfhi(gr[dt].y)));
            *(u32x2_t*)(y + (size_t)tok * LDY + 2048 + h * 128 + d4) = ow;
        }
    }
}

template <int CTRL> __device__ __forceinline__ float dppf(float oldv, float src) {
    return __int_as_float(__builtin_amdgcn_update_dpp(__float_as_int(oldv), __float_as_int(src), CTRL, 0xf, 0xf, false));
}
#define SCAN_STEP(SH) \
    "v_fmac_f32_dpp %4, %4, %0 " SH " row_mask:0xf bank_mask:0xf\n" \
    "v_fmac_f32_dpp %5, %5, %1 " SH " row_mask:0xf bank_mask:0xf\n" \
    "v_fmac_f32_dpp %6, %6, %2 " SH " row_mask:0xf bank_mask:0xf\n" \
    "v_fmac_f32_dpp %7, %7, %3 " SH " row_mask:0xf bank_mask:0xf\n" \
    "v_mul_f32_dpp %0, %0, %0 " SH " row_mask:0xf bank_mask:0xf\n" \
    "v_mul_f32_dpp %1, %1, %1 " SH " row_mask:0xf bank_mask:0xf\n" \
    "v_mul_f32_dpp %2, %2, %2 " SH " row_mask:0xf bank_mask:0xf\n" \
    "v_mul_f32_dpp %3, %3, %3 " SH " row_mask:0xf bank_mask:0xf\n"
template <int DIR> __device__ __forceinline__ void scan16x4(float (&A)[4], float (&B)[4]) {
    if (DIR == 0)
        asm volatile("s_nop 1\n" SCAN_STEP("row_shr:1") SCAN_STEP("row_shr:2") SCAN_STEP("row_shr:4") SCAN_STEP("row_shr:8")
                     : "+v"(A[0]), "+v"(A[1]), "+v"(A[2]), "+v"(A[3]), "+v"(B[0]), "+v"(B[1]), "+v"(B[2]), "+v"(B[3]));
    else
        asm volatile("s_nop 1\n" SCAN_STEP("row_shl:1") SCAN_STEP("row_shl:2") SCAN_STEP("row_shl:4") SCAN_STEP("row_shl:8")
                     : "+v"(A[0]), "+v"(A[1]), "+v"(A[2]), "+v"(A[3]), "+v"(B[0]), "+v"(B[1]), "+v"(B[2]), "+v"(B[3]));
}
template <int DIR> __device__ __forceinline__ void bcast4(const float (&v)[4], float (&o)[4]) {
    if (DIR == 0)
        asm volatile("s_nop 1\n"
                     "v_mov_b32_dpp %0, %4 row_newbcast:15 row_mask:0xf bank_mask:0xf\n" "v_mov_b32_dpp %1, %5 row_newbcast:15 row_mask:0xf bank_mask:0xf\n"
                     "v_mov_b32_dpp %2, %6 row_newbcast:15 row_mask:0xf bank_mask:0xf\n" "v_mov_b32_dpp %3, %7 row_newbcast:15 row_mask:0xf bank_mask:0xf\n"
                     : "=&v"(o[0]), "=&v"(o[1]), "=&v"(o[2]), "=&v"(o[3]) : "v"(v[0]), "v"(v[1]), "v"(v[2]), "v"(v[3]));
    else
        asm volatile("s_nop 1\n"
                     "v_mov_b32_dpp %0, %4 row_newbcast:0 row_mask:0xf bank_mask:0xf\n" "v_mov_b32_dpp %1, %5 row_newbcast:0 row_mask:0xf bank_mask:0xf\n"
                     "v_mov_b32_dpp %2, %6 row_newbcast:0 row_mask:0xf bank_mask:0xf\n" "v_mov_b32_dpp %3, %7 row_newbcast:0 row_mask:0xf bank_mask:0xf\n"
                     : "=&v"(o[0]), "=&v"(o[1]), "=&v"(o[2]), "=&v"(o[3]) : "v"(v[0]), "v"(v[1]), "v"(v[2]), "v"(v[3]));
}
struct LruW { bf16x8 Wa[4], Wi[4]; float ba[4], bi[4], c8[4]; };
struct LruX { bf16x8 x[2][4]; u32x2_t xr[2]; };
__device__ __forceinline__ void lru_loadw(LruW& W, const bf16_t* lruw, const float* ba_, const float* bi_, const float* lam_, int dir, int blk, int w, int ch4, int lane) {
    const int fr = lane & 15, fq = lane >> 4;
    const bf16_t* wa = lruw + ((size_t)((0 * 2 + dir) * 8 + blk) * 128 + w * 16 + fr) * 128 + fq * 8;
    const bf16_t* wi = lruw + ((size_t)((1 * 2 + dir) * 8 + blk) * 128 + w * 16 + fr) * 128 + fq * 8;
#pragma unroll
    for (int ks = 0; ks < 4; ++ks) { W.Wa[ks] = ld8(wa + ks * 32); W.Wi[ks] = ld8(wi + ks * 32); }
    const f32x4 a = *(const f32x4*)(ba_ + dir * 1024 + ch4), b = *(const f32x4*)(bi_ + dir * 1024 + ch4), l = *(const f32x4*)(lam_ + dir * 1024 + ch4);
#pragma unroll
    for (int jj = 0; jj < 4; ++jj) { W.ba[jj] = -1.4426950408889634f * a[jj]; W.bi[jj] = -1.4426950408889634f * b[jj]; W.c8[jj] = -8.0f * 1.4426950408889634f * log1pf(__expf(-l[jj])); }
}
__device__ __forceinline__ void conv_tile_to_lds(const bf16_t* z, const float* cw, const float* cb, LAS unsigned char* xl, int chunk, int blk, int T, int tid) {
    const int c = tid & 15, ch0 = blk * 128 + c * 8;
    float w[4][8], bb[8];
#pragma unroll
    for (int j = 0; j < 4; ++j) { const f32x4 a = *(const f32x4*)(cw + j * 1024 + ch0), b = *(const f32x4*)(cw + j * 1024 + ch0 + 4);
#pragma unroll
        for (int e = 0; e < 4; ++e) { w[j][e] = a[e]; w[j][4 + e] = b[e]; } }
    { const f32x4 a = *(const f32x4*)(cb + ch0), b = *(const f32x4*)(cb + ch0 + 4);
#pragma unroll
        for (int e = 0; e < 4; ++e) { bb[e] = a[e]; bb[4 + e] = b[e]; } }
    u32x4_t xin[4][4];
#pragma unroll
    for (int i = 0; i < 4; ++i) {
        const int r = (tid >> 4) + 32 * i, t = chunk * 128 + r, s = t & (T - 1);
#pragma unroll
        for (int j = 0; j < 4; ++j) {
            const int sj = s + j - 2;
            xin[i][j] = (u32x4_t){0u, 0u, 0u, 0u};
            if (sj >= 0 && sj < T) xin[i][j] = *(const u32x4_t*)(z + (size_t)(t + j - 2) * LDZ + ch0);
        }
    }
#pragma unroll
    for (int i = 0; i < 4; ++i) {
        const int r = (tid >> 4) + 32 * i;
        float acc[8];
#pragma unroll
        for (int e = 0; e < 8; ++e) acc[e] = bb[e];
#pragma unroll
        for (int j = 0; j < 4; ++j) {
            const u32x4_t xv = xin[i][j];
            acc[0] += w[j][0] * bflo(xv[0]); acc[1] += w[j][1] * bfhi(xv[0]); acc[2] += w[j][2] * bflo(xv[1]); acc[3] += w[j][3] * bfhi(xv[1]);
            acc[4] += w[j][4] * bflo(xv[2]); acc[5] += w[j][5] * bfhi(xv[2]); acc[6] += w[j][6] * bflo(xv[3]); acc[7] += w[j][7] * bfhi(xv[3]);
        }
        u32x4_t o; o.x = pk2(acc[0], acc[1]); o.y = pk2(acc[2], acc[3]); o.z = pk2(acc[4], acc[5]); o.w = pk2(acc[6], acc[7]);
        *(LAS u32x4_t*)(xl + r * 256 + ((c ^ (r & 15)) << 4)) = o;
    }
}
__device__ __forceinline__ void lru_loadx(LruX& X, const LAS unsigned char* xl, int r0, int w, int lane) {
    const int fr = lane & 15, fq = lane >> 4;
#pragma unroll
    for (int t = 0; t < 2; ++t) {
        const int r = r0 + t * 16 + fr;
        const LAS unsigned char* rp = xl + r * 256;
#pragma unroll
        for (int ks = 0; ks < 4; ++ks) X.x[t][ks] = *(const LAS bf16x8*)(rp + (((ks * 4 + fq) ^ fr) << 4));
        X.xr[t] = *(const LAS u32x2_t*)(rp + (((w * 2 + (fq >> 1)) ^ fr) << 4) + (fq & 1) * 8);
    }
}
template <int DIR, bool FINAL> __device__ __forceinline__ void lru_tile(const bf16x8 (&Xf)[4], const u32x2_t xr, const LruW& W, int lane, float (&hin)[4], float (&arun)[4], float (&hout)[4], unsigned (&lab)[4]) {
    f32x4 accR = {0.f, 0.f, 0.f, 0.f}, accI = {0.f, 0.f, 0.f, 0.f};
#pragma unroll
    for (int ks = 0; ks < 4; ++ks) { accR = mfma16(W.Wa[ks], Xf[ks], accR); accI = mfma16(W.Wi[ks], Xf[ks], accI); }
    const float xv[4] = {bflo(xr.x), bfhi(xr.x), bflo(xr.y), bfhi(xr.y)};
    const int src = (lane & 48) + (DIR == 0 ? 15 : 0);
    float A[4], B[4];
    typedef float f32x2 __attribute__((ext_vector_type(2)));
#pragma unroll
    for (int p = 0; p < 2; ++p) {
        const f32x2 ar = {accR[2 * p], accR[2 * p + 1]}, ai = {accI[2 * p], accI[2 * p + 1]};
        const f32x2 bar = {W.ba[2 * p], W.ba[2 * p + 1]}, bai = {W.bi[2 * p], W.bi[2 * p + 1]}, c8v = {W.c8[2 * p], W.c8[2 * p + 1]}, xvv = {xv[2 * p], xv[2 * p + 1]};
        const f32x2 tr = ar * (-1.4426950408889634f) + bar, ti = ai * (-1.4426950408889634f) + bai;
        f32x2 er, ei; er.x = __builtin_amdgcn_exp2f(tr.x); er.y = __builtin_amdgcn_exp2f(tr.y); ei.x = __builtin_amdgcn_exp2f(ti.x); ei.y = __builtin_amdgcn_exp2f(ti.y);
        er = er + 1.0f; ei = ei + 1.0f;
        f32x2 rg, ig; rg.x = frcp(er.x); rg.y = frcp(er.y); ig.x = frcp(ei.x); ig.y = frcp(ei.y);
        const f32x2 la = c8v * rg;
        f32x2 Av; Av.x = __builtin_amdgcn_exp2f(la.x); Av.y = __builtin_amdgcn_exp2f(la.y);
        f32x2 om = 1.0f - Av * Av;
        f32x2 sq; sq.x = __builtin_amdgcn_sqrtf(fmaxf(om.x, 0.f)); sq.y = __builtin_amdgcn_sqrtf(fmaxf(om.y, 0.f));
        const f32x2 Bv = sq * (ig * xvv);
        A[2 * p] = Av.x; A[2 * p + 1] = Av.y; B[2 * p] = Bv.x; B[2 * p + 1] = Bv.y;
        lab[2 * p] = __builtin_bit_cast(unsigned, __builtin_amdgcn_cvt_pkrtz(la.x, Bv.x));
        lab[2 * p + 1] = __builtin_bit_cast(unsigned, __builtin_amdgcn_cvt_pkrtz(la.y, Bv.y));
    }
    scan16x4<DIR>(A, B);
#pragma unroll
    for (int jj = 0; jj < 4; ++jj) hout[jj] = A[jj] * hin[jj] + B[jj];
    bcast4<DIR>(hout, hin);
    if (!FINAL) { float At[4]; bcast4<DIR>(A, At);
#pragma unroll
        for (int jj = 0; jj < 4; ++jj) arun[jj] *= At[jj]; }
}
template <bool FINAL> __device__ __forceinline__ void lru_item(const LAS unsigned char* xl, const bf16_t* z, const bf16_t* lruw, const float* ba_, const float* bi_, const float* lam_,
                                                               float* agg, const float* carry, bf16_t* y, unsigned* labuf, int item, int lane) {
    const int cgi = item & 63, chunk = item >> 6, blk = cgi >> 3, w = cgi & 7;
    const int fr = lane & 15, fq = lane >> 4;
    const int ch4 = blk * 128 + w * 16 + fq * 4;
    const int tokc = chunk * 128;
    LruX X[2]; LruW W0;
    lru_loadw(W0, lruw, ba_, bi_, lam_, 0, blk, w, ch4, lane);
    lru_loadx(X[0], xl, 0, w, lane);
    unsigned hf[8][2];
    float hin[4], arun[4];
#pragma unroll
    for (int jj = 0; jj < 4; ++jj) { hin[jj] = FINAL ? carry[(size_t)(0 * 128 + chunk) * 1024 + ch4 + jj] : 0.f; arun[jj] = 1.f; }
#pragma unroll
    for (int bi = 0; bi < 8; ++bi) {
        __builtin_amdgcn_sched_barrier(0);
        const int slot = bi < 4 ? (bi & 1) : ((bi + 1) & 1);
        const int pair = bi < 4 ? bi : 7 - bi;
        if (bi + 1 < 8 && bi + 1 != 4) {
            const int nslot = (bi + 1) < 4 ? ((bi + 1) & 1) : ((bi + 2) & 1);
            const int npair = (bi + 1) < 4 ? (bi + 1) : 7 - (bi + 1);
            lru_loadx(X[nslot], xl, npair * 32, w, lane);
        }
        if (bi == 4) {
            lru_loadw(W0, lruw, ba_, bi_, lam_, 1, blk, w, ch4, lane);
            if (!FINAL && fr == 0) {
#pragma unroll
                for (int jj = 0; jj < 4; ++jj) { float2 v; v.x = arun[jj]; v.y = hin[jj]; *(float2*)(agg + ((size_t)(0 * 128 + chunk) * 1024 + ch4 + jj) * 2) = v; }
            }
#pragma unroll
            for (int jj = 0; jj < 4; ++jj) { hin[jj] = FINAL ? carry[(size_t)(1 * 128 + chunk) * 1024 + ch4 + jj] : 0.f; arun[jj] = 1.f; }
        }
#pragma unroll
        for (int k = 0; k < 2; ++k) {
            const int t = bi < 4 ? k : 1 - k;
            const int tt = 2 * pair + t;
            float hv[4]; unsigned lab[4];
            if (bi < 4) lru_tile<0, FINAL>(X[slot].x[t], X[slot].xr[t], W0, lane, hin, arun, hv, lab);
            else lru_tile<1, FINAL>(X[slot].x[t], X[slot].xr[t], W0, lane, hin, arun, hv, lab);
            if (!FINAL) { u32x4_t lw; lw.x = lab[0]; lw.y = lab[1]; lw.z = lab[2]; lw.w = lab[3];
                *(u32x4_t*)(labuf + ((((size_t)(bi < 4 ? 0 : 1) * 128 + chunk) * 64 + cgi) * 8 + (2 * pair + t)) * 256 + lane * 4) = lw; }
            if (FINAL) {
                if (bi < 4) {
                    hf[tt][0] = pk2(hv[0], hv[1]); hf[tt][1] = pk2(hv[2], hv[3]);
                } else {
                    const int tok = tokc + tt * 16 + fr;
                    const u32x2_t gr = *(const u32x2_t*)(z + (size_t)tok * LDZ + 1024 + ch4);
                    const float gc[4] = {bflo(gr.x), bfhi(gr.x), bflo(gr.y), bfhi(gr.y)};
                    const float hfv[4] = {bflo(hf[tt][0]), bfhi(hf[tt][0]), bflo(hf[tt][1]), bfhi(hf[tt][1])};
                    float o[4];
#pragma unroll
                    for (int jj = 0; jj < 4; ++jj) o[jj] = (hfv[jj] + hv[jj]) * silu(gc[jj]);
                    u32x2_t ow; ow.x = pk2(o[0], o[1]); ow.y = pk2(o[2], o[3]);
                    *(u32x2_t*)(y + (size_t)tok * LDY + ch4) = ow;
                }
            }
        }
    }
    if (!FINAL && fr == 0) {
#pragma unroll
        for (int jj = 0; jj < 4; ++jj) { float2 v; v.x = arun[jj]; v.y = hin[jj]; *(float2*)(agg + ((size_t)(1 * 128 + chunk) * 1024 + ch4 + jj) * 2) = v; }
    }
}
struct LruF { u32x4_t L[2][8]; u32x2_t gr[8]; };
__device__ __forceinline__ void lru_final_load(LruF& F, const unsigned* labuf, const bf16_t* z, int item, int lane) {
    const int cgi = item & 63, chunk = item >> 6, fr = lane & 15, fq = lane >> 4;
    const int ch4 = cgi * 16 + fq * 4, tokc = chunk * 128;
#pragma unroll
    for (int d = 0; d < 2; ++d)
#pragma unroll
        for (int tt = 0; tt < 8; ++tt) F.L[d][tt] = *(const u32x4_t*)(labuf + ((((size_t)d * 128 + chunk) * 64 + cgi) * 8 + tt) * 256 + lane * 4);
#pragma unroll
    for (int tt = 0; tt < 8; ++tt) F.gr[tt] = *(const u32x2_t*)(z + (size_t)(tokc + tt * 16 + fr) * LDZ + 1024 + ch4);
}
template <bool WAVEC> __device__ __forceinline__ void lru_final_compute(const LruF& F, const float* carry, float hcv, bf16_t* y, int item, int lane) {
    typedef _Float16 h2_t __attribute__((ext_vector_type(2)));
    const int cgi = item & 63, chunk = item >> 6;
    const int fr = lane & 15, fq = lane >> 4;
    const int ch4 = cgi * 16 + fq * 4, tokc = chunk * 128;
    float hf[8][4];
    {
        float hin[4];
#pragma unroll
        for (int jj = 0; jj < 4; ++jj) hin[jj] = WAVEC ? __shfl(hcv, fq * 4 + jj) : carry[(size_t)(0 * 128 + chunk) * 1024 + ch4 + jj];
#pragma unroll
        for (int tt = 0; tt < 8; ++tt) {
            float A[4], B[4];
#pragma unroll
            for (int jj = 0; jj < 4; ++jj) {
                const unsigned wv = F.L[0][tt][jj]; const h2_t v = __builtin_bit_cast(h2_t, wv);
                A[jj] = __builtin_amdgcn_exp2f((float)v.x); B[jj] = (float)v.y;
            }
            scan16x4<0>(A, B);
#pragma unroll
            for (int jj = 0; jj < 4; ++jj) hf[tt][jj] = A[jj] * hin[jj] + B[jj];
            bcast4<0>(hf[tt], hin);
        }
    }
    {
        float hin[4];
#pragma unroll
        for (int jj = 0; jj < 4; ++jj) hin[jj] = WAVEC ? __shfl(hcv, 16 + fq * 4 + jj) : carry[(size_t)(1 * 128 + chunk) * 1024 + ch4 + jj];
#pragma unroll
        for (int s = 0; s < 8; ++s) {
            const int tt = 7 - s;
            float o[4], A[4], B[4];
#pragma unroll
            for (int jj = 0; jj < 4; ++jj) {
                const unsigned wv = F.L[1][tt][jj]; const h2_t v = __builtin_bit_cast(h2_t, wv);
                A[jj] = __builtin_amdgcn_exp2f((float)v.x); B[jj] = (float)v.y;
            }
            scan16x4<1>(A, B);
            float hb[4];
#pragma unroll
            for (int jj = 0; jj < 4; ++jj) { hb[jj] = A[jj] * hin[jj] + B[jj]; o[jj] = hf[tt][jj] + hb[jj]; }
            bcast4<1>(hb, hin);
            const float gc[4] = {bflo(F.gr[tt].x), bfhi(F.gr[tt].x), bflo(F.gr[tt].y), bfhi(F.gr[tt].y)};
            u32x2_t ow; ow.x = pk2(o[0] * silu(gc[0]), o[1] * silu(gc[1])); ow.y = pk2(o[2] * silu(gc[2]), o[3] * silu(gc[3]));
            *(u32x2_t*)(y + (size_t)(tokc + tt * 16 + fr) * LDY + ch4) = ow;
        }
    }
}
__device__ __forceinline__ void wave_carries(const float* agg, int cgi, int chunk0, int nseq, int lane, float (&hc)[4]) {
    const int q = lane >> 4, ch = cgi * 16 + (lane & 15);
    const bool up = (lane & 16) != 0;
    float2 ag[2][32];
#pragma unroll
    for (int dir = 0; dir < 2; ++dir)
#pragma unroll
        for (int cc = 0; cc < 32; ++cc) ag[dir][cc] = *(const float2*)(agg + ((size_t)(dir * 128 + 32 * q + cc) * 1024 + ch) * 2);
#pragma unroll
    for (int dir = 0; dir < 2; ++dir) {
        float A = 1.f, h = 0.f, Ap = 1.f, Hp = 0.f;
#pragma unroll
        for (int step = 0; step < 32; ++step) {
            const int cc = dir == 0 ? step : 31 - step;
            if (cc == chunk0) { Ap = A; Hp = h; }
            const float2 ah = ag[dir][cc];
            h = ah.x * h + ah.y; A *= ah.x;
        }
        float Aq[4], Hq[4], Apk[4], Hpk[4];
#pragma unroll
        for (int k = 0; k < 4; ++k) { const int src = k * 16 + (lane & 15); Aq[k] = __shfl(A, src); Hq[k] = __shfl(h, src); Apk[k] = __shfl(Ap, src); Hpk[k] = __shfl(Hp, src); }
        float S[4];
        if (dir == 0) { S[0] = 0.f; S[1] = Hq[0]; S[2] = Aq[1] * S[1] + Hq[1]; S[3] = Aq[2] * S[2] + Hq[2]; }
        else { S[3] = 0.f; S[2] = Hq[3]; S[1] = Aq[2] * S[2] + Hq[2]; S[0] = Aq[1] * S[1] + Hq[1]; }
#pragma unroll
        for (int k = 0; k < 4; ++k) { const float v = Apk[k] * (nseq == 1 ? S[k] : 0.f) + Hpk[k]; if (dir == 0) hc[k] = v; else hc[k] = up ? v : hc[k]; }
    }
}
__device__ __forceinline__ void carry_phase(const float* agg, float* carry, int nseq, int gtid, int gthreads) {
    const int nc = 128 / nseq;
    for (int idx = gtid; idx < 2 * nseq * 1024; idx += gthreads) {
        const int ch = idx & 1023, rest = idx >> 10, dir = rest & 1, sq = rest >> 1, base = sq * nc;
        float h = 0.f;
#pragma unroll 8
        for (int c = 0; c < nc; ++c) {
            const int C = base + (dir == 0 ? c : nc - 1 - c);
            const size_t o = (size_t)(dir * 128 + C) * 1024 + ch;
            const float2 ah = *(const float2*)(agg + o * 2);
            carry[o] = h;
            h = ah.x * h + ah.y;
        }
    }
}

__device__ __forceinline__ void sgu_item2(const bf16_t* vT, const LAS float* rstd, const LAS unsigned char* wsl, const bf16_t* z, const float* sgu_g, const float* sgu_b, bf16_t* y,
                                          int n, int g, int qd, int lane) {
    const int fr = lane & 15, fq = lane >> 4;
    const int tokc = n * 128, chq = g * 128 + qd * 32;
    bf16x8 Af[2][4];
#pragma unroll
    for (int t = 0; t < 2; ++t) {
        const bf16_t* ap = vT + (size_t)(chq + (fr >> 2) * 8 + (fr & 3) + 4 * t) * SEG + tokc + fq * 8;
#pragma unroll
        for (int ks = 0; ks < 4; ++ks) {
            const u32x4_t raw = *(const u32x4_t*)(ap + ks * 32);
            const f32x4 r0 = *(const LAS f32x4*)(rstd + ks * 32 + fq * 8), r1 = *(const LAS f32x4*)(rstd + ks * 32 + fq * 8 + 4);
            u32x4_t w;
            w.x = pk2(bflo(raw.x) * r0[0], bfhi(raw.x) * r0[1]); w.y = pk2(bflo(raw.y) * r0[2], bfhi(raw.y) * r0[3]);
            w.z = pk2(bflo(raw.z) * r1[0], bfhi(raw.z) * r1[1]); w.w = pk2(bflo(raw.w) * r1[2], bfhi(raw.w) * r1[3]);
            Af[t][ks] = __builtin_bit_cast(bf16x8, w);
        }
    }
    const int ch8 = chq + fq * 8;
    const f32x4 g0 = *(const f32x4*)(sgu_g + ch8), g1 = *(const f32x4*)(sgu_g + ch8 + 4);
    u32x4_t urv[8], grv[8]; float bsvv[8];
#pragma unroll
    for (int pt = 0; pt < 8; ++pt) { const int p = pt * 16 + fr, tok = tokc + p;
        urv[pt] = *(const u32x4_t*)(z + (size_t)tok * LDZ + 2048 + ch8); grv[pt] = *(const u32x4_t*)(z + (size_t)tok * LDZ + 3072 + ch8); bsvv[pt] = sgu_b[g * 128 + p]; }
#pragma unroll
    for (int pt = 0; pt < 8; ++pt) {
        const int p = pt * 16 + fr, tok = tokc + p;
        const u32x4_t ur = urv[pt], gr = grv[pt];
        const float bsv = bsvv[pt];
        const LAS unsigned char* bp = wsl + p * 256;
        f32x4 a0 = {0.f, 0.f, 0.f, 0.f}, a1 = {0.f, 0.f, 0.f, 0.f};
#pragma unroll
        for (int ks = 0; ks < 4; ++ks) { const bf16x8 Bf = *(const LAS bf16x8*)(bp + (((ks * 4 + fq) ^ fr) << 4)); a0 = mfma16(Af[0][ks], Bf, a0); a1 = mfma16(Af[1][ks], Bf, a1); }
        float o[8];
#pragma unroll
        for (int k = 0; k < 2; ++k) {
            o[2 * k] = bflo(ur[k]) * (a0[2 * k] * g0[2 * k] + bsv) * silu(bflo(gr[k]));
            o[2 * k + 1] = bfhi(ur[k]) * (a0[2 * k + 1] * g0[2 * k + 1] + bsv) * silu(bfhi(gr[k]));
            o[4 + 2 * k] = bflo(ur[2 + k]) * (a1[2 * k] * g1[2 * k] + bsv) * silu(bflo(gr[2 + k]));
            o[4 + 2 * k + 1] = bfhi(ur[2 + k]) * (a1[2 * k + 1] * g1[2 * k + 1] + bsv) * silu(bfhi(gr[2 + k]));
        }
        u32x4_t ow; ow.x = pk2(o[0], o[1]); ow.y = pk2(o[2], o[3]); ow.z = pk2(o[4], o[5]); ow.w = pk2(o[6], o[7]);
        *(u32x4_t*)(y + (size_t)tok * LDY + 1024 + ch8) = ow;
    }
}

__device__ __forceinline__ void sgu_item(const bf16_t* vT, const LAS float* rstd, const bf16_t* z, const bf16_t* sguw, const float* sgu_g, const float* sgu_b, bf16_t* y, int item, int lane) {
    const int dd = item & 7, g = (item >> 3) & 7, n = item >> 6;
    const int fr = lane & 15, fq = lane >> 4;
    const int tokc = n * 128;
    const bf16_t* ap = vT + (size_t)(g * 128 + dd * 16 + fr) * SEG + tokc + fq * 8;
    bf16x8 Af[4];
#pragma unroll
    for (int ks = 0; ks < 4; ++ks) {
        const u32x4_t raw = *(const u32x4_t*)(ap + ks * 32);
        const f32x4 r0 = *(const LAS f32x4*)(rstd + ks * 32 + fq * 8), r1 = *(const LAS f32x4*)(rstd + ks * 32 + fq * 8 + 4);
        u32x4_t w;
        w.x = pk2(bflo(raw.x) * r0[0], bfhi(raw.x) * r0[1]); w.y = pk2(bflo(raw.y) * r0[2], bfhi(raw.y) * r0[3]);
        w.z = pk2(bflo(raw.z) * r1[0], bfhi(raw.z) * r1[1]); w.w = pk2(bflo(raw.w) * r1[2], bfhi(raw.w) * r1[3]);
        Af[ks] = __builtin_bit_cast(bf16x8, w);
    }
    const int ch4 = g * 128 + dd * 16 + fq * 4;
    const f32x4 g4 = *(const f32x4*)(sgu_g + ch4);
#pragma unroll
    for (int pt = 0; pt < 8; ++pt) {
        const int p = pt * 16 + fr;
        const bf16_t* bp = sguw + (size_t)(g * 128 + p) * 128 + fq * 8;
        f32x4 acc = {0.f, 0.f, 0.f, 0.f};
#pragma unroll
        for (int ks = 0; ks < 4; ++ks) acc = mfma16(Af[ks], ld8(bp + ks * 32), acc);
        const int tok = tokc + p;
        const float bsv = sgu_b[g * 128 + p];
        const u32x2_t ur = *(const u32x2_t*)(z + (size_t)tok * LDZ + 2048 + ch4), gr = *(const u32x2_t*)(z + (size_t)tok * LDZ + 3072 + ch4);
        const float uu[4] = {bflo(ur.x), bfhi(ur.x), bflo(ur.y), bfhi(ur.y)}, gd[4] = {bflo(gr.x), bfhi(gr.x), bflo(gr.y), bfhi(gr.y)};
        float o[4];
#pragma unroll
        for (int jj = 0; jj < 4; ++jj) o[jj] = uu[jj] * (acc[jj] * g4[jj] + bsv) * silu(gd[jj]);
        u32x2_t ow; ow.x = pk2(o[0], o[1]); ow.y = pk2(o[2], o[3]);
        *(u32x2_t*)(y + (size_t)tok * LDY + 1024 + ch4) = ow;
    }
}

__global__ void __launch_bounds__(512, 2) fwd_megakernel(Params P) {
    extern __shared__ __attribute__((aligned(16))) unsigned char shm[];
    cg::grid_group grid = cg::this_grid();
    PG8_LAS unsigned char* lds = (PG8_LAS unsigned char*)shm;
    const int G = gridDim.x, NW = G * 8;
#define FRESH_TID() int tid = threadIdx.x; asm volatile("" : "+v"(tid)); const int lane = tid & 63, wid = tid >> 6, gw = blockIdx.x * 8 + wid; (void)lane; (void)gw
    unsigned char* ws = P.ws;
    bf16_t* WIN_E = (bf16_t*)(ws + WS_WIN_E); bf16_t* WIN_O = (bf16_t*)(ws + WS_WIN_O);
    bf16_t* WOUT_E = (bf16_t*)(ws + WS_WOUT_E); bf16_t* WOUT_O = (bf16_t*)(ws + WS_WOUT_O);
    bf16_t* WKV = (bf16_t*)(ws + WS_WKV); bf16_t* LRUW = (bf16_t*)(ws + WS_LRUW); bf16_t* SGUW = (bf16_t*)(ws + WS_SGUW);
    bf16_t* MEMN = (bf16_t*)(ws + WS_MEMN); bf16_t* MK = (bf16_t*)(ws + WS_MK); bf16_t* MVT = (bf16_t*)(ws + WS_MVT);
    bf16_t* H = (bf16_t*)(ws + WS_H); bf16_t* Z = (bf16_t*)(ws + WS_Z); bf16_t* VT = (bf16_t*)(ws + WS_VT); bf16_t* Y = (bf16_t*)(ws + WS_Y);
    float* AGG = (float*)(ws + WS_AGG); float* CARRY = (float*)(ws + WS_CARRY); float* RSTD = (float*)(ws + WS_RSTD); float* PART = (float*)(ws + WS_PART); unsigned* LAB = (unsigned*)(ws + WS_LAB);

    unsigned* BAR = (unsigned*)(ws + WS_BAR);
    volatile LAS unsigned* xst = (volatile LAS unsigned*)(lds + XST_OFF);
    {
        FRESH_TID();
        if (tid < 2) xst[tid] = 0u;
        if (blockIdx.x == 0) for (int i = tid; i < XCD_BAR_WORDS; i += 512) BAR[i] = 0u;
        LAS float* scr = (LAS float*)(lds + wid * 16384);
        constexpr int I0 = 16 * 288, I1 = 16 * 192, I2 = 40 * 32, I3 = 40 * 32, I4 = 16 * 32, I5 = 16 * 32, I6 = 16 * 8, I7 = 16 * 8;
        constexpr int NIT = I0 + I1 + I2 + I3 + I4 + I5 + I6 + I7;
#pragma unroll 1
        for (int it = gw; it < NIT; it += NW) {
            int r = it;
            if (r < I0) { transpose_item(P.in[7], 1024, 9216, WIN_E, scr, r, lane); continue; } r -= I0;
            if (r < I1) { transpose_item(P.in[12], 1024, 6144, WIN_O, scr, r, lane); continue; } r -= I1;
            if (r < I2) { transpose_item(P.in[11], 2560, 1024, WOUT_E, scr, r, lane); continue; } r -= I2;
            if (r < I3) { transpose_item(P.in[23], 2560, 1024, WOUT_O, scr, r, lane); continue; } r -= I3;
            if (r < I4) { transpose_item(P.in[6], 1024, 1024, WKV, scr, r, lane); continue; } r -= I4;
            if (r < I5) { transpose_item(P.in[6] + (size_t)1024 * 1024, 1024, 1024, WKV + (size_t)1024 * 1024, scr, r, lane); continue; } r -= I5;
            if (r < I6) { const int m = r >> 3; transpose_item(P.in[15] + (size_t)m * 16384, 128, 128, LRUW + (size_t)m * 16384, scr, r & 7, lane); continue; } r -= I6;
            { const int m = r >> 3; transpose_item(P.in[17] + (size_t)m * 16384, 128, 128, LRUW + (size_t)(16 + m) * 16384, scr, r & 7, lane); }
        }
        for (int i = blockIdx.x * 512 + tid; i < 8 * 128 * 128; i += G * 512) SGUW[i] = f2bf(P.in[21][i]);
        for (int it = gw; it < 2 * 1536; it += NW) {
            const int l = it / 1536, row = it - l * 1536;
            const float* src = row < 512 ? P.in[2] + (size_t)row * 1024 : P.in[3] + (size_t)(row - 512) * 1024;
            rms_row_bf16(src, P.in[5] + l * 1024, MEMN + ((size_t)l * 1536 + row) * 1024, lane);
        }
        for (int it = gw; it < SEG / 4; it += NW) rms_rows4_bf16(P.in[0] + (size_t)it * 4096, P.in[4], H + (size_t)it * 4096, lane);
    }

    grid.sync();
    const XcdBarrier xb = xcd_barrier_post(BAR, xst);
    for (int seg = 0; seg < 3; ++seg) {
        const float* xin = seg < 2 ? P.in[0] + (size_t)seg * SEG * 1024 : P.in[1];
        float* xout = P.out + (size_t)seg * SEG * 1024;
        const int T = seg < 2 ? 16384 : 4096, nseq = seg < 2 ? 1 : 4;

        {
            pg8::Gemm g; g.A = H; g.Bt = WIN_E; g.M = SEG; g.N = 8192; g.K = 1024; g.A1 = WIN_E + (size_t)6144 * 1024; g.Bt1 = H;
            pg8::DualOrder S; S.S0.init(SEG, 8192, G, blockIdx.x); S.S1.init(1024, SEG, G, blockIdx.x); S.skip_from = 24; S.skip_n = 4; S.G = G; S.c = blockIdx.x;
            pg8::EpiZ E; E.O = Z; E.ldc = LDZ; E.skip_from = 24; E.skip_n = 4; E.colsq = nullptr; E.colsq_ld = 0; E.O1 = VT; E.ldc1 = SEG; E.colsq1 = nullptr;
            pg8::gemm_phase(lds, g, S, E);
        }
        if (seg == 0) {
#pragma unroll 1
            for (int l = 0; l < 2; ++l) {
                {
                    pg8::Gemm g; g.A = MEMN + (size_t)l * 1536 * 1024; g.Bt = WKV + (size_t)l * 1024 * 1024; g.M = 1536; g.N = 512; g.K = 1024; g.A1 = g.A; g.Bt1 = g.Bt;
                    pg8::SkipOrder S; S.init(1536, 512, G, (blockIdx.x + G - (32 * l) % G) % G); S.skip_from = 1 << 20; S.skip_n = 0;
                    pg8::EpiZ E; E.O = MK + (size_t)l * 1536 * 512; E.ldc = 512; E.skip_from = 1 << 20; E.skip_n = 0; E.colsq = nullptr; E.colsq_ld = 0; E.O1 = E.O; E.ldc1 = 512; E.colsq1 = nullptr;
                    pg8::gemm_phase(lds, g, S, E);
                }
                {
                    pg8::Gemm g; g.A = WKV + (size_t)l * 1024 * 1024 + (size_t)512 * 1024; g.Bt = MEMN + (size_t)l * 1536 * 1024; g.M = 512; g.N = 1536; g.K = 1024; g.A1 = g.A; g.Bt1 = g.Bt;
                    pg8::SkipOrder S; S.init(512, 1536, G, (blockIdx.x + G - (32 * l + 16) % G) % G); S.skip_from = 1 << 20; S.skip_n = 0;
                    pg8::EpiZ E; E.O = MVT + (size_t)l * 512 * 1536; E.ldc = 1536; E.skip_from = 1 << 20; E.skip_n = 0; E.colsq = nullptr; E.colsq_ld = 0; E.O1 = E.O; E.ldc1 = 1536; E.colsq1 = nullptr;
                    pg8::gemm_phase(lds, g, S, E);
                }
            }
        }
        xcd_barrier(xb);

        { FRESH_TID();
        for (int u = blockIdx.x; u < 256; u += G) mem_unit(Z, 7168, 7680, MK, MVT, Y, u, seg, lds, tid);
#pragma unroll 1
        for (int u = blockIdx.x; u < 256; u += G) na_block(Z, VT, Y, P.in[10], u, T, lds, tid);
        for (int it = gw; it < 8192; it += NW) conv_even_item(Z, P.in[8], P.in[9], Y, 2 * it, T, lane);
        }
        xcd_barrier(xb);

        {
            pg8::Gemm g; g.A = Y; g.Bt = WOUT_E; g.M = SEG; g.N = 1024; g.K = 2560; g.A1 = g.A; g.Bt1 = g.Bt;
            pg8::StaticOrder S; S.init(SEG, 1024, G, blockIdx.x);
            pg8::EpiRes E; E.xin = xin; E.out = xout;
            pg8::gemm_phase(lds, g, S, E);
        }
        xcd_barrier(xb);

        { FRESH_TID();
        for (int it = gw; it < SEG / 4; it += NW) rms_rows4_bf16(xout + (size_t)it * 4096, P.in[4] + 1024, H + (size_t)it * 4096, lane); }
        xcd_barrier(xb);

        {
            pg8::Gemm g; g.A = H; g.Bt = WIN_O; g.M = SEG; g.N = 5120; g.K = 1024; g.A1 = WIN_O + (size_t)3072 * 1024; g.Bt1 = H;
            pg8::DualOrder S; S.S0.init(SEG, 5120, G, blockIdx.x); S.S1.init(1024, SEG, G, blockIdx.x); S.skip_from = 12; S.skip_n = 4; S.G = G; S.c = blockIdx.x;
            pg8::EpiZ E; E.O = Z; E.ldc = LDZ; E.skip_from = 12; E.skip_n = 4; E.colsq = nullptr; E.colsq_ld = SEG; E.O1 = VT; E.ldc1 = SEG; E.colsq1 = PART;
            pg8::gemm_phase(lds, g, S, E);
        }
        xcd_barrier(xb);

        { FRESH_TID();
        for (int u = blockIdx.x; u < 256; u += G) mem_unit(Z, 4096, 4608, MK + (size_t)1536 * 512, MVT + (size_t)512 * 1536, Y, u, seg, lds, tid);
#pragma unroll 1
        for (int u0 = blockIdx.x; u0 < 1024; u0 += 4 * G) {
            __syncthreads();
#pragma unroll 1
            for (int k = 0; k < 4; ++k) { const int u = u0 + k * G; if (u < 1024) conv_tile_to_lds(Z, P.in[13], P.in[14], lds + k * 32768, u >> 3, u & 7, T, tid); }
            __syncthreads();
#pragma unroll 1
            for (int k = 0; k < 4; ++k) { const int u = u0 + k * G; if (u < 1024) lru_item<false>(lds + k * 32768, Z, LRUW, P.in[16], P.in[18], P.in[19], AGG, CARRY, Y, LAB, (u >> 3) * 64 + (u & 7) * 8 + wid, lane); }
        }
#pragma unroll 1
        for (int u0 = blockIdx.x; u0 < 1024; u0 += 2 * G) {
            __syncthreads();
            LAS float* rsL = (LAS float*)lds;
            if (tid < 256) { const int u = u0 + (tid >> 7) * G;
              if (u < 1024) { const float* pp = PART + (u >> 3) * 128 + (tid & 127); float s = 0.f;
#pragma unroll
                for (int i = 0; i < 8; ++i) s += pp[(size_t)i * SEG];
                rsL[tid] = __builtin_amdgcn_rsqf(s * (1.0f / 1024.0f) + EPS); } }
            u32x4_t wsv[2][4];
#pragma unroll
            for (int s2 = 0; s2 < 2; ++s2) { const int u = u0 + s2 * G;
              if (u < 1024) { const int g = u & 7;
#pragma unroll
                for (int i = 0; i < 4; ++i) { const int idx = tid + 512 * i, p = idx >> 4, c = idx & 15; wsv[s2][i] = *(const u32x4_t*)(SGUW + (size_t)(g * 128 + p) * 128 + c * 8); } } }
#pragma unroll
            for (int s2 = 0; s2 < 2; ++s2) { const int u = u0 + s2 * G;
              if (u < 1024) {
#pragma unroll
                for (int i = 0; i < 4; ++i) { const int idx = tid + 512 * i, p = idx >> 4, c = idx & 15; *(LAS u32x4_t*)(lds + 4096 + s2 * 32768 + p * 256 + ((c ^ (p & 15)) << 4)) = wsv[s2][i]; } } }
            __syncthreads();
            { const int s2 = wid >> 2, u = u0 + s2 * G;
              if (u < 1024) sgu_item2(VT, rsL + s2 * 128, lds + 4096 + s2 * 32768, Z, P.in[20], P.in[22], Y, u >> 3, u & 7, wid & 3, lane); }
        } }
        xcd_barrier(xb);

        if (G == 256) {
            FRESH_TID();
            float hc[4];
            LruF F[2];
            lru_final_load(F[0], LAB, Z, gw, lane);
            wave_carries(AGG, gw & 63, gw >> 6, nseq, lane, hc);
#pragma unroll
            for (int k = 0; k < 4; ++k) {
                if (k < 3) lru_final_load(F[(k + 1) & 1], LAB, Z, gw + 2048 * (k + 1), lane);
                lru_final_compute<true>(F[k & 1], CARRY, hc[k], Y, gw + 2048 * k, lane);
            }
        } else {
            { FRESH_TID(); carry_phase(AGG, CARRY, nseq, blockIdx.x * 512 + tid, G * 512); }
            xcd_barrier(xb);
            { FRESH_TID();
#pragma unroll 1
            for (int it = gw; it < 8192; it += NW) { LruF F1; lru_final_load(F1, LAB, Z, it, lane); lru_final_compute<false>(F1, CARRY, 0.f, Y, it, lane); } }
        }
        if (seg < 2) { FRESH_TID();
            const float* xnx = seg == 0 ? P.in[0] + (size_t)SEG * 1024 : P.in[1];
            for (int it = gw; it < SEG / 4; it += NW) rms_rows4_bf16(xnx + (size_t)it * 4096, P.in[4], H + (size_t)it * 4096, lane); }
        xcd_barrier(xb);

        {
            pg8::Gemm g; g.A = Y; g.Bt = WOUT_O; g.M = SEG; g.N = 1024; g.K = 2560; g.A1 = g.A; g.Bt1 = g.Bt;
            pg8::StaticOrder S; S.init(SEG, 1024, G, blockIdx.x);
            pg8::EpiRes E; E.xin = xout; E.out = xout;
            pg8::gemm_phase(lds, g, S, E);
        }
        xcd_barrier(xb);

        { FRESH_TID();
        for (int it = gw; it < SEG / 4; it += NW) rms_rows4_f32(xout + (size_t)it * 4096, P.in[24], lane); }
    }
}

extern "C" void kernel_launch(void* const* d_in, const int* in_sizes, int n_in, void* d_out, int out_size, void* d_ws, size_t ws_size, hipStream_t stream) {
    static int grid_blocks = 0;
    if (grid_blocks == 0) {
        if (n_in != 25 || ws_size < WS_END) { fprintf(stderr, "kernel_launch: need 25 inputs and %zu bytes of workspace; got %d, %zu\n", (size_t)WS_END, n_in, ws_size); grid_blocks = -1; return; }
        int dev = 0, cus = 0, per_cu = 0;
        hipGetDevice(&dev);
        hipDeviceGetAttribute(&cus, hipDeviceAttributeMultiprocessorCount, dev);
        hipFuncSetAttribute((const void*)fwd_megakernel, hipFuncAttributeMaxDynamicSharedMemorySize, LDS_BYTES);
        hipOccupancyMaxActiveBlocksPerMultiprocessor(&per_cu, (const void*)fwd_megakernel, 512, LDS_BYTES);
        if (per_cu < 1) { fprintf(stderr, "kernel_launch: occupancy query says %d blocks per CU\n", per_cu); grid_blocks = -1; return; }
        grid_blocks = cus;
    }
    if (grid_blocks < 0) return;
    Params p{};
    for (int i = 0; i < 25; ++i) p.in[i] = (const float*)d_in[i];
    p.out = (float*)d_out; p.ws = (unsigned char*)d_ws;
    void* args[] = {&p};
    hipError_t e = hipLaunchCooperativeKernel((const void*)fwd_megakernel, dim3(grid_blocks), dim3(512), args, LDS_BYTES, stream);
    if (e != hipSuccess) fprintf(stderr, "cooperative launch failed: %s (grid %d)\n", hipGetErrorString(e), grid_blocks);
}
```

```cpp
#include <hip/hip_runtime.h>
#include <hip/hip_cooperative_groups.h>
#include <cstdio>
namespace cg = cooperative_groups;
namespace pg8 {
#define PG8_LAS __attribute__((address_space(3)))
typedef unsigned short bf16_t;
typedef short bf16x8 __attribute__((ext_vector_type(8)));
typedef float f32x4 __attribute__((ext_vector_type(4)));
typedef unsigned u32x4 __attribute__((ext_vector_type(4)));
constexpr int BM = 256, BK = 64, HALF = 128, HTB = HALF * BK * 2  , STAGE_BYTES = 8 * HTB, NXCD = 8, WGM = 4;

__host__ __device__ __forceinline__ int lds_byte(int r, int c) { const int st = (r >> 4) * 2 + (c >> 5), rr = r & 15, cc = c & 31, ob = rr * 64 + cc * 2; return st * 1024 + (ob ^ (((ob >> 9) & 1) << 5)); }
__host__ __device__ __forceinline__ void stage_rc(int b, int& R, int& C) { const int st = b / 1024, sb = b % 1024, swz = sb ^ (((sb >> 9) & 1) << 5); R = (st >> 1) * 16 + swz / 64; C = (st & 1) * 32 + (swz % 64) / 2; }
__host__ __device__ __forceinline__ int perm32(int rho) { const int n = rho >> 4, i = rho & 15; return 8 * (i >> 2) + 4 * n + (i & 3); }

struct Unit { int pm, pn, sel; };
struct Gemm { const bf16_t* A; const bf16_t* Bt; int M, N, K; const bf16_t* A1; const bf16_t* Bt1; };

struct StaticOrder {
    int nM, nN, nwg, G, c, wgm;
    __host__ __device__ void init(int M, int N, int G_, int c_, int wgm_ = 4) { nM = M / BM; nN = N / BM; nwg = nM * nN; G = G_; c = c_; wgm = wgm_; }
    __host__ __device__ void map(int wgid, Unit& u) const {
        { const int q = nwg / NXCD, r = nwg % NXCD, xcd = wgid % NXCD, off = wgid / NXCD; wgid = (xcd < r ? xcd * (q + 1) : r * (q + 1) + (xcd - r) * q) + off; }
        const int nig = wgm * nN, gid = wgid / nig, fm = gid * wgm, gsz = (nM - fm) < wgm ? (nM - fm) : wgm;
        u.pm = fm + ((wgid % nig) % gsz); u.pn = (wgid % nig) / gsz; u.sel = 0;
    }
    __host__ __device__ bool next(int i, Unit& u) const {
        const long L = (long)i * G + c; if (L >= nwg) return false;
        map((int)L, u); return true;
    }
    __device__ __forceinline__ void a_ready(const Unit&) const {}
    __device__ __forceinline__ void done(const Unit&) const {}
};

struct SkipOrder : StaticOrder {
    int skip_from, skip_n;
    __device__ __forceinline__ bool next(int i, Unit& u) const {
        if (!StaticOrder::next(i, u)) return false;
        if (u.pn >= skip_from) u.pn += skip_n;
        return true;
    }
};
struct DualOrder {
    StaticOrder S0, S1; int skip_from, skip_n, G, c;
    __device__ __forceinline__ bool next(int i, Unit& u) const {
        const long L = (long)i * G + c;
        if (L < S0.nwg) { S0.map((int)L, u); if (u.pn >= skip_from) u.pn += skip_n; return true; }
        if (L - S0.nwg < S1.nwg) { S1.map((int)(L - S0.nwg), u); u.sel = 1; return true; }
        return false;
    }
    __device__ __forceinline__ void a_ready(const Unit&) const {}
    __device__ __forceinline__ void done(const Unit&) const {}
};

__device__ __forceinline__ unsigned cvt_pk_bf16(float lo, float hi) { unsigned r; asm volatile("v_cvt_pk_bf16_f32 %0, %1, %2" : "=v"(r) : "v"(lo), "v"(hi)); return r; }

struct EpiZ {
    static constexpr bool PERM = true, AFTER_DRAIN = false;
    bf16_t* O; int ldc; int skip_from, skip_n; float* colsq; int colsq_ld; bf16_t* O1; int ldc1; float* colsq1;
    __device__ __forceinline__ void operator()(const f32x4 (&acc)[2][2][4][2], const Unit& u, int wr, int wc, int fr, int fq) const {
        const int row0 = u.pm * BM + wr * 64 + fr; const int ct = u.sel ? u.pn : ((u.pn >= skip_from + skip_n) ? (u.pn - skip_n) : u.pn);
        const int col0 = ct * BM + wc * 32 + 8 * fq;
        bf16_t* const O = u.sel ? this->O1 : this->O; const int ldc = u.sel ? this->ldc1 : this->ldc; float* const colsq = u.sel ? this->colsq1 : this->colsq;
#pragma unroll
        for (int ai = 0; ai < 2; ++ai)
#pragma unroll
            for (int m = 0; m < 4; ++m) { bf16_t* rowp = O + (size_t)(row0 + ai * HALF + m * 16) * ldc + col0;
#pragma unroll
                for (int bj = 0; bj < 2; ++bj) { const f32x4 v0 = acc[ai][bj][m][0], v1 = acc[ai][bj][m][1];
                    u32x4 w; w.x = cvt_pk_bf16(v0[0], v0[1]); w.y = cvt_pk_bf16(v0[2], v0[3]); w.z = cvt_pk_bf16(v1[0], v1[1]); w.w = cvt_pk_bf16(v1[2], v1[3]);
                    *(u32x4*)(rowp + bj * HALF) = w; } }
        if (colsq) {
#pragma unroll
            for (int bj = 0; bj < 2; ++bj)
#pragma unroll
                for (int n = 0; n < 2; ++n) {
                    f32x4 ss = {0.f, 0.f, 0.f, 0.f};
#pragma unroll
                    for (int ai = 0; ai < 2; ++ai)
#pragma unroll
                        for (int m = 0; m < 4; ++m) ss += acc[ai][bj][m][n] * acc[ai][bj][m][n];
#pragma unroll
                    for (int o = 1; o < 16; o <<= 1) { ss[0] += __shfl_xor(ss[0], o); ss[1] += __shfl_xor(ss[1], o); ss[2] += __shfl_xor(ss[2], o); ss[3] += __shfl_xor(ss[3], o); }
                    if (fr == 0) *(f32x4*)(colsq + (size_t)(2 * u.pm + wr) * colsq_ld + ct * BM + bj * HALF + wc * 32 + 8 * fq + 4 * n) = ss;
                }
        }
    }
};
struct EpiRes {
    static constexpr bool PERM = false, AFTER_DRAIN = false;
    const float* xin; float* out;
    __device__ __forceinline__ void operator()(const f32x4 (&acc)[2][2][4][2], const Unit& u, int wr, int wc, int fr, int fq) const {
        const int row0 = u.pm * BM + wr * 64 + fr, col0 = u.pn * BM + wc * 32 + 4 * fq;
#pragma unroll
        for (int ai = 0; ai < 2; ++ai)
#pragma unroll
            for (int m = 0; m < 4; ++m) { const size_t ro = (size_t)(row0 + ai * HALF + m * 16) * 1024 + col0;
#pragma unroll
                for (int bj = 0; bj < 2; ++bj)
#pragma unroll
                    for (int n = 0; n < 2; ++n) { const f32x4 xv = *(const f32x4*)(xin + ro + bj * HALF + n * 16);
                        *(f32x4*)(out + ro + bj * HALF + n * 16) = acc[ai][bj][m][n] + xv; } }
    }
};

template <class Epi, class Sched>
__device__ __forceinline__ void gemm_phase(PG8_LAS unsigned char* lds, const Gemm g, const Sched& S, const Epi& E) {
    int tid = threadIdx.x; asm volatile("" : "+v"(tid));
    const int wid = __builtin_amdgcn_readfirstlane(tid >> 6), lane = tid & 63, wr = wid >> 2, wc = wid & 3, fr = lane & 15, fq = lane >> 4;
    const int K = g.K, nt = K / BK;
    const char* gA = (const char*)g.A; const char* gB = (const char*)g.Bt; const char* gA1 = (const char*)g.A1; const char* gB1 = (const char*)g.Bt1; asm volatile("" : "+s"(gA), "+s"(gB), "+s"(gA1), "+s"(gB1));
    unsigned voffA[2], voffB[2];
#pragma unroll
    for (int i = 0; i < 2; ++i) { int R, C; stage_rc(tid * 16 + i * 8192, R, C); const int Rb = Epi::PERM ? ((R & ~31) + perm32(R & 31)) : R;
        voffA[i] = (unsigned)(R * K + C) * 2u; voffB[i] = (unsigned)(Rb * K + C) * 2u; }
    const size_t kstep = (size_t)(BK * 2);
    const size_t hstep = (size_t)HALF * K * 2;
    const size_t tstep = 2 * hstep;
    const unsigned ldsw = (unsigned)wid * 1024u;
    const int aoff = lds_byte(wr * 64 + fr, fq * 8), boff = lds_byte(wc * 32 + fr, fq * 8);
#define PG8_SA(b, h) (((b) * 2 + (h)) * HTB)
#define PG8_SB(b, h) ((4 + (b) * 2 + (h)) * HTB)
#define PG8_STAGE(bufoff, gbase, voff) do { _Pragma("unroll") for (int _i = 0; _i < 2; ++_i) \
        __builtin_amdgcn_global_load_lds((const unsigned*)((const char*)(gbase) + (voff)[_i]), (PG8_LAS unsigned*)(lds + (bufoff) + ldsw + _i * 8192), 16, 0, 0); } while (0)
#define PG8_LDA(dst, b, h) do { _Pragma("unroll") for (int m = 0; m < 4; ++m) _Pragma("unroll") for (int k = 0; k < 2; ++k) dst[m][k] = *(const PG8_LAS bf16x8*)(lds + PG8_SA(b, h) + aoff + m * 2048 + k * 1024); } while (0)
#define PG8_LDB(dst, b, h) do { _Pragma("unroll") for (int n = 0; n < 2; ++n) _Pragma("unroll") for (int k = 0; k < 2; ++k) dst[n][k] = *(const PG8_LAS bf16x8*)(lds + PG8_SB(b, h) + boff + n * 2048 + k * 1024); } while (0)
#define PG8_MMA(ai, bj, At, Bt) do { __builtin_amdgcn_s_setprio(1); _Pragma("unroll") for (int m = 0; m < 4; ++m) _Pragma("unroll") for (int n = 0; n < 2; ++n) _Pragma("unroll") for (int k = 0; k < 2; ++k) \
        acc[ai][bj][m][n] = __builtin_amdgcn_mfma_f32_16x16x32_bf16(Bt[n][k], At[m][k], acc[ai][bj][m][n], 0, 0, 0); __builtin_amdgcn_s_setprio(0); } while (0)
#define PG8_WAIT_V(n) asm volatile("s_waitcnt vmcnt(" #n ")" ::: "memory")
#define PG8_WAIT_L(n) asm volatile("s_waitcnt lgkmcnt(" #n ")" ::: "memory")
#define PG8_BAR __builtin_amdgcn_s_barrier()
#define PG8_SCHED __builtin_amdgcn_sched_barrier(0)
    Unit cur, nxt; int ui = 0;
    if (!S.next(0, cur)) return;
    f32x4 acc[2][2][4][2];
#pragma unroll
    for (int a = 0; a < 2; ++a)
#pragma unroll
        for (int b = 0; b < 2; ++b)
#pragma unroll
            for (int m = 0; m < 4; ++m)
#pragma unroll
                for (int n = 0; n < 2; ++n) acc[a][b][m][n] = (f32x4){0.f, 0.f, 0.f, 0.f};
    bf16x8 At[4][2], B0[2][2], B1[2][2];
    const char* cA = (cur.sel ? gA1 : gA) + (size_t)cur.pm * tstep; const char* cB = (cur.sel ? gB1 : gB) + (size_t)cur.pn * tstep;
    S.a_ready(cur);
    PG8_STAGE(PG8_SB(0, 0), cB, voffB); PG8_STAGE(PG8_SA(0, 0), cA, voffA); PG8_STAGE(PG8_SB(0, 1), cB + hstep, voffB); PG8_STAGE(PG8_SA(0, 1), cA + hstep, voffA);
    if (wr == 1) PG8_BAR;
    PG8_WAIT_V(4); PG8_BAR;
    PG8_STAGE(PG8_SB(1, 0), cB + kstep, voffB); PG8_STAGE(PG8_SA(1, 0), cA + kstep, voffA); PG8_STAGE(PG8_SB(1, 1), cB + hstep + kstep, voffB);
    PG8_WAIT_V(6); PG8_BAR;
    for (;;) {
        const bool has_next = S.next(ui + 1, nxt);
        const char* nA = has_next ? (nxt.sel ? gA1 : gA) + (size_t)nxt.pm * tstep : cA; const char* nB = has_next ? (nxt.sel ? gB1 : gB) + (size_t)nxt.pn * tstep : cB;
        for (int t = 0; t < nt; t += 2) {
            const bool last = (t == nt - 2);
            const char* a1 = cA + (size_t)(t + 1) * kstep;
            const char* a2 = last ? nA : cA + (size_t)(t + 2) * kstep; const char* b2 = last ? nB : cB + (size_t)(t + 2) * kstep;
            const char* a3 = a2 + kstep; const char* b3 = b2 + kstep;
            if (last && has_next) S.a_ready(nxt);
            PG8_LDB(B0, 0, 0); PG8_SCHED; PG8_LDA(At, 0, 0); PG8_STAGE(PG8_SA(1, 1), a1 + hstep, voffA);
            PG8_WAIT_L(8); PG8_BAR; PG8_WAIT_L(0); PG8_MMA(0, 0, At, B0); PG8_BAR; PG8_SCHED;
            PG8_LDB(B1, 0, 1); PG8_STAGE(PG8_SB(0, 0), b2, voffB);
            PG8_BAR; PG8_WAIT_L(0); PG8_MMA(0, 1, At, B1); PG8_BAR;
            PG8_LDA(At, 0, 1); PG8_STAGE(PG8_SA(0, 0), a2, voffA);
            PG8_BAR; PG8_WAIT_L(0); PG8_MMA(1, 0, At, B0); PG8_BAR; PG8_SCHED;
            PG8_STAGE(PG8_SB(0, 1), b2 + hstep, voffB);
            PG8_WAIT_V(6); PG8_BAR; PG8_MMA(1, 1, At, B1); PG8_BAR;
            PG8_LDB(B0, 1, 0); PG8_SCHED; PG8_LDA(At, 1, 0); PG8_STAGE(PG8_SA(0, 1), a2 + hstep, voffA);
            PG8_WAIT_L(8); PG8_BAR; PG8_WAIT_L(0); PG8_MMA(0, 0, At, B0); PG8_BAR; PG8_SCHED;
            PG8_LDB(B1, 1, 1); PG8_STAGE(PG8_SB(1, 0), b3, voffB);
            PG8_BAR; PG8_WAIT_L(0); PG8_MMA(0, 1, At, B1); PG8_BAR;
            PG8_LDA(At, 1, 1); PG8_STAGE(PG8_SA(1, 0), a3, voffA);
            PG8_BAR; PG8_WAIT_L(0); PG8_MMA(1, 0, At, B0); PG8_BAR; PG8_SCHED;
            PG8_STAGE(PG8_SB(1, 1), b3 + hstep, voffB);
            PG8_WAIT_V(6); PG8_BAR; PG8_MMA(1, 1, At, B1); PG8_BAR;
        }
        if constexpr (!Epi::AFTER_DRAIN) { E(acc, cur, wr, wc, fr, fq); S.done(cur); }
        if (!has_next) break;
#pragma unroll
        for (int a = 0; a < 2; ++a)
#pragma unroll
            for (int b = 0; b < 2; ++b)
#pragma unroll
                for (int m = 0; m < 4; ++m)
#pragma unroll
                    for (int n = 0; n < 2; ++n) acc[a][b][m][n] = (f32x4){0.f, 0.f, 0.f, 0.f};
        cur = nxt; cA = nA; cB = nB; ++ui;
    }
    PG8_WAIT_V(0);
    if (wr == 0) PG8_BAR;
    PG8_BAR;
    if constexpr (Epi::AFTER_DRAIN) { E.fused(acc, cur, wr, wc, fr, fq, lds, wid, lane); S.done(cur); }
#undef PG8_SA
#undef PG8_SB
#undef PG8_STAGE
#undef PG8_LDA
#undef PG8_LDB
#undef PG8_MMA
#undef PG8_WAIT_V
#undef PG8_WAIT_L
#undef PG8_BAR
#undef PG8_SCHED
}
}

#define XB_TMO      128
#define XB_XCNT(j)  (256  + 64 * (j))
#define XB_XSUB(j)  (1280 + 64 * (j))
#define XB_XGEN(j)  (2304 + 64 * (j))
#define XB_TOP      3328
#define XB_TOPGEN   3392
#define XCD_BAR_WORDS 3456
#define XB_SPIN_CAP (1u << 18)
#define LAS __attribute__((address_space(3)))

__device__ __forceinline__ unsigned xb_ld(unsigned* p)              { return __hip_atomic_load(p, __ATOMIC_RELAXED, __HIP_MEMORY_SCOPE_AGENT); }
__device__ __forceinline__ unsigned xb_add(unsigned* p, unsigned v) { return __hip_atomic_fetch_add(p, v, __ATOMIC_RELAXED, __HIP_MEMORY_SCOPE_AGENT); }
__device__ __forceinline__ unsigned xb_xcc_id() { return (unsigned)__builtin_amdgcn_s_getreg((3 << 11) | 20) & 0xFu; }
#define XB_SPIN(cond, bar) do { unsigned _sp = 0; while (cond) { __builtin_amdgcn_s_sleep(1); \
    if ((++_sp & 255u) == 0u) { if (xb_ld(&(bar)[XB_TMO])) break; if (_sp > XB_SPIN_CAP) { atomicAdd(&(bar)[XB_TMO], 1u); break; } } } } while (0)

struct XcdBarrier {
    unsigned* bar; unsigned x;
    volatile LAS unsigned* st;
};

__device__ __forceinline__ XcdBarrier xcd_barrier_post(unsigned* bar, volatile LAS unsigned* st) {
    XcdBarrier b; b.bar = bar; b.x = xb_xcc_id(); b.st = st;
    if (threadIdx.x == 0) (void)xb_add(&bar[XB_XCNT(b.x)], 1u);
    return b;
}
__device__ __forceinline__ void xcd_barrier_complete(unsigned* bar, unsigned x, unsigned& nloc, unsigned& nx) {
    const unsigned G = gridDim.x * gridDim.y * gridDim.z;
    unsigned sum, cnt, mine, sp = 0u;
    for (;;) {
        sum = 0u; cnt = 0u; mine = 0u;
#pragma unroll
        for (unsigned j = 0; j < 16; ++j) { const unsigned c = xb_ld(&bar[XB_XCNT(j)]); sum += c; cnt += (c > 0u) ? 1u : 0u; mine = (j == x) ? c : mine; }
        if (sum == G) break;
        __builtin_amdgcn_s_sleep(1);
        if ((++sp & 255u) == 0u) { if (xb_ld(&bar[XB_TMO])) break; if (sp > XB_SPIN_CAP) { atomicAdd(&bar[XB_TMO], 1u); break; } }
    }
    nloc = mine > 0u ? mine : 1u; nx = cnt > 0u ? cnt : 1u;
}

__device__ __forceinline__ void xcd_barrier(const XcdBarrier& b) {
    asm volatile("s_waitcnt vmcnt(0)" ::: "memory");
    __syncthreads();
    if (threadIdx.x == 0) {
        unsigned* bar = b.bar;
        __builtin_amdgcn_s_waitcnt(0);
        unsigned nloc = b.st[0], nx = b.st[1];
        if (nloc == 0u) { xcd_barrier_complete(bar, b.x, nloc, nx); b.st[0] = nloc; b.st[1] = nx; }
        const unsigned old = xb_add(&bar[XB_XSUB(b.x)], 1u);
        const unsigned gen = old / nloc;
        if (old + 1u == (gen + 1u) * nloc) {
            __builtin_amdgcn_fence(__ATOMIC_RELEASE, "agent");
            asm volatile("s_waitcnt vmcnt(0)" ::: "memory");
            const unsigned og = xb_add(&bar[XB_TOP], 1u);
            const unsigned tg = og / nx;
            if (og + 1u == (tg + 1u) * nx) xb_add(&bar[XB_TOPGEN], 1u);
            else XB_SPIN(xb_ld(&bar[XB_TOPGEN]) == tg, bar);
            __builtin_amdgcn_fence(__ATOMIC_ACQUIRE, "agent");
            xb_add(&bar[XB_XGEN(b.x)], 1u);
            asm volatile("s_waitcnt vmcnt(0)" ::: "memory");
        } else {
            XB_SPIN(xb_ld(&bar[XB_XGEN(b.x)]) == gen, bar);
            __builtin_amdgcn_fence(__ATOMIC_ACQUIRE, "agent");
            asm volatile("s_waitcnt vmcnt(0)" ::: "memory");
        }
    }
    __syncthreads();
}

using pg8::bf16_t; using pg8::bf16x8; using pg8::f32x4;
typedef unsigned u32x2_t __attribute__((ext_vector_type(2)));
typedef unsigned u32x4_t __attribute__((ext_vector_type(4)));

constexpr int DM = 1024, SEG = 16384, LDZ = 8192, LDY = 2560;
constexpr float EPS = 1e-6f;
constexpr int XST_OFF = 9 * 16384 + 2048;
constexpr int LDS_BYTES = XST_OFF + 64;
constexpr size_t WS_WIN_E = 0;
constexpr size_t WS_WIN_O = WS_WIN_E + (size_t)9216 * 1024 * 2;
constexpr size_t WS_WOUT_E = WS_WIN_O + (size_t)6144 * 1024 * 2;
constexpr size_t WS_WOUT_O = WS_WOUT_E + (size_t)1024 * 2560 * 2;
constexpr size_t WS_WKV = WS_WOUT_O + (size_t)1024 * 2560 * 2;
constexpr size_t WS_LRUW = WS_WKV + (size_t)2 * 1024 * 1024 * 2;
constexpr size_t WS_SGUW = WS_LRUW + (size_t)2 * 2 * 8 * 128 * 128 * 2;
constexpr size_t WS_MEMN = WS_SGUW + (size_t)8 * 128 * 128 * 2;
constexpr size_t WS_MK = WS_MEMN + (size_t)2 * 1536 * 1024 * 2;
constexpr size_t WS_MVT = WS_MK + (size_t)2 * 1536 * 512 * 2;
constexpr size_t WS_H = WS_MVT + (size_t)2 * 512 * 1536 * 2;
constexpr size_t WS_Z = WS_H + (size_t)SEG * 1024 * 2;
constexpr size_t WS_VT = WS_Z + (size_t)SEG * LDZ * 2;
constexpr size_t WS_Y = WS_VT + (size_t)1024 * SEG * 2;
constexpr size_t WS_AGG = WS_Y + (size_t)SEG * LDY * 2;
constexpr size_t WS_CARRY = WS_AGG + (size_t)2 * 128 * 1024 * 2 * 4;
constexpr size_t WS_RSTD = WS_CARRY + (size_t)2 * 128 * 1024 * 4;
constexpr size_t WS_PART = WS_RSTD + (size_t)SEG * 4;
constexpr size_t WS_BAR = WS_PART + (size_t)8 * SEG * 4;
constexpr size_t WS_LAB = WS_BAR + 16384;
constexpr size_t WS_END = WS_LAB + (size_t)2 * SEG * 1024 * 4;

struct Params { const float* in[25]; float* out; unsigned char* ws; };

__device__ __forceinline__ float bf2f(unsigned short b) { return __uint_as_float(((unsigned)b) << 16); }
__device__ __forceinline__ unsigned short f2bf(float f) { unsigned u = __float_as_uint(f); u += 0x7FFFu + ((u >> 16) & 1u); return (unsigned short)(u >> 16); }
__device__ __forceinline__ float bflo(unsigned w) { return __uint_as_float(w << 16); }
__device__ __forceinline__ float bfhi(unsigned w) { return __uint_as_float(w & 0xffff0000u); }
__device__ __forceinline__ unsigned pk2(float lo, float hi) { return pg8::cvt_pk_bf16(lo, hi); }
__device__ __forceinline__ float frcp(float x) { return __builtin_amdgcn_rcpf(x); }
__device__ __forceinline__ float silu(float x) { return x * frcp(1.0f + __expf(-x)); }
__device__ __forceinline__ float sigm(float x) { return frcp(1.0f + __expf(-x)); }
__device__ __forceinline__ float wave_sum(float v) {
#pragma unroll
    for (int o = 1; o < 64; o <<= 1) v += __shfl_xor(v, o);
    return v;
}
__device__ __forceinline__ f32x4 mfma16(bf16x8 a, bf16x8 b, f32x4 c) { return __builtin_amdgcn_mfma_f32_16x16x32_bf16(a, b, c, 0, 0, 0); }
__device__ __forceinline__ bf16x8 ld8(const bf16_t* p) { return *(const bf16x8*)p; }
__device__ __forceinline__ bf16x8 pack8(const float (&v)[8]) {
    u32x4_t w; w.x = pk2(v[0], v[1]); w.y = pk2(v[2], v[3]); w.z = pk2(v[4], v[5]); w.w = pk2(v[6], v[7]);
    return __builtin_bit_cast(bf16x8, w);
}

__device__ __forceinline__ void transpose_item(const float* W, int K, int N, bf16_t* WT, LAS float* scr, int item, int lane) {
    const int nblk = N >> 5, kb = item / nblk, nb = item - kb * nblk, k0 = 64 * kb, n0 = 32 * nb;
#pragma unroll 8
    for (int i = 0; i < 32; ++i) { const int kk = 2 * i + (lane >> 5); scr[kk * 33 + (lane & 31)] = W[(size_t)(k0 + kk) * N + n0 + (lane & 31)]; }
    asm volatile("s_waitcnt lgkmcnt(0)" ::: "memory");
    const int c = lane & 7;
#pragma unroll
    for (int j = 0; j < 4; ++j) { const int n = (lane >> 3) + 8 * j; const LAS float* s = scr + (8 * c) * 33 + n;
        u32x4_t o; o.x = pk2(s[0 * 33], s[1 * 33]); o.y = pk2(s[2 * 33], s[3 * 33]); o.z = pk2(s[4 * 33], s[5 * 33]); o.w = pk2(s[6 * 33], s[7 * 33]);
        *(u32x4_t*)(WT + (size_t)(n0 + n) * K + k0 + 8 * c) = o; }
    asm volatile("s_waitcnt lgkmcnt(0)" ::: "memory");
}

__device__ __forceinline__ void rms_row_bf16(const float* xrow, const float* g, bf16_t* orow, int lane) {
    const f32x4* xr = (const f32x4*)xrow + lane; f32x4 v[4]; float s = 0.f;
#pragma unroll
    for (int j = 0; j < 4; ++j) { v[j] = xr[64 * j]; s += (v[j].x * v[j].x + v[j].y * v[j].y) + (v[j].z * v[j].z + v[j].w * v[j].w); }
    const float rstd = __builtin_amdgcn_rsqf(wave_sum(s) * (1.0f / 1024.0f) + EPS);
    const f32x4* gr = (const f32x4*)g + lane; u32x2_t* o8 = (u32x2_t*)orow + lane;
#pragma unroll
    for (int j = 0; j < 4; ++j) { const f32x4 gg = gr[64 * j]; u32x2_t o; o.x = pk2(v[j].x * rstd * gg.x, v[j].y * rstd * gg.y); o.y = pk2(v[j].z * rstd * gg.z, v[j].w * rstd * gg.w); o8[64 * j] = o; }
}
__device__ __forceinline__ void rms_row_f32(float* xrow, const float* g, int lane) {
    f32x4* xr = (f32x4*)xrow + lane; f32x4 v[4]; float s = 0.f;
#pragma unroll
    for (int j = 0; j < 4; ++j) { v[j] = xr[64 * j]; s += (v[j].x * v[j].x + v[j].y * v[j].y) + (v[j].z * v[j].z + v[j].w * v[j].w); }
    const float rstd = __builtin_amdgcn_rsqf(wave_sum(s) * (1.0f / 1024.0f) + EPS);
    const f32x4* gr = (const f32x4*)g + lane;
#pragma unroll
    for (int j = 0; j < 4; ++j) { const f32x4 gg = gr[64 * j]; f32x4 o; o.x = v[j].x * rstd * gg.x; o.y = v[j].y * rstd * gg.y; o.z = v[j].z * rstd * gg.z; o.w = v[j].w * rstd * gg.w; xr[64 * j] = o; }
}

__device__ __forceinline__ void rms_rows4_bf16(const float* xrow, const float* g, bf16_t* orow, int lane) {
    f32x4 v[4][4]; float s[4];
#pragma unroll
    for (int r = 0; r < 4; ++r)
#pragma unroll
        for (int j = 0; j < 4; ++j) v[r][j] = ((const f32x4*)(xrow + (size_t)r * 1024))[lane + 64 * j];
    f32x4 gg[4];
#pragma unroll
    for (int j = 0; j < 4; ++j) gg[j] = ((const f32x4*)g)[lane + 64 * j];
#pragma unroll
    for (int r = 0; r < 4; ++r) { s[r] = 0.f;
#pragma unroll
        for (int j = 0; j < 4; ++j) s[r] += (v[r][j].x * v[r][j].x + v[r][j].y * v[r][j].y) + (v[r][j].z * v[r][j].z + v[r][j].w * v[r][j].w); }
#pragma unroll
    for (int o = 1; o < 64; o <<= 1) {
#pragma unroll
        for (int r = 0; r < 4; ++r) s[r] += __shfl_xor(s[r], o); }
#pragma unroll
    for (int r = 0; r < 4; ++r) { const float rstd = __builtin_amdgcn_rsqf(s[r] * (1.0f / 1024.0f) + EPS);
        u32x2_t* o8 = (u32x2_t*)(orow + (size_t)r * 1024) + lane;
#pragma unroll
        for (int j = 0; j < 4; ++j) { u32x2_t o; o.x = pk2(v[r][j].x * rstd * gg[j].x, v[r][j].y * rstd * gg[j].y); o.y = pk2(v[r][j].z * rstd * gg[j].z, v[r][j].w * rstd * gg[j].w); o8[64 * j] = o; } }
}
__device__ __forceinline__ void rms_rows4_f32(float* xrow, const float* g, int lane) {
    f32x4 v[4][4]; float s[4];
#pragma unroll
    for (int r = 0; r < 4; ++r)
#pragma unroll
        for (int j = 0; j < 4; ++j) v[r][j] = ((const f32x4*)(xrow + (size_t)r * 1024))[lane + 64 * j];
    f32x4 gg[4];
#pragma unroll
    for (int j = 0; j < 4; ++j) gg[j] = ((const f32x4*)g)[lane + 64 * j];
#pragma unroll
    for (int r = 0; r < 4; ++r) { s[r] = 0.f;
#pragma unroll
        for (int j = 0; j < 4; ++j) s[r] += (v[r][j].x * v[r][j].x + v[r][j].y * v[r][j].y) + (v[r][j].z * v[r][j].z + v[r][j].w * v[r][j].w); }
#pragma unroll
    for (int o = 1; o < 64; o <<= 1) {
#pragma unroll
        for (int r = 0; r < 4; ++r) s[r] += __shfl_xor(s[r], o); }
#pragma unroll
    for (int r = 0; r < 4; ++r) { const float rstd = __builtin_amdgcn_rsqf(s[r] * (1.0f / 1024.0f) + EPS);
        f32x4* xo = (f32x4*)(xrow + (size_t)r * 1024) + lane;
#pragma unroll
        for (int j = 0; j < 4; ++j) { f32x4 o; o.x = v[r][j].x * rstd * gg[j].x; o.y = v[r][j].y * rstd * gg[j].y; o.z = v[r][j].z * rstd * gg[j].z; o.w = v[r][j].w * rstd * gg[j].w; xo[64 * j] = o; } }
}

__device__ __forceinline__ void conv_even_item(const bf16_t* z, const float* cw, const float* cb, bf16_t* y, int t0, int T, int lane) {
    const int s = t0 & (T - 1);
#pragma unroll
    for (int half = 0; half < 2; ++half) {
        const int c0 = half * 512 + lane * 8;
        const bf16_t* zr = z + (size_t)t0 * LDZ + c0;
        u32x4_t cg[4], xv[4], bg[2], ga[2];
#pragma unroll
        for (int i = 0; i < 4; ++i) { cg[i] = (u32x4_t){0u, 0u, 0u, 0u}; xv[i] = (u32x4_t){0u, 0u, 0u, 0u}; }
        if (s > 0) { cg[0] = *(const u32x4_t*)(zr - LDZ + 1024); xv[0] = *(const u32x4_t*)(zr - LDZ + 2048); }
        cg[1] = *(const u32x4_t*)(zr + 1024); xv[1] = *(const u32x4_t*)(zr + 2048);
        cg[2] = *(const u32x4_t*)(zr + LDZ + 1024); xv[2] = *(const u32x4_t*)(zr + LDZ + 2048);
        if (s + 2 < T) { cg[3] = *(const u32x4_t*)(zr + 2 * LDZ + 1024); xv[3] = *(const u32x4_t*)(zr + 2 * LDZ + 2048); }
        bg[0] = *(const u32x4_t*)(zr); ga[0] = *(const u32x4_t*)(zr + 3072);
        bg[1] = *(const u32x4_t*)(zr + LDZ); ga[1] = *(const u32x4_t*)(zr + LDZ + 3072);
        float w0[8], w1[8], w2[8], bb[8];
#pragma unroll
        for (int e = 0; e < 8; e += 4) {
            const f32x4 a = *(const f32x4*)(cw + c0 + e), b = *(const f32x4*)(cw + 1024 + c0 + e), c = *(const f32x4*)(cw + 2048 + c0 + e), d = *(const f32x4*)(cb + c0 + e);
#pragma unroll
            for (int k = 0; k < 4; ++k) { w0[e + k] = a[k]; w1[e + k] = b[k]; w2[e + k] = c[k]; bb[e + k] = d[k]; }
        }
        float p[4][8];
#pragma unroll
        for (int i = 0; i < 4; ++i)
#pragma unroll
            for (int k = 0; k < 4; ++k) { p[i][2 * k] = bflo(cg[i][k]) * bflo(xv[i][k]); p[i][2 * k + 1] = bfhi(cg[i][k]) * bfhi(xv[i][k]); }
#pragma unroll
        for (int tt = 0; tt < 2; ++tt) {
            float o[8];
#pragma unroll
            for (int k = 0; k < 4; ++k) {
                const float cl = bb[2 * k] + w0[2 * k] * p[tt][2 * k] + w1[2 * k] * p[tt + 1][2 * k] + w2[2 * k] * p[tt + 2][2 * k];
                const float ch = bb[2 * k + 1] + w0[2 * k + 1] * p[tt][2 * k + 1] + w1[2 * k + 1] * p[tt + 1][2 * k + 1] + w2[2 * k + 1] * p[tt + 2][2 * k + 1];
                o[2 * k] = bflo(bg[tt][k]) * cl * silu(bflo(ga[tt][k]));
                o[2 * k + 1] = bfhi(bg[tt][k]) * ch * silu(bfhi(ga[tt][k]));
            }
            u32x4_t w; w.x = pk2(o[0], o[1]); w.y = pk2(o[2], o[3]); w.z = pk2(o[4], o[5]); w.w = pk2(o[6], o[7]);
            *(u32x4_t*)(y + (size_t)(t0 + tt) * LDY + c0) = w;
        }
    }
}

__device__ __forceinline__ void conv_odd_item(const bf16_t* z, const float* cw, const float* cb, bf16_t* xc, int t, int T, int lane) {
    const int s = t & (T - 1);
#pragma unroll
    for (int half = 0; half < 2; ++half) {
        const int c0 = half * 512 + lane * 8;
        const bf16_t* zr = z + (size_t)t * LDZ + c0;
        float acc[8];
#pragma unroll
        for (int e = 0; e < 8; e += 4) { const f32x4 d = *(const f32x4*)(cb + c0 + e); acc[e] = d[0]; acc[e + 1] = d[1]; acc[e + 2] = d[2]; acc[e + 3] = d[3]; }
#pragma unroll
        for (int j = 0; j < 4; ++j) {
            const int sj = s + j - 2;
            if (sj >= 0 && sj < T) {
                const u32x4_t xv = *(const u32x4_t*)(zr + (ptrdiff_t)(j - 2) * LDZ);
                const f32x4 wa = *(const f32x4*)(cw + j * 1024 + c0), wb = *(const f32x4*)(cw + j * 1024 + c0 + 4);
                acc[0] += wa[0] * bflo(xv[0]); acc[1] += wa[1] * bfhi(xv[0]); acc[2] += wa[2] * bflo(xv[1]); acc[3] += wa[3] * bfhi(xv[1]);
                acc[4] += wb[0] * bflo(xv[2]); acc[5] += wb[1] * bfhi(xv[2]); acc[6] += wb[2] * bflo(xv[3]); acc[7] += wb[3] * bfhi(xv[3]);
            }
        }
        u32x4_t w; w.x = pk2(acc[0], acc[1]); w.y = pk2(acc[2], acc[3]); w.z = pk2(acc[4], acc[5]); w.w = pk2(acc[6], acc[7]);
        *(u32x4_t*)(xc + (size_t)t * 1024 + c0) = w;
    }
}
__device__ __forceinline__ void rstd_item(const float* part, float* rstd, int tg, int lane) {
    const float* p = part + tg * 64 + lane; float s = 0.f;
#pragma unroll
    for (int i = 0; i < 8; ++i) s += p[(size_t)i * SEG];
    rstd[tg * 64 + lane] = __builtin_amdgcn_rsqf(s * (1.0f / 1024.0f) + EPS);
}

constexpr int NA_RING = 9 * 16384, NA_RPB = NA_RING, NA_LDS_END = NA_RING + 2048;
__device__ __forceinline__ int na_fk(int key) { return ((key >> 1) & 1) | (((key >> 3) & 3) << 1); }
__device__ __forceinline__ void na_stage_row(const bf16_t* z, const bf16_t* vT, LAS unsigned char* slot, int tokr, int h, int lt, int nth) {
    for (int idx = lt; idx < 512; idx += nth) {
        const int rw = idx >> 3, c = idx & 7;
        const u32x4_t kv = *(const u32x4_t*)(z + (size_t)(tokr + rw) * LDZ + 5120 + h * 64 + c * 8);
        const u32x4_t vv = *(const u32x4_t*)(vT + (size_t)(h * 64 + rw) * SEG + tokr + c * 8);
        *(LAS u32x4_t*)(slot + rw * 128 + ((c ^ na_fk(rw)) << 4)) = kv;
        *(LAS u32x4_t*)(slot + 8192 + rw * 128 + ((c ^ ((rw >> 1) & 7)) << 4)) = vv;
    }
}
__device__ __forceinline__ void na_block(const bf16_t* z, const bf16_t* vT, bf16_t* y, const float* rpb, int unit, int T, LAS unsigned char* lds, int tid) {
    const int h = unit & 15, R0 = (unit >> 4) * 16;
    const int rows = T >> 6, seq = R0 / rows, rr0 = R0 - seq * rows, seq_base = seq * T;
    const int lane = tid & 63, wid = tid >> 6, fr = lane & 15, fq = lane >> 4;
    LAS float* rpbL = (LAS float*)(lds + NA_RPB);
    __syncthreads();
    for (int i = tid; i < 465; i += 512) rpbL[i] = rpb[h * 465 + i];
    int rs0 = rr0 - 4; rs0 = rs0 < 0 ? 0 : rs0; rs0 = rs0 > rows - 8 ? rows - 8 : rs0;
    {
        const int rw = tid >> 3, c = tid & 7;
        u32x4_t kv[8], vv[8];
#pragma unroll
        for (int kr = 0; kr < 8; ++kr) { const int tokr = seq_base + (rs0 + kr) * 64;
            kv[kr] = *(const u32x4_t*)(z + (size_t)(tokr + rw) * LDZ + 5120 + h * 64 + c * 8);
            vv[kr] = *(const u32x4_t*)(vT + (size_t)(h * 64 + rw) * SEG + tokr + c * 8); }
#pragma unroll
        for (int kr = 0; kr < 8; ++kr) { LAS unsigned char* slot = lds + ((rs0 + kr) % 9) * 16384;
            *(LAS u32x4_t*)(slot + rw * 128 + ((c ^ na_fk(rw)) << 4)) = kv[kr];
            *(LAS u32x4_t*)(slot + 8192 + rw * 128 + ((c ^ ((rw >> 1) & 7)) << 4)) = vv[kr]; }
    }
    __syncthreads();
    const int g = wid & 3;
    const int wb = (g == 0) ? 0 : (g == 1) ? 8 : (g == 2) ? 24 : 32;
    const int keyA = wb + (fr >> 2) * 8 + (fr & 3);
    const int offK0 = keyA * 128 + (((0 + fq) ^ na_fk(keyA)) << 4), offK1 = keyA * 128 + (((4 + fq) ^ na_fk(keyA)) << 4);
    const int offV = 8192 + fr * 128 + ((((wb >> 3) + fq) ^ ((fr >> 1) & 7)) << 4);
    const int qc = g * 16 + fr;
    int cstart = qc - 8; cstart = cstart < 0 ? 0 : cstart; cstart = cstart > 48 ? 48 : cstart;
    int dcs[8]; bool oks[8];
#pragma unroll
    for (int e = 0; e < 8; ++e) { const int kc = wb + fq * 8 + e; oks[e] = (kc >= cstart) && (kc < cstart + 16); int dc = kc - qc; dc = dc < -15 ? -15 : dc; dc = dc > 15 ? 15 : dc; dcs[e] = dc + 15; }
    const bf16_t* zt = z + (size_t)(seq_base + rr0 * 64 + g * 16 + fr) * LDZ;
    bf16x8 q0 = ld8(zt + 4096 + h * 64 + fq * 8), q1 = ld8(zt + 4096 + h * 64 + fq * 8 + 32);
    u32x2_t gr[4];
#pragma unroll
    for (int dt = 0; dt < 4; ++dt) gr[dt] = *(const u32x2_t*)(zt + 6144 + h * 64 + dt * 16 + fq * 4);
#pragma unroll 1
    for (int i = 0; i < 16; ++i) {
        const int rr = rr0 + i;
        int rs = rr - 4; rs = rs < 0 ? 0 : rs; rs = rs > rows - 8 ? rows - 8 : rs;
        int rsn = rr - 3; rsn = rsn < 0 ? 0 : rsn; rsn = rsn > rows - 8 ? rows - 8 : rsn;
        if (wid >= 4) {
            if (i < 15 && rsn > rs) { const int a = rsn + 7, tokr = seq_base + a * 64, lt = tid - 256; LAS unsigned char* slot = lds + (a % 9) * 16384;
                u32x4_t kv[2], vv[2];
#pragma unroll
                for (int j = 0; j < 2; ++j) { const int idx = lt + 256 * j, rw = idx >> 3, c = idx & 7;
                    kv[j] = *(const u32x4_t*)(z + (size_t)(tokr + rw) * LDZ + 5120 + h * 64 + c * 8); vv[j] = *(const u32x4_t*)(vT + (size_t)(h * 64 + rw) * SEG + tokr + c * 8); }
#pragma unroll
                for (int j = 0; j < 2; ++j) { const int idx = lt + 256 * j, rw = idx >> 3, c = idx & 7;
                    *(LAS u32x4_t*)(slot + rw * 128 + ((c ^ na_fk(rw)) << 4)) = kv[j]; *(LAS u32x4_t*)(slot + 8192 + rw * 128 + ((c ^ ((rw >> 1) & 7)) << 4)) = vv[j]; } }
        } else {
            const bf16_t* ztc = zt + (size_t)i * 64 * LDZ;
            bf16x8 q0n = q0, q1n = q1; u32x2_t grn[4];
#pragma unroll
            for (int dt = 0; dt < 4; ++dt) grn[dt] = gr[dt];
            if (i < 15) {
                const bf16_t* ztn = ztc + (size_t)64 * LDZ;
                q0n = ld8(ztn + 4096 + h * 64 + fq * 8); q1n = ld8(ztn + 4096 + h * 64 + fq * 8 + 32);
#pragma unroll
                for (int dt = 0; dt < 4; ++dt) grn[dt] = *(const u32x2_t*)(ztn + 6144 + h * 64 + dt * 16 + fq * 4);
            }
            const LAS float* bp0 = rpbL + (rs - rr + 7) * 31;
            float s[8][8];
            float mx = -1e30f;
            int slot = rs % 9;
#pragma unroll
            for (int kr = 0; kr < 8; ++kr) {
                const LAS unsigned char* sb = lds + slot * 16384;
                slot = (slot == 8) ? 0 : slot + 1;
                const bf16x8 k00 = *(const LAS bf16x8*)(sb + offK0), k01 = *(const LAS bf16x8*)(sb + offK1);
                const bf16x8 k10 = *(const LAS bf16x8*)(sb + offK0 + 512), k11 = *(const LAS bf16x8*)(sb + offK1 + 512);
                f32x4 a0 = {0.f, 0.f, 0.f, 0.f}, a1 = {0.f, 0.f, 0.f, 0.f};
                a0 = mfma16(k00, q0, a0); a0 = mfma16(k01, q1, a0);
                a1 = mfma16(k10, q0, a1); a1 = mfma16(k11, q1, a1);
#pragma unroll
                for (int e = 0; e < 8; ++e) {
                    const float sc = (e < 4 ? a0[e & 3] : a1[e & 3]) * 0.125f + bp0[kr * 31 + dcs[e]];
                    s[kr][e] = oks[e] ? sc : -1e30f;
                    mx = fmaxf(mx, s[kr][e]);
                }
            }
            mx = fmaxf(mx, __shfl_xor(mx, 16)); mx = fmaxf(mx, __shfl_xor(mx, 32));
            float sum = 0.f;
#pragma unroll
            for (int kr = 0; kr < 8; ++kr)
#pragma unroll
                for (int e = 0; e < 8; ++e) { const float p = __expf(s[kr][e] - mx); s[kr][e] = p; sum += p; }
            sum += __shfl_xor(sum, 16); sum += __shfl_xor(sum, 32);
            f32x4 o[4];
#pragma unroll
            for (int dt = 0; dt < 4; ++dt) o[dt] = (f32x4){0.f, 0.f, 0.f, 0.f};
            slot = rs % 9;
#pragma unroll
            for (int kr = 0; kr < 8; ++kr) {
                const LAS unsigned char* sb = lds + slot * 16384 + offV;
                slot = (slot == 8) ? 0 : slot + 1;
                const bf16x8 pf = pack8(s[kr]);
#pragma unroll
                for (int dt = 0; dt < 4; ++dt) o[dt] = mfma16(*(const LAS bf16x8*)(sb + dt * 2048), pf, o[dt]);
            }
            const float inv = frcp(sum);
            bf16_t* yt = y + (size_t)(seq_base + rr * 64 + g * 16 + fr) * LDY + 1024 + h * 64;
#pragma unroll
            for (int dt = 0; dt < 4; ++dt) {
                u32x2_t ow;
                ow.x = pk2(o[dt][0] * inv * silu(bflo(gr[dt].x)), o[dt][1] * inv * silu(bfhi(gr[dt].x)));
                ow.y = pk2(o[dt][2] * inv * silu(bflo(gr[dt].y)), o[dt][3] * inv * silu(bfhi(gr[dt].y)));
                *(u32x2_t*)(yt + dt * 16 + fq * 4) = ow;
            }
            q0 = q0n; q1 = q1n;
#pragma unroll
            for (int dt = 0; dt < 4; ++dt) gr[dt] = grn[dt];
        }
        __syncthreads();
    }
}

__device__ __forceinline__ void mem_unit(const bf16_t* z, int qcol, int gcol, const bf16_t* mk, const bf16_t* mvT, bf16_t* y, int unit, int seg, LAS unsigned char* lds, int tid) {
    const int h = unit & 3, range = unit >> 2, tokr = range * 256;
    const int mb = seg < 2 ? seg : 2 + (tokr >> 12);
    const int lane = tid & 63, wid = tid >> 6, fr = lane & 15, fq = lane >> 4;
    __syncthreads();
    {
        u32x4_t kv[8], vv[8];
#pragma unroll
        for (int i = 0; i < 8; ++i) { const int idx = tid + 512 * i;
            kv[i] = *(const u32x4_t*)(mk + (size_t)(mb * 256 + (idx >> 4)) * 512 + h * 128 + (idx & 15) * 8);
            vv[i] = *(const u32x4_t*)(mvT + (size_t)(h * 128 + (idx >> 5)) * 1536 + mb * 256 + (idx & 31) * 8); }
#pragma unroll
        for (int i = 0; i < 8; ++i) { const int idx = tid + 512 * i;
            { const int rho = idx >> 4, c = idx & 15, f = (rho & 3) | (((rho >> 3) & 3) << 2); *(LAS u32x4_t*)(lds + rho * 256 + ((c ^ f) << 4)) = kv[i]; }
            { const int d = idx >> 5, c = idx & 31; *(LAS u32x4_t*)(lds + 65536 + d * 512 + ((c ^ (d & 15)) << 4)) = vv[i]; } }
    }
    __syncthreads();
    const int mrowA = (fr >> 2) * 8 + (fr & 3);
    const LAS unsigned char* kbase = lds + mrowA * 256 + ((fq ^ (fr & 3)) << 4);
    const LAS unsigned char* vbase = lds + 65536 + fr * 512 + ((fq ^ (fr & 3)) << 4);
    const int hi = fr >> 2;
#pragma unroll 1
    for (int gi = 0; gi < 2; ++gi) {
        const int tok = tokr + (wid + 8 * gi) * 16 + fr;
        const bf16_t* qp = z + (size_t)tok * LDZ + qcol + h * 128 + fq * 8;
        bf16x8 q[4];
#pragma unroll
        for (int ks = 0; ks < 4; ++ks) q[ks] = ld8(qp + ks * 32);
        u32x2_t gr[8];
#pragma unroll
        for (int dt = 0; dt < 8; ++dt) gr[dt] = *(const u32x2_t*)(z + (size_t)tok * LDZ + gcol + h * 128 + dt * 16 + fq * 4);
        float s[8][8];
        float mx = -1e30f;
#pragma unroll
        for (int kb = 0; kb < 8; ++kb) {
            f32x4 a0 = {0.f, 0.f, 0.f, 0.f}, a1 = {0.f, 0.f, 0.f, 0.f};
#pragma unroll
            for (int ks = 0; ks < 4; ++ks) {
                const LAS unsigned char* kp = kbase + kb * 8192 + ((ks ^ hi) << 6);
                a0 = mfma16(*(const LAS bf16x8*)kp, q[ks], a0); a1 = mfma16(*(const LAS bf16x8*)(kp + 1024), q[ks], a1);
            }
#pragma unroll
            for (int e = 0; e < 8; ++e) { s[kb][e] = (e < 4 ? a0[e & 3] : a1[e & 3]) * 0.08838834764831845f; mx = fmaxf(mx, s[kb][e]); }
        }
        mx = fmaxf(mx, __shfl_xor(mx, 16)); mx = fmaxf(mx, __shfl_xor(mx, 32));
        float sum = 0.f;
#pragma unroll
        for (int kb = 0; kb < 8; ++kb)
#pragma unroll
            for (int e = 0; e < 8; ++e) { const float p = __expf(s[kb][e] - mx); s[kb][e] = p; sum += p; }
        sum += __shfl_xor(sum, 16); sum += __shfl_xor(sum, 32);
        f32x4 o[8];
#pragma unroll
        for (int dt = 0; dt < 8; ++dt) o[dt] = (f32x4){0.f, 0.f, 0.f, 0.f};
#pragma unroll
        for (int kb = 0; kb < 8; ++kb) {
            const bf16x8 pf = pack8(s[kb]);
            const LAS unsigned char* vp = vbase + (((kb ^ hi) & 7) << 6);
#pragma unroll
            for (int dt = 0; dt < 8; ++dt) o[dt] = mfma16(*(const LAS bf16x8*)(vp + dt * 8192), pf, o[dt]);
        }
        const float inv = frcp(sum);
#pragma unroll
        for (int dt = 0; dt < 8; ++dt) {
            const int d4 = dt * 16 + fq * 4;
            u32x2_t ow;
            ow.x = pk2(o[dt][0] * inv * silu(bflo(gr[dt].x)), o[dt][1] * inv * silu(bfhi(gr[dt].x)));
            ow.y = pk2(o[dt][2] * inv * silu(bflo(gr[dt].y)), o[dt][3] * inv * silu(bfhi(gr[dt].y)));
            *(u32x2_t*)(y + (size_t)tok * LDY + 2048 + h * 128 + d4) = ow;
        }
    }
}

template <int CTRL> __device__ __forceinline__ float dppf(float oldv, float src) {
    return __int_as_float(__builtin_amdgcn_update_dpp(__float_as_int(oldv), __float_as_int(src), CTRL, 0xf, 0xf, false));
}
#define SCAN_STEP(SH) \
    "v_fmac_f32_dpp %4, %4, %0 " SH " row_mask:0xf bank_mask:0xf\n" \
    "v_fmac_f32_dpp %5, %5, %1 " SH " row_mask:0xf bank_mask:0xf\n" \
    "v_fmac_f32_dpp %6, %6, %2 " SH " row_mask:0xf bank_mask:0xf\n" \
    "v_fmac_f32_dpp %7, %7, %3 " SH " row_mask:0xf bank_mask:0xf\n" \
    "v_mul_f32_dpp %0, %0, %0 " SH " row_mask:0xf bank_mask:0xf\n" \
    "v_mul_f32_dpp %1, %1, %1 " SH " row_mask:0xf bank_mask:0xf\n" \
    "v_mul_f32_dpp %2, %2, %2 " SH " row_mask:0xf bank_mask:0xf\n" \
    "v_mul_f32_dpp %3, %3, %3 " SH " row_mask:0xf bank_mask:0xf\n"
template <int DIR> __device__ __forceinline__ void scan16x4(float (&A)[4], float (&B)[4]) {
    if (DIR == 0)
        asm volatile("s_nop 1\n" SCAN_STEP("row_shr:1") SCAN_STEP("row_shr:2") SCAN_STEP("row_shr:4") SCAN_STEP("row_shr:8")
                     : "+v"(A[0]), "+v"(A[1]), "+v"(A[2]), "+v"(A[3]), "+v"(B[0]), "+v"(B[1]), "+v"(B[2]), "+v"(B[3]));
    else
        asm volatile("s_nop 1\n" SCAN_STEP("row_shl:1") SCAN_STEP("row_shl:2") SCAN_STEP("row_shl:4") SCAN_STEP("row_shl:8")
                     : "+v"(A[0]), "+v"(A[1]), "+v"(A[2]), "+v"(A[3]), "+v"(B[0]), "+v"(B[1]), "+v"(B[2]), "+v"(B[3]));
}
template <int DIR> __device__ __forceinline__ void bcast4(const float (&v)[4], float (&o)[4]) {
    if (DIR == 0)
        asm volatile("s_nop 1\n"
                     "v_mov_b32_dpp %0, %4 row_newbcast:15 row_mask:0xf bank_mask:0xf\n" "v_mov_b32_dpp %1, %5 row_newbcast:15 row_mask:0xf bank_mask:0xf\n"
                     "v_mov_b32_dpp %2, %6 row_newbcast:15 row_mask:0xf bank_mask:0xf\n" "v_mov_b32_dpp %3, %7 row_newbcast:15 row_mask:0xf bank_mask:0xf\n"
                     : "=&v"(o[0]), "=&v"(o[1]), "=&v"(o[2]), "=&v"(o[3]) : "v"(v[0]), "v"(v[1]), "v"(v[2]), "v"(v[3]));
    else
        asm volatile("s_nop 1\n"
                     "v_mov_b32_dpp %0, %4 row_newbcast:0 row_mask:0xf bank_mask:0xf\n" "v_mov_b32_dpp %1, %5 row_newbcast:0 row_mask:0xf bank_mask:0xf\n"
                     "v_mov_b32_dpp %2, %6 row_newbcast:0 row_mask:0xf bank_mask:0xf\n" "v_mov_b32_dpp %3, %7 row_newbcast:0 row_mask:0xf bank_mask:0xf\n"
                     : "=&v"(o[0]), "=&v"(o[1]), "=&v"(o[2]), "=&v"(o[3]) : "v"(v[0]), "v"(v[1]), "v"(v[2]), "v"(v[3]));
}
struct LruW { bf16x8 Wa[4], Wi[4]; float ba[4], bi[4], c8[4]; };
struct LruX { bf16x8 x[2][4]; u32x2_t xr[2]; };
__device__ __forceinline__ void lru_loadw(LruW& W, const bf16_t* lruw, const float* ba_, const float* bi_, const float* lam_, int dir, int blk, int w, int ch4, int lane) {
    const int fr = lane & 15, fq = lane >> 4;
    const bf16_t* wa = lruw + ((size_t)((0 * 2 + dir) * 8 + blk) * 128 + w * 16 + fr) * 128 + fq * 8;
    const bf16_t* wi = lruw + ((size_t)((1 * 2 + dir) * 8 + blk) * 128 + w * 16 + fr) * 128 + fq * 8;
#pragma unroll
    for (int ks = 0; ks < 4; ++ks) { W.Wa[ks] = ld8(wa + ks * 32); W.Wi[ks] = ld8(wi + ks * 32); }
    const f32x4 a = *(const f32x4*)(ba_ + dir * 1024 + ch4), b = *(const f32x4*)(bi_ + dir * 1024 + ch4), l = *(const f32x4*)(lam_ + dir * 1024 + ch4);
#pragma unroll
    for (int jj = 0; jj < 4; ++jj) { W.ba[jj] = -1.4426950408889634f * a[jj]; W.bi[jj] = -1.4426950408889634f * b[jj]; W.c8[jj] = -8.0f * 1.4426950408889634f * log1pf(__expf(-l[jj])); }
}
__device__ __forceinline__ void conv_tile_to_lds(const bf16_t* z, const float* cw, const float* cb, LAS unsigned char* xl, int chunk, int blk, int T, int tid) {
    const int c = tid & 15, ch0 = blk * 128 + c * 8;
    float w[4][8], bb[8];
#pragma unroll
    for (int j = 0; j < 4; ++j) { const f32x4 a = *(const f32x4*)(cw + j * 1024 + ch0), b = *(const f32x4*)(cw + j * 1024 + ch0 + 4);
#pragma unroll
        for (int e = 0; e < 4; ++e) { w[j][e] = a[e]; w[j][4 + e] = b[e]; } }
    { const f32x4 a = *(const f32x4*)(cb + ch0), b = *(const f32x4*)(cb + ch0 + 4);
#pragma unroll
        for (int e = 0; e < 4; ++e) { bb[e] = a[e]; bb[4 + e] = b[e]; } }
    u32x4_t xin[4][4];
#pragma unroll
    for (int i = 0; i < 4; ++i) {
        const int r = (tid >> 4) + 32 * i, t = chunk * 128 + r, s = t & (T - 1);
#pragma unroll
        for (int j = 0; j < 4; ++j) {
            const int sj = s + j - 2;
            xin[i][j] = (u32x4_t){0u, 0u, 0u, 0u};
            if (sj >= 0 && sj < T) xin[i][j] = *(const u32x4_t*)(z + (size_t)(t + j - 2) * LDZ + ch0);
        }
    }
#pragma unroll
    for (int i = 0; i < 4; ++i) {
        const int r = (tid >> 4) + 32 * i;
        float acc[8];
#pragma unroll
        for (int e = 0; e < 8; ++e) acc[e] = bb[e];
#pragma unroll
        for (int j = 0; j < 4; ++j) {
            const u32x4_t xv = xin[i][j];
            acc[0] += w[j][0] * bflo(xv[0]); acc[1] += w[j][1] * bfhi(xv[0]); acc[2] += w[j][2] * bflo(xv[1]); acc[3] += w[j][3] * bfhi(xv[1]);
            acc[4] += w[j][4] * bflo(xv[2]); acc[5] += w[j][5] * bfhi(xv[2]); acc[6] += w[j][6] * bflo(xv[3]); acc[7] += w[j][7] * bfhi(xv[3]);
        }
        u32x4_t o; o.x = pk2(acc[0], acc[1]); o.y = pk2(acc[2], acc[3]); o.z = pk2(acc[4], acc[5]); o.w = pk2(acc[6], acc[7]);
        *(LAS u32x4_t*)(xl + r * 256 + ((c ^ (r & 15)) << 4)) = o;
    }
}
__device__ __forceinline__ void lru_loadx(LruX& X, const LAS unsigned char* xl, int r0, int w, int lane) {
    const int fr = lane & 15, fq = lane >> 4;
#pragma unroll
    for (int t = 0; t < 2; ++t) {
        const int r = r0 + t * 16 + fr;
        const LAS unsigned char* rp = xl + r * 256;
#pragma unroll
        for (int ks = 0; ks < 4; ++ks) X.x[t][ks] = *(const LAS bf16x8*)(rp + (((ks * 4 + fq) ^ fr) << 4));
        X.xr[t] = *(const LAS u32x2_t*)(rp + (((w * 2 + (fq >> 1)) ^ fr) << 4) + (fq & 1) * 8);
    }
}
template <int DIR, bool FINAL> __device__ __forceinline__ void lru_tile(const bf16x8 (&Xf)[4], const u32x2_t xr, const LruW& W, int lane, float (&hin)[4], float (&arun)[4], float (&hout)[4], unsigned (&lab)[4]) {
    f32x4 accR = {0.f, 0.f, 0.f, 0.f}, accI = {0.f, 0.f, 0.f, 0.f};
#pragma unroll
    for (int ks = 0; ks < 4; ++ks) { accR = mfma16(W.Wa[ks], Xf[ks], accR); accI = mfma16(W.Wi[ks], Xf[ks], accI); }
    const float xv[4] = {bflo(xr.x), bfhi(xr.x), bflo(xr.y), bfhi(xr.y)};
    const int src = (lane & 48) + (DIR == 0 ? 15 : 0);
    float A[4], B[4];
    typedef float f32x2 __attribute__((ext_vector_type(2)));
#pragma unroll
    for (int p = 0; p < 2; ++p) {
        const f32x2 ar = {accR[2 * p], accR[2 * p + 1]}, ai = {accI[2 * p], accI[2 * p + 1]};
        const f32x2 bar = {W.ba[2 * p], W.ba[2 * p + 1]}, bai = {W.bi[2 * p], W.bi[2 * p + 1]}, c8v = {W.c8[2 * p], W.c8[2 * p + 1]}, xvv = {xv[2 * p], xv[2 * p + 1]};
        const f32x2 tr = ar * (-1.4426950408889634f) + bar, ti = ai * (-1.4426950408889634f) + bai;
        f32x2 er, ei; er.x = __builtin_amdgcn_exp2f(tr.x); er.y = __builtin_amdgcn_exp2f(tr.y); ei.x = __builtin_amdgcn_exp2f(ti.x); ei.y = __builtin_amdgcn_exp2f(ti.y);
        er = er + 1.0f; ei = ei + 1.0f;
        f32x2 rg, ig; rg.x = frcp(er.x); rg.y = frcp(er.y); ig.x = frcp(ei.x); ig.y = frcp(ei.y);
        const f32x2 la = c8v * rg;
        f32x2 Av; Av.x = __builtin_amdgcn_exp2f(la.x); Av.y = __builtin_amdgcn_exp2f(la.y);
        f32x2 om = 1.0f - Av * Av;
        f32x2 sq; sq.x = __builtin_amdgcn_sqrtf(fmaxf(om.x, 0.f)); sq.y = __builtin_amdgcn_sqrtf(fmaxf(om.y, 0.f));
        const f32x2 Bv = sq * (ig * xvv);
        A[2 * p] = Av.x; A[2 * p + 1] = Av.y; B[2 * p] = Bv.x; B[2 * p + 1] = Bv.y;
        lab[2 * p] = __builtin_bit_cast(unsigned, __builtin_amdgcn_cvt_pkrtz(la.x, Bv.x));
        lab[2 * p + 1] = __builtin_bit_cast(unsigned, __builtin_amdgcn_cvt_pkrtz(la.y, Bv.y));
    }
    scan16x4<DIR>(A, B);
#pragma unroll
    for (int jj = 0; jj < 4; ++jj) hout[jj] = A[jj] * hin[jj] + B[jj];
    bcast4<DIR>(hout, hin);
    if (!FINAL) { float At[4]; bcast4<DIR>(A, At);
#pragma unroll
        for (int jj = 0; jj < 4; ++jj) arun[jj] *= At[jj]; }
}
template <bool FINAL> __device__ __forceinline__ void lru_item(const LAS unsigned char* xl, const bf16_t* z, const bf16_t* lruw, const float* ba_, const float* bi_, const float* lam_,
                                                               float* agg, const float* carry, bf16_t* y, unsigned* labuf, int item, int lane) {
    const int cgi = item & 63, chunk = item >> 6, blk = cgi >> 3, w = cgi & 7;
    const int fr = lane & 15, fq = lane >> 4;
    const int ch4 = blk * 128 + w * 16 + fq * 4;
    const int tokc = chunk * 128;
    LruX X[2]; LruW W0;
    lru_loadw(W0, lruw, ba_, bi_, lam_, 0, blk, w, ch4, lane);
    lru_loadx(X[0], xl, 0, w, lane);
    unsigned hf[8][2];
    float hin[4], arun[4];
#pragma unroll
    for (int jj = 0; jj < 4; ++jj) { hin[jj] = FINAL ? carry[(size_t)(0 * 128 + chunk) * 1024 + ch4 + jj] : 0.f; arun[jj] = 1.f; }
#pragma unroll
    for (int bi = 0; bi < 8; ++bi) {
        __builtin_amdgcn_sched_barrier(0);
        const int slot = bi < 4 ? (bi & 1) : ((bi + 1) & 1);
        const int pair = bi < 4 ? bi : 7 - bi;
        if (bi + 1 < 8 && bi + 1 != 4) {
            const int nslot = (bi + 1) < 4 ? ((bi + 1) & 1) : ((bi + 2) & 1);
            const int npair = (bi + 1) < 4 ? (bi + 1) : 7 - (bi + 1);
            lru_loadx(X[nslot], xl, npair * 32, w, lane);
        }
        if (bi == 4) {
            lru_loadw(W0, lruw, ba_, bi_, lam_, 1, blk, w, ch4, lane);
            if (!FINAL && fr == 0) {
#pragma unroll
                for (int jj = 0; jj < 4; ++jj) { float2 v; v.x = arun[jj]; v.y = hin[jj]; *(float2*)(agg + ((size_t)(0 * 128 + chunk) * 1024 + ch4 + jj) * 2) = v; }
            }
#pragma unroll
            for (int jj = 0; jj < 4; ++jj) { hin[jj] = FINAL ? carry[(size_t)(1 * 128 + chunk) * 1024 + ch4 + jj] : 0.f; arun[jj] = 1.f; }
        }
#pragma unroll
        for (int k = 0; k < 2; ++k) {
            const int t = bi < 4 ? k : 1 - k;
            const int tt = 2 * pair + t;
            float hv[4]; unsigned lab[4];
            if (bi < 4) lru_tile<0, FINAL>(X[slot].x[t], X[slot].xr[t], W0, lane, hin, arun, hv, lab);
            else lru_tile<1, FINAL>(X[slot].x[t], X[slot].xr[t], W0, lane, hin, arun, hv, lab);
            if (!FINAL) { u32x4_t lw; lw.x = lab[0]; lw.y = lab[1]; lw.z = lab[2]; lw.w = lab[3];
                *(u32x4_t*)(labuf + ((((size_t)(bi < 4 ? 0 : 1) * 128 + chunk) * 64 + cgi) * 8 + (2 * pair + t)) * 256 + lane * 4) = lw; }
            if (FINAL) {
                if (bi < 4) {
                    hf[tt][0] = pk2(hv[0], hv[1]); hf[tt][1] = pk2(hv[2], hv[3]);
                } else {
                    const int tok = tokc + tt * 16 + fr;
                    const u32x2_t gr = *(const u32x2_t*)(z + (size_t)tok * LDZ + 1024 + ch4);
                    const float gc[4] = {bflo(gr.x), bfhi(gr.x), bflo(gr.y), bfhi(gr.y)};
                    const float hfv[4] = {bflo(hf[tt][0]), bfhi(hf[tt][0]), bflo(hf[tt][1]), bfhi(hf[tt][1])};
                    float o[4];
#pragma unroll
                    for (int jj = 0; jj < 4; ++jj) o[jj] = (hfv[jj] + hv[jj]) * silu(gc[jj]);
                    u32x2_t ow; ow.x = pk2(o[0], o[1]); ow.y = pk2(o[2], o[3]);
                    *(u32x2_t*)(y + (size_t)tok * LDY + ch4) = ow;
                }
            }
        }
    }
    if (!FINAL && fr == 0) {
#pragma unroll
        for (int jj = 0; jj < 4; ++jj) { float2 v; v.x = arun[jj]; v.y = hin[jj]; *(float2*)(agg + ((size_t)(1 * 128 + chunk) * 1024 + ch4 + jj) * 2) = v; }
    }
}
struct LruF { u32x4_t L[2][8]; u32x2_t gr[8]; };
__device__ __forceinline__ void lru_final_load(LruF& F, const unsigned* labuf, const bf16_t* z, int item, int lane) {
    const int cgi = item & 63, chunk = item >> 6, fr = lane & 15, fq = lane >> 4;
    const int ch4 = cgi * 16 + fq * 4, tokc = chunk * 128;
#pragma unroll
    for (int d = 0; d < 2; ++d)
#pragma unroll
        for (int tt = 0; tt < 8; ++tt) F.L[d][tt] = *(const u32x4_t*)(labuf + ((((size_t)d * 128 + chunk) * 64 + cgi) * 8 + tt) * 256 + lane * 4);
#pragma unroll
    for (int tt = 0; tt < 8; ++tt) F.gr[tt] = *(const u32x2_t*)(z + (size_t)(tokc + tt * 16 + fr) * LDZ + 1024 + ch4);
}
template <bool WAVEC> __device__ __forceinline__ void lru_final_compute(const LruF& F, const float* carry, float hcv, bf16_t* y, int item, int lane) {
    typedef _Float16 h2_t __attribute__((ext_vector_type(2)));
    const int cgi = item & 63, chunk = item >> 6;
    const int fr = lane & 15, fq = lane >> 4;
    const int ch4 = cgi * 16 + fq * 4, tokc = chunk * 128;
    float hf[8][4];
    {
        float hin[4];
#pragma unroll
        for (int jj = 0; jj < 4; ++jj) hin[jj] = WAVEC ? __shfl(hcv, fq * 4 + jj) : carry[(size_t)(0 * 128 + chunk) * 1024 + ch4 + jj];
#pragma unroll
        for (int tt = 0; tt < 8; ++tt) {
            float A[4], B[4];
#pragma unroll
            for (int jj = 0; jj < 4; ++jj) {
                const unsigned wv = F.L[0][tt][jj]; const h2_t v = __builtin_bit_cast(h2_t, wv);
                A[jj] = __builtin_amdgcn_exp2f((float)v.x); B[jj] = (float)v.y;
            }
            scan16x4<0>(A, B);
#pragma unroll
            for (int jj = 0; jj < 4; ++jj) hf[tt][jj] = A[jj] * hin[jj] + B[jj];
            bcast4<0>(hf[tt], hin);
        }
    }
    {
        float hin[4];
#pragma unroll
        for (int jj = 0; jj < 4; ++jj) hin[jj] = WAVEC ? __shfl(hcv, 16 + fq * 4 + jj) : carry[(size_t)(1 * 128 + chunk) * 1024 + ch4 + jj];
#pragma unroll
        for (int s = 0; s < 8; ++s) {
            const int tt = 7 - s;
            float o[4], A[4], B[4];
#pragma unroll
            for (int jj = 0; jj < 4; ++jj) {
                const unsigned wv = F.L[1][tt][jj]; const h2_t v = __builtin_bit_cast(h2_t, wv);
                A[jj] = __builtin_amdgcn_exp2f((float)v.x); B[jj] = (float)v.y;
            }
            scan16x4<1>(A, B);
            float hb[4];
#pragma unroll
            for (int jj = 0; jj < 4; ++jj) { hb[jj] = A[jj] * hin[jj] + B[jj]; o[jj] = hf[tt][jj] + hb[jj]; }
            bcast4<1>(hb, hin);
            const float gc[4] = {bflo(F.gr[tt].x), bfhi(F.gr[tt].x), bflo(F.gr[tt].y), bfhi(F.gr[tt].y)};
            u32x2_t ow; ow.x = pk2(o[0] * silu(gc[0]), o[1] * silu(gc[1])); ow.y = pk2(o[2] * silu(gc[2]), o[3] * silu(gc[3]));
            *(u32x2_t*)(y + (size_t)(tokc + tt * 16 + fr) * LDY + ch4) = ow;
        }
    }
}
__device__ __forceinline__ void wave_carries(const float* agg, int cgi, int chunk0, int nseq, int lane, float (&hc)[4]) {
    const int q = lane >> 4, ch = cgi * 16 + (lane & 15);
    const bool up = (lane & 16) != 0;
    float2 ag[2][32];
#pragma unroll
    for (int dir = 0; dir < 2; ++dir)
#pragma unroll
        for (int cc = 0; cc < 32; ++cc) ag[dir][cc] = *(const float2*)(agg + ((size_t)(dir * 128 + 32 * q + cc) * 1024 + ch) * 2);
#pragma unroll
    for (int dir = 0; dir < 2; ++dir) {
        float A = 1.f, h = 0.f, Ap = 1.f, Hp = 0.f;
#pragma unroll
        for (int step = 0; step < 32; ++step) {
            const int cc = dir == 0 ? step : 31 - step;
            if (cc == chunk0) { Ap = A; Hp = h; }
            const float2 ah = ag[dir][cc];
            h = ah.x * h + ah.y; A *= ah.x;
        }
        float Aq[4], Hq[4], Apk[4], Hpk[4];
#pragma unroll
        for (int k = 0; k < 4; ++k) { const int src = k * 16 + (lane & 15); Aq[k] = __shfl(A, src); Hq[k] = __shfl(h, src); Apk[k] = __shfl(Ap, src); Hpk[k] = __shfl(Hp, src); }
        float S[4];
        if (dir == 0) { S[0] = 0.f; S[1] = Hq[0]; S[2] = Aq[1] * S[1] + Hq[1]; S[3] = Aq[2] * S[2] + Hq[2]; }
        else { S[3] = 0.f; S[2] = Hq[3]; S[1] = Aq[2] * S[2] + Hq[2]; S[0] = Aq[1] * S[1] + Hq[1]; }
#pragma unroll
        for (int k = 0; k < 4; ++k) { const float v = Apk[k] * (nseq == 1 ? S[k] : 0.f) + Hpk[k]; if (dir == 0) hc[k] = v; else hc[k] = up ? v : hc[k]; }
    }
}
__device__ __forceinline__ void carry_phase(const float* agg, float* carry, int nseq, int gtid, int gthreads) {
    const int nc = 128 / nseq;
    for (int idx = gtid; idx < 2 * nseq * 1024; idx += gthreads) {
        const int ch = idx & 1023, rest = idx >> 10, dir = rest & 1, sq = rest >> 1, base = sq * nc;
        float h = 0.f;
#pragma unroll 8
        for (int c = 0; c < nc; ++c) {
            const int C = base + (dir == 0 ? c : nc - 1 - c);
            const size_t o = (size_t)(dir * 128 + C) * 1024 + ch;
            const float2 ah = *(const float2*)(agg + o * 2);
            carry[o] = h;
            h = ah.x * h + ah.y;
        }
    }
}

__device__ __forceinline__ void sgu_item2(const bf16_t* vT, const LAS float* rstd, const LAS unsigned char* wsl, const bf16_t* z, const float* sgu_g, const float* sgu_b, bf16_t* y,
                                          int n, int g, int qd, int lane) {
    const int fr = lane & 15, fq = lane >> 4;
    const int tokc = n * 128, chq = g * 128 + qd * 32;
    bf16x8 Af[2][4];
#pragma unroll
    for (int t = 0; t < 2; ++t) {
        const bf16_t* ap = vT + (size_t)(chq + (fr >> 2) * 8 + (fr & 3) + 4 * t) * SEG + tokc + fq * 8;
#pragma unroll
        for (int ks = 0; ks < 4; ++ks) {
            const u32x4_t raw = *(const u32x4_t*)(ap + ks * 32);
            const f32x4 r0 = *(const LAS f32x4*)(rstd + ks * 32 + fq * 8), r1 = *(const LAS f32x4*)(rstd + ks * 32 + fq * 8 + 4);
            u32x4_t w;
            w.x = pk2(bflo(raw.x) * r0[0], bfhi(raw.x) * r0[1]); w.y = pk2(bflo(raw.y) * r0[2], bfhi(raw.y) * r0[3]);
            w.z = pk2(bflo(raw.z) * r1[0], bfhi(raw.z) * r1[1]); w.w = pk2(bflo(raw.w) * r1[2], bfhi(raw.w) * r1[3]);
            Af[t][ks] = __builtin_bit_cast(bf16x8, w);
        }
    }
    const int ch8 = chq + fq * 8;
    const f32x4 g0 = *(const f32x4*)(sgu_g + ch8), g1 = *(const f32x4*)(sgu_g + ch8 + 4);
    u32x4_t urv[8], grv[8]; float bsvv[8];
#pragma unroll
    for (int pt = 0; pt < 8; ++pt) { const int p = pt * 16 + fr, tok = tokc + p;
        urv[pt] = *(const u32x4_t*)(z + (size_t)tok * LDZ + 2048 + ch8); grv[pt] = *(const u32x4_t*)(z + (size_t)tok * LDZ + 3072 + ch8); bsvv[pt] = sgu_b[g * 128 + p]; }
#pragma unroll
    for (int pt = 0; pt < 8; ++pt) {
        const int p = pt * 16 + fr, tok = tokc + p;
        const u32x4_t ur = urv[pt], gr = grv[pt];
        const float bsv = bsvv[pt];
        const LAS unsigned char* bp = wsl + p * 256;
        f32x4 a0 = {0.f, 0.f, 0.f, 0.f}, a1 = {0.f, 0.f, 0.f, 0.f};
#pragma unroll
        for (int ks = 0; ks < 4; ++ks) { const bf16x8 Bf = *(const LAS bf16x8*)(bp + (((ks * 4 + fq) ^ fr) << 4)); a0 = mfma16(Af[0][ks], Bf, a0); a1 = mfma16(Af[1][ks], Bf, a1); }
        float o[8];
#pragma unroll
        for (int k = 0; k < 2; ++k) {
            o[2 * k] = bflo(ur[k]) * (a0[2 * k] * g0[2 * k] + bsv) * silu(bflo(gr[k]));
            o[2 * k + 1] = bfhi(ur[k]) * (a0[2 * k + 1] * g0[2 * k + 1] + bsv) * silu(bfhi(gr[k]));
            o[4 + 2 * k] = bflo(ur[2 + k]) * (a1[2 * k] * g1[2 * k] + bsv) * silu(bflo(gr[2 + k]));
            o[4 + 2 * k + 1] = bfhi(ur[2 + k]) * (a1[2 * k + 1] * g1[2 * k + 1] + bsv) * silu(bfhi(gr[2 + k]));
        }
        u32x4_t ow; ow.x = pk2(o[0], o[1]); ow.y = pk2(o[2], o[3]); ow.z = pk2(o[4], o[5]); ow.w = pk2(o[6], o[7]);
        *(u32x4_t*)(y + (size_t)tok * LDY + 1024 + ch8) = ow;
    }
}

__device__ __forceinline__ void sgu_item(const bf16_t* vT, const LAS float* rstd, const bf16_t* z, const bf16_t* sguw, const float* sgu_g, const float* sgu_b, bf16_t* y, int item, int lane) {
    const int dd = item & 7, g = (item >> 3) & 7, n = item >> 6;
    const int fr = lane & 15, fq = lane >> 4;
    const int tokc = n * 128;
    const bf16_t* ap = vT + (size_t)(g * 128 + dd * 16 + fr) * SEG + tokc + fq * 8;
    bf16x8 Af[4];
#pragma unroll
    for (int ks = 0; ks < 4; ++ks) {
        const u32x4_t raw = *(const u32x4_t*)(ap + ks * 32);
        const f32x4 r0 = *(const LAS f32x4*)(rstd + ks * 32 + fq * 8), r1 = *(const LAS f32x4*)(rstd + ks * 32 + fq * 8 + 4);
        u32x4_t w;
        w.x = pk2(bflo(raw.x) * r0[0], bfhi(raw.x) * r0[1]); w.y = pk2(bflo(raw.y) * r0[2], bfhi(raw.y) * r0[3]);
        w.z = pk2(bflo(raw.z) * r1[0], bfhi(raw.z) * r1[1]); w.w = pk2(bflo(raw.w) * r1[2], bfhi(raw.w) * r1[3]);
        Af[ks] = __builtin_bit_cast(bf16x8, w);
    }
    const int ch4 = g * 128 + dd * 16 + fq * 4;
    const f32x4 g4 = *(const f32x4*)(sgu_g + ch4);
#pragma unroll
    for (int pt = 0; pt < 8; ++pt) {
        const int p = pt * 16 + fr;
        const bf16_t* bp = sguw + (size_t)(g * 128 + p) * 128 + fq * 8;
        f32x4 acc = {0.f, 0.f, 0.f, 0.f};
#pragma unroll
        for (int ks = 0; ks < 4; ++ks) acc = mfma16(Af[ks], ld8(bp + ks * 32), acc);
        const int tok = tokc + p;
        const float bsv = sgu_b[g * 128 + p];
        const u32x2_t ur = *(const u32x2_t*)(z + (size_t)tok * LDZ + 2048 + ch4), gr = *(const u32x2_t*)(z + (size_t)tok * LDZ + 3072 + ch4);
        const float uu[4] = {bflo(ur.x), bfhi(ur.x), bflo(ur.y), bfhi(ur.y)}, gd[4] = {bflo(gr.x), bfhi(gr.x), bflo(gr.y), bfhi(gr.y)};
        float o[4];
#pragma unroll
        for (int jj = 0; jj < 4; ++jj) o[jj] = uu[jj] * (acc[jj] * g4[jj] + bsv) * silu(gd[jj]);
        u32x2_t ow; ow.x = pk2(o[0], o[1]); ow.y = pk2(o[2], o[3]);
        *(u32x2_t*)(y + (size_t)tok * LDY + 1024 + ch4) = ow;
    }
}

__global__ void __launch_bounds__(512, 2) fwd_megakernel(Params P) {
    extern __shared__ __attribute__((aligned(16))) unsigned char shm[];
    cg::grid_group grid = cg::this_grid();
    PG8_LAS unsigned char* lds = (PG8_LAS unsigned char*)shm;
    const int G = gridDim.x, NW = G * 8;
#define FRESH_TID() int tid = threadIdx.x; asm volatile("" : "+v"(tid)); const int lane = tid & 63, wid = tid >> 6, gw = blockIdx.x * 8 + wid; (void)lane; (void)gw
    unsigned char* ws = P.ws;
    bf16_t* WIN_E = (bf16_t*)(ws + WS_WIN_E); bf16_t* WIN_O = (bf16_t*)(ws + WS_WIN_O);
    bf16_t* WOUT_E = (bf16_t*)(ws + WS_WOUT_E); bf16_t* WOUT_O = (bf16_t*)(ws + WS_WOUT_O);
    bf16_t* WKV = (bf16_t*)(ws + WS_WKV); bf16_t* LRUW = (bf16_t*)(ws + WS_LRUW); bf16_t* SGUW = (bf16_t*)(ws + WS_SGUW);
    bf16_t* MEMN = (bf16_t*)(ws + WS_MEMN); bf16_t* MK = (bf16_t*)(ws + WS_MK); bf16_t* MVT = (bf16_t*)(ws + WS_MVT);
    bf16_t* H = (bf16_t*)(ws + WS_H); bf16_t* Z = (bf16_t*)(ws + WS_Z); bf16_t* VT = (bf16_t*)(ws + WS_VT); bf16_t* Y = (bf16_t*)(ws + WS_Y);
    float* AGG = (float*)(ws + WS_AGG); float* CARRY = (float*)(ws + WS_CARRY); float* RSTD = (float*)(ws + WS_RSTD); float* PART = (float*)(ws + WS_PART); unsigned* LAB = (unsigned*)(ws + WS_LAB);

    unsigned* BAR = (unsigned*)(ws + WS_BAR);
    volatile LAS unsigned* xst = (volatile LAS unsigned*)(lds + XST_OFF);
    {
        FRESH_TID();
        if (tid < 2) xst[tid] = 0u;
        if (blockIdx.x == 0) for (int i = tid; i < XCD_BAR_WORDS; i += 512) BAR[i] = 0u;
        LAS float* scr = (LAS float*)(lds + wid * 16384);
        constexpr int I0 = 16 * 288, I1 = 16 * 192, I2 = 40 * 32, I3 = 40 * 32, I4 = 16 * 32, I5 = 16 * 32, I6 = 16 * 8, I7 = 16 * 8;
        constexpr int NIT = I0 + I1 + I2 + I3 + I4 + I5 + I6 + I7;
#pragma unroll 1
        for (int it = gw; it < NIT; it += NW) {
            int r = it;
            if (r < I0) { transpose_item(P.in[7], 1024, 9216, WIN_E, scr, r, lane); continue; } r -= I0;
            if (r < I1) { transpose_item(P.in[12], 1024, 6144, WIN_O, scr, r, lane); continue; } r -= I1;
            if (r < I2) { transpose_item(P.in[11], 2560, 1024, WOUT_E, scr, r, lane); continue; } r -= I2;
            if (r < I3) { transpose_item(P.in[23], 2560, 1024, WOUT_O, scr, r, lane); continue; } r -= I3;
            if (r < I4) { transpose_item(P.in[6], 1024, 1024, WKV, scr, r, lane); continue; } r -= I4;
            if (r < I5) { transpose_item(P.in[6] + (size_t)1024 * 1024, 1024, 1024, WKV + (size_t)1024 * 1024, scr, r, lane); continue; } r -= I5;
            if (r < I6) { const int m = r >> 3; transpose_item(P.in[15] + (size_t)m * 16384, 128, 128, LRUW + (size_t)m * 16384, scr, r & 7, lane); continue; } r -= I6;
            { const int m = r >> 3; transpose_item(P.in[17] + (size_t)m * 16384, 128, 128, LRUW + (size_t)(16 + m) * 16384, scr, r & 7, lane); }
        }
        for (int i = blockIdx.x * 512 + tid; i < 8 * 128 * 128; i += G * 512) SGUW[i] = f2bf(P.in[21][i]);
        for (int it = gw; it < 2 * 1536; it += NW) {
            const int l = it / 1536, row = it - l * 1536;
            const float* src = row < 512 ? P.in[2] + (size_t)row * 1024 : P.in[3] + (size_t)(row - 512) * 1024;
            rms_row_bf16(src, P.in[5] + l * 1024, MEMN + ((size_t)l * 1536 + row) * 1024, lane);
        }
        for (int it = gw; it < SEG / 4; it += NW) rms_rows4_bf16(P.in[0] + (size_t)it * 4096, P.in[4], H + (size_t)it * 4096, lane);
    }

    grid.sync();
    const XcdBarrier xb = xcd_barrier_post(BAR, xst);
    for (int seg = 0; seg < 3; ++seg) {
        const float* xin = seg < 2 ? P.in[0] + (size_t)seg * SEG * 1024 : P.in[1];
        float* xout = P.out + (size_t)seg * SEG * 1024;
        const int T = seg < 2 ? 16384 : 4096, nseq = seg < 2 ? 1 : 4;

        {
            pg8::Gemm g; g.A = H; g.Bt = WIN_E; g.M = SEG; g.N = 8192; g.K = 1024; g.A1 = WIN_E + (size_t)6144 * 1024; g.Bt1 = H;
            pg8::DualOrder S; S.S0.init(SEG, 8192, G, blockIdx.x); S.S1.init(1024, SEG, G, blockIdx.x); S.skip_from = 24; S.skip_n = 4; S.G = G; S.c = blockIdx.x;
            pg8::EpiZ E; E.O = Z; E.ldc = LDZ; E.skip_from = 24; E.skip_n = 4; E.colsq = nullptr; E.colsq_ld = 0; E.O1 = VT; E.ldc1 = SEG; E.colsq1 = nullptr;
            pg8::gemm_phase(lds, g, S, E);
        }
        if (seg == 0) {
#pragma unroll 1
            for (int l = 0; l < 2; ++l) {
                {
                    pg8::Gemm g; g.A = MEMN + (size_t)l * 1536 * 1024; g.Bt = WKV + (size_t)l * 1024 * 1024; g.M = 1536; g.N = 512; g.K = 1024; g.A1 = g.A; g.Bt1 = g.Bt;
                    pg8::SkipOrder S; S.init(1536, 512, G, (blockIdx.x + G - (32 * l) % G) % G); S.skip_from = 1 << 20; S.skip_n = 0;
                    pg8::EpiZ E; E.O = MK + (size_t)l * 1536 * 512; E.ldc = 512; E.skip_from = 1 << 20; E.skip_n = 0; E.colsq = nullptr; E.colsq_ld = 0; E.O1 = E.O; E.ldc1 = 512; E.colsq1 = nullptr;
                    pg8::gemm_phase(lds, g, S, E);
                }
                {
                    pg8::Gemm g; g.A = WKV + (size_t)l * 1024 * 1024 + (size_t)512 * 1024; g.Bt = MEMN + (size_t)l * 1536 * 1024; g.M = 512; g.N = 1536; g.K = 1024; g.A1 = g.A; g.Bt1 = g.Bt;
                    pg8::SkipOrder S; S.init(512, 1536, G, (blockIdx.x + G - (32 * l + 16) % G) % G); S.skip_from = 1 << 20; S.skip_n = 0;
                    pg8::EpiZ E; E.O = MVT + (size_t)l * 512 * 1536; E.ldc = 1536; E.skip_from = 1 << 20; E.skip_n = 0; E.colsq = nullptr; E.colsq_ld = 0; E.O1 = E.O; E.ldc1 = 1536; E.colsq1 = nullptr;
                    pg8::gemm_phase(lds, g, S, E);
                }
            }
        }
        xcd_barrier(xb);

        { FRESH_TID();
        for (int u = blockIdx.x; u < 256; u += G) mem_unit(Z, 7168, 7680, MK, MVT, Y, u, seg, lds, tid);
#pragma unroll 1
        for (int u = blockIdx.x; u < 256; u += G) na_block(Z, VT, Y, P.in[10], u, T, lds, tid);
        for (int it = gw; it < 8192; it += NW) conv_even_item(Z, P.in[8], P.in[9], Y, 2 * it, T, lane);
        }
        xcd_barrier(xb);

        {
            pg8::Gemm g; g.A = Y; g.Bt = WOUT_E; g.M = SEG; g.N = 1024; g.K = 2560; g.A1 = g.A; g.Bt1 = g.Bt;
            pg8::StaticOrder S; S.init(SEG, 1024, G, blockIdx.x, 16);
            pg8::EpiRes E; E.xin = xin; E.out = xout;
            pg8::gemm_phase(lds, g, S, E);
        }
        xcd_barrier(xb);

        { FRESH_TID();
        for (int it = gw; it < SEG / 4; it += NW) rms_rows4_bf16(xout + (size_t)it * 4096, P.in[4] + 1024, H + (size_t)it * 4096, lane); }
        xcd_barrier(xb);

        {
            pg8::Gemm g; g.A = H; g.Bt = WIN_O; g.M = SEG; g.N = 5120; g.K = 1024; g.A1 = WIN_O + (size_t)3072 * 1024; g.Bt1 = H;
            pg8::DualOrder S; S.S0.init(SEG, 5120, G, blockIdx.x); S.S1.init(1024, SEG, G, blockIdx.x); S.skip_from = 12; S.skip_n = 4; S.G = G; S.c = blockIdx.x;
            pg8::EpiZ E; E.O = Z; E.ldc = LDZ; E.skip_from = 12; E.skip_n = 4; E.colsq = nullptr; E.colsq_ld = SEG; E.O1 = VT; E.ldc1 = SEG; E.colsq1 = PART;
            pg8::gemm_phase(lds, g, S, E);
        }
        xcd_barrier(xb);

        { FRESH_TID();
        for (int u = blockIdx.x; u < 256; u += G) mem_unit(Z, 4096, 4608, MK + (size_t)1536 * 512, MVT + (size_t)512 * 1536, Y, u, seg, lds, tid);
#pragma unroll 1
        for (int u0 = blockIdx.x; u0 < 1024; u0 += 4 * G) {
            __syncthreads();
#pragma unroll 1
            for (int k = 0; k < 4; ++k) { const int u = u0 + k * G; if (u < 1024) conv_tile_to_lds(Z, P.in[13], P.in[14], lds + k * 32768, u >> 3, u & 7, T, tid); }
            __syncthreads();
#pragma unroll 1
            for (int k = 0; k < 4; ++k) { const int u = u0 + k * G; if (u < 1024) lru_item<false>(lds + k * 32768, Z, LRUW, P.in[16], P.in[18], P.in[19], AGG, CARRY, Y, LAB, (u >> 3) * 64 + (u & 7) * 8 + wid, lane); }
        }
#pragma unroll 1
        for (int u0 = blockIdx.x; u0 < 1024; u0 += 2 * G) {
            __syncthreads();
            LAS float* rsL = (LAS float*)lds;
            if (tid < 256) { const int u = u0 + (tid >> 7) * G;
              if (u < 1024) { const float* pp = PART + (u >> 3) * 128 + (tid & 127); float s = 0.f;
#pragma unroll
                for (int i = 0; i < 8; ++i) s += pp[(size_t)i * SEG];
                rsL[tid] = __builtin_amdgcn_rsqf(s * (1.0f / 1024.0f) + EPS); } }
            u32x4_t wsv[2][4];
#pragma unroll
            for (int s2 = 0; s2 < 2; ++s2) { const int u = u0 + s2 * G;
              if (u < 1024) { const int g = u & 7;
#pragma unroll
                for (int i = 0; i < 4; ++i) { const int idx = tid + 512 * i, p = idx >> 4, c = idx & 15; wsv[s2][i] = *(const u32x4_t*)(SGUW + (size_t)(g * 128 + p) * 128 + c * 8); } } }
#pragma unroll
            for (int s2 = 0; s2 < 2; ++s2) { const int u = u0 + s2 * G;
              if (u < 1024) {
#pragma unroll
                for (int i = 0; i < 4; ++i) { const int idx = tid + 512 * i, p = idx >> 4, c = idx & 15; *(LAS u32x4_t*)(lds + 4096 + s2 * 32768 + p * 256 + ((c ^ (p & 15)) << 4)) = wsv[s2][i]; } } }
            __syncthreads();
            { const int s2 = wid >> 2, u = u0 + s2 * G;
              if (u < 1024) sgu_item2(VT, rsL + s2 * 128, lds + 4096 + s2 * 32768, Z, P.in[20], P.in[22], Y, u >> 3, u & 7, wid & 3, lane); }
        } }
        xcd_barrier(xb);

        if (G == 256) {
            FRESH_TID();
            float hc[4];
            LruF F[2];
            lru_final_load(F[0], LAB, Z, gw, lane);
            wave_carries(AGG, gw & 63, gw >> 6, nseq, lane, hc);
#pragma unroll
            for (int k = 0; k < 4; ++k) {
                if (k < 3) lru_final_load(F[(k + 1) & 1], LAB, Z, gw + 2048 * (k + 1), lane);
                lru_final_compute<true>(F[k & 1], CARRY, hc[k], Y, gw + 2048 * k, lane);
            }
        } else {
            { FRESH_TID(); carry_phase(AGG, CARRY, nseq, blockIdx.x * 512 + tid, G * 512); }
            xcd_barrier(xb);
            { FRESH_TID();
#pragma unroll 1
            for (int it = gw; it < 8192; it += NW) { LruF F1; lru_final_load(F1, LAB, Z, it, lane); lru_final_compute<false>(F1, CARRY, 0.f, Y, it, lane); } }
        }
        if (seg < 2) { FRESH_TID();
            const float* xnx = seg == 0 ? P.in[0] + (size_t)SEG * 1024 : P.in[1];
            for (int it = gw; it < SEG / 4; it += NW) rms_rows4_bf16(xnx + (size_t)it * 4096, P.in[4], H + (size_t)it * 4096, lane); }
        xcd_barrier(xb);

        {
            pg8::Gemm g; g.A = Y; g.Bt = WOUT_O; g.M = SEG; g.N = 1024; g.K = 2560; g.A1 = g.A; g.Bt1 = g.Bt;
            pg8::StaticOrder S; S.init(SEG, 1024, G, blockIdx.x, 16);
            pg8::EpiRes E; E.xin = xout; E.out = xout;
            pg8::gemm_phase(lds, g, S, E);
        }
        xcd_barrier(xb);

        { FRESH_TID();
        for (int it = gw; it < SEG / 4; it += NW) rms_rows4_f32(xout + (size_t)it * 4096, P.in[24], lane); }
    }
}

extern "C" void kernel_launch(void* const* d_in, const int* in_sizes, int n_in, void* d_out, int out_size, void* d_ws, size_t ws_size, hipStream_t stream) {
    static int grid_blocks = 0;
    if (grid_blocks == 0) {
        if (n_in != 25 || ws_size < WS_END) { fprintf(stderr, "kernel_launch: need 25 inputs and %zu bytes of workspace; got %d, %zu\n", (size_t)WS_END, n_in, ws_size); grid_blocks = -1; return; }
        int dev = 0, cus = 0, per_cu = 0;
        hipGetDevice(&dev);
        hipDeviceGetAttribute(&cus, hipDeviceAttributeMultiprocessorCount, dev);
        hipFuncSetAttribute((const void*)fwd_megakernel, hipFuncAttributeMaxDynamicSharedMemorySize, LDS_BYTES);
        hipOccupancyMaxActiveBlocksPerMultiprocessor(&per_cu, (const void*)fwd_megakernel, 512, LDS_BYTES);
        if (per_cu < 1) { fprintf(stderr, "kernel_launch: occupancy query says %d blocks per CU\n", per_cu); grid_blocks = -1; return; }
        grid_blocks = cus;
    }
    if (grid_blocks < 0) return;
    Params p{};
    for (int i = 0; i < 25; ++i) p.in[i] = (const float*)d_in[i];
    p.out = (float*)d_out; p.ws = (unsigned char*)d_ws;
    void* args[] = {&p};
    hipError_t e = hipLaunchCooperativeKernel((const void*)fwd_megakernel, dim3(grid_blocks), dim3(512), args, LDS_BYTES, stream);
    if (e != hipSuccess) fprintf(stderr, "cooperative launch failed: %s (grid %d)\n", hipGetErrorString(e), grid_blocks);
}
```

```cpp
#include <hip/hip_runtime.h>
#include <hip/hip_cooperative_groups.h>
#include <cstdio>
namespace cg = cooperative_groups;
namespace pg8 {
#define PG8_LAS __attribute__((address_space(3)))
typedef unsigned short bf16_t;
typedef short bf16x8 __attribute__((ext_vector_type(8)));
typedef float f32x4 __attribute__((ext_vector_type(4)));
typedef unsigned u32x4 __attribute__((ext_vector_type(4)));
constexpr int BM = 256, BK = 64, HALF = 128, HTB = HALF * BK * 2  , STAGE_BYTES = 8 * HTB, NXCD = 8, WGM = 4;

__host__ __device__ __forceinline__ int lds_byte(int r, int c) { const int st = (r >> 4) * 2 + (c >> 5), rr = r & 15, cc = c & 31, ob = rr * 64 + cc * 2; return st * 1024 + (ob ^ (((ob >> 9) & 1) << 5)); }
__host__ __device__ __forceinline__ void stage_rc(int b, int& R, int& C) { const int st = b / 1024, sb = b % 1024, swz = sb ^ (((sb >> 9) & 1) << 5); R = (st >> 1) * 16 + swz / 64; C = (st & 1) * 32 + (swz % 64) / 2; }
__host__ __device__ __forceinline__ int perm32(int rho) { const int n = rho >> 4, i = rho & 15; return 8 * (i >> 2) + 4 * n + (i & 3); }

struct Unit { int pm, pn, sel; };
struct Gemm { const bf16_t* A; const bf16_t* Bt; int M, N, K; const bf16_t* A1; const bf16_t* Bt1; };

struct StaticOrder {
    int nM, nN, nwg, G, c, wgm;
    __host__ __device__ void init(int M, int N, int G_, int c_, int wgm_ = 4) { nM = M / BM; nN = N / BM; nwg = nM * nN; G = G_; c = c_; wgm = wgm_; }
    __host__ __device__ void map(int wgid, Unit& u) const {
        { const int q = nwg / NXCD, r = nwg % NXCD, xcd = wgid % NXCD, off = wgid / NXCD; wgid = (xcd < r ? xcd * (q + 1) : r * (q + 1) + (xcd - r) * q) + off; }
        const int nig = wgm * nN, gid = wgid / nig, fm = gid * wgm, gsz = (nM - fm) < wgm ? (nM - fm) : wgm;
        u.pm = fm + ((wgid % nig) % gsz); u.pn = (wgid % nig) / gsz; u.sel = 0;
    }
    __host__ __device__ bool next(int i, Unit& u) const {
        const long L = (long)i * G + c; if (L >= nwg) return false;
        map((int)L, u); return true;
    }
    __device__ __forceinline__ void a_ready(const Unit&) const {}
    __device__ __forceinline__ void done(const Unit&) const {}
};

struct SkipOrder : StaticOrder {
    int skip_from, skip_n;
    __device__ __forceinline__ bool next(int i, Unit& u) const {
        if (!StaticOrder::next(i, u)) return false;
        if (u.pn >= skip_from) u.pn += skip_n;
        return true;
    }
};
struct DualOrder {
    StaticOrder S0, S1; int skip_from, skip_n, G, c;
    __device__ __forceinline__ bool next(int i, Unit& u) const {
        const long L = (long)i * G + c;
        if (L < S0.nwg) { S0.map((int)L, u); if (u.pn >= skip_from) u.pn += skip_n; return true; }
        if (L - S0.nwg < S1.nwg) { S1.map((int)(L - S0.nwg), u); u.sel = 1; return true; }
        return false;
    }
    __device__ __forceinline__ void a_ready(const Unit&) const {}
    __device__ __forceinline__ void done(const Unit&) const {}
};

__device__ __forceinline__ unsigned cvt_pk_bf16(float lo, float hi) { unsigned r; asm volatile("v_cvt_pk_bf16_f32 %0, %1, %2" : "=v"(r) : "v"(lo), "v"(hi)); return r; }

struct EpiZ {
    static constexpr bool PERM = true, AFTER_DRAIN = false;
    bf16_t* O; int ldc; int skip_from, skip_n; float* colsq; int colsq_ld; bf16_t* O1; int ldc1; float* colsq1;
    __device__ __forceinline__ void operator()(const f32x4 (&acc)[2][2][4][2], const Unit& u, int wr, int wc, int fr, int fq) const {
        const int row0 = u.pm * BM + wr * 64 + fr; const int ct = u.sel ? u.pn : ((u.pn >= skip_from + skip_n) ? (u.pn - skip_n) : u.pn);
        const int col0 = ct * BM + wc * 32 + 8 * fq;
        bf16_t* const O = u.sel ? this->O1 : this->O; const int ldc = u.sel ? this->ldc1 : this->ldc; float* const colsq = u.sel ? this->colsq1 : this->colsq;
#pragma unroll
        for (int ai = 0; ai < 2; ++ai)
#pragma unroll
            for (int m = 0; m < 4; ++m) { bf16_t* rowp = O + (size_t)(row0 + ai * HALF + m * 16) * ldc + col0;
#pragma unroll
                for (int bj = 0; bj < 2; ++bj) { const f32x4 v0 = acc[ai][bj][m][0], v1 = acc[ai][bj][m][1];
                    u32x4 w; w.x = cvt_pk_bf16(v0[0], v0[1]); w.y = cvt_pk_bf16(v0[2], v0[3]); w.z = cvt_pk_bf16(v1[0], v1[1]); w.w = cvt_pk_bf16(v1[2], v1[3]);
                    *(u32x4*)(rowp + bj * HALF) = w; } }
        if (colsq) {
#pragma unroll
            for (int bj = 0; bj < 2; ++bj)
#pragma unroll
                for (int n = 0; n < 2; ++n) {
                    f32x4 ss = {0.f, 0.f, 0.f, 0.f};
#pragma unroll
                    for (int ai = 0; ai < 2; ++ai)
#pragma unroll
                        for (int m = 0; m < 4; ++m) ss += acc[ai][bj][m][n] * acc[ai][bj][m][n];
#pragma unroll
                    for (int o = 1; o < 16; o <<= 1) { ss[0] += __shfl_xor(ss[0], o); ss[1] += __shfl_xor(ss[1], o); ss[2] += __shfl_xor(ss[2], o); ss[3] += __shfl_xor(ss[3], o); }
                    if (fr == 0) *(f32x4*)(colsq + (size_t)(2 * u.pm + wr) * colsq_ld + ct * BM + bj * HALF + wc * 32 + 8 * fq + 4 * n) = ss;
                }
        }
    }
};
struct EpiRes {
    static constexpr bool PERM = false, AFTER_DRAIN = false;
    const float* xin; float* out;
    __device__ __forceinline__ void operator()(const f32x4 (&acc)[2][2][4][2], const Unit& u, int wr, int wc, int fr, int fq) const {
        const int row0 = u.pm * BM + wr * 64 + fr, col0 = u.pn * BM + wc * 32 + 4 * fq;
#pragma unroll
        for (int ai = 0; ai < 2; ++ai)
#pragma unroll
            for (int m = 0; m < 4; ++m) { const size_t ro = (size_t)(row0 + ai * HALF + m * 16) * 1024 + col0;
#pragma unroll
                for (int bj = 0; bj < 2; ++bj)
#pragma unroll
                    for (int n = 0; n < 2; ++n) { const f32x4 xv = *(const f32x4*)(xin + ro + bj * HALF + n * 16);
                        *(f32x4*)(out + ro + bj * HALF + n * 16) = acc[ai][bj][m][n] + xv; } }
    }
};

template <class Epi, class Sched>
__device__ __forceinline__ void gemm_phase(PG8_LAS unsigned char* lds, const Gemm g, const Sched& S, const Epi& E) {
    int tid = threadIdx.x; asm volatile("" : "+v"(tid));
    const int wid = __builtin_amdgcn_readfirstlane(tid >> 6), lane = tid & 63, wr = wid >> 2, wc = wid & 3, fr = lane & 15, fq = lane >> 4;
    const int K = g.K, nt = K / BK;
    const char* gA = (const char*)g.A; const char* gB = (const char*)g.Bt; const char* gA1 = (const char*)g.A1; const char* gB1 = (const char*)g.Bt1; asm volatile("" : "+s"(gA), "+s"(gB), "+s"(gA1), "+s"(gB1));
    unsigned voffA[2], voffB[2];
#pragma unroll
    for (int i = 0; i < 2; ++i) { int R, C; stage_rc(tid * 16 + i * 8192, R, C); const int Rb = Epi::PERM ? ((R & ~31) + perm32(R & 31)) : R;
        voffA[i] = (unsigned)(R * K + C) * 2u; voffB[i] = (unsigned)(Rb * K + C) * 2u; }
    const size_t kstep = (size_t)(BK * 2);
    const size_t hstep = (size_t)HALF * K * 2;
    const size_t tstep = 2 * hstep;
    const unsigned ldsw = (unsigned)wid * 1024u;
    const int aoff = lds_byte(wr * 64 + fr, fq * 8), boff = lds_byte(wc * 32 + fr, fq * 8);
#define PG8_SA(b, h) (((b) * 2 + (h)) * HTB)
#define PG8_SB(b, h) ((4 + (b) * 2 + (h)) * HTB)
#define PG8_STAGE(bufoff, gbase, voff) do { _Pragma("unroll") for (int _i = 0; _i < 2; ++_i) \
        __builtin_amdgcn_global_load_lds((const unsigned*)((const char*)(gbase) + (voff)[_i]), (PG8_LAS unsigned*)(lds + (bufoff) + ldsw + _i * 8192), 16, 0, 0); } while (0)
#define PG8_LDA(dst, b, h) do { _Pragma("unroll") for (int m = 0; m < 4; ++m) _Pragma("unroll") for (int k = 0; k < 2; ++k) dst[m][k] = *(const PG8_LAS bf16x8*)(lds + PG8_SA(b, h) + aoff + m * 2048 + k * 1024); } while (0)
#define PG8_LDB(dst, b, h) do { _Pragma("unroll") for (int n = 0; n < 2; ++n) _Pragma("unroll") for (int k = 0; k < 2; ++k) dst[n][k] = *(const PG8_LAS bf16x8*)(lds + PG8_SB(b, h) + boff + n * 2048 + k * 1024); } while (0)
#define PG8_MMA(ai, bj, At, Bt) do { __builtin_amdgcn_s_setprio(1); _Pragma("unroll") for (int m = 0; m < 4; ++m) _Pragma("unroll") for (int n = 0; n < 2; ++n) _Pragma("unroll") for (int k = 0; k < 2; ++k) \
        acc[ai][bj][m][n] = __builtin_amdgcn_mfma_f32_16x16x32_bf16(Bt[n][k], At[m][k], acc[ai][bj][m][n], 0, 0, 0); __builtin_amdgcn_s_setprio(0); } while (0)
#define PG8_WAIT_V(n) asm volatile("s_waitcnt vmcnt(" #n ")" ::: "memory")
#define PG8_WAIT_L(n) asm volatile("s_waitcnt lgkmcnt(" #n ")" ::: "memory")
#define PG8_BAR __builtin_amdgcn_s_barrier()
#define PG8_SCHED __builtin_amdgcn_sched_barrier(0)
    Unit cur, nxt; int ui = 0;
    if (!S.next(0, cur)) return;
    f32x4 acc[2][2][4][2];
#pragma unroll
    for (int a = 0; a < 2; ++a)
#pragma unroll
        for (int b = 0; b < 2; ++b)
#pragma unroll
            for (int m = 0; m < 4; ++m)
#pragma unroll
                for (int n = 0; n < 2; ++n) acc[a][b][m][n] = (f32x4){0.f, 0.f, 0.f, 0.f};
    bf16x8 At[4][2], B0[2][2], B1[2][2];
    const char* cA = (cur.sel ? gA1 : gA) + (size_t)cur.pm * tstep; const char* cB = (cur.sel ? gB1 : gB) + (size_t)cur.pn * tstep;
    S.a_ready(cur);
    PG8_STAGE(PG8_SB(0, 0), cB, voffB); PG8_STAGE(PG8_SA(0, 0), cA, voffA); PG8_STAGE(PG8_SB(0, 1), cB + hstep, voffB); PG8_STAGE(PG8_SA(0, 1), cA + hstep, voffA);
    if (wr == 1) PG8_BAR;
    PG8_WAIT_V(4); PG8_BAR;
    PG8_STAGE(PG8_SB(1, 0), cB + kstep, voffB); PG8_STAGE(PG8_SA(1, 0), cA + kstep, voffA); PG8_STAGE(PG8_SB(1, 1), cB + hstep + kstep, voffB);
    PG8_WAIT_V(6); PG8_BAR;
    for (;;) {
        const bool has_next = S.next(ui + 1, nxt);
        const char* nA = has_next ? (nxt.sel ? gA1 : gA) + (size_t)nxt.pm * tstep : cA; const char* nB = has_next ? (nxt.sel ? gB1 : gB) + (size_t)nxt.pn * tstep : cB;
        for (int t = 0; t < nt; t += 2) {
            const bool last = (t == nt - 2);
            const char* a1 = cA + (size_t)(t + 1) * kstep;
            const char* a2 = last ? nA : cA + (size_t)(t + 2) * kstep; const char* b2 = last ? nB : cB + (size_t)(t + 2) * kstep;
            const char* a3 = a2 + kstep; const char* b3 = b2 + kstep;
            if (last && has_next) S.a_ready(nxt);
            PG8_LDB(B0, 0, 0); PG8_SCHED; PG8_LDA(At, 0, 0); PG8_STAGE(PG8_SA(1, 1), a1 + hstep, voffA);
            PG8_WAIT_L(8); PG8_BAR; PG8_WAIT_L(0); PG8_MMA(0, 0, At, B0); PG8_BAR; PG8_SCHED;
            PG8_LDB(B1, 0, 1); PG8_STAGE(PG8_SB(0, 0), b2, voffB);
            PG8_BAR; PG8_WAIT_L(0); PG8_MMA(0, 1, At, B1); PG8_BAR;
            PG8_LDA(At, 0, 1); PG8_STAGE(PG8_SA(0, 0), a2, voffA);
            PG8_BAR; PG8_WAIT_L(0); PG8_MMA(1, 0, At, B0); PG8_BAR; PG8_SCHED;
            PG8_STAGE(PG8_SB(0, 1), b2 + hstep, voffB);
            PG8_WAIT_V(6); PG8_BAR; PG8_MMA(1, 1, At, B1); PG8_BAR;
            PG8_LDB(B0, 1, 0); PG8_SCHED; PG8_LDA(At, 1, 0); PG8_STAGE(PG8_SA(0, 1), a2 + hstep, voffA);
            PG8_WAIT_L(8); PG8_BAR; PG8_WAIT_L(0); PG8_MMA(0, 0, At, B0); PG8_BAR; PG8_SCHED;
            PG8_LDB(B1, 1, 1); PG8_STAGE(PG8_SB(1, 0), b3, voffB);
            PG8_BAR; PG8_WAIT_L(0); PG8_MMA(0, 1, At, B1); PG8_BAR;
            PG8_LDA(At, 1, 1); PG8_STAGE(PG8_SA(1, 0), a3, voffA);
            PG8_BAR; PG8_WAIT_L(0); PG8_MMA(1, 0, At, B0); PG8_BAR; PG8_SCHED;
            PG8_STAGE(PG8_SB(1, 1), b3 + hstep, voffB);
            PG8_WAIT_V(6); PG8_BAR; PG8_MMA(1, 1, At, B1); PG8_BAR;
        }
        if constexpr (!Epi::AFTER_DRAIN) { E(acc, cur, wr, wc, fr, fq); S.done(cur); }
        if (!has_next) break;
#pragma unroll
        for (int a = 0; a < 2; ++a)
#pragma unroll
            for (int b = 0; b < 2; ++b)
#pragma unroll
                for (int m = 0; m < 4; ++m)
#pragma unroll
                    for (int n = 0; n < 2; ++n) acc[a][b][m][n] = (f32x4){0.f, 0.f, 0.f, 0.f};
        cur = nxt; cA = nA; cB = nB; ++ui;
    }
    PG8_WAIT_V(0);
    if (wr == 0) PG8_BAR;
    PG8_BAR;
    if constexpr (Epi::AFTER_DRAIN) { E.fused(acc, cur, wr, wc, fr, fq, lds, wid, lane); S.done(cur); }
#undef PG8_SA
#undef PG8_SB
#undef PG8_STAGE
#undef PG8_LDA
#undef PG8_LDB
#undef PG8_MMA
#undef PG8_WAIT_V
#undef PG8_WAIT_L
#undef PG8_BAR
#undef PG8_SCHED
}
}

#define XB_TMO      128
#define XB_XCNT(j)  (256  + 64 * (j))
#define XB_XSUB(j)  (1280 + 64 * (j))
#define XB_XGEN(j)  (2304 + 64 * (j))
#define XB_TOP      3328
#define XB_TOPGEN   3392
#define XCD_BAR_WORDS 3456
#define XB_SPIN_CAP (1u << 18)
#define LAS __attribute__((address_space(3)))

__device__ __forceinline__ unsigned xb_ld(unsigned* p)              { return __hip_atomic_load(p, __ATOMIC_RELAXED, __HIP_MEMORY_SCOPE_AGENT); }
__device__ __forceinline__ unsigned xb_add(unsigned* p, unsigned v) { return __hip_atomic_fetch_add(p, v, __ATOMIC_RELAXED, __HIP_MEMORY_SCOPE_AGENT); }
__device__ __forceinline__ unsigned xb_xcc_id() { return (unsigned)__builtin_amdgcn_s_getreg((3 << 11) | 20) & 0xFu; }
#define XB_SPIN(cond, bar) do { unsigned _sp = 0; while (cond) { __builtin_amdgcn_s_sleep(1); \
    if ((++_sp & 255u) == 0u) { if (xb_ld(&(bar)[XB_TMO])) break; if (_sp > XB_SPIN_CAP) { atomicAdd(&(bar)[XB_TMO], 1u); break; } } } } while (0)

struct XcdBarrier {
    unsigned* bar; unsigned x;
    volatile LAS unsigned* st;
};

__device__ __forceinline__ XcdBarrier xcd_barrier_post(unsigned* bar, volatile LAS unsigned* st) {
    XcdBarrier b; b.bar = bar; b.x = xb_xcc_id(); b.st = st;
    if (threadIdx.x == 0) (void)xb_add(&bar[XB_XCNT(b.x)], 1u);
    return b;
}
__device__ __forceinline__ void xcd_barrier_complete(unsigned* bar, unsigned x, unsigned& nloc, unsigned& nx) {
    const unsigned G = gridDim.x * gridDim.y * gridDim.z;
    unsigned sum, cnt, mine, sp = 0u;
    for (;;) {
        sum = 0u; cnt = 0u; mine = 0u;
#pragma unroll
        for (unsigned j = 0; j < 16; ++j) { const unsigned c = xb_ld(&bar[XB_XCNT(j)]); sum += c; cnt += (c > 0u) ? 1u : 0u; mine = (j == x) ? c : mine; }
        if (sum == G) break;
        __builtin_amdgcn_s_sleep(1);
        if ((++sp & 255u) == 0u) { if (xb_ld(&bar[XB_TMO])) break; if (sp > XB_SPIN_CAP) { atomicAdd(&bar[XB_TMO], 1u); break; } }
    }
    nloc = mine > 0u ? mine : 1u; nx = cnt > 0u ? cnt : 1u;
}

__device__ __forceinline__ void xcd_barrier(const XcdBarrier& b) {
    asm volatile("s_waitcnt vmcnt(0)" ::: "memory");
    __syncthreads();
    if (threadIdx.x == 0) {
        unsigned* bar = b.bar;
        __builtin_amdgcn_s_waitcnt(0);
        unsigned nloc = b.st[0], nx = b.st[1];
        if (nloc == 0u) { xcd_barrier_complete(bar, b.x, nloc, nx); b.st[0] = nloc; b.st[1] = nx; }
        const unsigned old = xb_add(&bar[XB_XSUB(b.x)], 1u);
        const unsigned gen = old / nloc;
        if (old + 1u == (gen + 1u) * nloc) {
            __builtin_amdgcn_fence(__ATOMIC_RELEASE, "agent");
            asm volatile("s_waitcnt vmcnt(0)" ::: "memory");
            const unsigned og = xb_add(&bar[XB_TOP], 1u);
            const unsigned tg = og / nx;
            if (og + 1u == (tg + 1u) * nx) xb_add(&bar[XB_TOPGEN], 1u);
            else XB_SPIN(xb_ld(&bar[XB_TOPGEN]) == tg, bar);
            __builtin_amdgcn_fence(__ATOMIC_ACQUIRE, "agent");
            xb_add(&bar[XB_XGEN(b.x)], 1u);
            asm volatile("s_waitcnt vmcnt(0)" ::: "memory");
        } else {
            XB_SPIN(xb_ld(&bar[XB_XGEN(b.x)]) == gen, bar);
            __builtin_amdgcn_fence(__ATOMIC_ACQUIRE, "agent");
            asm volatile("s_waitcnt vmcnt(0)" ::: "memory");
        }
    }
    __syncthreads();
}

using pg8::bf16_t; using pg8::bf16x8; using pg8::f32x4;
typedef unsigned u32x2_t __attribute__((ext_vector_type(2)));
typedef unsigned u32x4_t __attribute__((ext_vector_type(4)));

constexpr int DM = 1024, SEG = 16384, LDZ = 8192, LDY = 2560;
constexpr float EPS = 1e-6f;
constexpr int XST_OFF = 9 * 16384 + 2048;
constexpr int LDS_BYTES = XST_OFF + 64;
constexpr size_t WS_WIN_E = 0;
constexpr size_t WS_WIN_O = WS_WIN_E + (size_t)9216 * 1024 * 2;
constexpr size_t WS_WOUT_E = WS_WIN_O + (size_t)6144 * 1024 * 2;
constexpr size_t WS_WOUT_O = WS_WOUT_E + (size_t)1024 * 2560 * 2;
constexpr size_t WS_WKV = WS_WOUT_O + (size_t)1024 * 2560 * 2;
constexpr size_t WS_LRUW = WS_WKV + (size_t)2 * 1024 * 1024 * 2;
constexpr size_t WS_SGUW = WS_LRUW + (size_t)2 * 2 * 8 * 128 * 128 * 2;
constexpr size_t WS_MEMN = WS_SGUW + (size_t)8 * 128 * 128 * 2;
constexpr size_t WS_MK = WS_MEMN + (size_t)2 * 1536 * 1024 * 2;
constexpr size_t WS_MVT = WS_MK + (size_t)2 * 1536 * 512 * 2;
constexpr size_t WS_H = WS_MVT + (size_t)2 * 512 * 1536 * 2;
constexpr size_t WS_Z = WS_H + (size_t)SEG * 1024 * 2;
constexpr size_t WS_VT = WS_Z + (size_t)SEG * LDZ * 2;
constexpr size_t WS_Y = WS_VT + (size_t)1024 * SEG * 2;
constexpr size_t WS_AGG = WS_Y + (size_t)SEG * LDY * 2;
constexpr size_t WS_CARRY = WS_AGG + (size_t)2 * 128 * 1024 * 2 * 4;
constexpr size_t WS_RSTD = WS_CARRY + (size_t)2 * 128 * 1024 * 4;
constexpr size_t WS_PART = WS_RSTD + (size_t)SEG * 4;
constexpr size_t WS_BAR = WS_PART + (size_t)8 * SEG * 4;
constexpr size_t WS_LAB = WS_BAR + 16384;
constexpr size_t WS_END = WS_LAB + (size_t)2 * SEG * 1024 * 4;

struct Params { const float* in[25]; float* out; unsigned char* ws; };

__device__ __forceinline__ float bf2f(unsigned short b) { return __uint_as_float(((unsigned)b) << 16); }
__device__ __forceinline__ unsigned short f2bf(float f) { unsigned u = __float_as_uint(f); u += 0x7FFFu + ((u >> 16) & 1u); return (unsigned short)(u >> 16); }
__device__ __forceinline__ float bflo(unsigned w) { return __uint_as_float(w << 16); }
__device__ __forceinline__ float bfhi(unsigned w) { return __uint_as_float(w & 0xffff0000u); }
__device__ __forceinline__ unsigned pk2(float lo, float hi) { return pg8::cvt_pk_bf16(lo, hi); }
__device__ __forceinline__ float frcp(float x) { return __builtin_amdgcn_rcpf(x); }
__device__ __forceinline__ float silu(float x) { return x * frcp(1.0f + __expf(-x)); }
__device__ __forceinline__ float sigm(float x) { return frcp(1.0f + __expf(-x)); }
__device__ __forceinline__ float wave_sum(float v) {
#pragma unroll
    for (int o = 1; o < 64; o <<= 1) v += __shfl_xor(v, o);
    return v;
}
__device__ __forceinline__ f32x4 mfma16(bf16x8 a, bf16x8 b, f32x4 c) { return __builtin_amdgcn_mfma_f32_16x16x32_bf16(a, b, c, 0, 0, 0); }
__device__ __forceinline__ bf16x8 ld8(const bf16_t* p) { return *(const bf16x8*)p; }
__device__ __forceinline__ bf16x8 pack8(const float (&v)[8]) {
    u32x4_t w; w.x = pk2(v[0], v[1]); w.y = pk2(v[2], v[3]); w.z = pk2(v[4], v[5]); w.w = pk2(v[6], v[7]);
    return __builtin_bit_cast(bf16x8, w);
}

__device__ __forceinline__ void transpose_item(const float* W, int K, int N, bf16_t* WT, LAS float* scr, int item, int lane) {
    const int nblk = N >> 5, kb = item / nblk, nb = item - kb * nblk, k0 = 64 * kb, n0 = 32 * nb;
#pragma unroll 8
    for (int i = 0; i < 32; ++i) { const int kk = 2 * i + (lane >> 5); scr[kk * 33 + (lane & 31)] = W[(size_t)(k0 + kk) * N + n0 + (lane & 31)]; }
    asm volatile("s_waitcnt lgkmcnt(0)" ::: "memory");
    const int c = lane & 7;
#pragma unroll
    for (int j = 0; j < 4; ++j) { const int n = (lane >> 3) + 8 * j; const LAS float* s = scr + (8 * c) * 33 + n;
        u32x4_t o; o.x = pk2(s[0 * 33], s[1 * 33]); o.y = pk2(s[2 * 33], s[3 * 33]); o.z = pk2(s[4 * 33], s[5 * 33]); o.w = pk2(s[6 * 33], s[7 * 33]);
        *(u32x4_t*)(WT + (size_t)(n0 + n) * K + k0 + 8 * c) = o; }
    asm volatile("s_waitcnt lgkmcnt(0)" ::: "memory");
}

__device__ __forceinline__ void rms_row_bf16(const float* xrow, const float* g, bf16_t* orow, int lane) {
    const f32x4* xr = (const f32x4*)xrow + lane; f32x4 v[4]; float s = 0.f;
#pragma unroll
    for (int j = 0; j < 4; ++j) { v[j] = xr[64 * j]; s += (v[j].x * v[j].x + v[j].y * v[j].y) + (v[j].z * v[j].z + v[j].w * v[j].w); }
    const float rstd = __builtin_amdgcn_rsqf(wave_sum(s) * (1.0f / 1024.0f) + EPS);
    const f32x4* gr = (const f32x4*)g + lane; u32x2_t* o8 = (u32x2_t*)orow + lane;
#pragma unroll
    for (int j = 0; j < 4; ++j) { const f32x4 gg = gr[64 * j]; u32x2_t o; o.x = pk2(v[j].x * rstd * gg.x, v[j].y * rstd * gg.y); o.y = pk2(v[j].z * rstd * gg.z, v[j].w * rstd * gg.w); o8[64 * j] = o; }
}
__device__ __forceinline__ void rms_row_f32(float* xrow, const float* g, int lane) {
    f32x4* xr = (f32x4*)xrow + lane; f32x4 v[4]; float s = 0.f;
#pragma unroll
    for (int j = 0; j < 4; ++j) { v[j] = xr[64 * j]; s += (v[j].x * v[j].x + v[j].y * v[j].y) + (v[j].z * v[j].z + v[j].w * v[j].w); }
    const float rstd = __builtin_amdgcn_rsqf(wave_sum(s) * (1.0f / 1024.0f) + EPS);
    const f32x4* gr = (const f32x4*)g + lane;
#pragma unroll
    for (int j = 0; j < 4; ++j) { const f32x4 gg = gr[64 * j]; f32x4 o; o.x = v[j].x * rstd * gg.x; o.y = v[j].y * rstd * gg.y; o.z = v[j].z * rstd * gg.z; o.w = v[j].w * rstd * gg.w; xr[64 * j] = o; }
}

__device__ __forceinline__ void rms_rows4_bf16(const float* xrow, const float* g, bf16_t* orow, int lane) {
    f32x4 v[4][4]; float s[4];
#pragma unroll
    for (int r = 0; r < 4; ++r)
#pragma unroll
        for (int j = 0; j < 4; ++j) v[r][j] = ((const f32x4*)(xrow + (size_t)r * 1024))[lane + 64 * j];
    f32x4 gg[4];
#pragma unroll
    for (int j = 0; j < 4; ++j) gg[j] = ((const f32x4*)g)[lane + 64 * j];
#pragma unroll
    for (int r = 0; r < 4; ++r) { s[r] = 0.f;
#pragma unroll
        for (int j = 0; j < 4; ++j) s[r] += (v[r][j].x * v[r][j].x + v[r][j].y * v[r][j].y) + (v[r][j].z * v[r][j].z + v[r][j].w * v[r][j].w); }
#pragma unroll
    for (int o = 1; o < 64; o <<= 1) {
#pragma unroll
        for (int r = 0; r < 4; ++r) s[r] += __shfl_xor(s[r], o); }
#pragma unroll
    for (int r = 0; r < 4; ++r) { const float rstd = __builtin_amdgcn_rsqf(s[r] * (1.0f / 1024.0f) + EPS);
        u32x2_t* o8 = (u32x2_t*)(orow + (size_t)r * 1024) + lane;
#pragma unroll
        for (int j = 0; j < 4; ++j) { u32x2_t o; o.x = pk2(v[r][j].x * rstd * gg[j].x, v[r][j].y * rstd * gg[j].y); o.y = pk2(v[r][j].z * rstd * gg[j].z, v[r][j].w * rstd * gg[j].w); o8[64 * j] = o; } }
}
__device__ __forceinline__ void rms_rows4_f32(float* xrow, const float* g, int lane) {
    f32x4 v[4][4]; float s[4];
#pragma unroll
    for (int r = 0; r < 4; ++r)
#pragma unroll
        for (int j = 0; j < 4; ++j) v[r][j] = ((const f32x4*)(xrow + (size_t)r * 1024))[lane + 64 * j];
    f32x4 gg[4];
#pragma unroll
    for (int j = 0; j < 4; ++j) gg[j] = ((const f32x4*)g)[lane + 64 * j];
#pragma unroll
    for (int r = 0; r < 4; ++r) { s[r] = 0.f;
#pragma unroll
        for (int j = 0; j < 4; ++j) s[r] += (v[r][j].x * v[r][j].x + v[r][j].y * v[r][j].y) + (v[r][j].z * v[r][j].z + v[r][j].w * v[r][j].w); }
#pragma unroll
    for (int o = 1; o < 64; o <<= 1) {
#pragma unroll
        for (int r = 0; r < 4; ++r) s[r] += __shfl_xor(s[r], o); }
#pragma unroll
    for (int r = 0; r < 4; ++r) { const float rstd = __builtin_amdgcn_rsqf(s[r] * (1.0f / 1024.0f) + EPS);
        f32x4* xo = (f32x4*)(xrow + (size_t)r * 1024) + lane;
#pragma unroll
        for (int j = 0; j < 4; ++j) { f32x4 o; o.x = v[r][j].x * rstd * gg[j].x; o.y = v[r][j].y * rstd * gg[j].y; o.z = v[r][j].z * rstd * gg[j].z; o.w = v[r][j].w * rstd * gg[j].w; __builtin_nontemporal_store(o, &xo[64 * j]); } }
}

__device__ __forceinline__ void conv_even_item(const bf16_t* z, const float* cw, const float* cb, bf16_t* y, int t0, int T, int lane) {
    const int s = t0 & (T - 1);
#pragma unroll
    for (int half = 0; half < 2; ++half) {
        const int c0 = half * 512 + lane * 8;
        const bf16_t* zr = z + (size_t)t0 * LDZ + c0;
        u32x4_t cg[4], xv[4], bg[2], ga[2];
#pragma unroll
        for (int i = 0; i < 4; ++i) { cg[i] = (u32x4_t){0u, 0u, 0u, 0u}; xv[i] = (u32x4_t){0u, 0u, 0u, 0u}; }
        if (s > 0) { cg[0] = *(const u32x4_t*)(zr - LDZ + 1024); xv[0] = *(const u32x4_t*)(zr - LDZ + 2048); }
        cg[1] = *(const u32x4_t*)(zr + 1024); xv[1] = *(const u32x4_t*)(zr + 2048);
        cg[2] = *(const u32x4_t*)(zr + LDZ + 1024); xv[2] = *(const u32x4_t*)(zr + LDZ + 2048);
        if (s + 2 < T) { cg[3] = *(const u32x4_t*)(zr + 2 * LDZ + 1024); xv[3] = *(const u32x4_t*)(zr + 2 * LDZ + 2048); }
        bg[0] = *(const u32x4_t*)(zr); ga[0] = *(const u32x4_t*)(zr + 3072);
        bg[1] = *(const u32x4_t*)(zr + LDZ); ga[1] = *(const u32x4_t*)(zr + LDZ + 3072);
        float w0[8], w1[8], w2[8], bb[8];
#pragma unroll
        for (int e = 0; e < 8; e += 4) {
            const f32x4 a = *(const f32x4*)(cw + c0 + e), b = *(const f32x4*)(cw + 1024 + c0 + e), c = *(const f32x4*)(cw + 2048 + c0 + e), d = *(const f32x4*)(cb + c0 + e);
#pragma unroll
            for (int k = 0; k < 4; ++k) { w0[e + k] = a[k]; w1[e + k] = b[k]; w2[e + k] = c[k]; bb[e + k] = d[k]; }
        }
        float p[4][8];
#pragma unroll
        for (int i = 0; i < 4; ++i)
#pragma unroll
            for (int k = 0; k < 4; ++k) { p[i][2 * k] = bflo(cg[i][k]) * bflo(xv[i][k]); p[i][2 * k + 1] = bfhi(cg[i][k]) * bfhi(xv[i][k]); }
#pragma unroll
        for (int tt = 0; tt < 2; ++tt) {
            float o[8];
#pragma unroll
            for (int k = 0; k < 4; ++k) {
                const float cl = bb[2 * k] + w0[2 * k] * p[tt][2 * k] + w1[2 * k] * p[tt + 1][2 * k] + w2[2 * k] * p[tt + 2][2 * k];
                const float ch = bb[2 * k + 1] + w0[2 * k + 1] * p[tt][2 * k + 1] + w1[2 * k + 1] * p[tt + 1][2 * k + 1] + w2[2 * k + 1] * p[tt + 2][2 * k + 1];
                o[2 * k] = bflo(bg[tt][k]) * cl * silu(bflo(ga[tt][k]));
                o[2 * k + 1] = bfhi(bg[tt][k]) * ch * silu(bfhi(ga[tt][k]));
            }
            u32x4_t w; w.x = pk2(o[0], o[1]); w.y = pk2(o[2], o[3]); w.z = pk2(o[4], o[5]); w.w = pk2(o[6], o[7]);
            *(u32x4_t*)(y + (size_t)(t0 + tt) * LDY + c0) = w;
        }
    }
}

__device__ __forceinline__ void conv_odd_item(const bf16_t* z, const float* cw, const float* cb, bf16_t* xc, int t, int T, int lane) {
    const int s = t & (T - 1);
#pragma unroll
    for (int half = 0; half < 2; ++half) {
        const int c0 = half * 512 + lane * 8;
        const bf16_t* zr = z + (size_t)t * LDZ + c0;
        float acc[8];
#pragma unroll
        for (int e = 0; e < 8; e += 4) { const f32x4 d = *(const f32x4*)(cb + c0 + e); acc[e] = d[0]; acc[e + 1] = d[1]; acc[e + 2] = d[2]; acc[e + 3] = d[3]; }
#pragma unroll
        for (int j = 0; j < 4; ++j) {
            const int sj = s + j - 2;
            if (sj >= 0 && sj < T) {
                const u32x4_t xv = *(const u32x4_t*)(zr + (ptrdiff_t)(j - 2) * LDZ);
                const f32x4 wa = *(const f32x4*)(cw + j * 1024 + c0), wb = *(const f32x4*)(cw + j * 1024 + c0 + 4);
                acc[0] += wa[0] * bflo(xv[0]); acc[1] += wa[1] * bfhi(xv[0]); acc[2] += wa[2] * bflo(xv[1]); acc[3] += wa[3] * bfhi(xv[1]);
                acc[4] += wb[0] * bflo(xv[2]); acc[5] += wb[1] * bfhi(xv[2]); acc[6] += wb[2] * bflo(xv[3]); acc[7] += wb[3] * bfhi(xv[3]);
            }
        }
        u32x4_t w; w.x = pk2(acc[0], acc[1]); w.y = pk2(acc[2], acc[3]); w.z = pk2(acc[4], acc[5]); w.w = pk2(acc[6], acc[7]);
        *(u32x4_t*)(xc + (size_t)t * 1024 + c0) = w;
    }
}
__device__ __forceinline__ void rstd_item(const float* part, float* rstd, int tg, int lane) {
    const float* p = part + tg * 64 + lane; float s = 0.f;
#pragma unroll
    for (int i = 0; i < 8; ++i) s += p[(size_t)i * SEG];
    rstd[tg * 64 + lane] = __builtin_amdgcn_rsqf(s * (1.0f / 1024.0f) + EPS);
}

constexpr int NA_RING = 9 * 16384, NA_RPB = NA_RING, NA_LDS_END = NA_RING + 2048;
__device__ __forceinline__ int na_fk(int key) { return ((key >> 1) & 1) | (((key >> 3) & 3) << 1); }
__device__ __forceinline__ void na_stage_row(const bf16_t* z, const bf16_t* vT, LAS unsigned char* slot, int tokr, int h, int lt, int nth) {
    for (int idx = lt; idx < 512; idx += nth) {
        const int rw = idx >> 3, c = idx & 7;
        const u32x4_t kv = *(const u32x4_t*)(z + (size_t)(tokr + rw) * LDZ + 5120 + h * 64 + c * 8);
        const u32x4_t vv = *(const u32x4_t*)(vT + (size_t)(h * 64 + rw) * SEG + tokr + c * 8);
        *(LAS u32x4_t*)(slot + rw * 128 + ((c ^ na_fk(rw)) << 4)) = kv;
        *(LAS u32x4_t*)(slot + 8192 + rw * 128 + ((c ^ ((rw >> 1) & 7)) << 4)) = vv;
    }
}
__device__ __forceinline__ void na_block(const bf16_t* z, const bf16_t* vT, bf16_t* y, const float* rpb, int unit, int T, LAS unsigned char* lds, int tid) {
    const int h = unit & 15, R0 = (unit >> 4) * 16;
    const int rows = T >> 6, seq = R0 / rows, rr0 = R0 - seq * rows, seq_base = seq * T;
    const int lane = tid & 63, wid = tid >> 6, fr = lane & 15, fq = lane >> 4;
    LAS float* rpbL = (LAS float*)(lds + NA_RPB);
    __syncthreads();
    for (int i = tid; i < 465; i += 512) rpbL[i] = rpb[h * 465 + i];
    int rs0 = rr0 - 4; rs0 = rs0 < 0 ? 0 : rs0; rs0 = rs0 > rows - 8 ? rows - 8 : rs0;
    {
        const int rw = tid >> 3, c = tid & 7;
        u32x4_t kv[8], vv[8];
#pragma unroll
        for (int kr = 0; kr < 8; ++kr) { const int tokr = seq_base + (rs0 + kr) * 64;
            kv[kr] = *(const u32x4_t*)(z + (size_t)(tokr + rw) * LDZ + 5120 + h * 64 + c * 8);
            vv[kr] = *(const u32x4_t*)(vT + (size_t)(h * 64 + rw) * SEG + tokr + c * 8); }
#pragma unroll
        for (int kr = 0; kr < 8; ++kr) { LAS unsigned char* slot = lds + ((rs0 + kr) % 9) * 16384;
            *(LAS u32x4_t*)(slot + rw * 128 + ((c ^ na_fk(rw)) << 4)) = kv[kr];
            *(LAS u32x4_t*)(slot + 8192 + rw * 128 + ((c ^ ((rw >> 1) & 7)) << 4)) = vv[kr]; }
    }
    __syncthreads();
    const int g = wid & 3;
    const int wb = (g == 0) ? 0 : (g == 1) ? 8 : (g == 2) ? 24 : 32;
    const int keyA = wb + (fr >> 2) * 8 + (fr & 3);
    const int offK0 = keyA * 128 + (((0 + fq) ^ na_fk(keyA)) << 4), offK1 = keyA * 128 + (((4 + fq) ^ na_fk(keyA)) << 4);
    const int offV = 8192 + fr * 128 + ((((wb >> 3) + fq) ^ ((fr >> 1) & 7)) << 4);
    const int qc = g * 16 + fr;
    int cstart = qc - 8; cstart = cstart < 0 ? 0 : cstart; cstart = cstart > 48 ? 48 : cstart;
    int dcs[8]; bool oks[8];
#pragma unroll
    for (int e = 0; e < 8; ++e) { const int kc = wb + fq * 8 + e; oks[e] = (kc >= cstart) && (kc < cstart + 16); int dc = kc - qc; dc = dc < -15 ? -15 : dc; dc = dc > 15 ? 15 : dc; dcs[e] = dc + 15; }
    const bf16_t* zt = z + (size_t)(seq_base + rr0 * 64 + g * 16 + fr) * LDZ;
    bf16x8 q0 = ld8(zt + 4096 + h * 64 + fq * 8), q1 = ld8(zt + 4096 + h * 64 + fq * 8 + 32);
    u32x2_t gr[4];
#pragma unroll
    for (int dt = 0; dt < 4; ++dt) gr[dt] = *(const u32x2_t*)(zt + 6144 + h * 64 + dt * 16 + fq * 4);
#pragma unroll 1
    for (int i = 0; i < 16; ++i) {
        const int rr = rr0 + i;
        int rs = rr - 4; rs = rs < 0 ? 0 : rs; rs = rs > rows - 8 ? rows - 8 : rs;
        int rsn = rr - 3; rsn = rsn < 0 ? 0 : rsn; rsn = rsn > rows - 8 ? rows - 8 : rsn;
        if (wid >= 4) {
            if (i < 15 && rsn > rs) { const int a = rsn + 7, tokr = seq_base + a * 64, lt = tid - 256; LAS unsigned char* slot = lds + (a % 9) * 16384;
                u32x4_t kv[2], vv[2];
#pragma unroll
                for (int j = 0; j < 2; ++j) { const int idx = lt + 256 * j, rw = idx >> 3, c = idx & 7;
                    kv[j] = *(const u32x4_t*)(z + (size_t)(tokr + rw) * LDZ + 5120 + h * 64 + c * 8); vv[j] = *(const u32x4_t*)(vT + (size_t)(h * 64 + rw) * SEG + tokr + c * 8); }
#pragma unroll
                for (int j = 0; j < 2; ++j) { const int idx = lt + 256 * j, rw = idx >> 3, c = idx & 7;
                    *(LAS u32x4_t*)(slot + rw * 128 + ((c ^ na_fk(rw)) << 4)) = kv[j]; *(LAS u32x4_t*)(slot + 8192 + rw * 128 + ((c ^ ((rw >> 1) & 7)) << 4)) = vv[j]; } }
        } else {
            const bf16_t* ztc = zt + (size_t)i * 64 * LDZ;
            bf16x8 q0n = q0, q1n = q1; u32x2_t grn[4];
#pragma unroll
            for (int dt = 0; dt < 4; ++dt) grn[dt] = gr[dt];
            if (i < 15) {
                const bf16_t* ztn = ztc + (size_t)64 * LDZ;
                q0n = ld8(ztn + 4096 + h * 64 + fq * 8); q1n = ld8(ztn + 4096 + h * 64 + fq * 8 + 32);
#pragma unroll
                for (int dt = 0; dt < 4; ++dt) grn[dt] = *(const u32x2_t*)(ztn + 6144 + h * 64 + dt * 16 + fq * 4);
            }
            const LAS float* bp0 = rpbL + (rs - rr + 7) * 31;
            float s[8][8];
            float mx = -1e30f;
            int slot = rs % 9;
#pragma unroll
            for (int kr = 0; kr < 8; ++kr) {
                const LAS unsigned char* sb = lds + slot * 16384;
                slot = (slot == 8) ? 0 : slot + 1;
                const bf16x8 k00 = *(const LAS bf16x8*)(sb + offK0), k01 = *(const LAS bf16x8*)(sb + offK1);
                const bf16x8 k10 = *(const LAS bf16x8*)(sb + offK0 + 512), k11 = *(const LAS bf16x8*)(sb + offK1 + 512);
                f32x4 a0 = {0.f, 0.f, 0.f, 0.f}, a1 = {0.f, 0.f, 0.f, 0.f};
                a0 = mfma16(k00, q0, a0); a0 = mfma16(k01, q1, a0);
                a1 = mfma16(k10, q0, a1); a1 = mfma16(k11, q1, a1);
#pragma unroll
                for (int e = 0; e < 8; ++e) {
                    const float sc = (e < 4 ? a0[e & 3] : a1[e & 3]) * 0.125f + bp0[kr * 31 + dcs[e]];
                    s[kr][e] = oks[e] ? sc : -1e30f;
                    mx = fmaxf(mx, s[kr][e]);
                }
            }
            mx = fmaxf(mx, __shfl_xor(mx, 16)); mx = fmaxf(mx, __shfl_xor(mx, 32));
            float sum = 0.f;
#pragma unroll
            for (int kr = 0; kr < 8; ++kr)
#pragma unroll
                for (int e = 0; e < 8; ++e) { const float p = __expf(s[kr][e] - mx); s[kr][e] = p; sum += p; }
            sum += __shfl_xor(sum, 16); sum += __shfl_xor(sum, 32);
            f32x4 o[4];
#pragma unroll
            for (int dt = 0; dt < 4; ++dt) o[dt] = (f32x4){0.f, 0.f, 0.f, 0.f};
            slot = rs % 9;
#pragma unroll
            for (int kr = 0; kr < 8; ++kr) {
                const LAS unsigned char* sb = lds + slot * 16384 + offV;
                slot = (slot == 8) ? 0 : slot + 1;
                const bf16x8 pf = pack8(s[kr]);
#pragma unroll
                for (int dt = 0; dt < 4; ++dt) o[dt] = mfma16(*(const LAS bf16x8*)(sb + dt * 2048), pf, o[dt]);
            }
            const float inv = frcp(sum);
            bf16_t* yt = y + (size_t)(seq_base + rr * 64 + g * 16 + fr) * LDY + 1024 + h * 64;
#pragma unroll
            for (int dt = 0; dt < 4; ++dt) {
                u32x2_t ow;
                ow.x = pk2(o[dt][0] * inv * silu(bflo(gr[dt].x)), o[dt][1] * inv * silu(bfhi(gr[dt].x)));
                ow.y = pk2(o[dt][2] * inv * silu(bflo(gr[dt].y)), o[dt][3] * inv * silu(bfhi(gr[dt].y)));
                *(u32x2_t*)(yt + dt * 16 + fq * 4) = ow;
            }
            q0 = q0n; q1 = q1n;
#pragma unroll
            for (int dt = 0; dt < 4; ++dt) gr[dt] = grn[dt];
        }
        __syncthreads();
    }
}

__device__ __forceinline__ void mem_unit(const bf16_t* z, int qcol, int gcol, const bf16_t* mk, const bf16_t* mvT, bf16_t* y, int unit, int seg, LAS unsigned char* lds, int tid) {
    const int h = unit & 3, range = unit >> 2, tokr = range * 256;
    const int mb = seg < 2 ? seg : 2 + (tokr >> 12);
    const int lane = tid & 63, wid = tid >> 6, fr = lane & 15, fq = lane >> 4;
    __syncthreads();
    {
        u32x4_t kv[8], vv[8];
#pragma unroll
        for (int i = 0; i < 8; ++i) { const int idx = tid + 512 * i;
            kv[i] = *(const u32x4_t*)(mk + (size_t)(mb * 256 + (idx >> 4)) * 512 + h * 128 + (idx & 15) * 8);
            vv[i] = *(const u32x4_t*)(mvT + (size_t)(h * 128 + (idx >> 5)) * 1536 + mb * 256 + (idx & 31) * 8); }
#pragma unroll
        for (int i = 0; i < 8; ++i) { const int idx = tid + 512 * i;
            { const int rho = idx >> 4, c = idx & 15, f = (rho & 3) | (((rho >> 3) & 3) << 2); *(LAS u32x4_t*)(lds + rho * 256 + ((c ^ f) << 4)) = kv[i]; }
            { const int d = idx >> 5, c = idx & 31; *(LAS u32x4_t*)(lds + 65536 + d * 512 + ((c ^ (d & 15)) << 4)) = vv[i]; } }
    }
    __syncthreads();
    const int mrowA = (fr >> 2) * 8 + (fr & 3);
    const LAS unsigned char* kbase = lds + mrowA * 256 + ((fq ^ (fr & 3)) << 4);
    const LAS unsigned char* vbase = lds + 65536 + fr * 512 + ((fq ^ (fr & 3)) << 4);
    const int hi = fr >> 2;
#pragma unroll 1
    for (int gi = 0; gi < 2; ++gi) {
        const int tok = tokr + (wid + 8 * gi) * 16 + fr;
        const bf16_t* qp = z + (size_t)tok * LDZ + qcol + h * 128 + fq * 8;
        bf16x8 q[4];
#pragma unroll
        for (int ks = 0; ks < 4; ++ks) q[ks] = ld8(qp + ks * 32);
        u32x2_t gr[8];
#pragma unroll
        for (int dt = 0; dt < 8; ++dt) gr[dt] = *(const u32x2_t*)(z + (size_t)tok * LDZ + gcol + h * 128 + dt * 16 + fq * 4);
        float s[8][8];
        float mx = -1e30f;
#pragma unroll
        for (int kb = 0; kb < 8; ++kb) {
            f32x4 a0 = {0.f, 0.f, 0.f, 0.f}, a1 = {0.f, 0.f, 0.f, 0.f};
#pragma unroll
            for (int ks = 0; ks < 4; ++ks) {
                const LAS unsigned char* kp = kbase + kb * 8192 + ((ks ^ hi) << 6);
                a0 = mfma16(*(const LAS bf16x8*)kp, q[ks], a0); a1 = mfma16(*(const LAS bf16x8*)(kp + 1024), q[ks], a1);
            }
#pragma unroll
            for (int e = 0; e < 8; ++e) { s[kb][e] = (e < 4 ? a0[e & 3] : a1[e & 3]) * 0.08838834764831845f; mx = fmaxf(mx, s[kb][e]); }
        }
        mx = fmaxf(mx, __shfl_xor(mx, 16)); mx = fmaxf(mx, __shfl_xor(mx, 32));
        float sum = 0.f;
#pragma unroll
        for (int kb = 0; kb < 8; ++kb)
#pragma unroll
            for (int e = 0; e < 8; ++e) { const float p = __expf(s[kb][e] - mx); s[kb][e] = p; sum += p; }
        sum += __shfl_xor(sum, 16); sum += __shfl_xor(sum, 32);
        f32x4 o[8];
#pragma unroll
        for (int dt = 0; dt < 8; ++dt) o[dt] = (f32x4){0.f, 0.f, 0.f, 0.f};
#pragma unroll
        for (int kb = 0; kb < 8; ++kb) {
            const bf16x8 pf = pack8(s[kb]);
            const LAS unsigned char* vp = vbase + (((kb ^ hi) & 7) << 6);
#pragma unroll
            for (int dt = 0; dt < 8; ++dt) o[dt] = mfma16(*(const LAS bf16x8*)(vp + dt * 8192), pf, o[dt]);
        }
        const float inv = frcp(sum);
#pragma unroll
        for (int dt = 0; dt < 8; ++dt) {
            const int d4 = dt * 16 + fq * 4;
            u32x2_t ow;
            ow.x = pk2(o[dt][0] * inv * silu(bflo(gr[dt].x)), o[dt][1] * inv * silu(bfhi(gr[dt].x)));
            ow.y = pk2(o[dt][2] * inv * silu(bflo(gr[dt].y)), o[dt][3] * inv * silu(bfhi(gr[dt].y)));
            *(u32x2_t*)(y + (size_t)tok * LDY + 2048 + h * 128 + d4) = ow;
        }
    }
}

template <int CTRL> __device__ __forceinline__ float dppf(float oldv, float src) {
    return __int_as_float(__builtin_amdgcn_update_dpp(__float_as_int(oldv), __float_as_int(src), CTRL, 0xf, 0xf, false));
}
#define SCAN_STEP(SH) \
    "v_fmac_f32_dpp %4, %4, %0 " SH " row_mask:0xf bank_mask:0xf\n" \
    "v_fmac_f32_dpp %5, %5, %1 " SH " row_mask:0xf bank_mask:0xf\n" \
    "v_fmac_f32_dpp %6, %6, %2 " SH " row_mask:0xf bank_mask:0xf\n" \
    "v_fmac_f32_dpp %7, %7, %3 " SH " row_mask:0xf bank_mask:0xf\n" \
    "v_mul_f32_dpp %0, %0, %0 " SH " row_mask:0xf bank_mask:0xf\n" \
    "v_mul_f32_dpp %1, %1, %1 " SH " row_mask:0xf bank_mask:0xf\n" \
    "v_mul_f32_dpp %2, %2, %2 " SH " row_mask:0xf bank_mask:0xf\n" \
    "v_mul_f32_dpp %3, %3, %3 " SH " row_mask:0xf bank_mask:0xf\n"
template <int DIR> __device__ __forceinline__ void scan16x4(float (&A)[4], float (&B)[4]) {
    if (DIR == 0)
        asm volatile("s_nop 1\n" SCAN_STEP("row_shr:1") SCAN_STEP("row_shr:2") SCAN_STEP("row_shr:4") SCAN_STEP("row_shr:8")
                     : "+v"(A[0]), "+v"(A[1]), "+v"(A[2]), "+v"(A[3]), "+v"(B[0]), "+v"(B[1]), "+v"(B[2]), "+v"(B[3]));
    else
        asm volatile("s_nop 1\n" SCAN_STEP("row_shl:1") SCAN_STEP("row_shl:2") SCAN_STEP("row_shl:4") SCAN_STEP("row_shl:8")
                     : "+v"(A[0]), "+v"(A[1]), "+v"(A[2]), "+v"(A[3]), "+v"(B[0]), "+v"(B[1]), "+v"(B[2]), "+v"(B[3]));
}
template <int DIR> __device__ __forceinline__ void bcast4(const float (&v)[4], float (&o)[4]) {
    if (DIR == 0)
        asm volatile("s_nop 1\n"
                     "v_mov_b32_dpp %0, %4 row_newbcast:15 row_mask:0xf bank_mask:0xf\n" "v_mov_b32_dpp %1, %5 row_newbcast:15 row_mask:0xf bank_mask:0xf\n"
                     "v_mov_b32_dpp %2, %6 row_newbcast:15 row_mask:0xf bank_mask:0xf\n" "v_mov_b32_dpp %3, %7 row_newbcast:15 row_mask:0xf bank_mask:0xf\n"
                     : "=&v"(o[0]), "=&v"(o[1]), "=&v"(o[2]), "=&v"(o[3]) : "v"(v[0]), "v"(v[1]), "v"(v[2]), "v"(v[3]));
    else
        asm volatile("s_nop 1\n"
                     "v_mov_b32_dpp %0, %4 row_newbcast:0 row_mask:0xf bank_mask:0xf\n" "v_mov_b32_dpp %1, %5 row_newbcast:0 row_mask:0xf bank_mask:0xf\n"
                     "v_mov_b32_dpp %2, %6 row_newbcast:0 row_mask:0xf bank_mask:0xf\n" "v_mov_b32_dpp %3, %7 row_newbcast:0 row_mask:0xf bank_mask:0xf\n"
                     : "=&v"(o[0]), "=&v"(o[1]), "=&v"(o[2]), "=&v"(o[3]) : "v"(v[0]), "v"(v[1]), "v"(v[2]), "v"(v[3]));
}
struct LruW { bf16x8 Wa[4], Wi[4]; float ba[4], bi[4], c8[4]; };
struct LruX { bf16x8 x[2][4]; u32x2_t xr[2]; };
__device__ __forceinline__ void lru_loadw(LruW& W, const bf16_t* lruw, const float* ba_, const float* bi_, const float* lam_, int dir, int blk, int w, int ch4, int lane) {
    const int fr = lane & 15, fq = lane >> 4;
    const bf16_t* wa = lruw + ((size_t)((0 * 2 + dir) * 8 + blk) * 128 + w * 16 + fr) * 128 + fq * 8;
    const bf16_t* wi = lruw + ((size_t)((1 * 2 + dir) * 8 + blk) * 128 + w * 16 + fr) * 128 + fq * 8;
#pragma unroll
    for (int ks = 0; ks < 4; ++ks) { W.Wa[ks] = ld8(wa + ks * 32); W.Wi[ks] = ld8(wi + ks * 32); }
    const f32x4 a = *(const f32x4*)(ba_ + dir * 1024 + ch4), b = *(const f32x4*)(bi_ + dir * 1024 + ch4), l = *(const f32x4*)(lam_ + dir * 1024 + ch4);
#pragma unroll
    for (int jj = 0; jj < 4; ++jj) { W.ba[jj] = -1.4426950408889634f * a[jj]; W.bi[jj] = -1.4426950408889634f * b[jj]; W.c8[jj] = -8.0f * 1.4426950408889634f * log1pf(__expf(-l[jj])); }
}
__device__ __forceinline__ void conv_tile_to_lds(const bf16_t* z, const float* cw, const float* cb, LAS unsigned char* xl, int chunk, int blk, int T, int tid) {
    const int c = tid & 15, ch0 = blk * 128 + c * 8;
    float w[4][8], bb[8];
#pragma unroll
    for (int j = 0; j < 4; ++j) { const f32x4 a = *(const f32x4*)(cw + j * 1024 + ch0), b = *(const f32x4*)(cw + j * 1024 + ch0 + 4);
#pragma unroll
        for (int e = 0; e < 4; ++e) { w[j][e] = a[e]; w[j][4 + e] = b[e]; } }
    { const f32x4 a = *(const f32x4*)(cb + ch0), b = *(const f32x4*)(cb + ch0 + 4);
#pragma unroll
        for (int e = 0; e < 4; ++e) { bb[e] = a[e]; bb[4 + e] = b[e]; } }
    u32x4_t xin[4][4];
#pragma unroll
    for (int i = 0; i < 4; ++i) {
        const int r = (tid >> 4) + 32 * i, t = chunk * 128 + r, s = t & (T - 1);
#pragma unroll
        for (int j = 0; j < 4; ++j) {
            const int sj = s + j - 2;
            xin[i][j] = (u32x4_t){0u, 0u, 0u, 0u};
            if (sj >= 0 && sj < T) xin[i][j] = *(const u32x4_t*)(z + (size_t)(t + j - 2) * LDZ + ch0);
        }
    }
#pragma unroll
    for (int i = 0; i < 4; ++i) {
        const int r = (tid >> 4) + 32 * i;
        float acc[8];
#pragma unroll
        for (int e = 0; e < 8; ++e) acc[e] = bb[e];
#pragma unroll
        for (int j = 0; j < 4; ++j) {
            const u32x4_t xv = xin[i][j];
            acc[0] += w[j][0] * bflo(xv[0]); acc[1] += w[j][1] * bfhi(xv[0]); acc[2] += w[j][2] * bflo(xv[1]); acc[3] += w[j][3] * bfhi(xv[1]);
            acc[4] += w[j][4] * bflo(xv[2]); acc[5] += w[j][5] * bfhi(xv[2]); acc[6] += w[j][6] * bflo(xv[3]); acc[7] += w[j][7] * bfhi(xv[3]);
        }
        u32x4_t o; o.x = pk2(acc[0], acc[1]); o.y = pk2(acc[2], acc[3]); o.z = pk2(acc[4], acc[5]); o.w = pk2(acc[6], acc[7]);
        *(LAS u32x4_t*)(xl + r * 256 + ((c ^ (r & 15)) << 4)) = o;
    }
}
__device__ __forceinline__ void lru_loadx(LruX& X, const LAS unsigned char* xl, int r0, int w, int lane) {
    const int fr = lane & 15, fq = lane >> 4;
#pragma unroll
    for (int t = 0; t < 2; ++t) {
        const int r = r0 + t * 16 + fr;
        const LAS unsigned char* rp = xl + r * 256;
#pragma unroll
        for (int ks = 0; ks < 4; ++ks) X.x[t][ks] = *(const LAS bf16x8*)(rp + (((ks * 4 + fq) ^ fr) << 4));
        X.xr[t] = *(const LAS u32x2_t*)(rp + (((w * 2 + (fq >> 1)) ^ fr) << 4) + (fq & 1) * 8);
    }
}
template <int DIR, bool FINAL> __device__ __forceinline__ void lru_tile(const bf16x8 (&Xf)[4], const u32x2_t xr, const LruW& W, int lane, float (&hin)[4], float (&arun)[4], float (&hout)[4], unsigned (&lab)[4]) {
    f32x4 accR = {0.f, 0.f, 0.f, 0.f}, accI = {0.f, 0.f, 0.f, 0.f};
#pragma unroll
    for (int ks = 0; ks < 4; ++ks) { accR = mfma16(W.Wa[ks], Xf[ks], accR); accI = mfma16(W.Wi[ks], Xf[ks], accI); }
    const float xv[4] = {bflo(xr.x), bfhi(xr.x), bflo(xr.y), bfhi(xr.y)};
    const int src = (lane & 48) + (DIR == 0 ? 15 : 0);
    float A[4], B[4];
    typedef float f32x2 __attribute__((ext_vector_type(2)));
#pragma unroll
    for (int p = 0; p < 2; ++p) {
        const f32x2 ar = {accR[2 * p], accR[2 * p + 1]}, ai = {accI[2 * p], accI[2 * p + 1]};
        const f32x2 bar = {W.ba[2 * p], W.ba[2 * p + 1]}, bai = {W.bi[2 * p], W.bi[2 * p + 1]}, c8v = {W.c8[2 * p], W.c8[2 * p + 1]}, xvv = {xv[2 * p], xv[2 * p + 1]};
        const f32x2 tr = ar * (-1.4426950408889634f) + bar, ti = ai * (-1.4426950408889634f) + bai;
        f32x2 er, ei; er.x = __builtin_amdgcn_exp2f(tr.x); er.y = __builtin_amdgcn_exp2f(tr.y); ei.x = __builtin_amdgcn_exp2f(ti.x); ei.y = __builtin_amdgcn_exp2f(ti.y);
        er = er + 1.0f; ei = ei + 1.0f;
        f32x2 rg, ig; rg.x = frcp(er.x); rg.y = frcp(er.y); ig.x = frcp(ei.x); ig.y = frcp(ei.y);
        const f32x2 la = c8v * rg;
        f32x2 Av; Av.x = __builtin_amdgcn_exp2f(la.x); Av.y = __builtin_amdgcn_exp2f(la.y);
        f32x2 om = 1.0f - Av * Av;
        f32x2 sq; sq.x = __builtin_amdgcn_sqrtf(fmaxf(om.x, 0.f)); sq.y = __builtin_amdgcn_sqrtf(fmaxf(om.y, 0.f));
        const f32x2 Bv = sq * (ig * xvv);
        A[2 * p] = Av.x; A[2 * p + 1] = Av.y; B[2 * p] = Bv.x; B[2 * p + 1] = Bv.y;
        lab[2 * p] = __builtin_bit_cast(unsigned, __builtin_amdgcn_cvt_pkrtz(la.x, Bv.x));
        lab[2 * p + 1] = __builtin_bit_cast(unsigned, __builtin_amdgcn_cvt_pkrtz(la.y, Bv.y));
    }
    scan16x4<DIR>(A, B);
#pragma unroll
    for (int jj = 0; jj < 4; ++jj) hout[jj] = A[jj] * hin[jj] + B[jj];
    bcast4<DIR>(hout, hin);
    if (!FINAL) { float At[4]; bcast4<DIR>(A, At);
#pragma unroll
        for (int jj = 0; jj < 4; ++jj) arun[jj] *= At[jj]; }
}
template <bool FINAL> __device__ __forceinline__ void lru_item(const LAS unsigned char* xl, const bf16_t* z, const bf16_t* lruw, const float* ba_, const float* bi_, const float* lam_,
                                                               float* agg, const float* carry, bf16_t* y, unsigned* labuf, int item, int lane) {
    const int cgi = item & 63, chunk = item >> 6, blk = cgi >> 3, w = cgi & 7;
    const int fr = lane & 15, fq = lane >> 4;
    const int ch4 = blk * 128 + w * 16 + fq * 4;
    const int tokc = chunk * 128;
    LruX X[2]; LruW W0;
    lru_loadw(W0, lruw, ba_, bi_, lam_, 0, blk, w, ch4, lane);
    lru_loadx(X[0], xl, 0, w, lane);
    unsigned hf[8][2];
    float hin[4], arun[4];
#pragma unroll
    for (int jj = 0; jj < 4; ++jj) { hin[jj] = FINAL ? carry[(size_t)(0 * 128 + chunk) * 1024 + ch4 + jj] : 0.f; arun[jj] = 1.f; }
#pragma unroll
    for (int bi = 0; bi < 8; ++bi) {
        __builtin_amdgcn_sched_barrier(0);
        const int slot = bi < 4 ? (bi & 1) : ((bi + 1) & 1);
        const int pair = bi < 4 ? bi : 7 - bi;
        if (bi + 1 < 8 && bi + 1 != 4) {
            const int nslot = (bi + 1) < 4 ? ((bi + 1) & 1) : ((bi + 2) & 1);
            const int npair = (bi + 1) < 4 ? (bi + 1) : 7 - (bi + 1);
            lru_loadx(X[nslot], xl, npair * 32, w, lane);
        }
        if (bi == 4) {
            lru_loadw(W0, lruw, ba_, bi_, lam_, 1, blk, w, ch4, lane);
            if (!FINAL && fr == 0) {
#pragma unroll
                for (int jj = 0; jj < 4; ++jj) { float2 v; v.x = arun[jj]; v.y = hin[jj]; *(float2*)(agg + ((size_t)(0 * 128 + chunk) * 1024 + ch4 + jj) * 2) = v; }
            }
#pragma unroll
            for (int jj = 0; jj < 4; ++jj) { hin[jj] = FINAL ? carry[(size_t)(1 * 128 + chunk) * 1024 + ch4 + jj] : 0.f; arun[jj] = 1.f; }
        }
#pragma unroll
        for (int k = 0; k < 2; ++k) {
            const int t = bi < 4 ? k : 1 - k;
            const int tt = 2 * pair + t;
            float hv[4]; unsigned lab[4];
            if (bi < 4) lru_tile<0, FINAL>(X[slot].x[t], X[slot].xr[t], W0, lane, hin, arun, hv, lab);
            else lru_tile<1, FINAL>(X[slot].x[t], X[slot].xr[t], W0, lane, hin, arun, hv, lab);
            if (!FINAL) { u32x4_t lw; lw.x = lab[0]; lw.y = lab[1]; lw.z = lab[2]; lw.w = lab[3];
                *(u32x4_t*)(labuf + ((((size_t)(bi < 4 ? 0 : 1) * 128 + chunk) * 64 + cgi) * 8 + (2 * pair + t)) * 256 + lane * 4) = lw; }
            if (FINAL) {
                if (bi < 4) {
                    hf[tt][0] = pk2(hv[0], hv[1]); hf[tt][1] = pk2(hv[2], hv[3]);
                } else {
                    const int tok = tokc + tt * 16 + fr;
                    const u32x2_t gr = *(const u32x2_t*)(z + (size_t)tok * LDZ + 1024 + ch4);
                    const float gc[4] = {bflo(gr.x), bfhi(gr.x), bflo(gr.y), bfhi(gr.y)};
                    const float hfv[4] = {bflo(hf[tt][0]), bfhi(hf[tt][0]), bflo(hf[tt][1]), bfhi(hf[tt][1])};
                    float o[4];
#pragma unroll
                    for (int jj = 0; jj < 4; ++jj) o[jj] = (hfv[jj] + hv[jj]) * silu(gc[jj]);
                    u32x2_t ow; ow.x = pk2(o[0], o[1]); ow.y = pk2(o[2], o[3]);
                    *(u32x2_t*)(y + (size_t)tok * LDY + ch4) = ow;
                }
            }
        }
    }
    if (!FINAL && fr == 0) {
#pragma unroll
        for (int jj = 0; jj < 4; ++jj) { float2 v; v.x = arun[jj]; v.y = hin[jj]; *(float2*)(agg + ((size_t)(1 * 128 + chunk) * 1024 + ch4 + jj) * 2) = v; }
    }
}
struct LruF { u32x4_t L[2][8]; u32x2_t gr[8]; };
__device__ __forceinline__ void lru_final_load(LruF& F, const unsigned* labuf, const bf16_t* z, int item, int lane) {
    const int cgi = item & 63, chunk = item >> 6, fr = lane & 15, fq = lane >> 4;
    const int ch4 = cgi * 16 + fq * 4, tokc = chunk * 128;
#pragma unroll
    for (int d = 0; d < 2; ++d)
#pragma unroll
        for (int tt = 0; tt < 8; ++tt) F.L[d][tt] = *(const u32x4_t*)(labuf + ((((size_t)d * 128 + chunk) * 64 + cgi) * 8 + tt) * 256 + lane * 4);
#pragma unroll
    for (int tt = 0; tt < 8; ++tt) F.gr[tt] = *(const u32x2_t*)(z + (size_t)(tokc + tt * 16 + fr) * LDZ + 1024 + ch4);
}
template <bool WAVEC> __device__ __forceinline__ void lru_final_compute(const LruF& F, const float* carry, float hcv, bf16_t* y, int item, int lane) {
    typedef _Float16 h2_t __attribute__((ext_vector_type(2)));
    const int cgi = item & 63, chunk = item >> 6;
    const int fr = lane & 15, fq = lane >> 4;
    const int ch4 = cgi * 16 + fq * 4, tokc = chunk * 128;
    float hf[8][4];
    {
        float hin[4];
#pragma unroll
        for (int jj = 0; jj < 4; ++jj) hin[jj] = WAVEC ? __shfl(hcv, fq * 4 + jj) : carry[(size_t)(0 * 128 + chunk) * 1024 + ch4 + jj];
#pragma unroll
        for (int tt = 0; tt < 8; ++tt) {
            float A[4], B[4];
#pragma unroll
            for (int jj = 0; jj < 4; ++jj) {
                const unsigned wv = F.L[0][tt][jj]; const h2_t v = __builtin_bit_cast(h2_t, wv);
                A[jj] = __builtin_amdgcn_exp2f((float)v.x); B[jj] = (float)v.y;
            }
            scan16x4<0>(A, B);
#pragma unroll
            for (int jj = 0; jj < 4; ++jj) hf[tt][jj] = A[jj] * hin[jj] + B[jj];
            bcast4<0>(hf[tt], hin);
        }
    }
    {
        float hin[4];
#pragma unroll
        for (int jj = 0; jj < 4; ++jj) hin[jj] = WAVEC ? __shfl(hcv, 16 + fq * 4 + jj) : carry[(size_t)(1 * 128 + chunk) * 1024 + ch4 + jj];
#pragma unroll
        for (int s = 0; s < 8; ++s) {
            const int tt = 7 - s;
            float o[4], A[4], B[4];
#pragma unroll
            for (int jj = 0; jj < 4; ++jj) {
                const unsigned wv = F.L[1][tt][jj]; const h2_t v = __builtin_bit_cast(h2_t, wv);
                A[jj] = __builtin_amdgcn_exp2f((float)v.x); B[jj] = (float)v.y;
            }
            scan16x4<1>(A, B);
            float hb[4];
#pragma unroll
            for (int jj = 0; jj < 4; ++jj) { hb[jj] = A[jj] * hin[jj] + B[jj]; o[jj] = hf[tt][jj] + hb[jj]; }
            bcast4<1>(hb, hin);
            const float gc[4] = {bflo(F.gr[tt].x), bfhi(F.gr[tt].x), bflo(F.gr[tt].y), bfhi(F.gr[tt].y)};
            u32x2_t ow; ow.x = pk2(o[0] * silu(gc[0]), o[1] * silu(gc[1])); ow.y = pk2(o[2] * silu(gc[2]), o[3] * silu(gc[3]));
            *(u32x2_t*)(y + (size_t)(tokc + tt * 16 + fr) * LDY + ch4) = ow;
        }
    }
}
__device__ __forceinline__ void wave_carries(const float* agg, int cgi, int chunk0, int nseq, int lane, float (&hc)[4]) {
    const int q = lane >> 4, ch = cgi * 16 + (lane & 15);
    const bool up = (lane & 16) != 0;
    float2 ag[2][32];
#pragma unroll
    for (int dir = 0; dir < 2; ++dir)
#pragma unroll
        for (int cc = 0; cc < 32; ++cc) ag[dir][cc] = *(const float2*)(agg + ((size_t)(dir * 128 + 32 * q + cc) * 1024 + ch) * 2);
#pragma unroll
    for (int dir = 0; dir < 2; ++dir) {
        float A = 1.f, h = 0.f, Ap = 1.f, Hp = 0.f;
#pragma unroll
        for (int step = 0; step < 32; ++step) {
            const int cc = dir == 0 ? step : 31 - step;
            if (cc == chunk0) { Ap = A; Hp = h; }
            const float2 ah = ag[dir][cc];
            h = ah.x * h + ah.y; A *= ah.x;
        }
        float Aq[4], Hq[4], Apk[4], Hpk[4];
#pragma unroll
        for (int k = 0; k < 4; ++k) { const int src = k * 16 + (lane & 15); Aq[k] = __shfl(A, src); Hq[k] = __shfl(h, src); Apk[k] = __shfl(Ap, src); Hpk[k] = __shfl(Hp, src); }
        float S[4];
        if (dir == 0) { S[0] = 0.f; S[1] = Hq[0]; S[2] = Aq[1] * S[1] + Hq[1]; S[3] = Aq[2] * S[2] + Hq[2]; }
        else { S[3] = 0.f; S[2] = Hq[3]; S[1] = Aq[2] * S[2] + Hq[2]; S[0] = Aq[1] * S[1] + Hq[1]; }
#pragma unroll
        for (int k = 0; k < 4; ++k) { const float v = Apk[k] * (nseq == 1 ? S[k] : 0.f) + Hpk[k]; if (dir == 0) hc[k] = v; else hc[k] = up ? v : hc[k]; }
    }
}
__device__ __forceinline__ void carry_phase(const float* agg, float* carry, int nseq, int gtid, int gthreads) {
    const int nc = 128 / nseq;
    for (int idx = gtid; idx < 2 * nseq * 1024; idx += gthreads) {
        const int ch = idx & 1023, rest = idx >> 10, dir = rest & 1, sq = rest >> 1, base = sq * nc;
        float h = 0.f;
#pragma unroll 8
        for (int c = 0; c < nc; ++c) {
            const int C = base + (dir == 0 ? c : nc - 1 - c);
            const size_t o = (size_t)(dir * 128 + C) * 1024 + ch;
            const float2 ah = *(const float2*)(agg + o * 2);
            carry[o] = h;
            h = ah.x * h + ah.y;
        }
    }
}

__device__ __forceinline__ void sgu_item2(const bf16_t* vT, const LAS float* rstd, const LAS unsigned char* wsl, const bf16_t* z, const float* sgu_g, const float* sgu_b, bf16_t* y,
                                          int n, int g, int qd, int lane) {
    const int fr = lane & 15, fq = lane >> 4;
    const int tokc = n * 128, chq = g * 128 + qd * 32;
    bf16x8 Af[2][4];
#pragma unroll
    for (int t = 0; t < 2; ++t) {
        const bf16_t* ap = vT + (size_t)(chq + (fr >> 2) * 8 + (fr & 3) + 4 * t) * SEG + tokc + fq * 8;
#pragma unroll
        for (int ks = 0; ks < 4; ++ks) {
            const u32x4_t raw = *(const u32x4_t*)(ap + ks * 32);
            const f32x4 r0 = *(const LAS f32x4*)(rstd + ks * 32 + fq * 8), r1 = *(const LAS f32x4*)(rstd + ks * 32 + fq * 8 + 4);
            u32x4_t w;
            w.x = pk2(bflo(raw.x) * r0[0], bfhi(raw.x) * r0[1]); w.y = pk2(bflo(raw.y) * r0[2], bfhi(raw.y) * r0[3]);
            w.z = pk2(bflo(raw.z) * r1[0], bfhi(raw.z) * r1[1]); w.w = pk2(bflo(raw.w) * r1[2], bfhi(raw.w) * r1[3]);
            Af[t][ks] = __builtin_bit_cast(bf16x8, w);
        }
    }
    const int ch8 = chq + fq * 8;
    const f32x4 g0 = *(const f32x4*)(sgu_g + ch8), g1 = *(const f32x4*)(sgu_g + ch8 + 4);
    u32x4_t urv[8], grv[8]; float bsvv[8];
#pragma unroll
    for (int pt = 0; pt < 8; ++pt) { const int p = pt * 16 + fr, tok = tokc + p;
        urv[pt] = *(const u32x4_t*)(z + (size_t)tok * LDZ + 2048 + ch8); grv[pt] = *(const u32x4_t*)(z + (size_t)tok * LDZ + 3072 + ch8); bsvv[pt] = sgu_b[g * 128 + p]; }
#pragma unroll
    for (int pt = 0; pt < 8; ++pt) {
        const int p = pt * 16 + fr, tok = tokc + p;
        const u32x4_t ur = urv[pt], gr = grv[pt];
        const float bsv = bsvv[pt];
        const LAS unsigned char* bp = wsl + p * 256;
        f32x4 a0 = {0.f, 0.f, 0.f, 0.f}, a1 = {0.f, 0.f, 0.f, 0.f};
#pragma unroll
        for (int ks = 0; ks < 4; ++ks) { const bf16x8 Bf = *(const LAS bf16x8*)(bp + (((ks * 4 + fq) ^ fr) << 4)); a0 = mfma16(Af[0][ks], Bf, a0); a1 = mfma16(Af[1][ks], Bf, a1); }
        float o[8];
#pragma unroll
        for (int k = 0; k < 2; ++k) {
            o[2 * k] = bflo(ur[k]) * (a0[2 * k] * g0[2 * k] + bsv) * silu(bflo(gr[k]));
            o[2 * k + 1] = bfhi(ur[k]) * (a0[2 * k + 1] * g0[2 * k + 1] + bsv) * silu(bfhi(gr[k]));
            o[4 + 2 * k] = bflo(ur[2 + k]) * (a1[2 * k] * g1[2 * k] + bsv) * silu(bflo(gr[2 + k]));
            o[4 + 2 * k + 1] = bfhi(ur[2 + k]) * (a1[2 * k + 1] * g1[2 * k + 1] + bsv) * silu(bfhi(gr[2 + k]));
        }
        u32x4_t ow; ow.x = pk2(o[0], o[1]); ow.y = pk2(o[2], o[3]); ow.z = pk2(o[4], o[5]); ow.w = pk2(o[6], o[7]);
        *(u32x4_t*)(y + (size_t)tok * LDY + 1024 + ch8) = ow;
    }
}

__device__ __forceinline__ void sgu_item(const bf16_t* vT, const LAS float* rstd, const bf16_t* z, const bf16_t* sguw, const float* sgu_g, const float* sgu_b, bf16_t* y, int item, int lane) {
    const int dd = item & 7, g = (item >> 3) & 7, n = item >> 6;
    const int fr = lane & 15, fq = lane >> 4;
    const int tokc = n * 128;
    const bf16_t* ap = vT + (size_t)(g * 128 + dd * 16 + fr) * SEG + tokc + fq * 8;
    bf16x8 Af[4];
#pragma unroll
    for (int ks = 0; ks < 4; ++ks) {
        const u32x4_t raw = *(const u32x4_t*)(ap + ks * 32);
        const f32x4 r0 = *(const LAS f32x4*)(rstd + ks * 32 + fq * 8), r1 = *(const LAS f32x4*)(rstd + ks * 32 + fq * 8 + 4);
        u32x4_t w;
        w.x = pk2(bflo(raw.x) * r0[0], bfhi(raw.x) * r0[1]); w.y = pk2(bflo(raw.y) * r0[2], bfhi(raw.y) * r0[3]);
        w.z = pk2(bflo(raw.z) * r1[0], bfhi(raw.z) * r1[1]); w.w = pk2(bflo(raw.w) * r1[2], bfhi(raw.w) * r1[3]);
        Af[ks] = __builtin_bit_cast(bf16x8, w);
    }
    const int ch4 = g * 128 + dd * 16 + fq * 4;
    const f32x4 g4 = *(const f32x4*)(sgu_g + ch4);
#pragma unroll
    for (int pt = 0; pt < 8; ++pt) {
        const int p = pt * 16 + fr;
        const bf16_t* bp = sguw + (size_t)(g * 128 + p) * 128 + fq * 8;
        f32x4 acc = {0.f, 0.f, 0.f, 0.f};
#pragma unroll
        for (int ks = 0; ks < 4; ++ks) acc = mfma16(Af[ks], ld8(bp + ks * 32), acc);
        const int tok = tokc + p;
        const float bsv = sgu_b[g * 128 + p];
        const u32x2_t ur = *(const u32x2_t*)(z + (size_t)tok * LDZ + 2048 + ch4), gr = *(const u32x2_t*)(z + (size_t)tok * LDZ + 3072 + ch4);
        const float uu[4] = {bflo(ur.x), bfhi(ur.x), bflo(ur.y), bfhi(ur.y)}, gd[4] = {bflo(gr.x), bfhi(gr.x), bflo(gr.y), bfhi(gr.y)};
        float o[4];
#pragma unroll
        for (int jj = 0; jj < 4; ++jj) o[jj] = uu[jj] * (acc[jj] * g4[jj] + bsv) * silu(gd[jj]);
        u32x2_t ow; ow.x = pk2(o[0], o[1]); ow.y = pk2(o[2], o[3]);
        *(u32x2_t*)(y + (size_t)tok * LDY + 1024 + ch4) = ow;
    }
}

__global__ void __launch_bounds__(512, 2) fwd_megakernel(Params P) {
    extern __shared__ __attribute__((aligned(16))) unsigned char shm[];
    cg::grid_group grid = cg::this_grid();
    PG8_LAS unsigned char* lds = (PG8_LAS unsigned char*)shm;
    const int G = gridDim.x, NW = G * 8;
#define FRESH_TID() int tid = threadIdx.x; asm volatile("" : "+v"(tid)); const int lane = tid & 63, wid = tid >> 6, gw = blockIdx.x * 8 + wid; (void)lane; (void)gw
    unsigned char* ws = P.ws;
    bf16_t* WIN_E = (bf16_t*)(ws + WS_WIN_E); bf16_t* WIN_O = (bf16_t*)(ws + WS_WIN_O);
    bf16_t* WOUT_E = (bf16_t*)(ws + WS_WOUT_E); bf16_t* WOUT_O = (bf16_t*)(ws + WS_WOUT_O);
    bf16_t* WKV = (bf16_t*)(ws + WS_WKV); bf16_t* LRUW = (bf16_t*)(ws + WS_LRUW); bf16_t* SGUW = (bf16_t*)(ws + WS_SGUW);
    bf16_t* MEMN = (bf16_t*)(ws + WS_MEMN); bf16_t* MK = (bf16_t*)(ws + WS_MK); bf16_t* MVT = (bf16_t*)(ws + WS_MVT);
    bf16_t* H = (bf16_t*)(ws + WS_H); bf16_t* Z = (bf16_t*)(ws + WS_Z); bf16_t* VT = (bf16_t*)(ws + WS_VT); bf16_t* Y = (bf16_t*)(ws + WS_Y);
    float* AGG = (float*)(ws + WS_AGG); float* CARRY = (float*)(ws + WS_CARRY); float* RSTD = (float*)(ws + WS_RSTD); float* PART = (float*)(ws + WS_PART); unsigned* LAB = (unsigned*)(ws + WS_LAB);

    unsigned* BAR = (unsigned*)(ws + WS_BAR);
    volatile LAS unsigned* xst = (volatile LAS unsigned*)(lds + XST_OFF);
    {
        FRESH_TID();
        if (tid < 2) xst[tid] = 0u;
        if (blockIdx.x == 0) for (int i = tid; i < XCD_BAR_WORDS; i += 512) BAR[i] = 0u;
        LAS float* scr = (LAS float*)(lds + wid * 16384);
        constexpr int I0 = 16 * 288, I1 = 16 * 192, I2 = 40 * 32, I3 = 40 * 32, I4 = 16 * 32, I5 = 16 * 32, I6 = 16 * 8, I7 = 16 * 8;
        constexpr int NIT = I0 + I1 + I2 + I3 + I4 + I5 + I6 + I7;
#pragma unroll 1
        for (int it = gw; it < NIT; it += NW) {
            int r = it;
            if (r < I0) { transpose_item(P.in[7], 1024, 9216, WIN_E, scr, r, lane); continue; } r -= I0;
            if (r < I1) { transpose_item(P.in[12], 1024, 6144, WIN_O, scr, r, lane); continue; } r -= I1;
            if (r < I2) { transpose_item(P.in[11], 2560, 1024, WOUT_E, scr, r, lane); continue; } r -= I2;
            if (r < I3) { transpose_item(P.in[23], 2560, 1024, WOUT_O, scr, r, lane); continue; } r -= I3;
            if (r < I4) { transpose_item(P.in[6], 1024, 1024, WKV, scr, r, lane); continue; } r -= I4;
            if (r < I5) { transpose_item(P.in[6] + (size_t)1024 * 1024, 1024, 1024, WKV + (size_t)1024 * 1024, scr, r, lane); continue; } r -= I5;
            if (r < I6) { const int m = r >> 3; transpose_item(P.in[15] + (size_t)m * 16384, 128, 128, LRUW + (size_t)m * 16384, scr, r & 7, lane); continue; } r -= I6;
            { const int m = r >> 3; transpose_item(P.in[17] + (size_t)m * 16384, 128, 128, LRUW + (size_t)(16 + m) * 16384, scr, r & 7, lane); }
        }
        for (int i = blockIdx.x * 512 + tid; i < 8 * 128 * 128; i += G * 512) SGUW[i] = f2bf(P.in[21][i]);
        for (int it = gw; it < 2 * 1536; it += NW) {
            const int l = it / 1536, row = it - l * 1536;
            const float* src = row < 512 ? P.in[2] + (size_t)row * 1024 : P.in[3] + (size_t)(row - 512) * 1024;
            rms_row_bf16(src, P.in[5] + l * 1024, MEMN + ((size_t)l * 1536 + row) * 1024, lane);
        }
        for (int it = gw; it < SEG / 4; it += NW) rms_rows4_bf16(P.in[0] + (size_t)it * 4096, P.in[4], H + (size_t)it * 4096, lane);
    }

    grid.sync();
    const XcdBarrier xb = xcd_barrier_post(BAR, xst);
    for (int seg = 0; seg < 3; ++seg) {
        const float* xin = seg < 2 ? P.in[0] + (size_t)seg * SEG * 1024 : P.in[1];
        float* xout = P.out + (size_t)seg * SEG * 1024;
        const int T = seg < 2 ? 16384 : 4096, nseq = seg < 2 ? 1 : 4;

        {
            pg8::Gemm g; g.A = H; g.Bt = WIN_E; g.M = SEG; g.N = 8192; g.K = 1024; g.A1 = WIN_E + (size_t)6144 * 1024; g.Bt1 = H;
            pg8::DualOrder S; S.S0.init(SEG, 8192, G, blockIdx.x); S.S1.init(1024, SEG, G, blockIdx.x); S.skip_from = 24; S.skip_n = 4; S.G = G; S.c = blockIdx.x;
            pg8::EpiZ E; E.O = Z; E.ldc = LDZ; E.skip_from = 24; E.skip_n = 4; E.colsq = nullptr; E.colsq_ld = 0; E.O1 = VT; E.ldc1 = SEG; E.colsq1 = nullptr;
            pg8::gemm_phase(lds, g, S, E);
        }
        if (seg == 0) {
#pragma unroll 1
            for (int l = 0; l < 2; ++l) {
                {
                    pg8::Gemm g; g.A = MEMN + (size_t)l * 1536 * 1024; g.Bt = WKV + (size_t)l * 1024 * 1024; g.M = 1536; g.N = 512; g.K = 1024; g.A1 = g.A; g.Bt1 = g.Bt;
                    pg8::SkipOrder S; S.init(1536, 512, G, (blockIdx.x + G - (32 * l) % G) % G); S.skip_from = 1 << 20; S.skip_n = 0;
                    pg8::EpiZ E; E.O = MK + (size_t)l * 1536 * 512; E.ldc = 512; E.skip_from = 1 << 20; E.skip_n = 0; E.colsq = nullptr; E.colsq_ld = 0; E.O1 = E.O; E.ldc1 = 512; E.colsq1 = nullptr;
                    pg8::gemm_phase(lds, g, S, E);
                }
                {
                    pg8::Gemm g; g.A = WKV + (size_t)l * 1024 * 1024 + (size_t)512 * 1024; g.Bt = MEMN + (size_t)l * 1536 * 1024; g.M = 512; g.N = 1536; g.K = 1024; g.A1 = g.A; g.Bt1 = g.Bt;
                    pg8::SkipOrder S; S.init(512, 1536, G, (blockIdx.x + G - (32 * l + 16) % G) % G); S.skip_from = 1 << 20; S.skip_n = 0;
                    pg8::EpiZ E; E.O = MVT + (size_t)l * 512 * 1536; E.ldc = 1536; E.skip_from = 1 << 20; E.skip_n = 0; E.colsq = nullptr; E.colsq_ld = 0; E.O1 = E.O; E.ldc1 = 1536; E.colsq1 = nullptr;
                    pg8::gemm_phase(lds, g, S, E);
                }
            }
        }
        xcd_barrier(xb);

        { FRESH_TID();
        for (int u = blockIdx.x; u < 256; u += G) mem_unit(Z, 7168, 7680, MK, MVT, Y, u, seg, lds, tid);
#pragma unroll 1
        for (int u = blockIdx.x; u < 256; u += G) na_block(Z, VT, Y, P.in[10], u, T, lds, tid);
        for (int it = gw; it < 8192; it += NW) conv_even_item(Z, P.in[8], P.in[9], Y, 2 * it, T, lane);
        }
        xcd_barrier(xb);

        {
            pg8::Gemm g; g.A = Y; g.Bt = WOUT_E; g.M = SEG; g.N = 1024; g.K = 2560; g.A1 = g.A; g.Bt1 = g.Bt;
            pg8::StaticOrder S; S.init(SEG, 1024, G, blockIdx.x, 16);
            pg8::EpiRes E; E.xin = xin; E.out = xout;
            pg8::gemm_phase(lds, g, S, E);
        }
        xcd_barrier(xb);

        { FRESH_TID();
        for (int it = gw; it < SEG / 4; it += NW) rms_rows4_bf16(xout + (size_t)it * 4096, P.in[4] + 1024, H + (size_t)it * 4096, lane); }
        xcd_barrier(xb);

        {
            pg8::Gemm g; g.A = H; g.Bt = WIN_O; g.M = SEG; g.N = 5120; g.K = 1024; g.A1 = WIN_O + (size_t)3072 * 1024; g.Bt1 = H;
            pg8::DualOrder S; S.S0.init(SEG, 5120, G, blockIdx.x); S.S1.init(1024, SEG, G, blockIdx.x); S.skip_from = 12; S.skip_n = 4; S.G = G; S.c = blockIdx.x;
            pg8::EpiZ E; E.O = Z; E.ldc = LDZ; E.skip_from = 12; E.skip_n = 4; E.colsq = nullptr; E.colsq_ld = SEG; E.O1 = VT; E.ldc1 = SEG; E.colsq1 = PART;
            pg8::gemm_phase(lds, g, S, E);
        }
        xcd_barrier(xb);

        { FRESH_TID();
        for (int u = blockIdx.x; u < 256; u += G) mem_unit(Z, 4096, 4608, MK + (size_t)1536 * 512, MVT + (size_t)512 * 1536, Y, u, seg, lds, tid);
#pragma unroll 1
        for (int u0 = blockIdx.x; u0 < 1024; u0 += 4 * G) {
            __syncthreads();
#pragma unroll 1
            for (int k = 0; k < 4; ++k) { const int u = u0 + k * G; if (u < 1024) conv_tile_to_lds(Z, P.in[13], P.in[14], lds + k * 32768, u >> 3, u & 7, T, tid); }
            __syncthreads();
#pragma unroll 1
            for (int k = 0; k < 4; ++k) { const int u = u0 + k * G; if (u < 1024) lru_item<false>(lds + k * 32768, Z, LRUW, P.in[16], P.in[18], P.in[19], AGG, CARRY, Y, LAB, (u >> 3) * 64 + (u & 7) * 8 + wid, lane); }
        }
#pragma unroll 1
        for (int u0 = blockIdx.x; u0 < 1024; u0 += 2 * G) {
            __syncthreads();
            LAS float* rsL = (LAS float*)lds;
            if (tid < 256) { const int u = u0 + (tid >> 7) * G;
              if (u < 1024) { const float* pp = PART + (u >> 3) * 128 + (tid & 127); float s = 0.f;
#pragma unroll
                for (int i = 0; i < 8; ++i) s += pp[(size_t)i * SEG];
                rsL[tid] = __builtin_amdgcn_rsqf(s * (1.0f / 1024.0f) + EPS); } }
            u32x4_t wsv[2][4];
#pragma unroll
            for (int s2 = 0; s2 < 2; ++s2) { const int u = u0 + s2 * G;
              if (u < 1024) { const int g = u & 7;
#pragma unroll
                for (int i = 0; i < 4; ++i) { const int idx = tid + 512 * i, p = idx >> 4, c = idx & 15; wsv[s2][i] = *(const u32x4_t*)(SGUW + (size_t)(g * 128 + p) * 128 + c * 8); } } }
#pragma unroll
            for (int s2 = 0; s2 < 2; ++s2) { const int u = u0 + s2 * G;
              if (u < 1024) {
#pragma unroll
                for (int i = 0; i < 4; ++i) { const int idx = tid + 512 * i, p = idx >> 4, c = idx & 15; *(LAS u32x4_t*)(lds + 4096 + s2 * 32768 + p * 256 + ((c ^ (p & 15)) << 4)) = wsv[s2][i]; } } }
            __syncthreads();
            { const int s2 = wid >> 2, u = u0 + s2 * G;
              if (u < 1024) sgu_item2(VT, rsL + s2 * 128, lds + 4096 + s2 * 32768, Z, P.in[20], P.in[22], Y, u >> 3, u & 7, wid & 3, lane); }
        } }
        xcd_barrier(xb);

        if (G == 256) {
            FRESH_TID();
            float hc[4];
            LruF F[2];
            lru_final_load(F[0], LAB, Z, gw, lane);
            wave_carries(AGG, gw & 63, gw >> 6, nseq, lane, hc);
#pragma unroll
            for (int k = 0; k < 4; ++k) {
                if (k < 3) lru_final_load(F[(k + 1) & 1], LAB, Z, gw + 2048 * (k + 1), lane);
                lru_final_compute<true>(F[k & 1], CARRY, hc[k], Y, gw + 2048 * k, lane);
            }
        } else {
            { FRESH_TID(); carry_phase(AGG, CARRY, nseq, blockIdx.x * 512 + tid, G * 512); }
            xcd_barrier(xb);
            { FRESH_TID();
#pragma unroll 1
            for (int it = gw; it < 8192; it += NW) { LruF F1; lru_final_load(F1, LAB, Z, it, lane); lru_final_compute<false>(F1, CARRY, 0.f, Y, it, lane); } }
        }
        if (seg < 2) { FRESH_TID();
            const float* xnx = seg == 0 ? P.in[0] + (size_t)SEG * 1024 : P.in[1];
            for (int it = gw; it < SEG / 4; it += NW) rms_rows4_bf16(xnx + (size_t)it * 4096, P.in[4], H + (size_t)it * 4096, lane); }
        xcd_barrier(xb);

        {
            pg8::Gemm g; g.A = Y; g.Bt = WOUT_O; g.M = SEG; g.N = 1024; g.K = 2560; g.A1 = g.A; g.Bt1 = g.Bt;
            pg8::StaticOrder S; S.init(SEG, 1024, G, blockIdx.x, 16);
            pg8::EpiRes E; E.xin = xout; E.out = xout;
            pg8::gemm_phase(lds, g, S, E);
        }
        xcd_barrier(xb);

        { FRESH_TID();
        for (int it = gw; it < SEG / 4; it += NW) rms_rows4_f32(xout + (size_t)it * 4096, P.in[24], lane); }
    }
}

extern "C" void kernel_launch(void* const* d_in, const int* in_sizes, int n_in, void* d_out, int out_size, void* d_ws, size_t ws_size, hipStream_t stream) {
    static int grid_blocks = 0;
    if (grid_blocks == 0) {
        if (n_in != 25 || ws_size < WS_END) { fprintf(stderr, "kernel_launch: need 25 inputs and %zu bytes of workspace; got %d, %zu\n", (size_t)WS_END, n_in, ws_size); grid_blocks = -1; return; }
        int dev = 0, cus = 0, per_cu = 0;
        hipGetDevice(&dev);
        hipDeviceGetAttribute(&cus, hipDeviceAttributeMultiprocessorCount, dev);
        hipFuncSetAttribute((const void*)fwd_megakernel, hipFuncAttributeMaxDynamicSharedMemorySize, LDS_BYTES);
        hipOccupancyMaxActiveBlocksPerMultiprocessor(&per_cu, (const void*)fwd_megakernel, 512, LDS_BYTES);
        if (per_cu < 1) { fprintf(stderr, "kernel_launch: occupancy query says %d blocks per CU\n", per_cu); grid_blocks = -1; return; }
        grid_blocks = cus;
    }
    if (grid_blocks < 0) return;
    Params p{};
    for (int i = 0; i < 25; ++i) p.in[i] = (const float*)d_in[i];
    p.out = (float*)d_out; p.ws = (unsigned char*)d_ws;
    void* args[] = {&p};
    hipError_t e = hipLaunchCooperativeKernel((const void*)fwd_megakernel, dim3(grid_blocks), dim3(512), args, LDS_BYTES, stream);
    if (e != hipSuccess) fprintf(stderr, "cooperative launch failed: %s (grid %d)\n", hipGetErrorString(e), grid_blocks);
}
```

```cpp
#include <hip/hip_runtime.h>
#include <hip/hip_cooperative_groups.h>
#include <cstdio>
namespace cg = cooperative_groups;
namespace pg8 {
#define PG8_LAS __attribute__((address_space(3)))
typedef unsigned short bf16_t;
typedef short bf16x8 __attribute__((ext_vector_type(8)));
typedef float f32x4 __attribute__((ext_vector_type(4)));
typedef unsigned u32x4 __attribute__((ext_vector_type(4)));
constexpr int BM = 256, BK = 64, HALF = 128, HTB = HALF * BK * 2  , STAGE_BYTES = 8 * HTB, NXCD = 8, WGM = 4;

__host__ __device__ __forceinline__ int lds_byte(int r, int c) { const int st = (r >> 4) * 2 + (c >> 5), rr = r & 15, cc = c & 31, ob = rr * 64 + cc * 2; return st * 1024 + (ob ^ (((ob >> 9) & 1) << 5)); }
__host__ __device__ __forceinline__ void stage_rc(int b, int& R, int& C) { const int st = b / 1024, sb = b % 1024, swz = sb ^ (((sb >> 9) & 1) << 5); R = (st >> 1) * 16 + swz / 64; C = (st & 1) * 32 + (swz % 64) / 2; }
__host__ __device__ __forceinline__ int perm32(int rho) { const int n = rho >> 4, i = rho & 15; return 8 * (i >> 2) + 4 * n + (i & 3); }

struct Unit { int pm, pn, sel; };
struct Gemm { const bf16_t* A; const bf16_t* Bt; int M, N, K; const bf16_t* A1; const bf16_t* Bt1; };

struct StaticOrder {
    int nM, nN, nwg, G, c, wgm;
    __host__ __device__ void init(int M, int N, int G_, int c_, int wgm_ = 4) { nM = M / BM; nN = N / BM; nwg = nM * nN; G = G_; c = c_; wgm = wgm_; }
    __host__ __device__ void map(int wgid, Unit& u) const {
        { const int q = nwg / NXCD, r = nwg % NXCD, xcd = wgid % NXCD, off = wgid / NXCD; wgid = (xcd < r ? xcd * (q + 1) : r * (q + 1) + (xcd - r) * q) + off; }
        const int nig = wgm * nN, gid = wgid / nig, fm = gid * wgm, gsz = (nM - fm) < wgm ? (nM - fm) : wgm;
        u.pm = fm + ((wgid % nig) % gsz); u.pn = (wgid % nig) / gsz; u.sel = 0;
    }
    __host__ __device__ bool next(int i, Unit& u) const {
        const long L = (long)i * G + c; if (L >= nwg) return false;
        map((int)L, u); return true;
    }
    __device__ __forceinline__ void a_ready(const Unit&) const {}
    __device__ __forceinline__ void done(const Unit&) const {}
};

struct SkipOrder : StaticOrder {
    int skip_from, skip_n;
    __device__ __forceinline__ bool next(int i, Unit& u) const {
        if (!StaticOrder::next(i, u)) return false;
        if (u.pn >= skip_from) u.pn += skip_n;
        return true;
    }
};
struct DualOrder {
    StaticOrder S0, S1; int skip_from, skip_n, G, c;
    __device__ __forceinline__ bool next(int i, Unit& u) const {
        const long L = (long)i * G + c;
        if (L < S0.nwg) { S0.map((int)L, u); if (u.pn >= skip_from) u.pn += skip_n; return true; }
        if (L - S0.nwg < S1.nwg) { S1.map((int)(L - S0.nwg), u); u.sel = 1; return true; }
        return false;
    }
    __device__ __forceinline__ void a_ready(const Unit&) const {}
    __device__ __forceinline__ void done(const Unit&) const {}
};

__device__ __forceinline__ unsigned cvt_pk_bf16(float lo, float hi) { unsigned r; asm volatile("v_cvt_pk_bf16_f32 %0, %1, %2" : "=v"(r) : "v"(lo), "v"(hi)); return r; }

struct EpiZ {
    static constexpr bool PERM = true, AFTER_DRAIN = false;
    bf16_t* O; int ldc; int skip_from, skip_n; float* colsq; int colsq_ld; bf16_t* O1; int ldc1; float* colsq1;
    __device__ __forceinline__ void operator()(const f32x4 (&acc)[2][2][4][2], const Unit& u, int wr, int wc, int fr, int fq) const {
        const int row0 = u.pm * BM + wr * 64 + fr; const int ct = u.sel ? u.pn : ((u.pn >= skip_from + skip_n) ? (u.pn - skip_n) : u.pn);
        const int col0 = ct * BM + wc * 32 + 8 * fq;
        bf16_t* const O = u.sel ? this->O1 : this->O; const int ldc = u.sel ? this->ldc1 : this->ldc; float* const colsq = u.sel ? this->colsq1 : this->colsq;
#pragma unroll
        for (int ai = 0; ai < 2; ++ai)
#pragma unroll
            for (int m = 0; m < 4; ++m) { bf16_t* rowp = O + (size_t)(row0 + ai * HALF + m * 16) * ldc + col0;
#pragma unroll
                for (int bj = 0; bj < 2; ++bj) { const f32x4 v0 = acc[ai][bj][m][0], v1 = acc[ai][bj][m][1];
                    u32x4 w; w.x = cvt_pk_bf16(v0[0], v0[1]); w.y = cvt_pk_bf16(v0[2], v0[3]); w.z = cvt_pk_bf16(v1[0], v1[1]); w.w = cvt_pk_bf16(v1[2], v1[3]);
                    *(u32x4*)(rowp + bj * HALF) = w; } }
        if (colsq) {
#pragma unroll
            for (int bj = 0; bj < 2; ++bj)
#pragma unroll
                for (int n = 0; n < 2; ++n) {
                    f32x4 ss = {0.f, 0.f, 0.f, 0.f};
#pragma unroll
                    for (int ai = 0; ai < 2; ++ai)
#pragma unroll
                        for (int m = 0; m < 4; ++m) ss += acc[ai][bj][m][n] * acc[ai][bj][m][n];
#pragma unroll
                    for (int o = 1; o < 16; o <<= 1) { ss[0] += __shfl_xor(ss[0], o); ss[1] += __shfl_xor(ss[1], o); ss[2] += __shfl_xor(ss[2], o); ss[3] += __shfl_xor(ss[3], o); }
                    if (fr == 0) *(f32x4*)(colsq + (size_t)(2 * u.pm + wr) * colsq_ld + ct * BM + bj * HALF + wc * 32 + 8 * fq + 4 * n) = ss;
                }
        }
    }
};
struct EpiRes {
    static constexpr bool PERM = false, AFTER_DRAIN = false;
    const float* xin; float* out;
    __device__ __forceinline__ void operator()(const f32x4 (&acc)[2][2][4][2], const Unit& u, int wr, int wc, int fr, int fq) const {
        const int row0 = u.pm * BM + wr * 64 + fr, col0 = u.pn * BM + wc * 32 + 4 * fq;
#pragma unroll
        for (int ai = 0; ai < 2; ++ai)
#pragma unroll
            for (int m = 0; m < 4; ++m) { const size_t ro = (size_t)(row0 + ai * HALF + m * 16) * 1024 + col0;
#pragma unroll
                for (int bj = 0; bj < 2; ++bj)
#pragma unroll
                    for (int n = 0; n < 2; ++n) { const f32x4 xv = *(const f32x4*)(xin + ro + bj * HALF + n * 16);
                        *(f32x4*)(out + ro + bj * HALF + n * 16) = acc[ai][bj][m][n] + xv; } }
    }
};

template <class Epi, class Sched>
__device__ __forceinline__ void gemm_phase(PG8_LAS unsigned char* lds, const Gemm g, const Sched& S, const Epi& E) {
    int tid = threadIdx.x; asm volatile("" : "+v"(tid));
    const int wid = __builtin_amdgcn_readfirstlane(tid >> 6), lane = tid & 63, wr = wid >> 2, wc = wid & 3, fr = lane & 15, fq = lane >> 4;
    const int K = g.K, nt = K / BK;
    const char* gA = (const char*)g.A; const char* gB = (const char*)g.Bt; const char* gA1 = (const char*)g.A1; const char* gB1 = (const char*)g.Bt1; asm volatile("" : "+s"(gA), "+s"(gB), "+s"(gA1), "+s"(gB1));
    unsigned voffA[2], voffB[2];
#pragma unroll
    for (int i = 0; i < 2; ++i) { int R, C; stage_rc(tid * 16 + i * 8192, R, C); const int Rb = Epi::PERM ? ((R & ~31) + perm32(R & 31)) : R;
        voffA[i] = (unsigned)(R * K + C) * 2u; voffB[i] = (unsigned)(Rb * K + C) * 2u; }
    const size_t kstep = (size_t)(BK * 2);
    const size_t hstep = (size_t)HALF * K * 2;
    const size_t tstep = 2 * hstep;
    const unsigned ldsw = (unsigned)wid * 1024u;
    const int aoff = lds_byte(wr * 64 + fr, fq * 8), boff = lds_byte(wc * 32 + fr, fq * 8);
#define PG8_SA(b, h) (((b) * 2 + (h)) * HTB)
#define PG8_SB(b, h) ((4 + (b) * 2 + (h)) * HTB)
#define PG8_STAGE(bufoff, gbase, voff) do { _Pragma("unroll") for (int _i = 0; _i < 2; ++_i) \
        __builtin_amdgcn_global_load_lds((const unsigned*)((const char*)(gbase) + (voff)[_i]), (PG8_LAS unsigned*)(lds + (bufoff) + ldsw + _i * 8192), 16, 0, 0); } while (0)
#define PG8_LDA(dst, b, h) do { _Pragma("unroll") for (int m = 0; m < 4; ++m) _Pragma("unroll") for (int k = 0; k < 2; ++k) dst[m][k] = *(const PG8_LAS bf16x8*)(lds + PG8_SA(b, h) + aoff + m * 2048 + k * 1024); } while (0)
#define PG8_LDB(dst, b, h) do { _Pragma("unroll") for (int n = 0; n < 2; ++n) _Pragma("unroll") for (int k = 0; k < 2; ++k) dst[n][k] = *(const PG8_LAS bf16x8*)(lds + PG8_SB(b, h) + boff + n * 2048 + k * 1024); } while (0)
#define PG8_MMA(ai, bj, At, Bt) do { __builtin_amdgcn_s_setprio(1); _Pragma("unroll") for (int m = 0; m < 4; ++m) _Pragma("unroll") for (int n = 0; n < 2; ++n) _Pragma("unroll") for (int k = 0; k < 2; ++k) \
        acc[ai][bj][m][n] = __builtin_amdgcn_mfma_f32_16x16x32_bf16(Bt[n][k], At[m][k], acc[ai][bj][m][n], 0, 0, 0); __builtin_amdgcn_s_setprio(0); } while (0)
#define PG8_WAIT_V(n) asm volatile("s_waitcnt vmcnt(" #n ")" ::: "memory")
#define PG8_WAIT_L(n) asm volatile("s_waitcnt lgkmcnt(" #n ")" ::: "memory")
#define PG8_BAR __builtin_amdgcn_s_barrier()
#define PG8_SCHED __builtin_amdgcn_sched_barrier(0)
    Unit cur, nxt; int ui = 0;
    if (!S.next(0, cur)) return;
    f32x4 acc[2][2][4][2];
#pragma unroll
    for (int a = 0; a < 2; ++a)
#pragma unroll
        for (int b = 0; b < 2; ++b)
#pragma unroll
            for (int m = 0; m < 4; ++m)
#pragma unroll
                for (int n = 0; n < 2; ++n) acc[a][b][m][n] = (f32x4){0.f, 0.f, 0.f, 0.f};
    bf16x8 At[4][2], B0[2][2], B1[2][2];
    const char* cA = (cur.sel ? gA1 : gA) + (size_t)cur.pm * tstep; const char* cB = (cur.sel ? gB1 : gB) + (size_t)cur.pn * tstep;
    S.a_ready(cur);
    PG8_STAGE(PG8_SB(0, 0), cB, voffB); PG8_STAGE(PG8_SA(0, 0), cA, voffA); PG8_STAGE(PG8_SB(0, 1), cB + hstep, voffB); PG8_STAGE(PG8_SA(0, 1), cA + hstep, voffA);
    if (wr == 1) PG8_BAR;
    PG8_WAIT_V(4); PG8_BAR;
    PG8_STAGE(PG8_SB(1, 0), cB + kstep, voffB); PG8_STAGE(PG8_SA(1, 0), cA + kstep, voffA); PG8_STAGE(PG8_SB(1, 1), cB + hstep + kstep, voffB);
    PG8_WAIT_V(6); PG8_BAR;
    for (;;) {
        const bool has_next = S.next(ui + 1, nxt);
        const char* nA = has_next ? (nxt.sel ? gA1 : gA) + (size_t)nxt.pm * tstep : cA; const char* nB = has_next ? (nxt.sel ? gB1 : gB) + (size_t)nxt.pn * tstep : cB;
        for (int t = 0; t < nt; t += 2) {
            const bool last = (t == nt - 2);
            const char* a1 = cA + (size_t)(t + 1) * kstep;
            const char* a2 = last ? nA : cA + (size_t)(t + 2) * kstep; const char* b2 = last ? nB : cB + (size_t)(t + 2) * kstep;
            const char* a3 = a2 + kstep; const char* b3 = b2 + kstep;
            if (last && has_next) S.a_ready(nxt);
            PG8_LDB(B0, 0, 0); PG8_SCHED; PG8_LDA(At, 0, 0); PG8_STAGE(PG8_SA(1, 1), a1 + hstep, voffA);
            PG8_WAIT_L(8); PG8_BAR; PG8_WAIT_L(0); PG8_MMA(0, 0, At, B0); PG8_BAR; PG8_SCHED;
            PG8_LDB(B1, 0, 1); PG8_STAGE(PG8_SB(0, 0), b2, voffB);
            PG8_BAR; PG8_WAIT_L(0); PG8_MMA(0, 1, At, B1); PG8_BAR;
            PG8_LDA(At, 0, 1); PG8_STAGE(PG8_SA(0, 0), a2, voffA);
            PG8_BAR; PG8_WAIT_L(0); PG8_MMA(1, 0, At, B0); PG8_BAR; PG8_SCHED;
            PG8_STAGE(PG8_SB(0, 1), b2 + hstep, voffB);
            PG8_WAIT_V(6); PG8_BAR; PG8_MMA(1, 1, At, B1); PG8_BAR;
            PG8_LDB(B0, 1, 0); PG8_SCHED; PG8_LDA(At, 1, 0); PG8_STAGE(PG8_SA(0, 1), a2 + hstep, voffA);
            PG8_WAIT_L(8); PG8_BAR; PG8_WAIT_L(0); PG8_MMA(0, 0, At, B0); PG8_BAR; PG8_SCHED;
            PG8_LDB(B1, 1, 1); PG8_STAGE(PG8_SB(1, 0), b3, voffB);
            PG8_BAR; PG8_WAIT_L(0); PG8_MMA(0, 1, At, B1); PG8_BAR;
            PG8_LDA(At, 1, 1); PG8_STAGE(PG8_SA(1, 0), a3, voffA);
            PG8_BAR; PG8_WAIT_L(0); PG8_MMA(1, 0, At, B0); PG8_BAR; PG8_SCHED;
            PG8_STAGE(PG8_SB(1, 1), b3 + hstep, voffB);
            PG8_WAIT_V(6); PG8_BAR; PG8_MMA(1, 1, At, B1); PG8_BAR;
        }
        if constexpr (!Epi::AFTER_DRAIN) { E(acc, cur, wr, wc, fr, fq); S.done(cur); }
        if (!has_next) break;
#pragma unroll
        for (int a = 0; a < 2; ++a)
#pragma unroll
            for (int b = 0; b < 2; ++b)
#pragma unroll
                for (int m = 0; m < 4; ++m)
#pragma unroll
                    for (int n = 0; n < 2; ++n) acc[a][b][m][n] = (f32x4){0.f, 0.f, 0.f, 0.f};
        cur = nxt; cA = nA; cB = nB; ++ui;
    }
    PG8_WAIT_V(0);
    if (wr == 0) PG8_BAR;
    PG8_BAR;
    if constexpr (Epi::AFTER_DRAIN) { E.fused(acc, cur, wr, wc, fr, fq, lds, wid, lane); S.done(cur); }
#undef PG8_SA
#undef PG8_SB
#undef PG8_STAGE
#undef PG8_LDA
#undef PG8_LDB
#undef PG8_MMA
#undef PG8_WAIT_V
#undef PG8_WAIT_L
#undef PG8_BAR
#undef PG8_SCHED
}
}

#define XB_TMO      128
#define XB_XCNT(j)  (256  + 64 * (j))
#define XB_XSUB(j)  (1280 + 64 * (j))
#define XB_XGEN(j)  (2304 + 64 * (j))
#define XB_TOP      3328
#define XB_TOPGEN   3392
#define XCD_BAR_WORDS 3456
#define XB_SPIN_CAP (1u << 18)
#define LAS __attribute__((address_space(3)))

__device__ __forceinline__ unsigned xb_ld(unsigned* p)              { return __hip_atomic_load(p, __ATOMIC_RELAXED, __HIP_MEMORY_SCOPE_AGENT); }
__device__ __forceinline__ unsigned xb_add(unsigned* p, unsigned v) { return __hip_atomic_fetch_add(p, v, __ATOMIC_RELAXED, __HIP_MEMORY_SCOPE_AGENT); }
__device__ __forceinline__ unsigned xb_xcc_id() { return (unsigned)__builtin_amdgcn_s_getreg((3 << 11) | 20) & 0xFu; }
#define XB_SPIN(cond, bar) do { unsigned _sp = 0; while (cond) { __builtin_amdgcn_s_sleep(1); \
    if ((++_sp & 255u) == 0u) { if (xb_ld(&(bar)[XB_TMO])) break; if (_sp > XB_SPIN_CAP) { atomicAdd(&(bar)[XB_TMO], 1u); break; } } } } while (0)

struct XcdBarrier {
    unsigned* bar; unsigned x;
    volatile LAS unsigned* st;
};

__device__ __forceinline__ XcdBarrier xcd_barrier_post(unsigned* bar, volatile LAS unsigned* st) {
    XcdBarrier b; b.bar = bar; b.x = xb_xcc_id(); b.st = st;
    if (threadIdx.x == 0) (void)xb_add(&bar[XB_XCNT(b.x)], 1u);
    return b;
}
__device__ __forceinline__ void xcd_barrier_complete(unsigned* bar, unsigned x, unsigned& nloc, unsigned& nx) {
    const unsigned G = gridDim.x * gridDim.y * gridDim.z;
    unsigned sum, cnt, mine, sp = 0u;
    for (;;) {
        sum = 0u; cnt = 0u; mine = 0u;
#pragma unroll
        for (unsigned j = 0; j < 16; ++j) { const unsigned c = xb_ld(&bar[XB_XCNT(j)]); sum += c; cnt += (c > 0u) ? 1u : 0u; mine = (j == x) ? c : mine; }
        if (sum == G) break;
        __builtin_amdgcn_s_sleep(1);
        if ((++sp & 255u) == 0u) { if (xb_ld(&bar[XB_TMO])) break; if (sp > XB_SPIN_CAP) { atomicAdd(&bar[XB_TMO], 1u); break; } }
    }
    nloc = mine > 0u ? mine : 1u; nx = cnt > 0u ? cnt : 1u;
}

__device__ __forceinline__ void xcd_barrier(const XcdBarrier& b) {
    asm volatile("s_waitcnt vmcnt(0)" ::: "memory");
    __syncthreads();
    if (threadIdx.x == 0) {
        unsigned* bar = b.bar;
        __builtin_amdgcn_s_waitcnt(0);
        unsigned nloc = b.st[0], nx = b.st[1];
        if (nloc == 0u) { xcd_barrier_complete(bar, b.x, nloc, nx); b.st[0] = nloc; b.st[1] = nx; }
        const unsigned old = xb_add(&bar[XB_XSUB(b.x)], 1u);
        const unsigned gen = old / nloc;
        if (old + 1u == (gen + 1u) * nloc) {
            __builtin_amdgcn_fence(__ATOMIC_RELEASE, "agent");
            asm volatile("s_waitcnt vmcnt(0)" ::: "memory");
            const unsigned og = xb_add(&bar[XB_TOP], 1u);
            const unsigned tg = og / nx;
            if (og + 1u == (tg + 1u) * nx) xb_add(&bar[XB_TOPGEN], 1u);
            else XB_SPIN(xb_ld(&bar[XB_TOPGEN]) == tg, bar);
            __builtin_amdgcn_fence(__ATOMIC_ACQUIRE, "agent");
            xb_add(&bar[XB_XGEN(b.x)], 1u);
            asm volatile("s_waitcnt vmcnt(0)" ::: "memory");
        } else {
            XB_SPIN(xb_ld(&bar[XB_XGEN(b.x)]) == gen, bar);
            __builtin_amdgcn_fence(__ATOMIC_ACQUIRE, "agent");
            asm volatile("s_waitcnt vmcnt(0)" ::: "memory");
        }
    }
    __syncthreads();
}

using pg8::bf16_t; using pg8::bf16x8; using pg8::f32x4;
typedef unsigned u32x2_t __attribute__((ext_vector_type(2)));
typedef unsigned u32x4_t __attribute__((ext_vector_type(4)));

constexpr int DM = 1024, SEG = 16384, LDZ = 8192, LDY = 2560;
constexpr float EPS = 1e-6f;
constexpr int XST_OFF = 9 * 16384 + 2048;
constexpr int LDS_BYTES = XST_OFF + 64;
constexpr size_t WS_WIN_E = 0;
constexpr size_t WS_WIN_O = WS_WIN_E + (size_t)9216 * 1024 * 2;
constexpr size_t WS_WOUT_E = WS_WIN_O + (size_t)6144 * 1024 * 2;
constexpr size_t WS_WOUT_O = WS_WOUT_E + (size_t)1024 * 2560 * 2;
constexpr size_t WS_WKV = WS_WOUT_O + (size_t)1024 * 2560 * 2;
constexpr size_t WS_LRUW = WS_WKV + (size_t)2 * 1024 * 1024 * 2;
constexpr size_t WS_SGUW = WS_LRUW + (size_t)2 * 2 * 8 * 128 * 128 * 2;
constexpr size_t WS_MEMN = WS_SGUW + (size_t)8 * 128 * 128 * 2;
constexpr size_t WS_MK = WS_MEMN + (size_t)2 * 1536 * 1024 * 2;
constexpr size_t WS_MVT = WS_MK + (size_t)2 * 1536 * 512 * 2;
constexpr size_t WS_H = WS_MVT + (size_t)2 * 512 * 1536 * 2;
constexpr size_t WS_Z = WS_H + (size_t)SEG * 1024 * 2;
constexpr size_t WS_VT = WS_Z + (size_t)SEG * LDZ * 2;
constexpr size_t WS_Y = WS_VT + (size_t)1024 * SEG * 2;
constexpr size_t WS_AGG = WS_Y + (size_t)SEG * LDY * 2;
constexpr size_t WS_CARRY = WS_AGG + (size_t)2 * 128 * 1024 * 2 * 4;
constexpr size_t WS_RSTD = WS_CARRY + (size_t)2 * 128 * 1024 * 4;
constexpr size_t WS_PART = WS_RSTD + (size_t)SEG * 4;
constexpr size_t WS_BAR = WS_PART + (size_t)8 * SEG * 4;
constexpr size_t WS_LAB = WS_BAR + 16384;
constexpr size_t WS_END = WS_LAB + (size_t)2 * SEG * 1024 * 4;

struct Params { const float* in[25]; float* out; unsigned char* ws; };

__device__ __forceinline__ float bf2f(unsigned short b) { return __uint_as_float(((unsigned)b) << 16); }
__device__ __forceinline__ unsigned short f2bf(float f) { unsigned u = __float_as_uint(f); u += 0x7FFFu + ((u >> 16) & 1u); return (unsigned short)(u >> 16); }
__device__ __forceinline__ float bflo(unsigned w) { return __uint_as_float(w << 16); }
__device__ __forceinline__ float bfhi(unsigned w) { return __uint_as_float(w & 0xffff0000u); }
__device__ __forceinline__ unsigned pk2(float lo, float hi) { return pg8::cvt_pk_bf16(lo, hi); }
__device__ __forceinline__ float frcp(float x) { return __builtin_amdgcn_rcpf(x); }
__device__ __forceinline__ float silu(float x) { return x * frcp(1.0f + __expf(-x)); }
__device__ __forceinline__ float sigm(float x) { return frcp(1.0f + __expf(-x)); }
__device__ __forceinline__ float wave_sum(float v) {
#pragma unroll
    for (int o = 1; o < 64; o <<= 1) v += __shfl_xor(v, o);
    return v;
}
__device__ __forceinline__ f32x4 mfma16(bf16x8 a, bf16x8 b, f32x4 c) { return __builtin_amdgcn_mfma_f32_16x16x32_bf16(a, b, c, 0, 0, 0); }
__device__ __forceinline__ bf16x8 ld8(const bf16_t* p) { return *(const bf16x8*)p; }
__device__ __forceinline__ bf16x8 pack8(const float (&v)[8]) {
    u32x4_t w; w.x = pk2(v[0], v[1]); w.y = pk2(v[2], v[3]); w.z = pk2(v[4], v[5]); w.w = pk2(v[6], v[7]);
    return __builtin_bit_cast(bf16x8, w);
}

__device__ __forceinline__ void transpose_item(const float* W, int K, int N, bf16_t* WT, LAS float* scr, int item, int lane) {
    const int nblk = N >> 5, kb = item / nblk, nb = item - kb * nblk, k0 = 64 * kb, n0 = 32 * nb;
#pragma unroll 8
    for (int i = 0; i < 32; ++i) { const int kk = 2 * i + (lane >> 5); scr[kk * 33 + (lane & 31)] = W[(size_t)(k0 + kk) * N + n0 + (lane & 31)]; }
    asm volatile("s_waitcnt lgkmcnt(0)" ::: "memory");
    const int c = lane & 7;
#pragma unroll
    for (int j = 0; j < 4; ++j) { const int n = (lane >> 3) + 8 * j; const LAS float* s = scr + (8 * c) * 33 + n;
        u32x4_t o; o.x = pk2(s[0 * 33], s[1 * 33]); o.y = pk2(s[2 * 33], s[3 * 33]); o.z = pk2(s[4 * 33], s[5 * 33]); o.w = pk2(s[6 * 33], s[7 * 33]);
        *(u32x4_t*)(WT + (size_t)(n0 + n) * K + k0 + 8 * c) = o; }
    asm volatile("s_waitcnt lgkmcnt(0)" ::: "memory");
}

__device__ __forceinline__ void rms_row_bf16(const float* xrow, const float* g, bf16_t* orow, int lane) {
    const f32x4* xr = (const f32x4*)xrow + lane; f32x4 v[4]; float s = 0.f;
#pragma unroll
    for (int j = 0; j < 4; ++j) { v[j] = xr[64 * j]; s += (v[j].x * v[j].x + v[j].y * v[j].y) + (v[j].z * v[j].z + v[j].w * v[j].w); }
    const float rstd = __builtin_amdgcn_rsqf(wave_sum(s) * (1.0f / 1024.0f) + EPS);
    const f32x4* gr = (const f32x4*)g + lane; u32x2_t* o8 = (u32x2_t*)orow + lane;
#pragma unroll
    for (int j = 0; j < 4; ++j) { const f32x4 gg = gr[64 * j]; u32x2_t o; o.x = pk2(v[j].x * rstd * gg.x, v[j].y * rstd * gg.y); o.y = pk2(v[j].z * rstd * gg.z, v[j].w * rstd * gg.w); o8[64 * j] = o; }
}
__device__ __forceinline__ void rms_row_f32(float* xrow, const float* g, int lane) {
    f32x4* xr = (f32x4*)xrow + lane; f32x4 v[4]; float s = 0.f;
#pragma unroll
    for (int j = 0; j < 4; ++j) { v[j] = xr[64 * j]; s += (v[j].x * v[j].x + v[j].y * v[j].y) + (v[j].z * v[j].z + v[j].w * v[j].w); }
    const float rstd = __builtin_amdgcn_rsqf(wave_sum(s) * (1.0f / 1024.0f) + EPS);
    const f32x4* gr = (const f32x4*)g + lane;
#pragma unroll
    for (int j = 0; j < 4; ++j) { const f32x4 gg = gr[64 * j]; f32x4 o; o.x = v[j].x * rstd * gg.x; o.y = v[j].y * rstd * gg.y; o.z = v[j].z * rstd * gg.z; o.w = v[j].w * rstd * gg.w; xr[64 * j] = o; }
}

__device__ __forceinline__ void rms_rows4_bf16(const float* xrow, const float* g, bf16_t* orow, int lane) {
    f32x4 v[4][4]; float s[4];
#pragma unroll
    for (int r = 0; r < 4; ++r)
#pragma unroll
        for (int j = 0; j < 4; ++j) v[r][j] = ((const f32x4*)(xrow + (size_t)r * 1024))[lane + 64 * j];
    f32x4 gg[4];
#pragma unroll
    for (int j = 0; j < 4; ++j) gg[j] = ((const f32x4*)g)[lane + 64 * j];
#pragma unroll
    for (int r = 0; r < 4; ++r) { s[r] = 0.f;
#pragma unroll
        for (int j = 0; j < 4; ++j) s[r] += (v[r][j].x * v[r][j].x + v[r][j].y * v[r][j].y) + (v[r][j].z * v[r][j].z + v[r][j].w * v[r][j].w); }
#pragma unroll
    for (int o = 1; o < 64; o <<= 1) {
#pragma unroll
        for (int r = 0; r < 4; ++r) s[r] += __shfl_xor(s[r], o); }
#pragma unroll
    for (int r = 0; r < 4; ++r) { const float rstd = __builtin_amdgcn_rsqf(s[r] * (1.0f / 1024.0f) + EPS);
        u32x2_t* o8 = (u32x2_t*)(orow + (size_t)r * 1024) + lane;
#pragma unroll
        for (int j = 0; j < 4; ++j) { u32x2_t o; o.x = pk2(v[r][j].x * rstd * gg[j].x, v[r][j].y * rstd * gg[j].y); o.y = pk2(v[r][j].z * rstd * gg[j].z, v[r][j].w * rstd * gg[j].w); o8[64 * j] = o; } }
}
__device__ __forceinline__ void rms_rows4_f32(float* xrow, const float* g, int lane) {
    f32x4 v[4][4]; float s[4];
#pragma unroll
    for (int r = 0; r < 4; ++r)
#pragma unroll
        for (int j = 0; j < 4; ++j) v[r][j] = ((const f32x4*)(xrow + (size_t)r * 1024))[lane + 64 * j];
    f32x4 gg[4];
#pragma unroll
    for (int j = 0; j < 4; ++j) gg[j] = ((const f32x4*)g)[lane + 64 * j];
#pragma unroll
    for (int r = 0; r < 4; ++r) { s[r] = 0.f;
#pragma unroll
        for (int j = 0; j < 4; ++j) s[r] += (v[r][j].x * v[r][j].x + v[r][j].y * v[r][j].y) + (v[r][j].z * v[r][j].z + v[r][j].w * v[r][j].w); }
#pragma unroll
    for (int o = 1; o < 64; o <<= 1) {
#pragma unroll
        for (int r = 0; r < 4; ++r) s[r] += __shfl_xor(s[r], o); }
#pragma unroll
    for (int r = 0; r < 4; ++r) { const float rstd = __builtin_amdgcn_rsqf(s[r] * (1.0f / 1024.0f) + EPS);
        f32x4* xo = (f32x4*)(xrow + (size_t)r * 1024) + lane;
#pragma unroll
        for (int j = 0; j < 4; ++j) { f32x4 o; o.x = v[r][j].x * rstd * gg[j].x; o.y = v[r][j].y * rstd * gg[j].y; o.z = v[r][j].z * rstd * gg[j].z; o.w = v[r][j].w * rstd * gg[j].w; __builtin_nontemporal_store(o, &xo[64 * j]); } }
}

__device__ __forceinline__ void conv_even_item(const bf16_t* z, const float* cw, const float* cb, bf16_t* y, int t0, int T, int lane) {
    const int s = t0 & (T - 1);
#pragma unroll
    for (int half = 0; half < 2; ++half) {
        const int c0 = half * 512 + lane * 8;
        const bf16_t* zr = z + (size_t)t0 * LDZ + c0;
        u32x4_t cg[4], xv[4], bg[2], ga[2];
#pragma unroll
        for (int i = 0; i < 4; ++i) { cg[i] = (u32x4_t){0u, 0u, 0u, 0u}; xv[i] = (u32x4_t){0u, 0u, 0u, 0u}; }
        if (s > 0) { cg[0] = *(const u32x4_t*)(zr - LDZ + 1024); xv[0] = *(const u32x4_t*)(zr - LDZ + 2048); }
        cg[1] = *(const u32x4_t*)(zr + 1024); xv[1] = *(const u32x4_t*)(zr + 2048);
        cg[2] = *(const u32x4_t*)(zr + LDZ + 1024); xv[2] = *(const u32x4_t*)(zr + LDZ + 2048);
        if (s + 2 < T) { cg[3] = *(const u32x4_t*)(zr + 2 * LDZ + 1024); xv[3] = *(const u32x4_t*)(zr + 2 * LDZ + 2048); }
        bg[0] = *(const u32x4_t*)(zr); ga[0] = *(const u32x4_t*)(zr + 3072);
        bg[1] = *(const u32x4_t*)(zr + LDZ); ga[1] = *(const u32x4_t*)(zr + LDZ + 3072);
        float w0[8], w1[8], w2[8], bb[8];
#pragma unroll
        for (int e = 0; e < 8; e += 4) {
            const f32x4 a = *(const f32x4*)(cw + c0 + e), b = *(const f32x4*)(cw + 1024 + c0 + e), c = *(const f32x4*)(cw + 2048 + c0 + e), d = *(const f32x4*)(cb + c0 + e);
#pragma unroll
            for (int k = 0; k < 4; ++k) { w0[e + k] = a[k]; w1[e + k] = b[k]; w2[e + k] = c[k]; bb[e + k] = d[k]; }
        }
        float p[4][8];
#pragma unroll
        for (int i = 0; i < 4; ++i)
#pragma unroll
            for (int k = 0; k < 4; ++k) { p[i][2 * k] = bflo(cg[i][k]) * bflo(xv[i][k]); p[i][2 * k + 1] = bfhi(cg[i][k]) * bfhi(xv[i][k]); }
#pragma unroll
        for (int tt = 0; tt < 2; ++tt) {
            float o[8];
#pragma unroll
            for (int k = 0; k < 4; ++k) {
                const float cl = bb[2 * k] + w0[2 * k] * p[tt][2 * k] + w1[2 * k] * p[tt + 1][2 * k] + w2[2 * k] * p[tt + 2][2 * k];
                const float ch = bb[2 * k + 1] + w0[2 * k + 1] * p[tt][2 * k + 1] + w1[2 * k + 1] * p[tt + 1][2 * k + 1] + w2[2 * k + 1] * p[tt + 2][2 * k + 1];
                o[2 * k] = bflo(bg[tt][k]) * cl * silu(bflo(ga[tt][k]));
                o[2 * k + 1] = bfhi(bg[tt][k]) * ch * silu(bfhi(ga[tt][k]));
            }
            u32x4_t w; w.x = pk2(o[0], o[1]); w.y = pk2(o[2], o[3]); w.z = pk2(o[4], o[5]); w.w = pk2(o[6], o[7]);
            *(u32x4_t*)(y + (size_t)(t0 + tt) * LDY + c0) = w;
        }
    }
}

__device__ __forceinline__ void conv_odd_item(const bf16_t* z, const float* cw, const float* cb, bf16_t* xc, int t, int T, int lane) {
    const int s = t & (T - 1);
#pragma unroll
    for (int half = 0; half < 2; ++half) {
        const int c0 = half * 512 + lane * 8;
        const bf16_t* zr = z + (size_t)t * LDZ + c0;
        float acc[8];
#pragma unroll
        for (int e = 0; e < 8; e += 4) { const f32x4 d = *(const f32x4*)(cb + c0 + e); acc[e] = d[0]; acc[e + 1] = d[1]; acc[e + 2] = d[2]; acc[e + 3] = d[3]; }
#pragma unroll
        for (int j = 0; j < 4; ++j) {
            const int sj = s + j - 2;
            if (sj >= 0 && sj < T) {
                const u32x4_t xv = *(const u32x4_t*)(zr + (ptrdiff_t)(j - 2) * LDZ);
                const f32x4 wa = *(const f32x4*)(cw + j * 1024 + c0), wb = *(const f32x4*)(cw + j * 1024 + c0 + 4);
                acc[0] += wa[0] * bflo(xv[0]); acc[1] += wa[1] * bfhi(xv[0]); acc[2] += wa[2] * bflo(xv[1]); acc[3] += wa[3] * bfhi(xv[1]);
                acc[4] += wb[0] * bflo(xv[2]); acc[5] += wb[1] * bfhi(xv[2]); acc[6] += wb[2] * bflo(xv[3]); acc[7] += wb[3] * bfhi(xv[3]);
            }
        }
        u32x4_t w; w.x = pk2(acc[0], acc[1]); w.y = pk2(acc[2], acc[3]); w.z = pk2(acc[4], acc[5]); w.w = pk2(acc[6], acc[7]);
        *(u32x4_t*)(xc + (size_t)t * 1024 + c0) = w;
    }
}
__device__ __forceinline__ void rstd_item(const float* part, float* rstd, int tg, int lane) {
    const float* p = part + tg * 64 + lane; float s = 0.f;
#pragma unroll
    for (int i = 0; i < 8; ++i) s += p[(size_t)i * SEG];
    rstd[tg * 64 + lane] = __builtin_amdgcn_rsqf(s * (1.0f / 1024.0f) + EPS);
}

constexpr int NA_RING = 9 * 16384, NA_RPB = NA_RING, NA_LDS_END = NA_RING + 2048;
__device__ __forceinline__ int na_fk(int key) { return ((key >> 1) & 1) | (((key >> 3) & 3) << 1); }
__device__ __forceinline__ void na_stage_row(const bf16_t* z, const bf16_t* vT, LAS unsigned char* slot, int tokr, int h, int lt, int nth) {
    for (int idx = lt; idx < 512; idx += nth) {
        const int rw = idx >> 3, c = idx & 7;
        const u32x4_t kv = *(const u32x4_t*)(z + (size_t)(tokr + rw) * LDZ + 5120 + h * 64 + c * 8);
        const u32x4_t vv = *(const u32x4_t*)(vT + (size_t)(h * 64 + rw) * SEG + tokr + c * 8);
        *(LAS u32x4_t*)(slot + rw * 128 + ((c ^ na_fk(rw)) << 4)) = kv;
        *(LAS u32x4_t*)(slot + 8192 + rw * 128 + ((c ^ ((rw >> 1) & 7)) << 4)) = vv;
    }
}
__device__ __forceinline__ void na_block(const bf16_t* z, const bf16_t* vT, bf16_t* y, const float* rpb, int unit, int T, LAS unsigned char* lds, int tid) {
    const int h = unit & 15, R0 = (unit >> 4) * 16;
    const int rows = T >> 6, seq = R0 / rows, rr0 = R0 - seq * rows, seq_base = seq * T;
    const int lane = tid & 63, wid = tid >> 6, fr = lane & 15, fq = lane >> 4;
    LAS float* rpbL = (LAS float*)(lds + NA_RPB);
    __syncthreads();
    for (int i = tid; i < 465; i += 512) rpbL[i] = rpb[h * 465 + i];
    int rs0 = rr0 - 4; rs0 = rs0 < 0 ? 0 : rs0; rs0 = rs0 > rows - 8 ? rows - 8 : rs0;
    {
        const int rw = tid >> 3, c = tid & 7;
        u32x4_t kv[8], vv[8];
#pragma unroll
        for (int kr = 0; kr < 8; ++kr) { const int tokr = seq_base + (rs0 + kr) * 64;
            kv[kr] = *(const u32x4_t*)(z + (size_t)(tokr + rw) * LDZ + 5120 + h * 64 + c * 8);
            vv[kr] = *(const u32x4_t*)(vT + (size_t)(h * 64 + rw) * SEG + tokr + c * 8); }
#pragma unroll
        for (int kr = 0; kr < 8; ++kr) { LAS unsigned char* slot = lds + ((rs0 + kr) % 9) * 16384;
            *(LAS u32x4_t*)(slot + rw * 128 + ((c ^ na_fk(rw)) << 4)) = kv[kr];
            *(LAS u32x4_t*)(slot + 8192 + rw * 128 + ((c ^ ((rw >> 1) & 7)) << 4)) = vv[kr]; }
    }
    __syncthreads();
    const int g = wid & 3;
    const int wb = (g == 0) ? 0 : (g == 1) ? 8 : (g == 2) ? 24 : 32;
    const int keyA = wb + (fr >> 2) * 8 + (fr & 3);
    const int offK0 = keyA * 128 + (((0 + fq) ^ na_fk(keyA)) << 4), offK1 = keyA * 128 + (((4 + fq) ^ na_fk(keyA)) << 4);
    const int offV = 8192 + fr * 128 + ((((wb >> 3) + fq) ^ ((fr >> 1) & 7)) << 4);
    const int qc = g * 16 + fr;
    int cstart = qc - 8; cstart = cstart < 0 ? 0 : cstart; cstart = cstart > 48 ? 48 : cstart;
    int dcs[8]; bool oks[8];
#pragma unroll
    for (int e = 0; e < 8; ++e) { const int kc = wb + fq * 8 + e; oks[e] = (kc >= cstart) && (kc < cstart + 16); int dc = kc - qc; dc = dc < -15 ? -15 : dc; dc = dc > 15 ? 15 : dc; dcs[e] = dc + 15; }
    const bf16_t* zt = z + (size_t)(seq_base + rr0 * 64 + g * 16 + fr) * LDZ;
    bf16x8 q0 = ld8(zt + 4096 + h * 64 + fq * 8), q1 = ld8(zt + 4096 + h * 64 + fq * 8 + 32);
    u32x2_t gr[4];
#pragma unroll
    for (int dt = 0; dt < 4; ++dt) gr[dt] = *(const u32x2_t*)(zt + 6144 + h * 64 + dt * 16 + fq * 4);
#pragma unroll 1
    for (int i = 0; i < 16; ++i) {
        const int rr = rr0 + i;
        int rs = rr - 4; rs = rs < 0 ? 0 : rs; rs = rs > rows - 8 ? rows - 8 : rs;
        int rsn = rr - 3; rsn = rsn < 0 ? 0 : rsn; rsn = rsn > rows - 8 ? rows - 8 : rsn;
        if (wid >= 4) {
            if (i < 15 && rsn > rs) { const int a = rsn + 7, tokr = seq_base + a * 64, lt = tid - 256; LAS unsigned char* slot = lds + (a % 9) * 16384;
                u32x4_t kv[2], vv[2];
#pragma unroll
                for (int j = 0; j < 2; ++j) { const int idx = lt + 256 * j, rw = idx >> 3, c = idx & 7;
                    kv[j] = *(const u32x4_t*)(z + (size_t)(tokr + rw) * LDZ + 5120 + h * 64 + c * 8); vv[j] = *(const u32x4_t*)(vT + (size_t)(h * 64 + rw) * SEG + tokr + c * 8); }
#pragma unroll
                for (int j = 0; j < 2; ++j) { const int idx = lt + 256 * j, rw = idx >> 3, c = idx & 7;
                    *(LAS u32x4_t*)(slot + rw * 128 + ((c ^ na_fk(rw)) << 4)) = kv[j]; *(LAS u32x4_t*)(slot + 8192 + rw * 128 + ((c ^ ((rw >> 1) & 7)) << 4)) = vv[j]; } }
        } else {
            const bf16_t* ztc = zt + (size_t)i * 64 * LDZ;
            bf16x8 q0n = q0, q1n = q1; u32x2_t grn[4];
#pragma unroll
            for (int dt = 0; dt < 4; ++dt) grn[dt] = gr[dt];
            if (i < 15) {
                const bf16_t* ztn = ztc + (size_t)64 * LDZ;
                q0n = ld8(ztn + 4096 + h * 64 + fq * 8); q1n = ld8(ztn + 4096 + h * 64 + fq * 8 + 32);
#pragma unroll
                for (int dt = 0; dt < 4; ++dt) grn[dt] = *(const u32x2_t*)(ztn + 6144 + h * 64 + dt * 16 + fq * 4);
            }
            const LAS float* bp0 = rpbL + (rs - rr + 7) * 31;
            float s[8][8];
            float mx = -1e30f;
            int slot = rs % 9;
#pragma unroll
            for (int kr = 0; kr < 8; ++kr) {
                const LAS unsigned char* sb = lds + slot * 16384;
                slot = (slot == 8) ? 0 : slot + 1;
                const bf16x8 k00 = *(const LAS bf16x8*)(sb + offK0), k01 = *(const LAS bf16x8*)(sb + offK1);
                const bf16x8 k10 = *(const LAS bf16x8*)(sb + offK0 + 512), k11 = *(const LAS bf16x8*)(sb + offK1 + 512);
                f32x4 a0 = {0.f, 0.f, 0.f, 0.f}, a1 = {0.f, 0.f, 0.f, 0.f};
                a0 = mfma16(k00, q0, a0); a0 = mfma16(k01, q1, a0);
                a1 = mfma16(k10, q0, a1); a1 = mfma16(k11, q1, a1);
#pragma unroll
                for (int e = 0; e < 8; ++e) {
                    const float sc = (e < 4 ? a0[e & 3] : a1[e & 3]) * 0.125f + bp0[kr * 31 + dcs[e]];
                    s[kr][e] = oks[e] ? sc : -1e30f;
                    mx = fmaxf(mx, s[kr][e]);
                }
            }
            mx = fmaxf(mx, __shfl_xor(mx, 16)); mx = fmaxf(mx, __shfl_xor(mx, 32));
            float sum = 0.f;
#pragma unroll
            for (int kr = 0; kr < 8; ++kr)
#pragma unroll
                for (int e = 0; e < 8; ++e) { const float p = __expf(s[kr][e] - mx); s[kr][e] = p; sum += p; }
            sum += __shfl_xor(sum, 16); sum += __shfl_xor(sum, 32);
            f32x4 o[4];
#pragma unroll
            for (int dt = 0; dt < 4; ++dt) o[dt] = (f32x4){0.f, 0.f, 0.f, 0.f};
            slot = rs % 9;
#pragma unroll
            for (int kr = 0; kr < 8; ++kr) {
                const LAS unsigned char* sb = lds + slot * 16384 + offV;
                slot = (slot == 8) ? 0 : slot + 1;
                const bf16x8 pf = pack8(s[kr]);
#pragma unroll
                for (int dt = 0; dt < 4; ++dt) o[dt] = mfma16(*(const LAS bf16x8*)(sb + dt * 2048), pf, o[dt]);
            }
            const float inv = frcp(sum);
            bf16_t* yt = y + (size_t)(seq_base + rr * 64 + g * 16 + fr) * LDY + 1024 + h * 64;
#pragma unroll
            for (int dt = 0; dt < 4; ++dt) {
                u32x2_t ow;
                ow.x = pk2(o[dt][0] * inv * silu(bflo(gr[dt].x)), o[dt][1] * inv * silu(bfhi(gr[dt].x)));
                ow.y = pk2(o[dt][2] * inv * silu(bflo(gr[dt].y)), o[dt][3] * inv * silu(bfhi(gr[dt].y)));
                *(u32x2_t*)(yt + dt * 16 + fq * 4) = ow;
            }
            q0 = q0n; q1 = q1n;
#pragma unroll
            for (int dt = 0; dt < 4; ++dt) gr[dt] = grn[dt];
        }
        __syncthreads();
    }
}

__device__ __forceinline__ void mem_unit(const bf16_t* z, int qcol, int gcol, const bf16_t* mk, const bf16_t* mvT, bf16_t* y, int unit, int seg, LAS unsigned char* lds, int tid) {
    const int h = unit & 3, range = unit >> 2, tokr = range * 256;
    const int mb = seg < 2 ? seg : 2 + (tokr >> 12);
    const int lane = tid & 63, wid = tid >> 6, fr = lane & 15, fq = lane >> 4;
    __syncthreads();
    {
        u32x4_t kv[8], vv[8];
#pragma unroll
        for (int i = 0; i < 8; ++i) { const int idx = tid + 512 * i;
            kv[i] = *(const u32x4_t*)(mk + (size_t)(mb * 256 + (idx >> 4)) * 512 + h * 128 + (idx & 15) * 8);
            vv[i] = *(const u32x4_t*)(mvT + (size_t)(h * 128 + (idx >> 5)) * 1536 + mb * 256 + (idx & 31) * 8); }
#pragma unroll
        for (int i = 0; i < 8; ++i) { const int idx = tid + 512 * i;
            { const int rho = idx >> 4, c = idx & 15, f = (rho & 3) | (((rho >> 3) & 3) << 2); *(LAS u32x4_t*)(lds + rho * 256 + ((c ^ f) << 4)) = kv[i]; }
            { const int d = idx >> 5, c = idx & 31; *(LAS u32x4_t*)(lds + 65536 + d * 512 + ((c ^ (d & 15)) << 4)) = vv[i]; } }
    }
    __syncthreads();
    const int mrowA = (fr >> 2) * 8 + (fr & 3);
    const LAS unsigned char* kbase = lds + mrowA * 256 + ((fq ^ (fr & 3)) << 4);
    const LAS unsigned char* vbase = lds + 65536 + fr * 512 + ((fq ^ (fr & 3)) << 4);
    const int hi = fr >> 2;
#pragma unroll 1
    for (int gi = 0; gi < 2; ++gi) {
        const int tok = tokr + (wid + 8 * gi) * 16 + fr;
        const bf16_t* qp = z + (size_t)tok * LDZ + qcol + h * 128 + fq * 8;
        bf16x8 q[4];
#pragma unroll
        for (int ks = 0; ks < 4; ++ks) q[ks] = ld8(qp + ks * 32);
        u32x2_t gr[8];
#pragma unroll
        for (int dt = 0; dt < 8; ++dt) gr[dt] = *(const u32x2_t*)(z + (size_t)tok * LDZ + gcol + h * 128 + dt * 16 + fq * 4);
        float s[8][8];
        float mx = -1e30f;
#pragma unroll
        for (int kb = 0; kb < 8; ++kb) {
            f32x4 a0 = {0.f, 0.f, 0.f, 0.f}, a1 = {0.f, 0.f, 0.f, 0.f};
#pragma unroll
            for (int ks = 0; ks < 4; ++ks) {
                const LAS unsigned char* kp = kbase + kb * 8192 + ((ks ^ hi) << 6);
                a0 = mfma16(*(const LAS bf16x8*)kp, q[ks], a0); a1 = mfma16(*(const LAS bf16x8*)(kp + 1024), q[ks], a1);
            }
#pragma unroll
            for (int e = 0; e < 8; ++e) { s[kb][e] = (e < 4 ? a0[e & 3] : a1[e & 3]) * 0.08838834764831845f; mx = fmaxf(mx, s[kb][e]); }
        }
        mx = fmaxf(mx, __shfl_xor(mx, 16)); mx = fmaxf(mx, __shfl_xor(mx, 32));
        float sum = 0.f;
#pragma unroll
        for (int kb = 0; kb < 8; ++kb)
#pragma unroll
            for (int e = 0; e < 8; ++e) { const float p = __expf(s[kb][e] - mx); s[kb][e] = p; sum += p; }
        sum += __shfl_xor(sum, 16); sum += __shfl_xor(sum, 32);
        f32x4 o[8];
#pragma unroll
        for (int dt = 0; dt < 8; ++dt) o[dt] = (f32x4){0.f, 0.f, 0.f, 0.f};
#pragma unroll
        for (int kb = 0; kb < 8; ++kb) {
            const bf16x8 pf = pack8(s[kb]);
            const LAS unsigned char* vp = vbase + (((kb ^ hi) & 7) << 6);
#pragma unroll
            for (int dt = 0; dt < 8; ++dt) o[dt] = mfma16(*(const LAS bf16x8*)(vp + dt * 8192), pf, o[dt]);
        }
        const float inv = frcp(sum);
#pragma unroll
        for (int dt = 0; dt < 8; ++dt) {
            const int d4 = dt * 16 + fq * 4;
            u32x2_t ow;
            ow.x = pk2(o[dt][0] * inv * silu(bflo(gr[dt].x)), o[dt][1] * inv * silu(bfhi(gr[dt].x)));
            ow.y = pk2(o[dt][2] * inv * silu(bflo(gr[dt].y)), o[dt][3] * inv * silu(bfhi(gr[dt].y)));
            *(u32x2_t*)(y + (size_t)tok * LDY + 2048 + h * 128 + d4) = ow;
        }
    }
}

template <int CTRL> __device__ __forceinline__ float dppf(float oldv, float src) {
    return __int_as_float(__builtin_amdgcn_update_dpp(__float_as_int(oldv), __float_as_int(src), CTRL, 0xf, 0xf, false));
}
#define SCAN_STEP(SH) \
    "v_fmac_f32_dpp %4, %4, %0 " SH " row_mask:0xf bank_mask:0xf\n" \
    "v_fmac_f32_dpp %5, %5, %1 " SH " row_mask:0xf bank_mask:0xf\n" \
    "v_fmac_f32_dpp %6, %6, %2 " SH " row_mask:0xf bank_mask:0xf\n" \
    "v_fmac_f32_dpp %7, %7, %3 " SH " row_mask:0xf bank_mask:0xf\n" \
    "v_mul_f32_dpp %0, %0, %0 " SH " row_mask:0xf bank_mask:0xf\n" \
    "v_mul_f32_dpp %1, %1, %1 " SH " row_mask:0xf bank_mask:0xf\n" \
    "v_mul_f32_dpp %2, %2, %2 " SH " row_mask:0xf bank_mask:0xf\n" \
    "v_mul_f32_dpp %3, %3, %3 " SH " row_mask:0xf bank_mask:0xf\n"
template <int DIR> __device__ __forceinline__ void scan16x4(float (&A)[4], float (&B)[4]) {
    if (DIR == 0)
        asm volatile("s_nop 1\n" SCAN_STEP("row_shr:1") SCAN_STEP("row_shr:2") SCAN_STEP("row_shr:4") SCAN_STEP("row_shr:8")
                     : "+v"(A[0]), "+v"(A[1]), "+v"(A[2]), "+v"(A[3]), "+v"(B[0]), "+v"(B[1]), "+v"(B[2]), "+v"(B[3]));
    else
        asm volatile("s_nop 1\n" SCAN_STEP("row_shl:1") SCAN_STEP("row_shl:2") SCAN_STEP("row_shl:4") SCAN_STEP("row_shl:8")
                     : "+v"(A[0]), "+v"(A[1]), "+v"(A[2]), "+v"(A[3]), "+v"(B[0]), "+v"(B[1]), "+v"(B[2]), "+v"(B[3]));
}
template <int DIR> __device__ __forceinline__ void bcast4(const float (&v)[4], float (&o)[4]) {
    if (DIR == 0)
        asm volatile("s_nop 1\n"
                     "v_mov_b32_dpp %0, %4 row_newbcast:15 row_mask:0xf bank_mask:0xf\n" "v_mov_b32_dpp %1, %5 row_newbcast:15 row_mask:0xf bank_mask:0xf\n"
                     "v_mov_b32_dpp %2, %6 row_newbcast:15 row_mask:0xf bank_mask:0xf\n" "v_mov_b32_dpp %3, %7 row_newbcast:15 row_mask:0xf bank_mask:0xf\n"
                     : "=&v"(o[0]), "=&v"(o[1]), "=&v"(o[2]), "=&v"(o[3]) : "v"(v[0]), "v"(v[1]), "v"(v[2]), "v"(v[3]));
    else
        asm volatile("s_nop 1\n"
                     "v_mov_b32_dpp %0, %4 row_newbcast:0 row_mask:0xf bank_mask:0xf\n" "v_mov_b32_dpp %1, %5 row_newbcast:0 row_mask:0xf bank_mask:0xf\n"
                     "v_mov_b32_dpp %2, %6 row_newbcast:0 row_mask:0xf bank_mask:0xf\n" "v_mov_b32_dpp %3, %7 row_newbcast:0 row_mask:0xf bank_mask:0xf\n"
                     : "=&v"(o[0]), "=&v"(o[1]), "=&v"(o[2]), "=&v"(o[3]) : "v"(v[0]), "v"(v[1]), "v"(v[2]), "v"(v[3]));
}
struct LruW { bf16x8 Wa[4], Wi[4]; float ba[4], bi[4], c8[4]; };
struct LruX { bf16x8 x[2][4]; u32x2_t xr[2]; };
__device__ __forceinline__ void lru_loadw(LruW& W, const bf16_t* lruw, const float* ba_, const float* bi_, const float* lam_, int dir, int blk, int w, int ch4, int lane) {
    const int fr = lane & 15, fq = lane >> 4;
    const bf16_t* wa = lruw + ((size_t)((0 * 2 + dir) * 8 + blk) * 128 + w * 16 + fr) * 128 + fq * 8;
    const bf16_t* wi = lruw + ((size_t)((1 * 2 + dir) * 8 + blk) * 128 + w * 16 + fr) * 128 + fq * 8;
#pragma unroll
    for (int ks = 0; ks < 4; ++ks) { W.Wa[ks] = ld8(wa + ks * 32); W.Wi[ks] = ld8(wi + ks * 32); }
    const f32x4 a = *(const f32x4*)(ba_ + dir * 1024 + ch4), b = *(const f32x4*)(bi_ + dir * 1024 + ch4), l = *(const f32x4*)(lam_ + dir * 1024 + ch4);
#pragma unroll
    for (int jj = 0; jj < 4; ++jj) { W.ba[jj] = -1.4426950408889634f * a[jj]; W.bi[jj] = -1.4426950408889634f * b[jj]; W.c8[jj] = -8.0f * 1.4426950408889634f * log1pf(__expf(-l[jj])); }
}
__device__ __forceinline__ void conv_tile_to_lds(const bf16_t* z, const float* cw, const float* cb, LAS unsigned char* xl, int chunk, int blk, int T, int tid) {
    const int c = tid & 15, ch0 = blk * 128 + c * 8;
    float w[4][8], bb[8];
#pragma unroll
    for (int j = 0; j < 4; ++j) { const f32x4 a = *(const f32x4*)(cw + j * 1024 + ch0), b = *(const f32x4*)(cw + j * 1024 + ch0 + 4);
#pragma unroll
        for (int e = 0; e < 4; ++e) { w[j][e] = a[e]; w[j][4 + e] = b[e]; } }
    { const f32x4 a = *(const f32x4*)(cb + ch0), b = *(const f32x4*)(cb + ch0 + 4);
#pragma unroll
        for (int e = 0; e < 4; ++e) { bb[e] = a[e]; bb[4 + e] = b[e]; } }
    u32x4_t xin[4][4];
#pragma unroll
    for (int i = 0; i < 4; ++i) {
        const int r = (tid >> 4) + 32 * i, t = chunk * 128 + r, s = t & (T - 1);
#pragma unroll
        for (int j = 0; j < 4; ++j) {
            const int sj = s + j - 2;
            xin[i][j] = (u32x4_t){0u, 0u, 0u, 0u};
            if (sj >= 0 && sj < T) xin[i][j] = *(const u32x4_t*)(z + (size_t)(t + j - 2) * LDZ + ch0);
        }
    }
#pragma unroll
    for (int i = 0; i < 4; ++i) {
        const int r = (tid >> 4) + 32 * i;
        float acc[8];
#pragma unroll
        for (int e = 0; e < 8; ++e) acc[e] = bb[e];
#pragma unroll
        for (int j = 0; j < 4; ++j) {
            const u32x4_t xv = xin[i][j];
            acc[0] += w[j][0] * bflo(xv[0]); acc[1] += w[j][1] * bfhi(xv[0]); acc[2] += w[j][2] * bflo(xv[1]); acc[3] += w[j][3] * bfhi(xv[1]);
            acc[4] += w[j][4] * bflo(xv[2]); acc[5] += w[j][5] * bfhi(xv[2]); acc[6] += w[j][6] * bflo(xv[3]); acc[7] += w[j][7] * bfhi(xv[3]);
        }
        u32x4_t o; o.x = pk2(acc[0], acc[1]); o.y = pk2(acc[2], acc[3]); o.z = pk2(acc[4], acc[5]); o.w = pk2(acc[6], acc[7]);
        *(LAS u32x4_t*)(xl + r * 256 + ((c ^ (r & 15)) << 4)) = o;
    }
}
__device__ __forceinline__ void lru_loadx(LruX& X, const LAS unsigned char* xl, int r0, int w, int lane) {
    const int fr = lane & 15, fq = lane >> 4;
#pragma unroll
    for (int t = 0; t < 2; ++t) {
        const int r = r0 + t * 16 + fr;
        const LAS unsigned char* rp = xl + r * 256;
#pragma unroll
        for (int ks = 0; ks < 4; ++ks) X.x[t][ks] = *(const LAS bf16x8*)(rp + (((ks * 4 + fq) ^ fr) << 4));
        X.xr[t] = *(const LAS u32x2_t*)(rp + (((w * 2 + (fq >> 1)) ^ fr) << 4) + (fq & 1) * 8);
    }
}
template <int DIR, bool FINAL> __device__ __forceinline__ void lru_tile(const bf16x8 (&Xf)[4], const u32x2_t xr, const LruW& W, int lane, float (&hin)[4], float (&arun)[4], float (&hout)[4], unsigned (&lab)[4]) {
    f32x4 accR = {0.f, 0.f, 0.f, 0.f}, accI = {0.f, 0.f, 0.f, 0.f};
#pragma unroll
    for (int ks = 0; ks < 4; ++ks) { accR = mfma16(W.Wa[ks], Xf[ks], accR); accI = mfma16(W.Wi[ks], Xf[ks], accI); }
    const float xv[4] = {bflo(xr.x), bfhi(xr.x), bflo(xr.y), bfhi(xr.y)};
    const int src = (lane & 48) + (DIR == 0 ? 15 : 0);
    float A[4], B[4];
    typedef float f32x2 __attribute__((ext_vector_type(2)));
#pragma unroll
    for (int p = 0; p < 2; ++p) {
        const f32x2 ar = {accR[2 * p], accR[2 * p + 1]}, ai = {accI[2 * p], accI[2 * p + 1]};
        const f32x2 bar = {W.ba[2 * p], W.ba[2 * p + 1]}, bai = {W.bi[2 * p], W.bi[2 * p + 1]}, c8v = {W.c8[2 * p], W.c8[2 * p + 1]}, xvv = {xv[2 * p], xv[2 * p + 1]};
        const f32x2 tr = ar * (-1.4426950408889634f) + bar, ti = ai * (-1.4426950408889634f) + bai;
        f32x2 er, ei; er.x = __builtin_amdgcn_exp2f(tr.x); er.y = __builtin_amdgcn_exp2f(tr.y); ei.x = __builtin_amdgcn_exp2f(ti.x); ei.y = __builtin_amdgcn_exp2f(ti.y);
        er = er + 1.0f; ei = ei + 1.0f;
        f32x2 rg, ig; rg.x = frcp(er.x); rg.y = frcp(er.y); ig.x = frcp(ei.x); ig.y = frcp(ei.y);
        const f32x2 la = c8v * rg;
        f32x2 Av; Av.x = __builtin_amdgcn_exp2f(la.x); Av.y = __builtin_amdgcn_exp2f(la.y);
        f32x2 om = 1.0f - Av * Av;
        f32x2 sq; sq.x = __builtin_amdgcn_sqrtf(fmaxf(om.x, 0.f)); sq.y = __builtin_amdgcn_sqrtf(fmaxf(om.y, 0.f));
        const f32x2 Bv = sq * (ig * xvv);
        A[2 * p] = Av.x; A[2 * p + 1] = Av.y; B[2 * p] = Bv.x; B[2 * p + 1] = Bv.y;
        lab[2 * p] = __builtin_bit_cast(unsigned, __builtin_amdgcn_cvt_pkrtz(la.x, Bv.x));
        lab[2 * p + 1] = __builtin_bit_cast(unsigned, __builtin_amdgcn_cvt_pkrtz(la.y, Bv.y));
    }
    scan16x4<DIR>(A, B);
#pragma unroll
    for (int jj = 0; jj < 4; ++jj) hout[jj] = A[jj] * hin[jj] + B[jj];
    bcast4<DIR>(hout, hin);
    if (!FINAL) { float At[4]; bcast4<DIR>(A, At);
#pragma unroll
        for (int jj = 0; jj < 4; ++jj) arun[jj] *= At[jj]; }
}
template <bool FINAL> __device__ __forceinline__ void lru_item(const LAS unsigned char* xl, const bf16_t* z, const bf16_t* lruw, const float* ba_, const float* bi_, const float* lam_,
                                                               float* agg, const float* carry, bf16_t* y, unsigned* labuf, int item, int lane) {
    const int cgi = item & 63, chunk = item >> 6, blk = cgi >> 3, w = cgi & 7;
    const int fr = lane & 15, fq = lane >> 4;
    const int ch4 = blk * 128 + w * 16 + fq * 4;
    const int tokc = chunk * 128;
    LruX X[2]; LruW W0;
    lru_loadw(W0, lruw, ba_, bi_, lam_, 0, blk, w, ch4, lane);
    lru_loadx(X[0], xl, 0, w, lane);
    unsigned hf[8][2];
    float hin[4], arun[4];
#pragma unroll
    for (int jj = 0; jj < 4; ++jj) { hin[jj] = FINAL ? carry[(size_t)(0 * 128 + chunk) * 1024 + ch4 + jj] : 0.f; arun[jj] = 1.f; }
#pragma unroll
    for (int bi = 0; bi < 8; ++bi) {
        __builtin_amdgcn_sched_barrier(0);
        const int slot = bi < 4 ? (bi & 1) : ((bi + 1) & 1);
        const int pair = bi < 4 ? bi : 7 - bi;
        if (bi + 1 < 8 && bi + 1 != 4) {
            const int nslot = (bi + 1) < 4 ? ((bi + 1) & 1) : ((bi + 2) & 1);
            const int npair = (bi + 1) < 4 ? (bi + 1) : 7 - (bi + 1);
            lru_loadx(X[nslot], xl, npair * 32, w, lane);
        }
        if (bi == 4) {
            lru_loadw(W0, lruw, ba_, bi_, lam_, 1, blk, w, ch4, lane);
            if (!FINAL && fr == 0) {
#pragma unroll
                for (int jj = 0; jj < 4; ++jj) { float2 v; v.x = arun[jj]; v.y = hin[jj]; *(float2*)(agg + ((size_t)(0 * 128 + chunk) * 1024 + ch4 + jj) * 2) = v; }
            }
#pragma unroll
            for (int jj = 0; jj < 4; ++jj) { hin[jj] = FINAL ? carry[(size_t)(1 * 128 + chunk) * 1024 + ch4 + jj] : 0.f; arun[jj] = 1.f; }
        }
#pragma unroll
        for (int k = 0; k < 2; ++k) {
            const int t = bi < 4 ? k : 1 - k;
            const int tt = 2 * pair + t;
            float hv[4]; unsigned lab[4];
            if (bi < 4) lru_tile<0, FINAL>(X[slot].x[t], X[slot].xr[t], W0, lane, hin, arun, hv, lab);
            else lru_tile<1, FINAL>(X[slot].x[t], X[slot].xr[t], W0, lane, hin, arun, hv, lab);
            if (!FINAL) { u32x4_t lw; lw.x = lab[0]; lw.y = lab[1]; lw.z = lab[2]; lw.w = lab[3];
                *(u32x4_t*)(labuf + ((((size_t)(bi < 4 ? 0 : 1) * 128 + chunk) * 64 + cgi) * 8 + (2 * pair + t)) * 256 + lane * 4) = lw; }
            if (FINAL) {
                if (bi < 4) {
                    hf[tt][0] = pk2(hv[0], hv[1]); hf[tt][1] = pk2(hv[2], hv[3]);
                } else {
                    const int tok = tokc + tt * 16 + fr;
                    const u32x2_t gr = *(const u32x2_t*)(z + (size_t)tok * LDZ + 1024 + ch4);
                    const float gc[4] = {bflo(gr.x), bfhi(gr.x), bflo(gr.y), bfhi(gr.y)};
                    const float hfv[4] = {bflo(hf[tt][0]), bfhi(hf[tt][0]), bflo(hf[tt][1]), bfhi(hf[tt][1])};
                    float o[4];
#pragma unroll
                    for (int jj = 0; jj < 4; ++jj) o[jj] = (hfv[jj] + hv[jj]) * silu(gc[jj]);
                    u32x2_t ow; ow.x = pk2(o[0], o[1]); ow.y = pk2(o[2], o[3]);
                    *(u32x2_t*)(y + (size_t)tok * LDY + ch4) = ow;
                }
            }
        }
    }
    if (!FINAL && fr == 0) {
#pragma unroll
        for (int jj = 0; jj < 4; ++jj) { float2 v; v.x = arun[jj]; v.y = hin[jj]; *(float2*)(agg + ((size_t)(1 * 128 + chunk) * 1024 + ch4 + jj) * 2) = v; }
    }
}
struct LruF { u32x4_t L[2][8]; u32x2_t gr[8]; };
__device__ __forceinline__ void lru_final_load(LruF& F, const unsigned* labuf, const bf16_t* z, int item, int lane) {
    const int cgi = item & 63, chunk = item >> 6, fr = lane & 15, fq = lane >> 4;
    const int ch4 = cgi * 16 + fq * 4, tokc = chunk * 128;
#pragma unroll
    for (int d = 0; d < 2; ++d)
#pragma unroll
        for (int tt = 0; tt < 8; ++tt) F.L[d][tt] = __builtin_nontemporal_load((const u32x4_t*)(labuf + ((((size_t)d * 128 + chunk) * 64 + cgi) * 8 + tt) * 256 + lane * 4));
#pragma unroll
    for (int tt = 0; tt < 8; ++tt) F.gr[tt] = *(const u32x2_t*)(z + (size_t)(tokc + tt * 16 + fr) * LDZ + 1024 + ch4);
}
template <bool WAVEC> __device__ __forceinline__ void lru_final_compute(const LruF& F, const float* carry, float hcv, bf16_t* y, int item, int lane) {
    typedef _Float16 h2_t __attribute__((ext_vector_type(2)));
    const int cgi = item & 63, chunk = item >> 6;
    const int fr = lane & 15, fq = lane >> 4;
    const int ch4 = cgi * 16 + fq * 4, tokc = chunk * 128;
    float hf[8][4];
    {
        float hin[4];
#pragma unroll
        for (int jj = 0; jj < 4; ++jj) hin[jj] = WAVEC ? __shfl(hcv, fq * 4 + jj) : carry[(size_t)(0 * 128 + chunk) * 1024 + ch4 + jj];
#pragma unroll
        for (int tt = 0; tt < 8; ++tt) {
            float A[4], B[4];
#pragma unroll
            for (int jj = 0; jj < 4; ++jj) {
                const unsigned wv = F.L[0][tt][jj]; const h2_t v = __builtin_bit_cast(h2_t, wv);
                A[jj] = __builtin_amdgcn_exp2f((float)v.x); B[jj] = (float)v.y;
            }
            scan16x4<0>(A, B);
#pragma unroll
            for (int jj = 0; jj < 4; ++jj) hf[tt][jj] = A[jj] * hin[jj] + B[jj];
            bcast4<0>(hf[tt], hin);
        }
    }
    {
        float hin[4];
#pragma unroll
        for (int jj = 0; jj < 4; ++jj) hin[jj] = WAVEC ? __shfl(hcv, 16 + fq * 4 + jj) : carry[(size_t)(1 * 128 + chunk) * 1024 + ch4 + jj];
#pragma unroll
        for (int s = 0; s < 8; ++s) {
            const int tt = 7 - s;
            float o[4], A[4], B[4];
#pragma unroll
            for (int jj = 0; jj < 4; ++jj) {
                const unsigned wv = F.L[1][tt][jj]; const h2_t v = __builtin_bit_cast(h2_t, wv);
                A[jj] = __builtin_amdgcn_exp2f((float)v.x); B[jj] = (float)v.y;
            }
            scan16x4<1>(A, B);
            float hb[4];
#pragma unroll
            for (int jj = 0; jj < 4; ++jj) { hb[jj] = A[jj] * hin[jj] + B[jj]; o[jj] = hf[tt][jj] + hb[jj]; }
            bcast4<1>(hb, hin);
            const float gc[4] = {bflo(F.gr[tt].x), bfhi(F.gr[tt].x), bflo(F.gr[tt].y), bfhi(F.gr[tt].y)};
            u32x2_t ow; ow.x = pk2(o[0] * silu(gc[0]), o[1] * silu(gc[1])); ow.y = pk2(o[2] * silu(gc[2]), o[3] * silu(gc[3]));
            *(u32x2_t*)(y + (size_t)(tokc + tt * 16 + fr) * LDY + ch4) = ow;
        }
    }
}
__device__ __forceinline__ void wave_carries(const float* agg, int cgi, int chunk0, int nseq, int lane, float (&hc)[4]) {
    const int q = lane >> 4, ch = cgi * 16 + (lane & 15);
    const bool up = (lane & 16) != 0;
    float2 ag[2][32];
#pragma unroll
    for (int dir = 0; dir < 2; ++dir)
#pragma unroll
        for (int cc = 0; cc < 32; ++cc) ag[dir][cc] = *(const float2*)(agg + ((size_t)(dir * 128 + 32 * q + cc) * 1024 + ch) * 2);
#pragma unroll
    for (int dir = 0; dir < 2; ++dir) {
        float A = 1.f, h = 0.f, Ap = 1.f, Hp = 0.f;
#pragma unroll
        for (int step = 0; step < 32; ++step) {
            const int cc = dir == 0 ? step : 31 - step;
            if (cc == chunk0) { Ap = A; Hp = h; }
            const float2 ah = ag[dir][cc];
            h = ah.x * h + ah.y; A *= ah.x;
        }
        float Aq[4], Hq[4], Apk[4], Hpk[4];
#pragma unroll
        for (int k = 0; k < 4; ++k) { const int src = k * 16 + (lane & 15); Aq[k] = __shfl(A, src); Hq[k] = __shfl(h, src); Apk[k] = __shfl(Ap, src); Hpk[k] = __shfl(Hp, src); }
        float S[4];
        if (dir == 0) { S[0] = 0.f; S[1] = Hq[0]; S[2] = Aq[1] * S[1] + Hq[1]; S[3] = Aq[2] * S[2] + Hq[2]; }
        else { S[3] = 0.f; S[2] = Hq[3]; S[1] = Aq[2] * S[2] + Hq[2]; S[0] = Aq[1] * S[1] + Hq[1]; }
#pragma unroll
        for (int k = 0; k < 4; ++k) { const float v = Apk[k] * (nseq == 1 ? S[k] : 0.f) + Hpk[k]; if (dir == 0) hc[k] = v; else hc[k] = up ? v : hc[k]; }
    }
}
__device__ __forceinline__ void carry_phase(const float* agg, float* carry, int nseq, int gtid, int gthreads) {
    const int nc = 128 / nseq;
    for (int idx = gtid; idx < 2 * nseq * 1024; idx += gthreads) {
        const int ch = idx & 1023, rest = idx >> 10, dir = rest & 1, sq = rest >> 1, base = sq * nc;
        float h = 0.f;
#pragma unroll 8
        for (int c = 0; c < nc; ++c) {
            const int C = base + (dir == 0 ? c : nc - 1 - c);
            const size_t o = (size_t)(dir * 128 + C) * 1024 + ch;
            const float2 ah = *(const float2*)(agg + o * 2);
            carry[o] = h;
            h = ah.x * h + ah.y;
        }
    }
}

__device__ __forceinline__ void sgu_item2(const bf16_t* vT, const LAS float* rstd, const LAS unsigned char* wsl, const bf16_t* z, const float* sgu_g, const float* sgu_b, bf16_t* y,
                                          int n, int g, int qd, int lane) {
    const int fr = lane & 15, fq = lane >> 4;
    const int tokc = n * 128, chq = g * 128 + qd * 32;
    bf16x8 Af[2][4];
#pragma unroll
    for (int t = 0; t < 2; ++t) {
        const bf16_t* ap = vT + (size_t)(chq + (fr >> 2) * 8 + (fr & 3) + 4 * t) * SEG + tokc + fq * 8;
#pragma unroll
        for (int ks = 0; ks < 4; ++ks) {
            const u32x4_t raw = *(const u32x4_t*)(ap + ks * 32);
            const f32x4 r0 = *(const LAS f32x4*)(rstd + ks * 32 + fq * 8), r1 = *(const LAS f32x4*)(rstd + ks * 32 + fq * 8 + 4);
            u32x4_t w;
            w.x = pk2(bflo(raw.x) * r0[0], bfhi(raw.x) * r0[1]); w.y = pk2(bflo(raw.y) * r0[2], bfhi(raw.y) * r0[3]);
            w.z = pk2(bflo(raw.z) * r1[0], bfhi(raw.z) * r1[1]); w.w = pk2(bflo(raw.w) * r1[2], bfhi(raw.w) * r1[3]);
            Af[t][ks] = __builtin_bit_cast(bf16x8, w);
        }
    }
    const int ch8 = chq + fq * 8;
    const f32x4 g0 = *(const f32x4*)(sgu_g + ch8), g1 = *(const f32x4*)(sgu_g + ch8 + 4);
    u32x4_t urv[8], grv[8]; float bsvv[8];
#pragma unroll
    for (int pt = 0; pt < 8; ++pt) { const int p = pt * 16 + fr, tok = tokc + p;
        urv[pt] = *(const u32x4_t*)(z + (size_t)tok * LDZ + 2048 + ch8); grv[pt] = *(const u32x4_t*)(z + (size_t)tok * LDZ + 3072 + ch8); bsvv[pt] = sgu_b[g * 128 + p]; }
#pragma unroll
    for (int pt = 0; pt < 8; ++pt) {
        const int p = pt * 16 + fr, tok = tokc + p;
        const u32x4_t ur = urv[pt], gr = grv[pt];
        const float bsv = bsvv[pt];
        const LAS unsigned char* bp = wsl + p * 256;
        f32x4 a0 = {0.f, 0.f, 0.f, 0.f}, a1 = {0.f, 0.f, 0.f, 0.f};
#pragma unroll
        for (int ks = 0; ks < 4; ++ks) { const bf16x8 Bf = *(const LAS bf16x8*)(bp + (((ks * 4 + fq) ^ fr) << 4)); a0 = mfma16(Af[0][ks], Bf, a0); a1 = mfma16(Af[1][ks], Bf, a1); }
        float o[8];
#pragma unroll
        for (int k = 0; k < 2; ++k) {
            o[2 * k] = bflo(ur[k]) * (a0[2 * k] * g0[2 * k] + bsv) * silu(bflo(gr[k]));
            o[2 * k + 1] = bfhi(ur[k]) * (a0[2 * k + 1] * g0[2 * k + 1] + bsv) * silu(bfhi(gr[k]));
            o[4 + 2 * k] = bflo(ur[2 + k]) * (a1[2 * k] * g1[2 * k] + bsv) * silu(bflo(gr[2 + k]));
            o[4 + 2 * k + 1] = bfhi(ur[2 + k]) * (a1[2 * k + 1] * g1[2 * k + 1] + bsv) * silu(bfhi(gr[2 + k]));
        }
        u32x4_t ow; ow.x = pk2(o[0], o[1]); ow.y = pk2(o[2], o[3]); ow.z = pk2(o[4], o[5]); ow.w = pk2(o[6], o[7]);
        *(u32x4_t*)(y + (size_t)tok * LDY + 1024 + ch8) = ow;
    }
}

__device__ __forceinline__ void sgu_item(const bf16_t* vT, const LAS float* rstd, const bf16_t* z, const bf16_t* sguw, const float* sgu_g, const float* sgu_b, bf16_t* y, int item, int lane) {
    const int dd = item & 7, g = (item >> 3) & 7, n = item >> 6;
    const int fr = lane & 15, fq = lane >> 4;
    const int tokc = n * 128;
    const bf16_t* ap = vT + (size_t)(g * 128 + dd * 16 + fr) * SEG + tokc + fq * 8;
    bf16x8 Af[4];
#pragma unroll
    for (int ks = 0; ks < 4; ++ks) {
        const u32x4_t raw = *(const u32x4_t*)(ap + ks * 32);
        const f32x4 r0 = *(const LAS f32x4*)(rstd + ks * 32 + fq * 8), r1 = *(const LAS f32x4*)(rstd + ks * 32 + fq * 8 + 4);
        u32x4_t w;
        w.x = pk2(bflo(raw.x) * r0[0], bfhi(raw.x) * r0[1]); w.y = pk2(bflo(raw.y) * r0[2], bfhi(raw.y) * r0[3]);
        w.z = pk2(bflo(raw.z) * r1[0], bfhi(raw.z) * r1[1]); w.w = pk2(bflo(raw.w) * r1[2], bfhi(raw.w) * r1[3]);
        Af[ks] = __builtin_bit_cast(bf16x8, w);
    }
    const int ch4 = g * 128 + dd * 16 + fq * 4;
    const f32x4 g4 = *(const f32x4*)(sgu_g + ch4);
#pragma unroll
    for (int pt = 0; pt < 8; ++pt) {
        const int p = pt * 16 + fr;
        const bf16_t* bp = sguw + (size_t)(g * 128 + p) * 128 + fq * 8;
        f32x4 acc = {0.f, 0.f, 0.f, 0.f};
#pragma unroll
        for (int ks = 0; ks < 4; ++ks) acc = mfma16(Af[ks], ld8(bp + ks * 32), acc);
        const int tok = tokc + p;
        const float bsv = sgu_b[g * 128 + p];
        const u32x2_t ur = *(const u32x2_t*)(z + (size_t)tok * LDZ + 2048 + ch4), gr = *(const u32x2_t*)(z + (size_t)tok * LDZ + 3072 + ch4);
        const float uu[4] = {bflo(ur.x), bfhi(ur.x), bflo(ur.y), bfhi(ur.y)}, gd[4] = {bflo(gr.x), bfhi(gr.x), bflo(gr.y), bfhi(gr.y)};
        float o[4];
#pragma unroll
        for (int jj = 0; jj < 4; ++jj) o[jj] = uu[jj] * (acc[jj] * g4[jj] + bsv) * silu(gd[jj]);
        u32x2_t ow; ow.x = pk2(o[0], o[1]); ow.y = pk2(o[2], o[3]);
        *(u32x2_t*)(y + (size_t)tok * LDY + 1024 + ch4) = ow;
    }
}

__global__ void __launch_bounds__(512, 2) fwd_megakernel(Params P) {
    extern __shared__ __attribute__((aligned(16))) unsigned char shm[];
    cg::grid_group grid = cg::this_grid();
    PG8_LAS unsigned char* lds = (PG8_LAS unsigned char*)shm;
    const int G = gridDim.x, NW = G * 8;
#define FRESH_TID() int tid = threadIdx.x; asm volatile("" : "+v"(tid)); const int lane = tid & 63, wid = tid >> 6, gw = blockIdx.x * 8 + wid; (void)lane; (void)gw
    unsigned char* ws = P.ws;
    bf16_t* WIN_E = (bf16_t*)(ws + WS_WIN_E); bf16_t* WIN_O = (bf16_t*)(ws + WS_WIN_O);
    bf16_t* WOUT_E = (bf16_t*)(ws + WS_WOUT_E); bf16_t* WOUT_O = (bf16_t*)(ws + WS_WOUT_O);
    bf16_t* WKV = (bf16_t*)(ws + WS_WKV); bf16_t* LRUW = (bf16_t*)(ws + WS_LRUW); bf16_t* SGUW = (bf16_t*)(ws + WS_SGUW);
    bf16_t* MEMN = (bf16_t*)(ws + WS_MEMN); bf16_t* MK = (bf16_t*)(ws + WS_MK); bf16_t* MVT = (bf16_t*)(ws + WS_MVT);
    bf16_t* H = (bf16_t*)(ws + WS_H); bf16_t* Z = (bf16_t*)(ws + WS_Z); bf16_t* VT = (bf16_t*)(ws + WS_VT); bf16_t* Y = (bf16_t*)(ws + WS_Y);
    float* AGG = (float*)(ws + WS_AGG); float* CARRY = (float*)(ws + WS_CARRY); float* RSTD = (float*)(ws + WS_RSTD); float* PART = (float*)(ws + WS_PART); unsigned* LAB = (unsigned*)(ws + WS_LAB);

    unsigned* BAR = (unsigned*)(ws + WS_BAR);
    volatile LAS unsigned* xst = (volatile LAS unsigned*)(lds + XST_OFF);
    {
        FRESH_TID();
        if (tid < 2) xst[tid] = 0u;
        if (blockIdx.x == 0) for (int i = tid; i < XCD_BAR_WORDS; i += 512) BAR[i] = 0u;
        LAS float* scr = (LAS float*)(lds + wid * 16384);
        constexpr int I0 = 16 * 288, I1 = 16 * 192, I2 = 40 * 32, I3 = 40 * 32, I4 = 16 * 32, I5 = 16 * 32, I6 = 16 * 8, I7 = 16 * 8;
        constexpr int NIT = I0 + I1 + I2 + I3 + I4 + I5 + I6 + I7;
#pragma unroll 1
        for (int it = gw; it < NIT; it += NW) {
            int r = it;
            if (r < I0) { transpose_item(P.in[7], 1024, 9216, WIN_E, scr, r, lane); continue; } r -= I0;
            if (r < I1) { transpose_item(P.in[12], 1024, 6144, WIN_O, scr, r, lane); continue; } r -= I1;
            if (r < I2) { transpose_item(P.in[11], 2560, 1024, WOUT_E, scr, r, lane); continue; } r -= I2;
            if (r < I3) { transpose_item(P.in[23], 2560, 1024, WOUT_O, scr, r, lane); continue; } r -= I3;
            if (r < I4) { transpose_item(P.in[6], 1024, 1024, WKV, scr, r, lane); continue; } r -= I4;
            if (r < I5) { transpose_item(P.in[6] + (size_t)1024 * 1024, 1024, 1024, WKV + (size_t)1024 * 1024, scr, r, lane); continue; } r -= I5;
            if (r < I6) { const int m = r >> 3; transpose_item(P.in[15] + (size_t)m * 16384, 128, 128, LRUW + (size_t)m * 16384, scr, r & 7, lane); continue; } r -= I6;
            { const int m = r >> 3; transpose_item(P.in[17] + (size_t)m * 16384, 128, 128, LRUW + (size_t)(16 + m) * 16384, scr, r & 7, lane); }
        }
        for (int i = blockIdx.x * 512 + tid; i < 8 * 128 * 128; i += G * 512) SGUW[i] = f2bf(P.in[21][i]);
        for (int it = gw; it < 2 * 1536; it += NW) {
            const int l = it / 1536, row = it - l * 1536;
            const float* src = row < 512 ? P.in[2] + (size_t)row * 1024 : P.in[3] + (size_t)(row - 512) * 1024;
            rms_row_bf16(src, P.in[5] + l * 1024, MEMN + ((size_t)l * 1536 + row) * 1024, lane);
        }
        for (int it = gw; it < SEG / 4; it += NW) rms_rows4_bf16(P.in[0] + (size_t)it * 4096, P.in[4], H + (size_t)it * 4096, lane);
    }

    grid.sync();
    const XcdBarrier xb = xcd_barrier_post(BAR, xst);
    for (int seg = 0; seg < 3; ++seg) {
        const float* xin = seg < 2 ? P.in[0] + (size_t)seg * SEG * 1024 : P.in[1];
        float* xout = P.out + (size_t)seg * SEG * 1024;
        const int T = seg < 2 ? 16384 : 4096, nseq = seg < 2 ? 1 : 4;

        {
            pg8::Gemm g; g.A = H; g.Bt = WIN_E; g.M = SEG; g.N = 8192; g.K = 1024; g.A1 = WIN_E + (size_t)6144 * 1024; g.Bt1 = H;
            pg8::DualOrder S; S.S0.init(SEG, 8192, G, blockIdx.x); S.S1.init(1024, SEG, G, blockIdx.x); S.skip_from = 24; S.skip_n = 4; S.G = G; S.c = blockIdx.x;
            pg8::EpiZ E; E.O = Z; E.ldc = LDZ; E.skip_from = 24; E.skip_n = 4; E.colsq = nullptr; E.colsq_ld = 0; E.O1 = VT; E.ldc1 = SEG; E.colsq1 = nullptr;
            pg8::gemm_phase(lds, g, S, E);
        }
        if (seg == 0) {
#pragma unroll 1
            for (int l = 0; l < 2; ++l) {
                {
                    pg8::Gemm g; g.A = MEMN + (size_t)l * 1536 * 1024; g.Bt = WKV + (size_t)l * 1024 * 1024; g.M = 1536; g.N = 512; g.K = 1024; g.A1 = g.A; g.Bt1 = g.Bt;
                    pg8::SkipOrder S; S.init(1536, 512, G, (blockIdx.x + G - (32 * l) % G) % G); S.skip_from = 1 << 20; S.skip_n = 0;
                    pg8::EpiZ E; E.O = MK + (size_t)l * 1536 * 512; E.ldc = 512; E.skip_from = 1 << 20; E.skip_n = 0; E.colsq = nullptr; E.colsq_ld = 0; E.O1 = E.O; E.ldc1 = 512; E.colsq1 = nullptr;
                    pg8::gemm_phase(lds, g, S, E);
                }
                {
                    pg8::Gemm g; g.A = WKV + (size_t)l * 1024 * 1024 + (size_t)512 * 1024; g.Bt = MEMN + (size_t)l * 1536 * 1024; g.M = 512; g.N = 1536; g.K = 1024; g.A1 = g.A; g.Bt1 = g.Bt;
                    pg8::SkipOrder S; S.init(512, 1536, G, (blockIdx.x + G - (32 * l + 16) % G) % G); S.skip_from = 1 << 20; S.skip_n = 0;
                    pg8::EpiZ E; E.O = MVT + (size_t)l * 512 * 1536; E.ldc = 1536; E.skip_from = 1 << 20; E.skip_n = 0; E.colsq = nullptr; E.colsq_ld = 0; E.O1 = E.O; E.ldc1 = 1536; E.colsq1 = nullptr;
                    pg8::gemm_phase(lds, g, S, E);
                }
            }
        }
        xcd_barrier(xb);

        { FRESH_TID();
        for (int u = blockIdx.x; u < 256; u += G) mem_unit(Z, 7168, 7680, MK, MVT, Y, u, seg, lds, tid);
#pragma unroll 1
        for (int u = blockIdx.x; u < 256; u += G) na_block(Z, VT, Y, P.in[10], u, T, lds, tid);
        for (int it = gw; it < 8192; it += NW) conv_even_item(Z, P.in[8], P.in[9], Y, 2 * it, T, lane);
        }
        xcd_barrier(xb);

        {
            pg8::Gemm g; g.A = Y; g.Bt = WOUT_E; g.M = SEG; g.N = 1024; g.K = 2560; g.A1 = g.A; g.Bt1 = g.Bt;
            pg8::StaticOrder S; S.init(SEG, 1024, G, blockIdx.x, 16);
            pg8::EpiRes E; E.xin = xin; E.out = xout;
            pg8::gemm_phase(lds, g, S, E);
        }
        xcd_barrier(xb);

        { FRESH_TID();
        for (int it = gw; it < SEG / 4; it += NW) rms_rows4_bf16(xout + (size_t)it * 4096, P.in[4] + 1024, H + (size_t)it * 4096, lane); }
        xcd_barrier(xb);

        {
            pg8::Gemm g; g.A = H; g.Bt = WIN_O; g.M = SEG; g.N = 5120; g.K = 1024; g.A1 = WIN_O + (size_t)3072 * 1024; g.Bt1 = H;
            pg8::DualOrder S; S.S0.init(SEG, 5120, G, blockIdx.x); S.S1.init(1024, SEG, G, blockIdx.x); S.skip_from = 12; S.skip_n = 4; S.G = G; S.c = blockIdx.x;
            pg8::EpiZ E; E.O = Z; E.ldc = LDZ; E.skip_from = 12; E.skip_n = 4; E.colsq = nullptr; E.colsq_ld = SEG; E.O1 = VT; E.ldc1 = SEG; E.colsq1 = PART;
            pg8::gemm_phase(lds, g, S, E);
        }
        xcd_barrier(xb);

        { FRESH_TID();
        for (int u = blockIdx.x; u < 256; u += G) mem_unit(Z, 4096, 4608, MK + (size_t)1536 * 512, MVT + (size_t)512 * 1536, Y, u, seg, lds, tid);
#pragma unroll 1
        for (int u0 = blockIdx.x; u0 < 1024; u0 += 4 * G) {
            __syncthreads();
#pragma unroll 1
            for (int k = 0; k < 4; ++k) { const int u = u0 + k * G; if (u < 1024) conv_tile_to_lds(Z, P.in[13], P.in[14], lds + k * 32768, u >> 3, u & 7, T, tid); }
            __syncthreads();
#pragma unroll 1
            for (int k = 0; k < 4; ++k) { const int u = u0 + k * G; if (u < 1024) lru_item<false>(lds + k * 32768, Z, LRUW, P.in[16], P.in[18], P.in[19], AGG, CARRY, Y, LAB, (u >> 3) * 64 + (u & 7) * 8 + wid, lane); }
        }
#pragma unroll 1
        for (int u0 = blockIdx.x; u0 < 1024; u0 += 2 * G) {
            __syncthreads();
            LAS float* rsL = (LAS float*)lds;
            if (tid < 256) { const int u = u0 + (tid >> 7) * G;
              if (u < 1024) { const float* pp = PART + (u >> 3) * 128 + (tid & 127); float s = 0.f;
#pragma unroll
                for (int i = 0; i < 8; ++i) s += pp[(size_t)i * SEG];
                rsL[tid] = __builtin_amdgcn_rsqf(s * (1.0f / 1024.0f) + EPS); } }
            u32x4_t wsv[2][4];
#pragma unroll
            for (int s2 = 0; s2 < 2; ++s2) { const int u = u0 + s2 * G;
              if (u < 1024) { const int g = u & 7;
#pragma unroll
                for (int i = 0; i < 4; ++i) { const int idx = tid + 512 * i, p = idx >> 4, c = idx & 15; wsv[s2][i] = *(const u32x4_t*)(SGUW + (size_t)(g * 128 + p) * 128 + c * 8); } } }
#pragma unroll
            for (int s2 = 0; s2 < 2; ++s2) { const int u = u0 + s2 * G;
              if (u < 1024) {
#pragma unroll
                for (int i = 0; i < 4; ++i) { const int idx = tid + 512 * i, p = idx >> 4, c = idx & 15; *(LAS u32x4_t*)(lds + 4096 + s2 * 32768 + p * 256 + ((c ^ (p & 15)) << 4)) = wsv[s2][i]; } } }
            __syncthreads();
            { const int s2 = wid >> 2, u = u0 + s2 * G;
              if (u < 1024) sgu_item2(VT, rsL + s2 * 128, lds + 4096 + s2 * 32768, Z, P.in[20], P.in[22], Y, u >> 3, u & 7, wid & 3, lane); }
        } }
        xcd_barrier(xb);

        if (G == 256) {
            FRESH_TID();
            float hc[4];
            LruF F[2];
            lru_final_load(F[0], LAB, Z, gw, lane);
            wave_carries(AGG, gw & 63, gw >> 6, nseq, lane, hc);
#pragma unroll
            for (int k = 0; k < 4; ++k) {
                if (k < 3) lru_final_load(F[(k + 1) & 1], LAB, Z, gw + 2048 * (k + 1), lane);
                lru_final_compute<true>(F[k & 1], CARRY, hc[k], Y, gw + 2048 * k, lane);
            }
        } else {
            { FRESH_TID(); carry_phase(AGG, CARRY, nseq, blockIdx.x * 512 + tid, G * 512); }
            xcd_barrier(xb);
            { FRESH_TID();
#pragma unroll 1
            for (int it = gw; it < 8192; it += NW) { LruF F1; lru_final_load(F1, LAB, Z, it, lane); lru_final_compute<false>(F1, CARRY, 0.f, Y, it, lane); } }
        }
        if (seg < 2) { FRESH_TID();
            const float* xnx = seg == 0 ? P.in[0] + (size_t)SEG * 1024 : P.in[1];
            for (int it = gw; it < SEG / 4; it += NW) rms_rows4_bf16(xnx + (size_t)it * 4096, P.in[4], H + (size_t)it * 4096, lane); }
        xcd_barrier(xb);

        {
            pg8::Gemm g; g.A = Y; g.Bt = WOUT_O; g.M = SEG; g.N = 1024; g.K = 2560; g.A1 = g.A; g.Bt1 = g.Bt;
            pg8::StaticOrder S; S.init(SEG, 1024, G, blockIdx.x, 16);
            pg8::EpiRes E; E.xin = xout; E.out = xout;
            pg8::gemm_phase(lds, g, S, E);
        }
        xcd_barrier(xb);

        { FRESH_TID();
        for (int it = gw; it < SEG / 4; it += NW) rms_rows4_f32(xout + (size_t)it * 4096, P.in[24], lane); }
    }
}

extern "C" void kernel_launch(void* const* d_in, const int* in_sizes, int n_in, void* d_out, int out_size, void* d_ws, size_t ws_size, hipStream_t stream) {
    static int grid_blocks = 0;
    if (grid_blocks == 0) {
        if (n_in != 25 || ws_size < WS_END) { fprintf(stderr, "kernel_launch: need 25 inputs and %zu bytes of workspace; got %d, %zu\n", (size_t)WS_END, n_in, ws_size); grid_blocks = -1; return; }
        int dev = 0, cus = 0, per_cu = 0;
        hipGetDevice(&dev);
        hipDeviceGetAttribute(&cus, hipDeviceAttributeMultiprocessorCount, dev);
        hipFuncSetAttribute((const void*)fwd_megakernel, hipFuncAttributeMaxDynamicSharedMemorySize, LDS_BYTES);
        hipOccupancyMaxActiveBlocksPerMultiprocessor(&per_cu, (const void*)fwd_megakernel, 512, LDS_BYTES);
        if (per_cu < 1) { fprintf(stderr, "kernel_launch: occupancy query says %d blocks per CU\n", per_cu); grid_blocks = -1; return; }
        grid_blocks = cus;
    }
    if (grid_blocks < 0) return;
    Params p{};
    for (int i = 0; i < 25; ++i) p.in[i] = (const float*)d_in[i];
    p.out = (float*)d_out; p.ws = (unsigned char*)d_ws;
    void* args[] = {&p};
    hipError_t e = hipLaunchCooperativeKernel((const void*)fwd_megakernel, dim3(grid_blocks), dim3(512), args, LDS_BYTES, stream);
    if (e != hipSuccess) fprintf(stderr, "cooperative launch failed: %s (grid %d)\n", hipGetErrorString(e), grid_blocks);
}
```

```cpp
#include <hip/hip_runtime.h>
#include <hip/hip_cooperative_groups.h>
#include <cstdio>
namespace cg = cooperative_groups;
namespace pg8 {
#define PG8_LAS __attribute__((address_space(3)))
typedef unsigned short bf16_t;
typedef short bf16x8 __attribute__((ext_vector_type(8)));
typedef float f32x4 __attribute__((ext_vector_type(4)));
typedef unsigned u32x4 __attribute__((ext_vector_type(4)));
constexpr int BM = 256, BK = 64, HALF = 128, HTB = HALF * BK * 2  , STAGE_BYTES = 8 * HTB, NXCD = 8, WGM = 4;

__host__ __device__ __forceinline__ int lds_byte(int r, int c) { const int st = (r >> 4) * 2 + (c >> 5), rr = r & 15, cc = c & 31, ob = rr * 64 + cc * 2; return st * 1024 + (ob ^ (((ob >> 9) & 1) << 5)); }
__host__ __device__ __forceinline__ void stage_rc(int b, int& R, int& C) { const int st = b / 1024, sb = b % 1024, swz = sb ^ (((sb >> 9) & 1) << 5); R = (st >> 1) * 16 + swz / 64; C = (st & 1) * 32 + (swz % 64) / 2; }
__host__ __device__ __forceinline__ int perm32(int rho) { const int n = rho >> 4, i = rho & 15; return 8 * (i >> 2) + 4 * n + (i & 3); }

struct Unit { int pm, pn, sel; };
struct Gemm { const bf16_t* A; const bf16_t* Bt; int M, N, K; const bf16_t* A1; const bf16_t* Bt1; };

struct StaticOrder {
    int nM, nN, nwg, G, c, wgm;
    __host__ __device__ void init(int M, int N, int G_, int c_, int wgm_ = 4) { nM = M / BM; nN = N / BM; nwg = nM * nN; G = G_; c = c_; wgm = wgm_; }
    __host__ __device__ void map(int wgid, Unit& u) const {
        { const int q = nwg / NXCD, r = nwg % NXCD, xcd = wgid % NXCD, off = wgid / NXCD; wgid = (xcd < r ? xcd * (q + 1) : r * (q + 1) + (xcd - r) * q) + off; }
        const int nig = wgm * nN, gid = wgid / nig, fm = gid * wgm, gsz = (nM - fm) < wgm ? (nM - fm) : wgm;
        u.pm = fm + ((wgid % nig) % gsz); u.pn = (wgid % nig) / gsz; u.sel = 0;
    }
    __host__ __device__ bool next(int i, Unit& u) const {
        const long L = (long)i * G + c; if (L >= nwg) return false;
        map((int)L, u); return true;
    }
    __device__ __forceinline__ void a_ready(const Unit&) const {}
    __device__ __forceinline__ void done(const Unit&) const {}
};

struct SkipOrder : StaticOrder {
    int skip_from, skip_n;
    __device__ __forceinline__ bool next(int i, Unit& u) const {
        if (!StaticOrder::next(i, u)) return false;
        if (u.pn >= skip_from) u.pn += skip_n;
        return true;
    }
};
struct DualOrder {
    StaticOrder S0, S1; int skip_from, skip_n, G, c;
    __device__ __forceinline__ bool next(int i, Unit& u) const {
        const long L = (long)i * G + c;
        if (L < S0.nwg) { S0.map((int)L, u); if (u.pn >= skip_from) u.pn += skip_n; return true; }
        if (L - S0.nwg < S1.nwg) { S1.map((int)(L - S0.nwg), u); u.sel = 1; return true; }
        return false;
    }
    __device__ __forceinline__ void a_ready(const Unit&) const {}
    __device__ __forceinline__ void done(const Unit&) const {}
};

__device__ __forceinline__ unsigned cvt_pk_bf16(float lo, float hi) { unsigned r; asm volatile("v_cvt_pk_bf16_f32 %0, %1, %2" : "=v"(r) : "v"(lo), "v"(hi)); return r; }

struct EpiZ {
    static constexpr bool PERM = true, AFTER_DRAIN = false;
    bf16_t* O; int ldc; int skip_from, skip_n; float* colsq; int colsq_ld; bf16_t* O1; int ldc1; float* colsq1;
    __device__ __forceinline__ void operator()(const f32x4 (&acc)[2][2][4][2], const Unit& u, int wr, int wc, int fr, int fq) const {
        const int row0 = u.pm * BM + wr * 64 + fr; const int ct = u.sel ? u.pn : ((u.pn >= skip_from + skip_n) ? (u.pn - skip_n) : u.pn);
        const int col0 = ct * BM + wc * 32 + 8 * fq;
        bf16_t* const O = u.sel ? this->O1 : this->O; const int ldc = u.sel ? this->ldc1 : this->ldc; float* const colsq = u.sel ? this->colsq1 : this->colsq;
#pragma unroll
        for (int ai = 0; ai < 2; ++ai)
#pragma unroll
            for (int m = 0; m < 4; ++m) { bf16_t* rowp = O + (size_t)(row0 + ai * HALF + m * 16) * ldc + col0;
#pragma unroll
                for (int bj = 0; bj < 2; ++bj) { const f32x4 v0 = acc[ai][bj][m][0], v1 = acc[ai][bj][m][1];
                    u32x4 w; w.x = cvt_pk_bf16(v0[0], v0[1]); w.y = cvt_pk_bf16(v0[2], v0[3]); w.z = cvt_pk_bf16(v1[0], v1[1]); w.w = cvt_pk_bf16(v1[2], v1[3]);
                    *(u32x4*)(rowp + bj * HALF) = w; } }
        if (colsq) {
#pragma unroll
            for (int bj = 0; bj < 2; ++bj)
#pragma unroll
                for (int n = 0; n < 2; ++n) {
                    f32x4 ss = {0.f, 0.f, 0.f, 0.f};
#pragma unroll
                    for (int ai = 0; ai < 2; ++ai)
#pragma unroll
                        for (int m = 0; m < 4; ++m) ss += acc[ai][bj][m][n] * acc[ai][bj][m][n];
#pragma unroll
                    for (int o = 1; o < 16; o <<= 1) { ss[0] += __shfl_xor(ss[0], o); ss[1] += __shfl_xor(ss[1], o); ss[2] += __shfl_xor(ss[2], o); ss[3] += __shfl_xor(ss[3], o); }
                    if (fr == 0) *(f32x4*)(colsq + (size_t)(2 * u.pm + wr) * colsq_ld + ct * BM + bj * HALF + wc * 32 + 8 * fq + 4 * n) = ss;
                }
        }
    }
};
struct EpiRes {
    static constexpr bool PERM = false, AFTER_DRAIN = false;
    const float* xin; float* out;
    __device__ __forceinline__ void operator()(const f32x4 (&acc)[2][2][4][2], const Unit& u, int wr, int wc, int fr, int fq) const {
        const int row0 = u.pm * BM + wr * 64 + fr, col0 = u.pn * BM + wc * 32 + 4 * fq;
#pragma unroll
        for (int ai = 0; ai < 2; ++ai)
#pragma unroll
            for (int m = 0; m < 4; ++m) { const size_t ro = (size_t)(row0 + ai * HALF + m * 16) * 1024 + col0;
#pragma unroll
                for (int bj = 0; bj < 2; ++bj)
#pragma unroll
                    for (int n = 0; n < 2; ++n) { const f32x4 xv = *(const f32x4*)(xin + ro + bj * HALF + n * 16);
                        *(f32x4*)(out + ro + bj * HALF + n * 16) = acc[ai][bj][m][n] + xv; } }
    }
};

template <class Epi, class Sched>
__device__ __forceinline__ void gemm_phase(PG8_LAS unsigned char* lds, const Gemm g, const Sched& S, const Epi& E) {
    int tid = threadIdx.x; asm volatile("" : "+v"(tid));
    const int wid = __builtin_amdgcn_readfirstlane(tid >> 6), lane = tid & 63, wr = wid >> 2, wc = wid & 3, fr = lane & 15, fq = lane >> 4;
    const int K = g.K, nt = K / BK;
    const char* gA = (const char*)g.A; const char* gB = (const char*)g.Bt; const char* gA1 = (const char*)g.A1; const char* gB1 = (const char*)g.Bt1; asm volatile("" : "+s"(gA), "+s"(gB), "+s"(gA1), "+s"(gB1));
    unsigned voffA[2], voffB[2];
#pragma unroll
    for (int i = 0; i < 2; ++i) { int R, C; stage_rc(tid * 16 + i * 8192, R, C); const int Rb = Epi::PERM ? ((R & ~31) + perm32(R & 31)) : R;
        voffA[i] = (unsigned)(R * K + C) * 2u; voffB[i] = (unsigned)(Rb * K + C) * 2u; }
    const size_t kstep = (size_t)(BK * 2);
    const size_t hstep = (size_t)HALF * K * 2;
    const size_t tstep = 2 * hstep;
    const unsigned ldsw = (unsigned)wid * 1024u;
    const int aoff = lds_byte(wr * 64 + fr, fq * 8), boff = lds_byte(wc * 32 + fr, fq * 8);
#define PG8_SA(b, h) (((b) * 2 + (h)) * HTB)
#define PG8_SB(b, h) ((4 + (b) * 2 + (h)) * HTB)
#define PG8_STAGE(bufoff, gbase, voff) do { _Pragma("unroll") for (int _i = 0; _i < 2; ++_i) \
        __builtin_amdgcn_global_load_lds((const unsigned*)((const char*)(gbase) + (voff)[_i]), (PG8_LAS unsigned*)(lds + (bufoff) + ldsw + _i * 8192), 16, 0, 0); } while (0)
#define PG8_LDA(dst, b, h) do { _Pragma("unroll") for (int m = 0; m < 4; ++m) _Pragma("unroll") for (int k = 0; k < 2; ++k) dst[m][k] = *(const PG8_LAS bf16x8*)(lds + PG8_SA(b, h) + aoff + m * 2048 + k * 1024); } while (0)
#define PG8_LDB(dst, b, h) do { _Pragma("unroll") for (int n = 0; n < 2; ++n) _Pragma("unroll") for (int k = 0; k < 2; ++k) dst[n][k] = *(const PG8_LAS bf16x8*)(lds + PG8_SB(b, h) + boff + n * 2048 + k * 1024); } while (0)
#define PG8_MMA(ai, bj, At, Bt) do { __builtin_amdgcn_s_setprio(1); _Pragma("unroll") for (int m = 0; m < 4; ++m) _Pragma("unroll") for (int n = 0; n < 2; ++n) _Pragma("unroll") for (int k = 0; k < 2; ++k) \
        acc[ai][bj][m][n] = __builtin_amdgcn_mfma_f32_16x16x32_bf16(Bt[n][k], At[m][k], acc[ai][bj][m][n], 0, 0, 0); __builtin_amdgcn_s_setprio(0); } while (0)
#define PG8_WAIT_V(n) asm volatile("s_waitcnt vmcnt(" #n ")" ::: "memory")
#define PG8_WAIT_L(n) asm volatile("s_waitcnt lgkmcnt(" #n ")" ::: "memory")
#define PG8_BAR __builtin_amdgcn_s_barrier()
#define PG8_SCHED __builtin_amdgcn_sched_barrier(0)
    Unit cur, nxt; int ui = 0;
    if (!S.next(0, cur)) return;
    f32x4 acc[2][2][4][2];
#pragma unroll
    for (int a = 0; a < 2; ++a)
#pragma unroll
        for (int b = 0; b < 2; ++b)
#pragma unroll
            for (int m = 0; m < 4; ++m)
#pragma unroll
                for (int n = 0; n < 2; ++n) acc[a][b][m][n] = (f32x4){0.f, 0.f, 0.f, 0.f};
    bf16x8 At[4][2], B0[2][2], B1[2][2];
    const char* cA = (cur.sel ? gA1 : gA) + (size_t)cur.pm * tstep; const char* cB = (cur.sel ? gB1 : gB) + (size_t)cur.pn * tstep;
    S.a_ready(cur);
    PG8_STAGE(PG8_SB(0, 0), cB, voffB); PG8_STAGE(PG8_SB(0, 1), cB + hstep, voffB); PG8_STAGE(PG8_SA(0, 0), cA, voffA); PG8_STAGE(PG8_SA(0, 1), cA + hstep, voffA);
    if (wr == 1) PG8_BAR;
    PG8_WAIT_V(2); PG8_BAR;
    PG8_STAGE(PG8_SB(1, 0), cB + kstep, voffB); PG8_STAGE(PG8_SA(1, 0), cA + kstep, voffA); PG8_STAGE(PG8_SB(1, 1), cB + hstep + kstep, voffB);
    PG8_WAIT_V(6); PG8_BAR;
    for (;;) {
        const bool has_next = S.next(ui + 1, nxt);
        const char* nA = has_next ? (nxt.sel ? gA1 : gA) + (size_t)nxt.pm * tstep : cA; const char* nB = has_next ? (nxt.sel ? gB1 : gB) + (size_t)nxt.pn * tstep : cB;
        for (int t = 0; t < nt; t += 2) {
            const bool last = (t == nt - 2);
            const char* a1 = cA + (size_t)(t + 1) * kstep;
            const char* a2 = last ? nA : cA + (size_t)(t + 2) * kstep; const char* b2 = last ? nB : cB + (size_t)(t + 2) * kstep;
            const char* a3 = a2 + kstep; const char* b3 = b2 + kstep;
            if (last && has_next) S.a_ready(nxt);
            PG8_LDB(B0, 0, 0); PG8_LDB(B1, 0, 1); PG8_SCHED; PG8_LDA(At, 0, 0); PG8_STAGE(PG8_SA(1, 1), a1 + hstep, voffA);
            PG8_WAIT_V(8); PG8_WAIT_L(0); PG8_BAR; PG8_MMA(0, 0, At, B0); PG8_MMA(0, 1, At, B1); PG8_BAR; PG8_SCHED;
            PG8_LDA(At, 0, 1); PG8_STAGE(PG8_SB(0, 0), b2, voffB); PG8_STAGE(PG8_SB(0, 1), b2 + hstep, voffB); PG8_STAGE(PG8_SA(0, 0), a2, voffA);
            PG8_WAIT_V(8); PG8_WAIT_L(0); PG8_BAR; PG8_MMA(1, 0, At, B0); PG8_MMA(1, 1, At, B1); PG8_BAR; PG8_SCHED;
            PG8_LDB(B0, 1, 0); PG8_LDB(B1, 1, 1); PG8_SCHED; PG8_LDA(At, 1, 0); PG8_STAGE(PG8_SA(0, 1), a2 + hstep, voffA);
            PG8_WAIT_V(8); PG8_WAIT_L(0); PG8_BAR; PG8_MMA(0, 0, At, B0); PG8_MMA(0, 1, At, B1); PG8_BAR; PG8_SCHED;
            PG8_LDA(At, 1, 1); PG8_STAGE(PG8_SB(1, 0), b3, voffB); PG8_STAGE(PG8_SB(1, 1), b3 + hstep, voffB); PG8_STAGE(PG8_SA(1, 0), a3, voffA);
            PG8_WAIT_V(8); PG8_WAIT_L(0); PG8_BAR; PG8_MMA(1, 0, At, B0); PG8_MMA(1, 1, At, B1); PG8_BAR; PG8_SCHED;
        }
        if constexpr (!Epi::AFTER_DRAIN) { E(acc, cur, wr, wc, fr, fq); S.done(cur); }
        if (!has_next) break;
#pragma unroll
        for (int a = 0; a < 2; ++a)
#pragma unroll
            for (int b = 0; b < 2; ++b)
#pragma unroll
                for (int m = 0; m < 4; ++m)
#pragma unroll
                    for (int n = 0; n < 2; ++n) acc[a][b][m][n] = (f32x4){0.f, 0.f, 0.f, 0.f};
        cur = nxt; cA = nA; cB = nB; ++ui;
    }
    PG8_WAIT_V(0);
    if (wr == 0) PG8_BAR;
    PG8_BAR;
    if constexpr (Epi::AFTER_DRAIN) { E.fused(acc, cur, wr, wc, fr, fq, lds, wid, lane); S.done(cur); }
#undef PG8_SA
#undef PG8_SB
#undef PG8_STAGE
#undef PG8_LDA
#undef PG8_LDB
#undef PG8_MMA
#undef PG8_WAIT_V
#undef PG8_WAIT_L
#undef PG8_BAR
#undef PG8_SCHED
}
}

#define XB_TMO      128
#define XB_XCNT(j)  (256  + 64 * (j))
#define XB_XSUB(j)  (1280 + 64 * (j))
#define XB_XGEN(j)  (2304 + 64 * (j))
#define XB_TOP      3328
#define XB_TOPGEN   3392
#define XCD_BAR_WORDS 3456
#define XB_SPIN_CAP (1u << 18)
#define LAS __attribute__((address_space(3)))

__device__ __forceinline__ unsigned xb_ld(unsigned* p)              { return __hip_atomic_load(p, __ATOMIC_RELAXED, __HIP_MEMORY_SCOPE_AGENT); }
__device__ __forceinline__ unsigned xb_add(unsigned* p, unsigned v) { return __hip_atomic_fetch_add(p, v, __ATOMIC_RELAXED, __HIP_MEMORY_SCOPE_AGENT); }
__device__ __forceinline__ unsigned xb_xcc_id() { return (unsigned)__builtin_amdgcn_s_getreg((3 << 11) | 20) & 0xFu; }
#define XB_SPIN(cond, bar) do { unsigned _sp = 0; while (cond) { __builtin_amdgcn_s_sleep(1); \
    if ((++_sp & 255u) == 0u) { if (xb_ld(&(bar)[XB_TMO])) break; if (_sp > XB_SPIN_CAP) { atomicAdd(&(bar)[XB_TMO], 1u); break; } } } } while (0)

struct XcdBarrier {
    unsigned* bar; unsigned x;
    volatile LAS unsigned* st;
};

__device__ __forceinline__ XcdBarrier xcd_barrier_post(unsigned* bar, volatile LAS unsigned* st) {
    XcdBarrier b; b.bar = bar; b.x = xb_xcc_id(); b.st = st;
    if (threadIdx.x == 0) (void)xb_add(&bar[XB_XCNT(b.x)], 1u);
    return b;
}
__device__ __forceinline__ void xcd_barrier_complete(unsigned* bar, unsigned x, unsigned& nloc, unsigned& nx) {
    const unsigned G = gridDim.x * gridDim.y * gridDim.z;
    unsigned sum, cnt, mine, sp = 0u;
    for (;;) {
        sum = 0u; cnt = 0u; mine = 0u;
#pragma unroll
        for (unsigned j = 0; j < 16; ++j) { const unsigned c = xb_ld(&bar[XB_XCNT(j)]); sum += c; cnt += (c > 0u) ? 1u : 0u; mine = (j == x) ? c : mine; }
        if (sum == G) break;
        __builtin_amdgcn_s_sleep(1);
        if ((++sp & 255u) == 0u) { if (xb_ld(&bar[XB_TMO])) break; if (sp > XB_SPIN_CAP) { atomicAdd(&bar[XB_TMO], 1u); break; } }
    }
    nloc = mine > 0u ? mine : 1u; nx = cnt > 0u ? cnt : 1u;
}

__device__ __forceinline__ void xcd_barrier(const XcdBarrier& b) {
    asm volatile("s_waitcnt vmcnt(0)" ::: "memory");
    __syncthreads();
    if (threadIdx.x == 0) {
        unsigned* bar = b.bar;
        __builtin_amdgcn_s_waitcnt(0);
        unsigned nloc = b.st[0], nx = b.st[1];
        if (nloc == 0u) { xcd_barrier_complete(bar, b.x, nloc, nx); b.st[0] = nloc; b.st[1] = nx; }
        const unsigned old = xb_add(&bar[XB_XSUB(b.x)], 1u);
        const unsigned gen = old / nloc;
        if (old + 1u == (gen + 1u) * nloc) {
            __builtin_amdgcn_fence(__ATOMIC_RELEASE, "agent");
            asm volatile("s_waitcnt vmcnt(0)" ::: "memory");
            const unsigned og = xb_add(&bar[XB_TOP], 1u);
            const unsigned tg = og / nx;
            if (og + 1u == (tg + 1u) * nx) xb_add(&bar[XB_TOPGEN], 1u);
            else XB_SPIN(xb_ld(&bar[XB_TOPGEN]) == tg, bar);
            __builtin_amdgcn_fence(__ATOMIC_ACQUIRE, "agent");
            xb_add(&bar[XB_XGEN(b.x)], 1u);
            asm volatile("s_waitcnt vmcnt(0)" ::: "memory");
        } else {
            XB_SPIN(xb_ld(&bar[XB_XGEN(b.x)]) == gen, bar);
            __builtin_amdgcn_fence(__ATOMIC_ACQUIRE, "agent");
            asm volatile("s_waitcnt vmcnt(0)" ::: "memory");
        }
    }
    __syncthreads();
}

using pg8::bf16_t; using pg8::bf16x8; using pg8::f32x4;
typedef unsigned u32x2_t __attribute__((ext_vector_type(2)));
typedef unsigned u32x4_t __attribute__((ext_vector_type(4)));

constexpr int DM = 1024, SEG = 16384, LDZ = 8192, LDY = 2560;
constexpr float EPS = 1e-6f;
constexpr int XST_OFF = 9 * 16384 + 2048;
constexpr int LDS_BYTES = XST_OFF + 64;
constexpr size_t WS_WIN_E = 0;
constexpr size_t WS_WIN_O = WS_WIN_E + (size_t)9216 * 1024 * 2;
constexpr size_t WS_WOUT_E = WS_WIN_O + (size_t)6144 * 1024 * 2;
constexpr size_t WS_WOUT_O = WS_WOUT_E + (size_t)1024 * 2560 * 2;
constexpr size_t WS_WKV = WS_WOUT_O + (size_t)1024 * 2560 * 2;
constexpr size_t WS_LRUW = WS_WKV + (size_t)2 * 1024 * 1024 * 2;
constexpr size_t WS_SGUW = WS_LRUW + (size_t)2 * 2 * 8 * 128 * 128 * 2;
constexpr size_t WS_MEMN = WS_SGUW + (size_t)8 * 128 * 128 * 2;
constexpr size_t WS_MK = WS_MEMN + (size_t)2 * 1536 * 1024 * 2;
constexpr size_t WS_MVT = WS_MK + (size_t)2 * 1536 * 512 * 2;
constexpr size_t WS_H = WS_MVT + (size_t)2 * 512 * 1536 * 2;
constexpr size_t WS_Z = WS_H + (size_t)SEG * 1024 * 2;
constexpr size_t WS_VT = WS_Z + (size_t)SEG * LDZ * 2;
constexpr size_t WS_Y = WS_VT + (size_t)1024 * SEG * 2;
constexpr size_t WS_AGG = WS_Y + (size_t)SEG * LDY * 2;
constexpr size_t WS_CARRY = WS_AGG + (size_t)2 * 128 * 1024 * 2 * 4;
constexpr size_t WS_RSTD = WS_CARRY + (size_t)2 * 128 * 1024 * 4;
constexpr size_t WS_PART = WS_RSTD + (size_t)SEG * 4;
constexpr size_t WS_BAR = WS_PART + (size_t)8 * SEG * 4;
constexpr size_t WS_LAB = WS_BAR + 16384;
constexpr size_t WS_END = WS_LAB + (size_t)2 * SEG * 1024 * 4;

struct Params { const float* in[25]; float* out; unsigned char* ws; };

__device__ __forceinline__ float bf2f(unsigned short b) { return __uint_as_float(((unsigned)b) << 16); }
__device__ __forceinline__ unsigned short f2bf(float f) { unsigned u = __float_as_uint(f); u += 0x7FFFu + ((u >> 16) & 1u); return (unsigned short)(u >> 16); }
__device__ __forceinline__ float bflo(unsigned w) { return __uint_as_float(w << 16); }
__device__ __forceinline__ float bfhi(unsigned w) { return __uint_as_float(w & 0xffff0000u); }
__device__ __forceinline__ unsigned pk2(float lo, float hi) { return pg8::cvt_pk_bf16(lo, hi); }
__device__ __forceinline__ float frcp(float x) { return __builtin_amdgcn_rcpf(x); }
__device__ __forceinline__ float silu(float x) { return x * frcp(1.0f + __expf(-x)); }
__device__ __forceinline__ float sigm(float x) { return frcp(1.0f + __expf(-x)); }
__device__ __forceinline__ float wave_sum(float v) {
#pragma unroll
    for (int o = 1; o < 64; o <<= 1) v += __shfl_xor(v, o);
    return v;
}
__device__ __forceinline__ f32x4 mfma16(bf16x8 a, bf16x8 b, f32x4 c) { return __builtin_amdgcn_mfma_f32_16x16x32_bf16(a, b, c, 0, 0, 0); }
__device__ __forceinline__ bf16x8 ld8(const bf16_t* p) { return *(const bf16x8*)p; }
__device__ __forceinline__ bf16x8 pack8(const float (&v)[8]) {
    u32x4_t w; w.x = pk2(v[0], v[1]); w.y = pk2(v[2], v[3]); w.z = pk2(v[4], v[5]); w.w = pk2(v[6], v[7]);
    return __builtin_bit_cast(bf16x8, w);
}

__device__ __forceinline__ void transpose_item(const float* W, int K, int N, bf16_t* WT, LAS float* scr, int item, int lane) {
    const int nblk = N >> 5, kb = item / nblk, nb = item - kb * nblk, k0 = 64 * kb, n0 = 32 * nb;
#pragma unroll 8
    for (int i = 0; i < 32; ++i) { const int kk = 2 * i + (lane >> 5); scr[kk * 33 + (lane & 31)] = W[(size_t)(k0 + kk) * N + n0 + (lane & 31)]; }
    asm volatile("s_waitcnt lgkmcnt(0)" ::: "memory");
    const int c = lane & 7;
#pragma unroll
    for (int j = 0; j < 4; ++j) { const int n = (lane >> 3) + 8 * j; const LAS float* s = scr + (8 * c) * 33 + n;
        u32x4_t o; o.x = pk2(s[0 * 33], s[1 * 33]); o.y = pk2(s[2 * 33], s[3 * 33]); o.z = pk2(s[4 * 33], s[5 * 33]); o.w = pk2(s[6 * 33], s[7 * 33]);
        *(u32x4_t*)(WT + (size_t)(n0 + n) * K + k0 + 8 * c) = o; }
    asm volatile("s_waitcnt lgkmcnt(0)" ::: "memory");
}

__device__ __forceinline__ void rms_row_bf16(const float* xrow, const float* g, bf16_t* orow, int lane) {
    const f32x4* xr = (const f32x4*)xrow + lane; f32x4 v[4]; float s = 0.f;
#pragma unroll
    for (int j = 0; j < 4; ++j) { v[j] = xr[64 * j]; s += (v[j].x * v[j].x + v[j].y * v[j].y) + (v[j].z * v[j].z + v[j].w * v[j].w); }
    const float rstd = __builtin_amdgcn_rsqf(wave_sum(s) * (1.0f / 1024.0f) + EPS);
    const f32x4* gr = (const f32x4*)g + lane; u32x2_t* o8 = (u32x2_t*)orow + lane;
#pragma unroll
    for (int j = 0; j < 4; ++j) { const f32x4 gg = gr[64 * j]; u32x2_t o; o.x = pk2(v[j].x * rstd * gg.x, v[j].y * rstd * gg.y); o.y = pk2(v[j].z * rstd * gg.z, v[j].w * rstd * gg.w); o8[64 * j] = o; }
}
__device__ __forceinline__ void rms_row_f32(float* xrow, const float* g, int lane) {
    f32x4* xr = (f32x4*)xrow + lane; f32x4 v[4]; float s = 0.f;
#pragma unroll
    for (int j = 0; j < 4; ++j) { v[j] = xr[64 * j]; s += (v[j].x * v[j].x + v[j].y * v[j].y) + (v[j].z * v[j].z + v[j].w * v[j].w); }
    const float rstd = __builtin_amdgcn_rsqf(wave_sum(s) * (1.0f / 1024.0f) + EPS);
    const f32x4* gr = (const f32x4*)g + lane;
#pragma unroll
    for (int j = 0; j < 4; ++j) { const f32x4 gg = gr[64 * j]; f32x4 o; o.x = v[j].x * rstd * gg.x; o.y = v[j].y * rstd * gg.y; o.z = v[j].z * rstd * gg.z; o.w = v[j].w * rstd * gg.w; xr[64 * j] = o; }
}

__device__ __forceinline__ void rms_rows4_bf16(const float* xrow, const float* g, bf16_t* orow, int lane) {
    f32x4 v[4][4]; float s[4];
#pragma unroll
    for (int r = 0; r < 4; ++r)
#pragma unroll
        for (int j = 0; j < 4; ++j) v[r][j] = ((const f32x4*)(xrow + (size_t)r * 1024))[lane + 64 * j];
    f32x4 gg[4];
#pragma unroll
    for (int j = 0; j < 4; ++j) gg[j] = ((const f32x4*)g)[lane + 64 * j];
#pragma unroll
    for (int r = 0; r < 4; ++r) { s[r] = 0.f;
#pragma unroll
        for (int j = 0; j < 4; ++j) s[r] += (v[r][j].x * v[r][j].x + v[r][j].y * v[r][j].y) + (v[r][j].z * v[r][j].z + v[r][j].w * v[r][j].w); }
#pragma unroll
    for (int o = 1; o < 64; o <<= 1) {
#pragma unroll
        for (int r = 0; r < 4; ++r) s[r] += __shfl_xor(s[r], o); }
#pragma unroll
    for (int r = 0; r < 4; ++r) { const float rstd = __builtin_amdgcn_rsqf(s[r] * (1.0f / 1024.0f) + EPS);
        u32x2_t* o8 = (u32x2_t*)(orow + (size_t)r * 1024) + lane;
#pragma unroll
        for (int j = 0; j < 4; ++j) { u32x2_t o; o.x = pk2(v[r][j].x * rstd * gg[j].x, v[r][j].y * rstd * gg[j].y); o.y = pk2(v[r][j].z * rstd * gg[j].z, v[r][j].w * rstd * gg[j].w); o8[64 * j] = o; } }
}
__device__ __forceinline__ void rms_rows4_f32(float* xrow, const float* g, int lane) {
    f32x4 v[4][4]; float s[4];
#pragma unroll
    for (int r = 0; r < 4; ++r)
#pragma unroll
        for (int j = 0; j < 4; ++j) v[r][j] = ((const f32x4*)(xrow + (size_t)r * 1024))[lane + 64 * j];
    f32x4 gg[4];
#pragma unroll
    for (int j = 0; j < 4; ++j) gg[j] = ((const f32x4*)g)[lane + 64 * j];
#pragma unroll
    for (int r = 0; r < 4; ++r) { s[r] = 0.f;
#pragma unroll
        for (int j = 0; j < 4; ++j) s[r] += (v[r][j].x * v[r][j].x + v[r][j].y * v[r][j].y) + (v[r][j].z * v[r][j].z + v[r][j].w * v[r][j].w); }
#pragma unroll
    for (int o = 1; o < 64; o <<= 1) {
#pragma unroll
        for (int r = 0; r < 4; ++r) s[r] += __shfl_xor(s[r], o); }
#pragma unroll
    for (int r = 0; r < 4; ++r) { const float rstd = __builtin_amdgcn_rsqf(s[r] * (1.0f / 1024.0f) + EPS);
        f32x4* xo = (f32x4*)(xrow + (size_t)r * 1024) + lane;
#pragma unroll
        for (int j = 0; j < 4; ++j) { f32x4 o; o.x = v[r][j].x * rstd * gg[j].x; o.y = v[r][j].y * rstd * gg[j].y; o.z = v[r][j].z * rstd * gg[j].z; o.w = v[r][j].w * rstd * gg[j].w; __builtin_nontemporal_store(o, &xo[64 * j]); } }
}

__device__ __forceinline__ void conv_even_item(const bf16_t* z, const float* cw, const float* cb, bf16_t* y, int t0, int T, int lane) {
    const int s = t0 & (T - 1);
#pragma unroll
    for (int half = 0; half < 2; ++half) {
        const int c0 = half * 512 + lane * 8;
        const bf16_t* zr = z + (size_t)t0 * LDZ + c0;
        u32x4_t cg[4], xv[4], bg[2], ga[2];
#pragma unroll
        for (int i = 0; i < 4; ++i) { cg[i] = (u32x4_t){0u, 0u, 0u, 0u}; xv[i] = (u32x4_t){0u, 0u, 0u, 0u}; }
        if (s > 0) { cg[0] = *(const u32x4_t*)(zr - LDZ + 1024); xv[0] = *(const u32x4_t*)(zr - LDZ + 2048); }
        cg[1] = *(const u32x4_t*)(zr + 1024); xv[1] = *(const u32x4_t*)(zr + 2048);
        cg[2] = *(const u32x4_t*)(zr + LDZ + 1024); xv[2] = *(const u32x4_t*)(zr + LDZ + 2048);
        if (s + 2 < T) { cg[3] = *(const u32x4_t*)(zr + 2 * LDZ + 1024); xv[3] = *(const u32x4_t*)(zr + 2 * LDZ + 2048); }
        bg[0] = *(const u32x4_t*)(zr); ga[0] = *(const u32x4_t*)(zr + 3072);
        bg[1] = *(const u32x4_t*)(zr + LDZ); ga[1] = *(const u32x4_t*)(zr + LDZ + 3072);
        float w0[8], w1[8], w2[8], bb[8];
#pragma unroll
        for (int e = 0; e < 8; e += 4) {
            const f32x4 a = *(const f32x4*)(cw + c0 + e), b = *(const f32x4*)(cw + 1024 + c0 + e), c = *(const f32x4*)(cw + 2048 + c0 + e), d = *(const f32x4*)(cb + c0 + e);
#pragma unroll
            for (int k = 0; k < 4; ++k) { w0[e + k] = a[k]; w1[e + k] = b[k]; w2[e + k] = c[k]; bb[e + k] = d[k]; }
        }
        float p[4][8];
#pragma unroll
        for (int i = 0; i < 4; ++i)
#pragma unroll
            for (int k = 0; k < 4; ++k) { p[i][2 * k] = bflo(cg[i][k]) * bflo(xv[i][k]); p[i][2 * k + 1] = bfhi(cg[i][k]) * bfhi(xv[i][k]); }
#pragma unroll
        for (int tt = 0; tt < 2; ++tt) {
            float o[8];
#pragma unroll
            for (int k = 0; k < 4; ++k) {
                const float cl = bb[2 * k] + w0[2 * k] * p[tt][2 * k] + w1[2 * k] * p[tt + 1][2 * k] + w2[2 * k] * p[tt + 2][2 * k];
                const float ch = bb[2 * k + 1] + w0[2 * k + 1] * p[tt][2 * k + 1] + w1[2 * k + 1] * p[tt + 1][2 * k + 1] + w2[2 * k + 1] * p[tt + 2][2 * k + 1];
                o[2 * k] = bflo(bg[tt][k]) * cl * silu(bflo(ga[tt][k]));
                o[2 * k + 1] = bfhi(bg[tt][k]) * ch * silu(bfhi(ga[tt][k]));
            }
            u32x4_t w; w.x = pk2(o[0], o[1]); w.y = pk2(o[2], o[3]); w.z = pk2(o[4], o[5]); w.w = pk2(o[6], o[7]);
            *(u32x4_t*)(y + (size_t)(t0 + tt) * LDY + c0) = w;
        }
    }
}

__device__ __forceinline__ void conv_odd_item(const bf16_t* z, const float* cw, const float* cb, bf16_t* xc, int t, int T, int lane) {
    const int s = t & (T - 1);
#pragma unroll
    for (int half = 0; half < 2; ++half) {
        const int c0 = half * 512 + lane * 8;
        const bf16_t* zr = z + (size_t)t * LDZ + c0;
        float acc[8];
#pragma unroll
        for (int e = 0; e < 8; e += 4) { const f32x4 d = *(const f32x4*)(cb + c0 + e); acc[e] = d[0]; acc[e + 1] = d[1]; acc[e + 2] = d[2]; acc[e + 3] = d[3]; }
#pragma unroll
        for (int j = 0; j < 4; ++j) {
            const int sj = s + j - 2;
            if (sj >= 0 && sj < T) {
                const u32x4_t xv = *(const u32x4_t*)(zr + (ptrdiff_t)(j - 2) * LDZ);
                const f32x4 wa = *(const f32x4*)(cw + j * 1024 + c0), wb = *(const f32x4*)(cw + j * 1024 + c0 + 4);
                acc[0] += wa[0] * bflo(xv[0]); acc[1] += wa[1] * bfhi(xv[0]); acc[2] += wa[2] * bflo(xv[1]); acc[3] += wa[3] * bfhi(xv[1]);
                acc[4] += wb[0] * bflo(xv[2]); acc[5] += wb[1] * bfhi(xv[2]); acc[6] += wb[2] * bflo(xv[3]); acc[7] += wb[3] * bfhi(xv[3]);
            }
        }
        u32x4_t w; w.x = pk2(acc[0], acc[1]); w.y = pk2(acc[2], acc[3]); w.z = pk2(acc[4], acc[5]); w.w = pk2(acc[6], acc[7]);
        *(u32x4_t*)(xc + (size_t)t * 1024 + c0) = w;
    }
}
__device__ __forceinline__ void rstd_item(const float* part, float* rstd, int tg, int lane) {
    const float* p = part + tg * 64 + lane; float s = 0.f;
#pragma unroll
    for (int i = 0; i < 8; ++i) s += p[(size_t)i * SEG];
    rstd[tg * 64 + lane] = __builtin_amdgcn_rsqf(s * (1.0f / 1024.0f) + EPS);
}

constexpr int NA_RING = 9 * 16384, NA_RPB = NA_RING, NA_LDS_END = NA_RING + 2048;
__device__ __forceinline__ int na_fk(int key) { return ((key >> 1) & 1) | (((key >> 3) & 3) << 1); }
__device__ __forceinline__ void na_stage_row(const bf16_t* z, const bf16_t* vT, LAS unsigned char* slot, int tokr, int h, int lt, int nth) {
    for (int idx = lt; idx < 512; idx += nth) {
        const int rw = idx >> 3, c = idx & 7;
        const u32x4_t kv = *(const u32x4_t*)(z + (size_t)(tokr + rw) * LDZ + 5120 + h * 64 + c * 8);
        const u32x4_t vv = *(const u32x4_t*)(vT + (size_t)(h * 64 + rw) * SEG + tokr + c * 8);
        *(LAS u32x4_t*)(slot + rw * 128 + ((c ^ na_fk(rw)) << 4)) = kv;
        *(LAS u32x4_t*)(slot + 8192 + rw * 128 + ((c ^ ((rw >> 1) & 7)) << 4)) = vv;
    }
}
__device__ __forceinline__ void na_block(const bf16_t* z, const bf16_t* vT, bf16_t* y, const float* rpb, int unit, int T, LAS unsigned char* lds, int tid) {
    const int h = unit & 15, R0 = (unit >> 4) * 16;
    const int rows = T >> 6, seq = R0 / rows, rr0 = R0 - seq * rows, seq_base = seq * T;
    const int lane = tid & 63, wid = tid >> 6, fr = lane & 15, fq = lane >> 4;
    LAS float* rpbL = (LAS float*)(lds + NA_RPB);
    __syncthreads();
    for (int i = tid; i < 465; i += 512) rpbL[i] = rpb[h * 465 + i];
    int rs0 = rr0 - 4; rs0 = rs0 < 0 ? 0 : rs0; rs0 = rs0 > rows - 8 ? rows - 8 : rs0;
    {
        const int rw = tid >> 3, c = tid & 7;
        u32x4_t kv[8], vv[8];
#pragma unroll
        for (int kr = 0; kr < 8; ++kr) { const int tokr = seq_base + (rs0 + kr) * 64;
            kv[kr] = *(const u32x4_t*)(z + (size_t)(tokr + rw) * LDZ + 5120 + h * 64 + c * 8);
            vv[kr] = *(const u32x4_t*)(vT + (size_t)(h * 64 + rw) * SEG + tokr + c * 8); }
#pragma unroll
        for (int kr = 0; kr < 8; ++kr) { LAS unsigned char* slot = lds + ((rs0 + kr) % 9) * 16384;
            *(LAS u32x4_t*)(slot + rw * 128 + ((c ^ na_fk(rw)) << 4)) = kv[kr];
            *(LAS u32x4_t*)(slot + 8192 + rw * 128 + ((c ^ ((rw >> 1) & 7)) << 4)) = vv[kr]; }
    }
    __syncthreads();
    const int g = wid & 3;
    const int wb = (g == 0) ? 0 : (g == 1) ? 8 : (g == 2) ? 24 : 32;
    const int keyA = wb + (fr >> 2) * 8 + (fr & 3);
    const int offK0 = keyA * 128 + (((0 + fq) ^ na_fk(keyA)) << 4), offK1 = keyA * 128 + (((4 + fq) ^ na_fk(keyA)) << 4);
    const int offV = 8192 + fr * 128 + ((((wb >> 3) + fq) ^ ((fr >> 1) & 7)) << 4);
    const int qc = g * 16 + fr;
    int cstart = qc - 8; cstart = cstart < 0 ? 0 : cstart; cstart = cstart > 48 ? 48 : cstart;
    int dcs[8]; bool oks[8];
#pragma unroll
    for (int e = 0; e < 8; ++e) { const int kc = wb + fq * 8 + e; oks[e] = (kc >= cstart) && (kc < cstart + 16); int dc = kc - qc; dc = dc < -15 ? -15 : dc; dc = dc > 15 ? 15 : dc; dcs[e] = dc + 15; }
    const bf16_t* zt = z + (size_t)(seq_base + rr0 * 64 + g * 16 + fr) * LDZ;
    bf16x8 q0 = ld8(zt + 4096 + h * 64 + fq * 8), q1 = ld8(zt + 4096 + h * 64 + fq * 8 + 32);
    u32x2_t gr[4];
#pragma unroll
    for (int dt = 0; dt < 4; ++dt) gr[dt] = *(const u32x2_t*)(zt + 6144 + h * 64 + dt * 16 + fq * 4);
#pragma unroll 1
    for (int i = 0; i < 16; ++i) {
        const int rr = rr0 + i;
        int rs = rr - 4; rs = rs < 0 ? 0 : rs; rs = rs > rows - 8 ? rows - 8 : rs;
        int rsn = rr - 3; rsn = rsn < 0 ? 0 : rsn; rsn = rsn > rows - 8 ? rows - 8 : rsn;
        if (wid >= 4) {
            if (i < 15 && rsn > rs) { const int a = rsn + 7, tokr = seq_base + a * 64, lt = tid - 256; LAS unsigned char* slot = lds + (a % 9) * 16384;
                u32x4_t kv[2], vv[2];
#pragma unroll
                for (int j = 0; j < 2; ++j) { const int idx = lt + 256 * j, rw = idx >> 3, c = idx & 7;
                    kv[j] = *(const u32x4_t*)(z + (size_t)(tokr + rw) * LDZ + 5120 + h * 64 + c * 8); vv[j] = *(const u32x4_t*)(vT + (size_t)(h * 64 + rw) * SEG + tokr + c * 8); }
#pragma unroll
                for (int j = 0; j < 2; ++j) { const int idx = lt + 256 * j, rw = idx >> 3, c = idx & 7;
                    *(LAS u32x4_t*)(slot + rw * 128 + ((c ^ na_fk(rw)) << 4)) = kv[j]; *(LAS u32x4_t*)(slot + 8192 + rw * 128 + ((c ^ ((rw >> 1) & 7)) << 4)) = vv[j]; } }
        } else {
            const bf16_t* ztc = zt + (size_t)i * 64 * LDZ;
            bf16x8 q0n = q0, q1n = q1; u32x2_t grn[4];
#pragma unroll
            for (int dt = 0; dt < 4; ++dt) grn[dt] = gr[dt];
            if (i < 15) {
                const bf16_t* ztn = ztc + (size_t)64 * LDZ;
                q0n = ld8(ztn + 4096 + h * 64 + fq * 8); q1n = ld8(ztn + 4096 + h * 64 + fq * 8 + 32);
#pragma unroll
                for (int dt = 0; dt < 4; ++dt) grn[dt] = *(const u32x2_t*)(ztn + 6144 + h * 64 + dt * 16 + fq * 4);
            }
            const LAS float* bp0 = rpbL + (rs - rr + 7) * 31;
            float s[8][8];
            float mx = -1e30f;
            int slot = rs % 9;
#pragma unroll
            for (int kr = 0; kr < 8; ++kr) {
                const LAS unsigned char* sb = lds + slot * 16384;
                slot = (slot == 8) ? 0 : slot + 1;
                const bf16x8 k00 = *(const LAS bf16x8*)(sb + offK0), k01 = *(const LAS bf16x8*)(sb + offK1);
                const bf16x8 k10 = *(const LAS bf16x8*)(sb + offK0 + 512), k11 = *(const LAS bf16x8*)(sb + offK1 + 512);
                f32x4 a0 = {0.f, 0.f, 0.f, 0.f}, a1 = {0.f, 0.f, 0.f, 0.f};
                a0 = mfma16(k00, q0, a0); a0 = mfma16(k01, q1, a0);
                a1 = mfma16(k10, q0, a1); a1 = mfma16(k11, q1, a1);
#pragma unroll
                for (int e = 0; e < 8; ++e) {
                    const float sc = (e < 4 ? a0[e & 3] : a1[e & 3]) * 0.125f + bp0[kr * 31 + dcs[e]];
                    s[kr][e] = oks[e] ? sc : -1e30f;
                    mx = fmaxf(mx, s[kr][e]);
                }
            }
            mx = fmaxf(mx, __shfl_xor(mx, 16)); mx = fmaxf(mx, __shfl_xor(mx, 32));
            float sum = 0.f;
#pragma unroll
            for (int kr = 0; kr < 8; ++kr)
#pragma unroll
                for (int e = 0; e < 8; ++e) { const float p = __expf(s[kr][e] - mx); s[kr][e] = p; sum += p; }
            sum += __shfl_xor(sum, 16); sum += __shfl_xor(sum, 32);
            f32x4 o[4];
#pragma unroll
            for (int dt = 0; dt < 4; ++dt) o[dt] = (f32x4){0.f, 0.f, 0.f, 0.f};
            slot = rs % 9;
#pragma unroll
            for (int kr = 0; kr < 8; ++kr) {
                const LAS unsigned char* sb = lds + slot * 16384 + offV;
                slot = (slot == 8) ? 0 : slot + 1;
                const bf16x8 pf = pack8(s[kr]);
#pragma unroll
                for (int dt = 0; dt < 4; ++dt) o[dt] = mfma16(*(const LAS bf16x8*)(sb + dt * 2048), pf, o[dt]);
            }
            const float inv = frcp(sum);
            bf16_t* yt = y + (size_t)(seq_base + rr * 64 + g * 16 + fr) * LDY + 1024 + h * 64;
#pragma unroll
            for (int dt = 0; dt < 4; ++dt) {
                u32x2_t ow;
                ow.x = pk2(o[dt][0] * inv * silu(bflo(gr[dt].x)), o[dt][1] * inv * silu(bfhi(gr[dt].x)));
                ow.y = pk2(o[dt][2] * inv * silu(bflo(gr[dt].y)), o[dt][3] * inv * silu(bfhi(gr[dt].y)));
                *(u32x2_t*)(yt + dt * 16 + fq * 4) = ow;
            }
            q0 = q0n; q1 = q1n;
#pragma unroll
            for (int dt = 0; dt < 4; ++dt) gr[dt] = grn[dt];
        }
        __syncthreads();
    }
}

__device__ __forceinline__ void mem_unit(const bf16_t* z, int qcol, int gcol, const bf16_t* mk, const bf16_t* mvT, bf16_t* y, int unit, int seg, LAS unsigned char* lds, int tid) {
    const int h = unit & 3, range = unit >> 2, tokr = range * 256;
    const int mb = seg < 2 ? seg : 2 + (tokr >> 12);
    const int lane = tid & 63, wid = tid >> 6, fr = lane & 15, fq = lane >> 4;
    __syncthreads();
    {
        u32x4_t kv[8], vv[8];
#pragma unroll
        for (int i = 0; i < 8; ++i) { const int idx = tid + 512 * i;
            kv[i] = *(const u32x4_t*)(mk + (size_t)(mb * 256 + (idx >> 4)) * 512 + h * 128 + (idx & 15) * 8);
            vv[i] = *(const u32x4_t*)(mvT + (size_t)(h * 128 + (idx >> 5)) * 1536 + mb * 256 + (idx & 31) * 8); }
#pragma unroll
        for (int i = 0; i < 8; ++i) { const int idx = tid + 512 * i;
            { const int rho = idx >> 4, c = idx & 15, f = (rho & 3) | (((rho >> 3) & 3) << 2); *(LAS u32x4_t*)(lds + rho * 256 + ((c ^ f) << 4)) = kv[i]; }
            { const int d = idx >> 5, c = idx & 31; *(LAS u32x4_t*)(lds + 65536 + d * 512 + ((c ^ (d & 15)) << 4)) = vv[i]; } }
    }
    __syncthreads();
    const int mrowA = (fr >> 2) * 8 + (fr & 3);
    const LAS unsigned char* kbase = lds + mrowA * 256 + ((fq ^ (fr & 3)) << 4);
    const LAS unsigned char* vbase = lds + 65536 + fr * 512 + ((fq ^ (fr & 3)) << 4);
    const int hi = fr >> 2;
#pragma unroll 1
    for (int gi = 0; gi < 2; ++gi) {
        const int tok = tokr + (wid + 8 * gi) * 16 + fr;
        const bf16_t* qp = z + (size_t)tok * LDZ + qcol + h * 128 + fq * 8;
        bf16x8 q[4];
#pragma unroll
        for (int ks = 0; ks < 4; ++ks) q[ks] = ld8(qp + ks * 32);
        u32x2_t gr[8];
#pragma unroll
        for (int dt = 0; dt < 8; ++dt) gr[dt] = *(const u32x2_t*)(z + (size_t)tok * LDZ + gcol + h * 128 + dt * 16 + fq * 4);
        float s[8][8];
        float mx = -1e30f;
#pragma unroll
        for (int kb = 0; kb < 8; ++kb) {
            f32x4 a0 = {0.f, 0.f, 0.f, 0.f}, a1 = {0.f, 0.f, 0.f, 0.f};
#pragma unroll
            for (int ks = 0; ks < 4; ++ks) {
                const LAS unsigned char* kp = kbase + kb * 8192 + ((ks ^ hi) << 6);
                a0 = mfma16(*(const LAS bf16x8*)kp, q[ks], a0); a1 = mfma16(*(const LAS bf16x8*)(kp + 1024), q[ks], a1);
            }
#pragma unroll
            for (int e = 0; e < 8; ++e) { s[kb][e] = (e < 4 ? a0[e & 3] : a1[e & 3]) * 0.08838834764831845f; mx = fmaxf(mx, s[kb][e]); }
        }
        mx = fmaxf(mx, __shfl_xor(mx, 16)); mx = fmaxf(mx, __shfl_xor(mx, 32));
        float sum = 0.f;
#pragma unroll
        for (int kb = 0; kb < 8; ++kb)
#pragma unroll
            for (int e = 0; e < 8; ++e) { const float p = __expf(s[kb][e] - mx); s[kb][e] = p; sum += p; }
        sum += __shfl_xor(sum, 16); sum += __shfl_xor(sum, 32);
        f32x4 o[8];
#pragma unroll
        for (int dt = 0; dt < 8; ++dt) o[dt] = (f32x4){0.f, 0.f, 0.f, 0.f};
#pragma unroll
        for (int kb = 0; kb < 8; ++kb) {
            const bf16x8 pf = pack8(s[kb]);
            const LAS unsigned char* vp = vbase + (((kb ^ hi) & 7) << 6);
#pragma unroll
            for (int dt = 0; dt < 8; ++dt) o[dt] = mfma16(*(const LAS bf16x8*)(vp + dt * 8192), pf, o[dt]);
        }
        const float inv = frcp(sum);
#pragma unroll
        for (int dt = 0; dt < 8; ++dt) {
            const int d4 = dt * 16 + fq * 4;
            u32x2_t ow;
            ow.x = pk2(o[dt][0] * inv * silu(bflo(gr[dt].x)), o[dt][1] * inv * silu(bfhi(gr[dt].x)));
            ow.y = pk2(o[dt][2] * inv * silu(bflo(gr[dt].y)), o[dt][3] * inv * silu(bfhi(gr[dt].y)));
            *(u32x2_t*)(y + (size_t)tok * LDY + 2048 + h * 128 + d4) = ow;
        }
    }
}

template <int CTRL> __device__ __forceinline__ float dppf(float oldv, float src) {
    return __int_as_float(__builtin_amdgcn_update_dpp(__float_as_int(oldv), __float_as_int(src), CTRL, 0xf, 0xf, false));
}
#define SCAN_STEP(SH) \
    "v_fmac_f32_dpp %4, %4, %0 " SH " row_mask:0xf bank_mask:0xf\n" \
    "v_fmac_f32_dpp %5, %5, %1 " SH " row_mask:0xf bank_mask:0xf\n" \
    "v_fmac_f32_dpp %6, %6, %2 " SH " row_mask:0xf bank_mask:0xf\n" \
    "v_fmac_f32_dpp %7, %7, %3 " SH " row_mask:0xf bank_mask:0xf\n" \
    "v_mul_f32_dpp %0, %0, %0 " SH " row_mask:0xf bank_mask:0xf\n" \
    "v_mul_f32_dpp %1, %1, %1 " SH " row_mask:0xf bank_mask:0xf\n" \
    "v_mul_f32_dpp %2, %2, %2 " SH " row_mask:0xf bank_mask:0xf\n" \
    "v_mul_f32_dpp %3, %3, %3 " SH " row_mask:0xf bank_mask:0xf\n"
template <int DIR> __device__ __forceinline__ void scan16x4(float (&A)[4], float (&B)[4]) {
    if (DIR == 0)
        asm volatile("s_nop 1\n" SCAN_STEP("row_shr:1") SCAN_STEP("row_shr:2") SCAN_STEP("row_shr:4") SCAN_STEP("row_shr:8")
                     : "+v"(A[0]), "+v"(A[1]), "+v"(A[2]), "+v"(A[3]), "+v"(B[0]), "+v"(B[1]), "+v"(B[2]), "+v"(B[3]));
    else
        asm volatile("s_nop 1\n" SCAN_STEP("row_shl:1") SCAN_STEP("row_shl:2") SCAN_STEP("row_shl:4") SCAN_STEP("row_shl:8")
                     : "+v"(A[0]), "+v"(A[1]), "+v"(A[2]), "+v"(A[3]), "+v"(B[0]), "+v"(B[1]), "+v"(B[2]), "+v"(B[3]));
}
template <int DIR> __device__ __forceinline__ void bcast4(const float (&v)[4], float (&o)[4]) {
    if (DIR == 0)
        asm volatile("s_nop 1\n"
                     "v_mov_b32_dpp %0, %4 row_newbcast:15 row_mask:0xf bank_mask:0xf\n" "v_mov_b32_dpp %1, %5 row_newbcast:15 row_mask:0xf bank_mask:0xf\n"
                     "v_mov_b32_dpp %2, %6 row_newbcast:15 row_mask:0xf bank_mask:0xf\n" "v_mov_b32_dpp %3, %7 row_newbcast:15 row_mask:0xf bank_mask:0xf\n"
                     : "=&v"(o[0]), "=&v"(o[1]), "=&v"(o[2]), "=&v"(o[3]) : "v"(v[0]), "v"(v[1]), "v"(v[2]), "v"(v[3]));
    else
        asm volatile("s_nop 1\n"
                     "v_mov_b32_dpp %0, %4 row_newbcast:0 row_mask:0xf bank_mask:0xf\n" "v_mov_b32_dpp %1, %5 row_newbcast:0 row_mask:0xf bank_mask:0xf\n"
                     "v_mov_b32_dpp %2, %6 row_newbcast:0 row_mask:0xf bank_mask:0xf\n" "v_mov_b32_dpp %3, %7 row_newbcast:0 row_mask:0xf bank_mask:0xf\n"
                     : "=&v"(o[0]), "=&v"(o[1]), "=&v"(o[2]), "=&v"(o[3]) : "v"(v[0]), "v"(v[1]), "v"(v[2]), "v"(v[3]));
}
struct LruW { bf16x8 Wa[4], Wi[4]; float ba[4], bi[4], c8[4]; };
struct LruX { bf16x8 x[2][4]; u32x2_t xr[2]; };
__device__ __forceinline__ void lru_loadw(LruW& W, const bf16_t* lruw, const float* ba_, const float* bi_, const float* lam_, int dir, int blk, int w, int ch4, int lane) {
    const int fr = lane & 15, fq = lane >> 4;
    const bf16_t* wa = lruw + ((size_t)((0 * 2 + dir) * 8 + blk) * 128 + w * 16 + fr) * 128 + fq * 8;
    const bf16_t* wi = lruw + ((size_t)((1 * 2 + dir) * 8 + blk) * 128 + w * 16 + fr) * 128 + fq * 8;
#pragma unroll
    for (int ks = 0; ks < 4; ++ks) { W.Wa[ks] = ld8(wa + ks * 32); W.Wi[ks] = ld8(wi + ks * 32); }
    const f32x4 a = *(const f32x4*)(ba_ + dir * 1024 + ch4), b = *(const f32x4*)(bi_ + dir * 1024 + ch4), l = *(const f32x4*)(lam_ + dir * 1024 + ch4);
#pragma unroll
    for (int jj = 0; jj < 4; ++jj) { W.ba[jj] = -1.4426950408889634f * a[jj]; W.bi[jj] = -1.4426950408889634f * b[jj]; W.c8[jj] = -8.0f * 1.4426950408889634f * log1pf(__expf(-l[jj])); }
}
__device__ __forceinline__ void conv_tile_to_lds(const bf16_t* z, const float* cw, const float* cb, LAS unsigned char* xl, int chunk, int blk, int T, int tid) {
    const int c = tid & 15, ch0 = blk * 128 + c * 8;
    float w[4][8], bb[8];
#pragma unroll
    for (int j = 0; j < 4; ++j) { const f32x4 a = *(const f32x4*)(cw + j * 1024 + ch0), b = *(const f32x4*)(cw + j * 1024 + ch0 + 4);
#pragma unroll
        for (int e = 0; e < 4; ++e) { w[j][e] = a[e]; w[j][4 + e] = b[e]; } }
    { const f32x4 a = *(const f32x4*)(cb + ch0), b = *(const f32x4*)(cb + ch0 + 4);
#pragma unroll
        for (int e = 0; e < 4; ++e) { bb[e] = a[e]; bb[4 + e] = b[e]; } }
    u32x4_t xin[4][4];
#pragma unroll
    for (int i = 0; i < 4; ++i) {
        const int r = (tid >> 4) + 32 * i, t = chunk * 128 + r, s = t & (T - 1);
#pragma unroll
        for (int j = 0; j < 4; ++j) {
            const int sj = s + j - 2;
            xin[i][j] = (u32x4_t){0u, 0u, 0u, 0u};
            if (sj >= 0 && sj < T) xin[i][j] = *(const u32x4_t*)(z + (size_t)(t + j - 2) * LDZ + ch0);
        }
    }
#pragma unroll
    for (int i = 0; i < 4; ++i) {
        const int r = (tid >> 4) + 32 * i;
        float acc[8];
#pragma unroll
        for (int e = 0; e < 8; ++e) acc[e] = bb[e];
#pragma unroll
        for (int j = 0; j < 4; ++j) {
            const u32x4_t xv = xin[i][j];
            acc[0] += w[j][0] * bflo(xv[0]); acc[1] += w[j][1] * bfhi(xv[0]); acc[2] += w[j][2] * bflo(xv[1]); acc[3] += w[j][3] * bfhi(xv[1]);
            acc[4] += w[j][4] * bflo(xv[2]); acc[5] += w[j][5] * bfhi(xv[2]); acc[6] += w[j][6] * bflo(xv[3]); acc[7] += w[j][7] * bfhi(xv[3]);
        }
        u32x4_t o; o.x = pk2(acc[0], acc[1]); o.y = pk2(acc[2], acc[3]); o.z = pk2(acc[4], acc[5]); o.w = pk2(acc[6], acc[7]);
        *(LAS u32x4_t*)(xl + r * 256 + ((c ^ (r & 15)) << 4)) = o;
    }
}
__device__ __forceinline__ void lru_loadx(LruX& X, const LAS unsigned char* xl, int r0, int w, int lane) {
    const int fr = lane & 15, fq = lane >> 4;
#pragma unroll
    for (int t = 0; t < 2; ++t) {
        const int r = r0 + t * 16 + fr;
        const LAS unsigned char* rp = xl + r * 256;
#pragma unroll
        for (int ks = 0; ks < 4; ++ks) X.x[t][ks] = *(const LAS bf16x8*)(rp + (((ks * 4 + fq) ^ fr) << 4));
        X.xr[t] = *(const LAS u32x2_t*)(rp + (((w * 2 + (fq >> 1)) ^ fr) << 4) + (fq & 1) * 8);
    }
}
template <int DIR, bool FINAL> __device__ __forceinline__ void lru_tile(const bf16x8 (&Xf)[4], const u32x2_t xr, const LruW& W, int lane, float (&hin)[4], float (&arun)[4], float (&hout)[4], unsigned (&lab)[4]) {
    f32x4 accR = {0.f, 0.f, 0.f, 0.f}, accI = {0.f, 0.f, 0.f, 0.f};
#pragma unroll
    for (int ks = 0; ks < 4; ++ks) { accR = mfma16(W.Wa[ks], Xf[ks], accR); accI = mfma16(W.Wi[ks], Xf[ks], accI); }
    const float xv[4] = {bflo(xr.x), bfhi(xr.x), bflo(xr.y), bfhi(xr.y)};
    const int src = (lane & 48) + (DIR == 0 ? 15 : 0);
    float A[4], B[4];
    typedef float f32x2 __attribute__((ext_vector_type(2)));
#pragma unroll
    for (int p = 0; p < 2; ++p) {
        const f32x2 ar = {accR[2 * p], accR[2 * p + 1]}, ai = {accI[2 * p], accI[2 * p + 1]};
        const f32x2 bar = {W.ba[2 * p], W.ba[2 * p + 1]}, bai = {W.bi[2 * p], W.bi[2 * p + 1]}, c8v = {W.c8[2 * p], W.c8[2 * p + 1]}, xvv = {xv[2 * p], xv[2 * p + 1]};
        const f32x2 tr = ar * (-1.4426950408889634f) + bar, ti = ai * (-1.4426950408889634f) + bai;
        f32x2 er, ei; er.x = __builtin_amdgcn_exp2f(tr.x); er.y = __builtin_amdgcn_exp2f(tr.y); ei.x = __builtin_amdgcn_exp2f(ti.x); ei.y = __builtin_amdgcn_exp2f(ti.y);
        er = er + 1.0f; ei = ei + 1.0f;
        f32x2 rg, ig; rg.x = frcp(er.x); rg.y = frcp(er.y); ig.x = frcp(ei.x); ig.y = frcp(ei.y);
        const f32x2 la = c8v * rg;
        f32x2 Av; Av.x = __builtin_amdgcn_exp2f(la.x); Av.y = __builtin_amdgcn_exp2f(la.y);
        f32x2 om = 1.0f - Av * Av;
        f32x2 sq; sq.x = __builtin_amdgcn_sqrtf(fmaxf(om.x, 0.f)); sq.y = __builtin_amdgcn_sqrtf(fmaxf(om.y, 0.f));
        const f32x2 Bv = sq * (ig * xvv);
        A[2 * p] = Av.x; A[2 * p + 1] = Av.y; B[2 * p] = Bv.x; B[2 * p + 1] = Bv.y;
        lab[2 * p] = __builtin_bit_cast(unsigned, __builtin_amdgcn_cvt_pkrtz(la.x, Bv.x));
        lab[2 * p + 1] = __builtin_bit_cast(unsigned, __builtin_amdgcn_cvt_pkrtz(la.y, Bv.y));
    }
    scan16x4<DIR>(A, B);
#pragma unroll
    for (int jj = 0; jj < 4; ++jj) hout[jj] = A[jj] * hin[jj] + B[jj];
    bcast4<DIR>(hout, hin);
    if (!FINAL) { float At[4]; bcast4<DIR>(A, At);
#pragma unroll
        for (int jj = 0; jj < 4; ++jj) arun[jj] *= At[jj]; }
}
template <bool FINAL> __device__ __forceinline__ void lru_item(const LAS unsigned char* xl, const bf16_t* z, const bf16_t* lruw, const float* ba_, const float* bi_, const float* lam_,
                                                               float* agg, const float* carry, bf16_t* y, unsigned* labuf, int item, int lane) {
    const int cgi = item & 63, chunk = item >> 6, blk = cgi >> 3, w = cgi & 7;
    const int fr = lane & 15, fq = lane >> 4;
    const int ch4 = blk * 128 + w * 16 + fq * 4;
    const int tokc = chunk * 128;
    LruX X[2]; LruW W0;
    lru_loadw(W0, lruw, ba_, bi_, lam_, 0, blk, w, ch4, lane);
    lru_loadx(X[0], xl, 0, w, lane);
    unsigned hf[8][2];
    float hin[4], arun[4];
#pragma unroll
    for (int jj = 0; jj < 4; ++jj) { hin[jj] = FINAL ? carry[(size_t)(0 * 128 + chunk) * 1024 + ch4 + jj] : 0.f; arun[jj] = 1.f; }
#pragma unroll
    for (int bi = 0; bi < 8; ++bi) {
        __builtin_amdgcn_sched_barrier(0);
        const int slot = bi < 4 ? (bi & 1) : ((bi + 1) & 1);
        const int pair = bi < 4 ? bi : 7 - bi;
        if (bi + 1 < 8 && bi + 1 != 4) {
            const int nslot = (bi + 1) < 4 ? ((bi + 1) & 1) : ((bi + 2) & 1);
            const int npair = (bi + 1) < 4 ? (bi + 1) : 7 - (bi + 1);
            lru_loadx(X[nslot], xl, npair * 32, w, lane);
        }
        if (bi == 4) {
            lru_loadw(W0, lruw, ba_, bi_, lam_, 1, blk, w, ch4, lane);
            if (!FINAL && fr == 0) {
#pragma unroll
                for (int jj = 0; jj < 4; ++jj) { float2 v; v.x = arun[jj]; v.y = hin[jj]; *(float2*)(agg + ((size_t)(0 * 128 + chunk) * 1024 + ch4 + jj) * 2) = v; }
            }
#pragma unroll
            for (int jj = 0; jj < 4; ++jj) { hin[jj] = FINAL ? carry[(size_t)(1 * 128 + chunk) * 1024 + ch4 + jj] : 0.f; arun[jj] = 1.f; }
        }
#pragma unroll
        for (int k = 0; k < 2; ++k) {
            const int t = bi < 4 ? k : 1 - k;
            const int tt = 2 * pair + t;
            float hv[4]; unsigned lab[4];
            if (bi < 4) lru_tile<0, FINAL>(X[slot].x[t], X[slot].xr[t], W0, lane, hin, arun, hv, lab);
            else lru_tile<1, FINAL>(X[slot].x[t], X[slot].xr[t], W0, lane, hin, arun, hv, lab);
            if (!FINAL) { u32x4_t lw; lw.x = lab[0]; lw.y = lab[1]; lw.z = lab[2]; lw.w = lab[3];
                *(u32x4_t*)(labuf + ((((size_t)(bi < 4 ? 0 : 1) * 128 + chunk) * 64 + cgi) * 8 + (2 * pair + t)) * 256 + lane * 4) = lw; }
            if (FINAL) {
                if (bi < 4) {
                    hf[tt][0] = pk2(hv[0], hv[1]); hf[tt][1] = pk2(hv[2], hv[3]);
                } else {
                    const int tok = tokc + tt * 16 + fr;
                    const u32x2_t gr = *(const u32x2_t*)(z + (size_t)tok * LDZ + 1024 + ch4);
                    const float gc[4] = {bflo(gr.x), bfhi(gr.x), bflo(gr.y), bfhi(gr.y)};
                    const float hfv[4] = {bflo(hf[tt][0]), bfhi(hf[tt][0]), bflo(hf[tt][1]), bfhi(hf[tt][1])};
                    float o[4];
#pragma unroll
                    for (int jj = 0; jj < 4; ++jj) o[jj] = (hfv[jj] + hv[jj]) * silu(gc[jj]);
                    u32x2_t ow; ow.x = pk2(o[0], o[1]); ow.y = pk2(o[2], o[3]);
                    *(u32x2_t*)(y + (size_t)tok * LDY + ch4) = ow;
                }
            }
        }
    }
    if (!FINAL && fr == 0) {
#pragma unroll
        for (int jj = 0; jj < 4; ++jj) { float2 v; v.x = arun[jj]; v.y = hin[jj]; *(float2*)(agg + ((size_t)(1 * 128 + chunk) * 1024 + ch4 + jj) * 2) = v; }
    }
}
struct LruF { u32x4_t L[2][8]; u32x2_t gr[8]; };
__device__ __forceinline__ void lru_final_load(LruF& F, const unsigned* labuf, const bf16_t* z, int item, int lane) {
    const int cgi = item & 63, chunk = item >> 6, fr = lane & 15, fq = lane >> 4;
    const int ch4 = cgi * 16 + fq * 4, tokc = chunk * 128;
#pragma unroll
    for (int d = 0; d < 2; ++d)
#pragma unroll
        for (int tt = 0; tt < 8; ++tt) F.L[d][tt] = __builtin_nontemporal_load((const u32x4_t*)(labuf + ((((size_t)d * 128 + chunk) * 64 + cgi) * 8 + tt) * 256 + lane * 4));
#pragma unroll
    for (int tt = 0; tt < 8; ++tt) F.gr[tt] = *(const u32x2_t*)(z + (size_t)(tokc + tt * 16 + fr) * LDZ + 1024 + ch4);
}
template <bool WAVEC> __device__ __forceinline__ void lru_final_compute(const LruF& F, const float* carry, float hcv, bf16_t* y, int item, int lane) {
    typedef _Float16 h2_t __attribute__((ext_vector_type(2)));
    const int cgi = item & 63, chunk = item >> 6;
    const int fr = lane & 15, fq = lane >> 4;
    const int ch4 = cgi * 16 + fq * 4, tokc = chunk * 128;
    float hf[8][4];
    {
        float hin[4];
#pragma unroll
        for (int jj = 0; jj < 4; ++jj) hin[jj] = WAVEC ? __shfl(hcv, fq * 4 + jj) : carry[(size_t)(0 * 128 + chunk) * 1024 + ch4 + jj];
#pragma unroll
        for (int tt = 0; tt < 8; ++tt) {
            float A[4], B[4];
#pragma unroll
            for (int jj = 0; jj < 4; ++jj) {
                const unsigned wv = F.L[0][tt][jj]; const h2_t v = __builtin_bit_cast(h2_t, wv);
                A[jj] = __builtin_amdgcn_exp2f((float)v.x); B[jj] = (float)v.y;
            }
            scan16x4<0>(A, B);
#pragma unroll
            for (int jj = 0; jj < 4; ++jj) hf[tt][jj] = A[jj] * hin[jj] + B[jj];
            bcast4<0>(hf[tt], hin);
        }
    }
    {
        float hin[4];
#pragma unroll
        for (int jj = 0; jj < 4; ++jj) hin[jj] = WAVEC ? __shfl(hcv, 16 + fq * 4 + jj) : carry[(size_t)(1 * 128 + chunk) * 1024 + ch4 + jj];
#pragma unroll
        for (int s = 0; s < 8; ++s) {
            const int tt = 7 - s;
            float o[4], A[4], B[4];
#pragma unroll
            for (int jj = 0; jj < 4; ++jj) {
                const unsigned wv = F.L[1][tt][jj]; const h2_t v = __builtin_bit_cast(h2_t, wv);
                A[jj] = __builtin_amdgcn_exp2f((float)v.x); B[jj] = (float)v.y;
            }
            scan16x4<1>(A, B);
            float hb[4];
#pragma unroll
            for (int jj = 0; jj < 4; ++jj) { hb[jj] = A[jj] * hin[jj] + B[jj]; o[jj] = hf[tt][jj] + hb[jj]; }
            bcast4<1>(hb, hin);
            const float gc[4] = {bflo(F.gr[tt].x), bfhi(F.gr[tt].x), bflo(F.gr[tt].y), bfhi(F.gr[tt].y)};
            u32x2_t ow; ow.x = pk2(o[0] * silu(gc[0]), o[1] * silu(gc[1])); ow.y = pk2(o[2] * silu(gc[2]), o[3] * silu(gc[3]));
            *(u32x2_t*)(y + (size_t)(tokc + tt * 16 + fr) * LDY + ch4) = ow;
        }
    }
}
__device__ __forceinline__ void wave_carries(const float* agg, int cgi, int chunk0, int nseq, int lane, float (&hc)[4]) {
    const int q = lane >> 4, ch = cgi * 16 + (lane & 15);
    const bool up = (lane & 16) != 0;
    float2 ag[2][32];
#pragma unroll
    for (int dir = 0; dir < 2; ++dir)
#pragma unroll
        for (int cc = 0; cc < 32; ++cc) ag[dir][cc] = *(const float2*)(agg + ((size_t)(dir * 128 + 32 * q + cc) * 1024 + ch) * 2);
#pragma unroll
    for (int dir = 0; dir < 2; ++dir) {
        float A = 1.f, h = 0.f, Ap = 1.f, Hp = 0.f;
#pragma unroll
        for (int step = 0; step < 32; ++step) {
            const int cc = dir == 0 ? step : 31 - step;
            if (cc == chunk0) { Ap = A; Hp = h; }
            const float2 ah = ag[dir][cc];
            h = ah.x * h + ah.y; A *= ah.x;
        }
        float Aq[4], Hq[4], Apk[4], Hpk[4];
#pragma unroll
        for (int k = 0; k < 4; ++k) { const int src = k * 16 + (lane & 15); Aq[k] = __shfl(A, src); Hq[k] = __shfl(h, src); Apk[k] = __shfl(Ap, src); Hpk[k] = __shfl(Hp, src); }
        float S[4];
        if (dir == 0) { S[0] = 0.f; S[1] = Hq[0]; S[2] = Aq[1] * S[1] + Hq[1]; S[3] = Aq[2] * S[2] + Hq[2]; }
        else { S[3] = 0.f; S[2] = Hq[3]; S[1] = Aq[2] * S[2] + Hq[2]; S[0] = Aq[1] * S[1] + Hq[1]; }
#pragma unroll
        for (int k = 0; k < 4; ++k) { const float v = Apk[k] * (nseq == 1 ? S[k] : 0.f) + Hpk[k]; if (dir == 0) hc[k] = v; else hc[k] = up ? v : hc[k]; }
    }
}
__device__ __forceinline__ void carry_phase(const float* agg, float* carry, int nseq, int gtid, int gthreads) {
    const int nc = 128 / nseq;
    for (int idx = gtid; idx < 2 * nseq * 1024; idx += gthreads) {
        const int ch = idx & 1023, rest = idx >> 10, dir = rest & 1, sq = rest >> 1, base = sq * nc;
        float h = 0.f;
#pragma unroll 8
        for (int c = 0; c < nc; ++c) {
            const int C = base + (dir == 0 ? c : nc - 1 - c);
            const size_t o = (size_t)(dir * 128 + C) * 1024 + ch;
            const float2 ah = *(const float2*)(agg + o * 2);
            carry[o] = h;
            h = ah.x * h + ah.y;
        }
    }
}

__device__ __forceinline__ void sgu_item2(const bf16_t* vT, const LAS float* rstd, const LAS unsigned char* wsl, const bf16_t* z, const float* sgu_g, const float* sgu_b, bf16_t* y,
                                          int n, int g, int qd, int lane) {
    const int fr = lane & 15, fq = lane >> 4;
    const int tokc = n * 128, chq = g * 128 + qd * 32;
    bf16x8 Af[2][4];
#pragma unroll
    for (int t = 0; t < 2; ++t) {
        const bf16_t* ap = vT + (size_t)(chq + (fr >> 2) * 8 + (fr & 3) + 4 * t) * SEG + tokc + fq * 8;
#pragma unroll
        for (int ks = 0; ks < 4; ++ks) {
            const u32x4_t raw = *(const u32x4_t*)(ap + ks * 32);
            const f32x4 r0 = *(const LAS f32x4*)(rstd + ks * 32 + fq * 8), r1 = *(const LAS f32x4*)(rstd + ks * 32 + fq * 8 + 4);
            u32x4_t w;
            w.x = pk2(bflo(raw.x) * r0[0], bfhi(raw.x) * r0[1]); w.y = pk2(bflo(raw.y) * r0[2], bfhi(raw.y) * r0[3]);
            w.z = pk2(bflo(raw.z) * r1[0], bfhi(raw.z) * r1[1]); w.w = pk2(bflo(raw.w) * r1[2], bfhi(raw.w) * r1[3]);
            Af[t][ks] = __builtin_bit_cast(bf16x8, w);
        }
    }
    const int ch8 = chq + fq * 8;
    const f32x4 g0 = *(const f32x4*)(sgu_g + ch8), g1 = *(const f32x4*)(sgu_g + ch8 + 4);
    u32x4_t urv[8], grv[8]; float bsvv[8];
#pragma unroll
    for (int pt = 0; pt < 8; ++pt) { const int p = pt * 16 + fr, tok = tokc + p;
        urv[pt] = *(const u32x4_t*)(z + (size_t)tok * LDZ + 2048 + ch8); grv[pt] = *(const u32x4_t*)(z + (size_t)tok * LDZ + 3072 + ch8); bsvv[pt] = sgu_b[g * 128 + p]; }
#pragma unroll
    for (int pt = 0; pt < 8; ++pt) {
        const int p = pt * 16 + fr, tok = tokc + p;
        const u32x4_t ur = urv[pt], gr = grv[pt];
        const float bsv = bsvv[pt];
        const LAS unsigned char* bp = wsl + p * 256;
        f32x4 a0 = {0.f, 0.f, 0.f, 0.f}, a1 = {0.f, 0.f, 0.f, 0.f};
#pragma unroll
        for (int ks = 0; ks < 4; ++ks) { const bf16x8 Bf = *(const LAS bf16x8*)(bp + (((ks * 4 + fq) ^ fr) << 4)); a0 = mfma16(Af[0][ks], Bf, a0); a1 = mfma16(Af[1][ks], Bf, a1); }
        float o[8];
#pragma unroll
        for (int k = 0; k < 2; ++k) {
            o[2 * k] = bflo(ur[k]) * (a0[2 * k] * g0[2 * k] + bsv) * silu(bflo(gr[k]));
            o[2 * k + 1] = bfhi(ur[k]) * (a0[2 * k + 1] * g0[2 * k + 1] + bsv) * silu(bfhi(gr[k]));
            o[4 + 2 * k] = bflo(ur[2 + k]) * (a1[2 * k] * g1[2 * k] + bsv) * silu(bflo(gr[2 + k]));
            o[4 + 2 * k + 1] = bfhi(ur[2 + k]) * (a1[2 * k + 1] * g1[2 * k + 1] + bsv) * silu(bfhi(gr[2 + k]));
        }
        u32x4_t ow; ow.x = pk2(o[0], o[1]); ow.y = pk2(o[2], o[3]); ow.z = pk2(o[4], o[5]); ow.w = pk2(o[6], o[7]);
        *(u32x4_t*)(y + (size_t)tok * LDY + 1024 + ch8) = ow;
    }
}

__device__ __forceinline__ void sgu_item(const bf16_t* vT, const LAS float* rstd, const bf16_t* z, const bf16_t* sguw, const float* sgu_g, const float* sgu_b, bf16_t* y, int item, int lane) {
    const int dd = item & 7, g = (item >> 3) & 7, n = item >> 6;
    const int fr = lane & 15, fq = lane >> 4;
    const int tokc = n * 128;
    const bf16_t* ap = vT + (size_t)(g * 128 + dd * 16 + fr) * SEG + tokc + fq * 8;
    bf16x8 Af[4];
#pragma unroll
    for (int ks = 0; ks < 4; ++ks) {
        const u32x4_t raw = *(const u32x4_t*)(ap + ks * 32);
        const f32x4 r0 = *(const LAS f32x4*)(rstd + ks * 32 + fq * 8), r1 = *(const LAS f32x4*)(rstd + ks * 32 + fq * 8 + 4);
        u32x4_t w;
        w.x = pk2(bflo(raw.x) * r0[0], bfhi(raw.x) * r0[1]); w.y = pk2(bflo(raw.y) * r0[2], bfhi(raw.y) * r0[3]);
        w.z = pk2(bflo(raw.z) * r1[0], bfhi(raw.z) * r1[1]); w.w = pk2(bflo(raw.w) * r1[2], bfhi(raw.w) * r1[3]);
        Af[ks] = __builtin_bit_cast(bf16x8, w);
    }
    const int ch4 = g * 128 + dd * 16 + fq * 4;
    const f32x4 g4 = *(const f32x4*)(sgu_g + ch4);
#pragma unroll
    for (int pt = 0; pt < 8; ++pt) {
        const int p = pt * 16 + fr;
        const bf16_t* bp = sguw + (size_t)(g * 128 + p) * 128 + fq * 8;
        f32x4 acc = {0.f, 0.f, 0.f, 0.f};
#pragma unroll
        for (int ks = 0; ks < 4; ++ks) acc = mfma16(Af[ks], ld8(bp + ks * 32), acc);
        const int tok = tokc + p;
        const float bsv = sgu_b[g * 128 + p];
        const u32x2_t ur = *(const u32x2_t*)(z + (size_t)tok * LDZ + 2048 + ch4), gr = *(const u32x2_t*)(z + (size_t)tok * LDZ + 3072 + ch4);
        const float uu[4] = {bflo(ur.x), bfhi(ur.x), bflo(ur.y), bfhi(ur.y)}, gd[4] = {bflo(gr.x), bfhi(gr.x), bflo(gr.y), bfhi(gr.y)};
        float o[4];
#pragma unroll
        for (int jj = 0; jj < 4; ++jj) o[jj] = uu[jj] * (acc[jj] * g4[jj] + bsv) * silu(gd[jj]);
        u32x2_t ow; ow.x = pk2(o[0], o[1]); ow.y = pk2(o[2], o[3]);
        *(u32x2_t*)(y + (size_t)tok * LDY + 1024 + ch4) = ow;
    }
}

__global__ void __launch_bounds__(512, 2) fwd_megakernel(Params P) {
    extern __shared__ __attribute__((aligned(16))) unsigned char shm[];
    cg::grid_group grid = cg::this_grid();
    PG8_LAS unsigned char* lds = (PG8_LAS unsigned char*)shm;
    const int G = gridDim.x, NW = G * 8;
#define FRESH_TID() int tid = threadIdx.x; asm volatile("" : "+v"(tid)); const int lane = tid & 63, wid = tid >> 6, gw = blockIdx.x * 8 + wid; (void)lane; (void)gw
    unsigned char* ws = P.ws;
    bf16_t* WIN_E = (bf16_t*)(ws + WS_WIN_E); bf16_t* WIN_O = (bf16_t*)(ws + WS_WIN_O);
    bf16_t* WOUT_E = (bf16_t*)(ws + WS_WOUT_E); bf16_t* WOUT_O = (bf16_t*)(ws + WS_WOUT_O);
    bf16_t* WKV = (bf16_t*)(ws + WS_WKV); bf16_t* LRUW = (bf16_t*)(ws + WS_LRUW); bf16_t* SGUW = (bf16_t*)(ws + WS_SGUW);
    bf16_t* MEMN = (bf16_t*)(ws + WS_MEMN); bf16_t* MK = (bf16_t*)(ws + WS_MK); bf16_t* MVT = (bf16_t*)(ws + WS_MVT);
    bf16_t* H = (bf16_t*)(ws + WS_H); bf16_t* Z = (bf16_t*)(ws + WS_Z); bf16_t* VT = (bf16_t*)(ws + WS_VT); bf16_t* Y = (bf16_t*)(ws + WS_Y);
    float* AGG = (float*)(ws + WS_AGG); float* CARRY = (float*)(ws + WS_CARRY); float* RSTD = (float*)(ws + WS_RSTD); float* PART = (float*)(ws + WS_PART); unsigned* LAB = (unsigned*)(ws + WS_LAB);

    unsigned* BAR = (unsigned*)(ws + WS_BAR);
    volatile LAS unsigned* xst = (volatile LAS unsigned*)(lds + XST_OFF);
    {
        FRESH_TID();
        if (tid < 2) xst[tid] = 0u;
        if (blockIdx.x == 0) for (int i = tid; i < XCD_BAR_WORDS; i += 512) BAR[i] = 0u;
        LAS float* scr = (LAS float*)(lds + wid * 16384);
        constexpr int I0 = 16 * 288, I1 = 16 * 192, I2 = 40 * 32, I3 = 40 * 32, I4 = 16 * 32, I5 = 16 * 32, I6 = 16 * 8, I7 = 16 * 8;
        constexpr int NIT = I0 + I1 + I2 + I3 + I4 + I5 + I6 + I7;
#pragma unroll 1
        for (int it = gw; it < NIT; it += NW) {
            int r = it;
            if (r < I0) { transpose_item(P.in[7], 1024, 9216, WIN_E, scr, r, lane); continue; } r -= I0;
            if (r < I1) { transpose_item(P.in[12], 1024, 6144, WIN_O, scr, r, lane); continue; } r -= I1;
            if (r < I2) { transpose_item(P.in[11], 2560, 1024, WOUT_E, scr, r, lane); continue; } r -= I2;
            if (r < I3) { transpose_item(P.in[23], 2560, 1024, WOUT_O, scr, r, lane); continue; } r -= I3;
            if (r < I4) { transpose_item(P.in[6], 1024, 1024, WKV, scr, r, lane); continue; } r -= I4;
            if (r < I5) { transpose_item(P.in[6] + (size_t)1024 * 1024, 1024, 1024, WKV + (size_t)1024 * 1024, scr, r, lane); continue; } r -= I5;
            if (r < I6) { const int m = r >> 3; transpose_item(P.in[15] + (size_t)m * 16384, 128, 128, LRUW + (size_t)m * 16384, scr, r & 7, lane); continue; } r -= I6;
            { const int m = r >> 3; transpose_item(P.in[17] + (size_t)m * 16384, 128, 128, LRUW + (size_t)(16 + m) * 16384, scr, r & 7, lane); }
        }
        for (int i = blockIdx.x * 512 + tid; i < 8 * 128 * 128; i += G * 512) SGUW[i] = f2bf(P.in[21][i]);
        for (int it = gw; it < 2 * 1536; it += NW) {
            const int l = it / 1536, row = it - l * 1536;
            const float* src = row < 512 ? P.in[2] + (size_t)row * 1024 : P.in[3] + (size_t)(row - 512) * 1024;
            rms_row_bf16(src, P.in[5] + l * 1024, MEMN + ((size_t)l * 1536 + row) * 1024, lane);
        }
        for (int it = gw; it < SEG / 4; it += NW) rms_rows4_bf16(P.in[0] + (size_t)it * 4096, P.in[4], H + (size_t)it * 4096, lane);
    }

    grid.sync();
    const XcdBarrier xb = xcd_barrier_post(BAR, xst);
    for (int seg = 0; seg < 3; ++seg) {
        const float* xin = seg < 2 ? P.in[0] + (size_t)seg * SEG * 1024 : P.in[1];
        float* xout = P.out + (size_t)seg * SEG * 1024;
        const int T = seg < 2 ? 16384 : 4096, nseq = seg < 2 ? 1 : 4;

        {
            pg8::Gemm g; g.A = H; g.Bt = WIN_E; g.M = SEG; g.N = 8192; g.K = 1024; g.A1 = WIN_E + (size_t)6144 * 1024; g.Bt1 = H;
            pg8::DualOrder S; S.S0.init(SEG, 8192, G, blockIdx.x); S.S1.init(1024, SEG, G, blockIdx.x); S.skip_from = 24; S.skip_n = 4; S.G = G; S.c = blockIdx.x;
            pg8::EpiZ E; E.O = Z; E.ldc = LDZ; E.skip_from = 24; E.skip_n = 4; E.colsq = nullptr; E.colsq_ld = 0; E.O1 = VT; E.ldc1 = SEG; E.colsq1 = nullptr;
            pg8::gemm_phase(lds, g, S, E);
        }
        if (seg == 0) {
#pragma unroll 1
            for (int l = 0; l < 2; ++l) {
                {
                    pg8::Gemm g; g.A = MEMN + (size_t)l * 1536 * 1024; g.Bt = WKV + (size_t)l * 1024 * 1024; g.M = 1536; g.N = 512; g.K = 1024; g.A1 = g.A; g.Bt1 = g.Bt;
                    pg8::SkipOrder S; S.init(1536, 512, G, (blockIdx.x + G - (32 * l) % G) % G); S.skip_from = 1 << 20; S.skip_n = 0;
                    pg8::EpiZ E; E.O = MK + (size_t)l * 1536 * 512; E.ldc = 512; E.skip_from = 1 << 20; E.skip_n = 0; E.colsq = nullptr; E.colsq_ld = 0; E.O1 = E.O; E.ldc1 = 512; E.colsq1 = nullptr;
                    pg8::gemm_phase(lds, g, S, E);
                }
                {
                    pg8::Gemm g; g.A = WKV + (size_t)l * 1024 * 1024 + (size_t)512 * 1024; g.Bt = MEMN + (size_t)l * 1536 * 1024; g.M = 512; g.N = 1536; g.K = 1024; g.A1 = g.A; g.Bt1 = g.Bt;
                    pg8::SkipOrder S; S.init(512, 1536, G, (blockIdx.x + G - (32 * l + 16) % G) % G); S.skip_from = 1 << 20; S.skip_n = 0;
                    pg8::EpiZ E; E.O = MVT + (size_t)l * 512 * 1536; E.ldc = 1536; E.skip_from = 1 << 20; E.skip_n = 0; E.colsq = nullptr; E.colsq_ld = 0; E.O1 = E.O; E.ldc1 = 1536; E.colsq1 = nullptr;
                    pg8::gemm_phase(lds, g, S, E);
                }
            }
        }
        xcd_barrier(xb);

        { FRESH_TID();
        for (int u = blockIdx.x; u < 256; u += G) mem_unit(Z, 7168, 7680, MK, MVT, Y, u, seg, lds, tid);
#pragma unroll 1
        for (int u = blockIdx.x; u < 256; u += G) na_block(Z, VT, Y, P.in[10], u, T, lds, tid);
        for (int it = gw; it < 8192; it += NW) conv_even_item(Z, P.in[8], P.in[9], Y, 2 * it, T, lane);
        }
        xcd_barrier(xb);

        {
            pg8::Gemm g; g.A = Y; g.Bt = WOUT_E; g.M = SEG; g.N = 1024; g.K = 2560; g.A1 = g.A; g.Bt1 = g.Bt;
            pg8::StaticOrder S; S.init(SEG, 1024, G, blockIdx.x, 16);
            pg8::EpiRes E; E.xin = xin; E.out = xout;
            pg8::gemm_phase(lds, g, S, E);
        }
        xcd_barrier(xb);

        { FRESH_TID();
        for (int it = gw; it < SEG / 4; it += NW) rms_rows4_bf16(xout + (size_t)it * 4096, P.in[4] + 1024, H + (size_t)it * 4096, lane); }
        xcd_barrier(xb);

        {
            pg8::Gemm g; g.A = H; g.Bt = WIN_O; g.M = SEG; g.N = 5120; g.K = 1024; g.A1 = WIN_O + (size_t)3072 * 1024; g.Bt1 = H;
            pg8::DualOrder S; S.S0.init(SEG, 5120, G, blockIdx.x); S.S1.init(1024, SEG, G, blockIdx.x); S.skip_from = 12; S.skip_n = 4; S.G = G; S.c = blockIdx.x;
            pg8::EpiZ E; E.O = Z; E.ldc = LDZ; E.skip_from = 12; E.skip_n = 4; E.colsq = nullptr; E.colsq_ld = SEG; E.O1 = VT; E.ldc1 = SEG; E.colsq1 = PART;
            pg8::gemm_phase(lds, g, S, E);
        }
        xcd_barrier(xb);

        { FRESH_TID();
        for (int u = blockIdx.x; u < 256; u += G) mem_unit(Z, 4096, 4608, MK + (size_t)1536 * 512, MVT + (size_t)512 * 1536, Y, u, seg, lds, tid);
#pragma unroll 1
        for (int u0 = blockIdx.x; u0 < 1024; u0 += 4 * G) {
            __syncthreads();
#pragma unroll 1
            for (int k = 0; k < 4; ++k) { const int u = u0 + k * G; if (u < 1024) conv_tile_to_lds(Z, P.in[13], P.in[14], lds + k * 32768, u >> 3, u & 7, T, tid); }
            __syncthreads();
#pragma unroll 1
            for (int k = 0; k < 4; ++k) { const int u = u0 + k * G; if (u < 1024) lru_item<false>(lds + k * 32768, Z, LRUW, P.in[16], P.in[18], P.in[19], AGG, CARRY, Y, LAB, (u >> 3) * 64 + (u & 7) * 8 + wid, lane); }
        }
#pragma unroll 1
        for (int u0 = blockIdx.x; u0 < 1024; u0 += 2 * G) {
            __syncthreads();
            LAS float* rsL = (LAS float*)lds;
            if (tid < 256) { const int u = u0 + (tid >> 7) * G;
              if (u < 1024) { const float* pp = PART + (u >> 3) * 128 + (tid & 127); float s = 0.f;
#pragma unroll
                for (int i = 0; i < 8; ++i) s += pp[(size_t)i * SEG];
                rsL[tid] = __builtin_amdgcn_rsqf(s * (1.0f / 1024.0f) + EPS); } }
            u32x4_t wsv[2][4];
#pragma unroll
            for (int s2 = 0; s2 < 2; ++s2) { const int u = u0 + s2 * G;
              if (u < 1024) { const int g = u & 7;
#pragma unroll
                for (int i = 0; i < 4; ++i) { const int idx = tid + 512 * i, p = idx >> 4, c = idx & 15; wsv[s2][i] = *(const u32x4_t*)(SGUW + (size_t)(g * 128 + p) * 128 + c * 8); } } }
#pragma unroll
            for (int s2 = 0; s2 < 2; ++s2) { const int u = u0 + s2 * G;
              if (u < 1024) {
#pragma unroll
                for (int i = 0; i < 4; ++i) { const int idx = tid + 512 * i, p = idx >> 4, c = idx & 15; *(LAS u32x4_t*)(lds + 4096 + s2 * 32768 + p * 256 + ((c ^ (p & 15)) << 4)) = wsv[s2][i]; } } }
            __syncthreads();
            { const int s2 = wid >> 2, u = u0 + s2 * G;
              if (u < 1024) sgu_item2(VT, rsL + s2 * 128, lds + 4096 + s2 * 32768, Z, P.in[20], P.in[22], Y, u >> 3, u & 7, wid & 3, lane); }
        } }
        xcd_barrier(xb);

        if (G == 256) {
            FRESH_TID();
            float hc[4];
            LruF F[2];
            lru_final_load(F[0], LAB, Z, gw, lane);
            wave_carries(AGG, gw & 63, gw >> 6, nseq, lane, hc);
#pragma unroll
            for (int k = 0; k < 4; ++k) {
                if (k < 3) lru_final_load(F[(k + 1) & 1], LAB, Z, gw + 2048 * (k + 1), lane);
                lru_final_compute<true>(F[k & 1], CARRY, hc[k], Y, gw + 2048 * k, lane);
            }
        } else {
            { FRESH_TID(); carry_phase(AGG, CARRY, nseq, blockIdx.x * 512 + tid, G * 512); }
            xcd_barrier(xb);
            { FRESH_TID();
#pragma unroll 1
            for (int it = gw; it < 8192; it += NW) { LruF F1; lru_final_load(F1, LAB, Z, it, lane); lru_final_compute<false>(F1, CARRY, 0.f, Y, it, lane); } }
        }
        if (seg < 2) { FRESH_TID();
            const float* xnx = seg == 0 ? P.in[0] + (size_t)SEG * 1024 : P.in[1];
            for (int it = gw; it < SEG / 4; it += NW) rms_rows4_bf16(xnx + (size_t)it * 4096, P.in[4], H + (size_t)it * 4096, lane); }
        xcd_barrier(xb);

        {
            pg8::Gemm g; g.A = Y; g.Bt = WOUT_O; g.M = SEG; g.N = 1024; g.K = 2560; g.A1 = g.A; g.Bt1 = g.Bt;
            pg8::StaticOrder S; S.init(SEG, 1024, G, blockIdx.x, 16);
            pg8::EpiRes E; E.xin = xout; E.out = xout;
            pg8::gemm_phase(lds, g, S, E);
        }
        xcd_barrier(xb);

        { FRESH_TID();
        for (int it = gw; it < SEG / 4; it += NW) rms_rows4_f32(xout + (size_t)it * 4096, P.in[24], lane); }
    }
}

extern "C" void kernel_launch(void* const* d_in, const int* in_sizes, int n_in, void* d_out, int out_size, void* d_ws, size_t ws_size, hipStream_t stream) {
    static int grid_blocks = 0;
    if (grid_blocks == 0) {
        if (n_in != 25 || ws_size < WS_END) { fprintf(stderr, "kernel_launch: need 25 inputs and %zu bytes of workspace; got %d, %zu\n", (size_t)WS_END, n_in, ws_size); grid_blocks = -1; return; }
        int dev = 0, cus = 0, per_cu = 0;
        hipGetDevice(&dev);
        hipDeviceGetAttribute(&cus, hipDeviceAttributeMultiprocessorCount, dev);
        hipFuncSetAttribute((const void*)fwd_megakernel, hipFuncAttributeMaxDynamicSharedMemorySize, LDS_BYTES);
        hipOccupancyMaxActiveBlocksPerMultiprocessor(&per_cu, (const void*)fwd_megakernel, 512, LDS_BYTES);
        if (per_cu < 1) { fprintf(stderr, "kernel_launch: occupancy query says %d blocks per CU\n", per_cu); grid_blocks = -1; return; }
        grid_blocks = cus;
    }
    if (grid_blocks < 0) return;
    Params p{};
    for (int i = 0; i < 25; ++i) p.in[i] = (const float*)d_in[i];
    p.out = (float*)d_out; p.ws = (unsigned char*)d_ws;
    void* args[] = {&p};
    hipError_t e = hipLaunchCooperativeKernel((const void*)fwd_megakernel, dim3(grid_blocks), dim3(512), args, LDS_BYTES, stream);
    if (e != hipSuccess) fprintf(stderr, "cooperative launch failed: %s (grid %d)\n", hipGetErrorString(e), grid_blocks);
}
```
